# Optimizing an MI355X kernel written in HIP

```python
import math
import jax, jax.numpy as jnp
from jax import lax
import numpy as np

D_MODEL = 1024
BATCH = 8
SEQ = 2048
DEPTH = 4

N_META = 16
N_A_LAYERS = DEPTH // 2
N_B_LAYERS = DEPTH - N_A_LAYERS
SSM_GROUP = 16
SSM_GROUPS = D_MODEL // SSM_GROUP
SSM_STATE = 64
DT_MIN = 1e-3
DT_MAX = 1e-1
HEAD_DIM = 64
N_Q_HEADS = D_MODEL // HEAD_DIM
N_KV_HEADS = 4
GQA_GROUP = N_Q_HEADS // N_KV_HEADS
KV_DIM = N_KV_HEADS * HEAD_DIM
WINDOW = 128
BLOCK = 128
PAD_FRONT = BLOCK - N_META
NEG = -1e30
N_EXPERT_GROUPS = 4
EXPERTS_PER_GROUP = 8
N_EXPERTS = N_EXPERT_GROUPS * EXPERTS_PER_GROUP
TOP_K = 2
D_EXPERT = D_MODEL // 2
MOE_BLOCK = 128
RMS_EPS = 1e-6

kernel_name = 'yoco_s5_swa_sink_hier_moe'

F32 = jnp.float32


def rmsnorm(x, g):
    xf = x.astype(F32)
    y = xf * lax.rsqrt(jnp.mean(xf * xf, axis=-1, keepdims=True) + RMS_EPS)
    return (y * g.astype(F32)).astype(x.dtype)


def s5_mixer(u, a_re, a_im, log_dt, b_re, b_im, c_re, c_im, d_skip, w_glu):
    bsz, L, _ = u.shape
    uf = u.astype(F32)
    ug = uf.reshape(bsz, L, SSM_GROUPS, SSM_GROUP).astype(jnp.complex64)
    lam = lax.complex(a_re.astype(F32), a_im.astype(F32))
    dt = jnp.exp(log_dt.astype(F32))[:, None]
    a_bar = jnp.exp(lam * dt)
    b = lax.complex(b_re.astype(F32), b_im.astype(F32))
    b_bar = ((a_bar - 1.0) / lam)[:, :, None] * b
    bu = jnp.einsum('blgc,gpc->blgp', ug, b_bar)
    a_seq = jnp.broadcast_to(a_bar, bu.shape)

    def combine(e1, e2):
        a1, s1 = e1
        a2, s2 = e2
        return a2 * a1, a2 * s1 + s2

    _, states = lax.associative_scan(combine, (a_seq, bu), axis=1)
    c = lax.complex(c_re.astype(F32), c_im.astype(F32))
    y = jnp.einsum('blgp,gcp->blgc', states, c).real.reshape(bsz, L, D_MODEL)
    z = jax.nn.gelu(y + d_skip.astype(F32) * uf).astype(u.dtype)
    val, gate = jnp.split(z @ w_glu, 2, axis=-1)
    return val * jax.nn.sigmoid(gate)


def to_blocks(t):
    t = jnp.pad(t, ((0, 0), (PAD_FRONT, 0)) + ((0, 0),) * (t.ndim - 2))
    return t.reshape((t.shape[0], t.shape[1] // BLOCK, BLOCK) + t.shape[2:])


def band_keys(tb):
    prev = jnp.pad(tb, ((0, 0), (1, 0), (0, 0), (0, 0), (0, 0)))[:, :-1]
    return jnp.concatenate([prev, tb], axis=2)


def shared_kv(h, w_kv, b_kv):
    bsz, L, _ = h.shape
    k, v = jnp.split(h @ w_kv + b_kv, 2, axis=-1)
    k = k.reshape(bsz, L, N_KV_HEADS, HEAD_DIM)
    v = v.reshape(bsz, L, N_KV_HEADS, HEAD_DIM)
    k_band = band_keys(to_blocks(k))
    v_band = band_keys(to_blocks(v))
    return k_band, v_band, k[:, :N_META], v[:, :N_META]


def swa_sink_attention(h, w_q, b_q, sinks, w_o, b_o, k_band, v_band, k_meta, v_meta):
    bsz, L, _ = h.shape
    q = (h @ w_q + b_q).reshape(bsz, L, N_KV_HEADS, GQA_GROUP, HEAD_DIM)
    qb = to_blocks(q)
    nb = qb.shape[1]
    scale = HEAD_DIM ** -0.5
    s_band = jnp.einsum('bnqkgd,bnskd->bnkgqs', qb, k_band).astype(F32) * scale
    s_meta = jnp.einsum('bnqkgd,bmkd->bnkgqm', qb, k_meta).astype(F32) * scale
    qpos = jnp.arange(nb)[:, None] * BLOCK + jnp.arange(BLOCK)[None, :]
    kpos = jnp.arange(nb)[:, None] * BLOCK - BLOCK + jnp.arange(2 * BLOCK)[None, :]
    diff = qpos[:, :, None] - kpos[:, None, :]
    band_ok = (kpos[:, None, :] >= BLOCK) & (diff >= 0) & (diff < WINDOW)
    mpos = PAD_FRONT + jnp.arange(N_META)
    meta_ok = mpos[None, None, :] <= qpos[:, :, None]
    s_band = jnp.where(band_ok[None, :, None, None], s_band, NEG)
    s_meta = jnp.where(meta_ok[None, :, None, None], s_meta, NEG)
    sink = sinks.astype(F32).reshape(1, 1, N_KV_HEADS, GQA_GROUP, 1, 1)
    sink = jnp.broadcast_to(sink, s_meta.shape[:-1] + (1,))
    probs = jax.nn.softmax(jnp.concatenate([sink, s_meta, s_band], axis=-1), axis=-1)
    p_meta = probs[..., 1:1 + N_META].astype(v_band.dtype)
    p_band = probs[..., 1 + N_META:].astype(v_band.dtype)
    o = (jnp.einsum('bnkgqm,bmkd->bnqkgd', p_meta, v_meta)
         + jnp.einsum('bnkgqs,bnskd->bnqkgd', p_band, v_band))
    o = o.reshape(bsz, nb * BLOCK, D_MODEL)[:, PAD_FRONT:]
    return o @ w_o + b_o


def hier_moe(h, w_grp, b_grp, w_exp, b_exp, w_gate, w_up, w_down):
    bsz, L, D = h.shape
    t = h.reshape(-1, D)
    T = t.shape[0]
    grp_prob = jax.nn.softmax((t @ w_grp + b_grp).astype(F32), axis=-1)
    p_g, g_idx = lax.top_k(grp_prob, 1)
    exp_logits = (t @ w_exp + b_exp).astype(F32).reshape(T, N_EXPERT_GROUPS, EXPERTS_PER_GROUP)
    sel_idx = jnp.broadcast_to(g_idx[:, :, None], (T, 1, EXPERTS_PER_GROUP))
    sel_logits = jnp.take_along_axis(exp_logits, sel_idx, axis=1)[:, 0]
    q_top, e_local = lax.top_k(jax.nn.softmax(sel_logits, axis=-1), TOP_K)
    q_top = q_top / jnp.sum(q_top, axis=-1, keepdims=True)
    gates = p_g * q_top
    experts = g_idx * EXPERTS_PER_GROUP + e_local
    n_assign = T * TOP_K
    flat_e = experts.reshape(-1)
    flat_tok = jnp.repeat(jnp.arange(T), TOP_K)
    flat_gate = gates.reshape(-1)
    order = jnp.argsort(flat_e)
    se = flat_e[order]
    stok = flat_tok[order]
    sgate = flat_gate[order]
    counts = jnp.bincount(flat_e, length=N_EXPERTS)
    padded = (counts + MOE_BLOCK - 1) // MOE_BLOCK * MOE_BLOCK
    pad_end = jnp.cumsum(padded)
    pad_start = pad_end - padded
    start = jnp.cumsum(counts) - counts
    dest = pad_start[se] + jnp.arange(n_assign) - start[se]
    n_rows = (n_assign // MOE_BLOCK + 1 + N_EXPERTS) * MOE_BLOCK
    n_blk = n_rows // MOE_BLOCK
    row_tok = jnp.full((n_rows,), T, dtype=jnp.int32).at[dest].set(stok)
    t_pad = jnp.concatenate([t, jnp.zeros((1, D), t.dtype)], axis=0)
    xb = t_pad[row_tok].reshape(n_blk, MOE_BLOCK, D)
    blk_e = jnp.minimum(jnp.searchsorted(pad_end, jnp.arange(n_blk) * MOE_BLOCK, side='right'),
                        N_EXPERTS - 1)

    def run_block(args):
        xblk, e = args
        hid = jax.nn.silu(xblk @ w_gate[e]) * (xblk @ w_up[e])
        return hid @ w_down[e]

    yb = lax.map(run_block, (xb, blk_e)).reshape(n_rows, D)
    contrib = yb[dest] * sgate[:, None].astype(yb.dtype)
    out = jnp.zeros_like(t).at[stok].add(contrib)
    return out.reshape(bsz, L, D)


def setup_inputs(seed: int = 0) -> dict:
    key = jax.random.key(seed)
    ks = iter(jax.random.split(key, 40))
    nrm = lambda shape, s: jax.random.normal(next(ks), shape, F32) * s
    G, P, C = SSM_GROUPS, SSM_STATE, SSM_GROUP
    a_im0 = jnp.pi * jnp.arange(P, dtype=F32)
    return {
        'x': nrm((BATCH, SEQ, D_MODEL), 1.0),
        'meta_tokens': nrm((N_META, D_MODEL), 1.0),
        'norm_mix': 1.0 + nrm((DEPTH, D_MODEL), 0.02),
        'norm_ffn': 1.0 + nrm((DEPTH, D_MODEL), 0.02),
        'norm_kv': 1.0 + nrm((D_MODEL,), 0.02),
        'norm_final': 1.0 + nrm((D_MODEL,), 0.02),
        'ssm_a_re': -0.5 * jnp.exp(nrm((N_A_LAYERS, G, P), 0.05)),
        'ssm_a_im': a_im0 + nrm((N_A_LAYERS, G, P), 0.01),
        'ssm_log_dt': jax.random.uniform(next(ks), (N_A_LAYERS, G), F32,
                                         minval=math.log(DT_MIN), maxval=math.log(DT_MAX)),
        'ssm_b_re': nrm((N_A_LAYERS, G, P, C), (2 * C) ** -0.5),
        'ssm_b_im': nrm((N_A_LAYERS, G, P, C), (2 * C) ** -0.5),
        'ssm_c_re': nrm((N_A_LAYERS, G, C, P), P ** -0.5),
        'ssm_c_im': nrm((N_A_LAYERS, G, C, P), P ** -0.5),
        'ssm_d': nrm((N_A_LAYERS, D_MODEL), 1.0),
        'ssm_w_glu': nrm((N_A_LAYERS, D_MODEL, 2 * D_MODEL), D_MODEL ** -0.5),
        'w_kv': nrm((D_MODEL, 2 * KV_DIM), D_MODEL ** -0.5),
        'b_kv': nrm((2 * KV_DIM,), 0.01),
        'w_q': nrm((N_B_LAYERS, D_MODEL, D_MODEL), D_MODEL ** -0.5),
        'b_q': nrm((N_B_LAYERS, D_MODEL), 0.01),
        'attn_sinks': nrm((N_B_LAYERS, N_Q_HEADS), 1.0),
        'w_o': nrm((N_B_LAYERS, D_MODEL, D_MODEL), D_MODEL ** -0.5),
        'b_o': nrm((N_B_LAYERS, D_MODEL), 0.01),
        'moe_w_grp': nrm((DEPTH, D_MODEL, N_EXPERT_GROUPS), D_MODEL ** -0.5),
        'moe_b_grp': nrm((DEPTH, N_EXPERT_GROUPS), 0.01),
        'moe_w_exp': nrm((DEPTH, D_MODEL, N_EXPERTS), D_MODEL ** -0.5),
        'moe_b_exp': nrm((DEPTH, N_EXPERTS), 0.01),
        'moe_w_gate': nrm((DEPTH, N_EXPERTS, D_MODEL, D_EXPERT), D_MODEL ** -0.5),
        'moe_w_up': nrm((DEPTH, N_EXPERTS, D_MODEL, D_EXPERT), D_MODEL ** -0.5),
        'moe_w_down': nrm((DEPTH, N_EXPERTS, D_EXPERT, D_MODEL), D_EXPERT ** -0.5),
    }


def reference(x, meta_tokens, norm_mix, norm_ffn, norm_kv, norm_final,
              ssm_a_re, ssm_a_im, ssm_log_dt, ssm_b_re, ssm_b_im, ssm_c_re, ssm_c_im,
              ssm_d, ssm_w_glu, w_kv, b_kv, w_q, b_q, attn_sinks, w_o, b_o,
              moe_w_grp, moe_b_grp, moe_w_exp, moe_b_exp, moe_w_gate, moe_w_up, moe_w_down):
    bsz = x.shape[0]
    meta = jnp.broadcast_to(meta_tokens[None].astype(x.dtype), (bsz, N_META, D_MODEL))
    h = jnp.concatenate([meta, x], axis=1)
    shared = None
    for layer in range(DEPTH):
        if layer < N_A_LAYERS:
            i = layer
            h = h + s5_mixer(rmsnorm(h, norm_mix[layer]), ssm_a_re[i], ssm_a_im[i], ssm_log_dt[i],
                             ssm_b_re[i], ssm_b_im[i], ssm_c_re[i], ssm_c_im[i],
                             ssm_d[i], ssm_w_glu[i])
        else:
            if shared is None:
                shared = shared_kv(rmsnorm(h, norm_kv), w_kv, b_kv)
            j = layer - N_A_LAYERS
            k_band, v_band, k_meta, v_meta = shared
            h = h + swa_sink_attention(rmsnorm(h, norm_mix[layer]), w_q[j], b_q[j], attn_sinks[j],
                                       w_o[j], b_o[j], k_band, v_band, k_meta, v_meta)
        h = h + hier_moe(rmsnorm(h, norm_ffn[layer]), moe_w_grp[layer], moe_b_grp[layer],
                         moe_w_exp[layer], moe_b_exp[layer], moe_w_gate[layer],
                         moe_w_up[layer], moe_w_down[layer])
    h = rmsnorm(h, norm_final)
    return h[:, N_META:]
```

```cpp
#include <hip/hip_runtime.h>
#include <cstdio>
#include <cstdint>

#ifndef MK_N_LAUNCHES
#define MK_N_LAUNCHES 0
#endif

#define LAS __attribute__((address_space(3)))
typedef unsigned short bf16_t;
typedef short bf16x8 __attribute__((ext_vector_type(8)));
typedef float f32x4 __attribute__((ext_vector_type(4)));
typedef float f32x2 __attribute__((ext_vector_type(2)));
typedef unsigned u32x4 __attribute__((ext_vector_type(4)));
typedef unsigned u32x2 __attribute__((ext_vector_type(2)));

constexpr int D = 1024, NB = 8, SEQ = 2048, NMETA = 16, LT = SEQ + NMETA  , T = NB * LT  ;
constexpr int NEXP = 32, DEXP = 512, NGRP = 4, EPG = 8;
constexpr int NTHREADS = 512, GRID = 256;
constexpr int LDS_BYTES = 155648;
constexpr float RMS_EPS = 1e-6f;

constexpr size_t al256(size_t x) { return (x + 255) & ~(size_t)255; }
constexpr size_t WS_CTL = 0;
constexpr size_t CTL_BYTES = 32768;
constexpr int CW_BAR = 0;
constexpr int CW_CNT = 4096;
constexpr size_t WS_H = WS_CTL + CTL_BYTES;
constexpr size_t WS_U = WS_H + al256((size_t)T * D * 4);
constexpr size_t WS_Z = WS_U + al256((size_t)T * D * 2);
constexpr size_t WS_XN = WS_Z + al256((size_t)T * D * 2);
constexpr size_t WS_KVN = WS_XN + al256((size_t)T * D * 2);
constexpr size_t WS_Q = WS_KVN + al256((size_t)T * D * 2);
constexpr size_t WS_K = WS_Q + al256((size_t)T * D * 2);
constexpr size_t WS_VT = WS_K + al256((size_t)T * 256 * 2);
constexpr size_t WS_SSQ = WS_VT + al256((size_t)T * 256 * 2);
constexpr size_t WS_LTOK = WS_SSQ + al256((size_t)T * 32 * 4);
constexpr size_t WS_LGATE = WS_LTOK + al256((size_t)NEXP * T * 4);
constexpr int HB_ROWS = 2 * T + NEXP * 256;
constexpr size_t WS_HB = WS_LGATE + al256((size_t)NEXP * T * 4);
constexpr size_t WS_YB = WS_HB + al256((size_t)HB_ROWS * DEXP * 2);
constexpr size_t TBL_K = 0, TBL_M = 16 * 1024, TBL_N = TBL_M + 64 * 1024, TBL_A16 = TBL_N + 64 * 1024, TBL_STRIDE = TBL_A16 + 512;
constexpr size_t WS_TBL = WS_YB + al256((size_t)T * 2 * D * 2);
constexpr size_t WS_END = WS_TBL + al256((size_t)2 * 64 * TBL_STRIDE);

struct Args {
    const float* in[29];
    float* out;
    unsigned char* ws;
    int ph_lo, ph_hi;
};

__device__ __forceinline__ unsigned cvt_pk_bf16(float lo, float hi) { unsigned r; asm volatile("v_cvt_pk_bf16_f32 %0, %1, %2" : "=v"(r) : "v"(lo), "v"(hi)); return r; }
__device__ __forceinline__ float bf16_lo(unsigned w) { return __uint_as_float(w << 16); }
__device__ __forceinline__ float bf16_hi(unsigned w) { return __uint_as_float(w & 0xffff0000u); }
__device__ __forceinline__ float fast_rcp(float x) { return __builtin_amdgcn_rcpf(x); }
__device__ __forceinline__ float fast_exp(float x) { return __builtin_amdgcn_exp2f(x * 1.4426950408889634f); }
__device__ __forceinline__ float sigmoidf_(float x) { return fast_rcp(1.0f + fast_exp(-x)); }
__device__ __forceinline__ float gelu_tanh(float x) { const float v = 0.7978845608028654f * (x + 0.044715f * x * x * x); return x * sigmoidf_(2.0f * v); }
__device__ __forceinline__ bf16x8 as_bf16x8(u32x4 v) { return __builtin_bit_cast(bf16x8, v); }
__device__ __forceinline__ f32x4 mfma16(bf16x8 a, bf16x8 b, f32x4 c) { return __builtin_amdgcn_mfma_f32_16x16x32_bf16(a, b, c, 0, 0, 0); }
__device__ __forceinline__ float wave_sum(float v) {
#pragma unroll
    for (int o = 32; o >= 1; o >>= 1) v += __shfl_xor(v, o);
    return v;
}

__device__ __forceinline__ int opaque_tid() { int t = threadIdx.x; asm volatile("" : "+v"(t)); return t; }

#define XB_TMO      128
#define XB_XCNT(j)  (256  + 64 * (j))
#define XB_XSUB(j)  (1280 + 64 * (j))
#define XB_XGEN(j)  (2304 + 64 * (j))
#define XB_TOP      3328
#define XB_TOPGEN   3392
#define XCD_BAR_WORDS 3456
#define XB_SPIN_CAP (1u << 22)
__device__ __forceinline__ unsigned xb_ld(unsigned* p)              { return __hip_atomic_load(p, __ATOMIC_RELAXED, __HIP_MEMORY_SCOPE_AGENT); }
__device__ __forceinline__ unsigned xb_add(unsigned* p, unsigned v) { return __hip_atomic_fetch_add(p, v, __ATOMIC_RELAXED, __HIP_MEMORY_SCOPE_AGENT); }
__device__ __forceinline__ unsigned xb_xcc_id() { return (unsigned)__builtin_amdgcn_s_getreg((3 << 11) | 20) & 0xFu; }
#define XB_SPIN(cond, bar) do { unsigned _sp = 0; while (cond) { __builtin_amdgcn_s_sleep(1); \
    if ((++_sp & 255u) == 0u) { if (xb_ld(&(bar)[XB_TMO])) break; if (_sp > XB_SPIN_CAP) { atomicAdd(&(bar)[XB_TMO], 1u); break; } } } } while (0)
struct XcdBarrier { unsigned* bar; unsigned x; volatile LAS unsigned* st; };
__device__ __forceinline__ XcdBarrier xcd_barrier_post(unsigned* bar, volatile LAS unsigned* st) {
    XcdBarrier b; b.bar = bar; b.x = xb_xcc_id(); b.st = st;
    if (threadIdx.x == 0) (void)xb_add(&bar[XB_XCNT(b.x)], 1u);
    return b;
}
__device__ __forceinline__ void xcd_barrier_complete(unsigned* bar, unsigned x, unsigned& nloc, unsigned& nx) {
    const unsigned G = gridDim.x;
    unsigned sum, cnt, mine, sp = 0u;
    for (;;) {
        sum = 0u; cnt = 0u; mine = 0u;
#pragma unroll
        for (unsigned j = 0; j < 16; ++j) { const unsigned c = xb_ld(&bar[XB_XCNT(j)]); sum += c; cnt += (c > 0u) ? 1u : 0u; mine = (j == x) ? c : mine; }
        if (sum == G) break;
        __builtin_amdgcn_s_sleep(1);
        if ((++sp & 255u) == 0u) { if (xb_ld(&bar[XB_TMO])) break; if (sp > XB_SPIN_CAP) { atomicAdd(&bar[XB_TMO], 1u); break; } }
    }
    nloc = mine > 0u ? mine : 1u; nx = cnt > 0u ? cnt : 1u;
}
__device__ __forceinline__ void xcd_barrier(const XcdBarrier& b) {
    asm volatile("s_waitcnt vmcnt(0)" ::: "memory");
    __syncthreads();
    if (threadIdx.x == 0) {
        unsigned* bar = b.bar;
        __builtin_amdgcn_s_waitcnt(0);
        unsigned nloc = b.st[0], nx = b.st[1];
        if (nloc == 0u) { xcd_barrier_complete(bar, b.x, nloc, nx); b.st[0] = nloc; b.st[1] = nx; }
        const unsigned old = xb_add(&bar[XB_XSUB(b.x)], 1u);
        const unsigned gen = old / nloc;
        if (old + 1u == (gen + 1u) * nloc) {
            __builtin_amdgcn_fence(__ATOMIC_RELEASE, "agent");
            asm volatile("s_waitcnt vmcnt(0)" ::: "memory");
            const unsigned og = xb_add(&bar[XB_TOP], 1u);
            const unsigned tg = og / nx;
            if (og + 1u == (tg + 1u) * nx) xb_add(&bar[XB_TOPGEN], 1u);
            else XB_SPIN(xb_ld(&bar[XB_TOPGEN]) == tg, bar);
            __builtin_amdgcn_fence(__ATOMIC_ACQUIRE, "agent");
            xb_add(&bar[XB_XGEN(b.x)], 1u);
            asm volatile("s_waitcnt vmcnt(0)" ::: "memory");
        } else {
            XB_SPIN(xb_ld(&bar[XB_XGEN(b.x)]) == gen, bar);
            __builtin_amdgcn_fence(__ATOMIC_ACQUIRE, "agent");
            asm volatile("s_waitcnt vmcnt(0)" ::: "memory");
        }
    }
    __syncthreads();
}

__device__ __forceinline__ int tile_off(int row, int chunk) { return row * 128 + ((chunk ^ (row & 7)) << 4); }
template <bool PAIRED> __device__ __forceinline__ int brow_of(int wn, int nt) { return PAIRED ? ((nt >> 1) * 64 + wn * 32 + (nt & 1) * 16) : (wn * 64 + nt * 16); }

template <int NKT, bool PAIRED>
__device__ __forceinline__ void gemm_mainloop(LAS unsigned char* lds, const bf16_t* a0, const bf16_t* a1, const bf16_t* a2, const bf16_t* a3,
                                              const float* wp, int ldw, f32x4 (&acc)[4][4]) {
    const int tid = opaque_tid(), lane = tid & 63, wid = tid >> 6, wm = wid >> 1, wn = wid & 1, tc = lane & 15, q4 = lane >> 4;
    const int ar = tid >> 3, akc = tid & 7, bn = tid & 127, bkg = tid >> 7;
    LAS unsigned char* As = lds; LAS unsigned char* Bs = lds + 65536;
    u32x4 ra[4]; float rb[16];
#pragma unroll
    for (int mt = 0; mt < 4; ++mt)
#pragma unroll
        for (int nt = 0; nt < 4; ++nt) acc[mt][nt] = (f32x4){0.f, 0.f, 0.f, 0.f};
    const int aoff0 = tile_off(ar, akc), aoff1 = tile_off(ar + 64, akc), aoff2 = tile_off(ar + 128, akc), aoff3 = tile_off(ar + 192, akc);
    const int boff0 = tile_off(bn, 2 * bkg), boff1 = tile_off(bn, 2 * bkg + 1);
    int xoff[4], woff[4];
#pragma unroll
    for (int mt = 0; mt < 4; ++mt) xoff[mt] = (wm * 64 + mt * 16 + tc) * 128;
#pragma unroll
    for (int nt = 0; nt < 4; ++nt) woff[nt] = (brow_of<PAIRED>(wn, nt) + tc) * 128;
    const int sw = tc & 7;
    ra[0] = *(const u32x4*)a0; ra[1] = *(const u32x4*)a1; ra[2] = *(const u32x4*)a2; ra[3] = *(const u32x4*)a3;
#pragma unroll
    for (int j = 0; j < 16; ++j) rb[j] = wp[(size_t)j * ldw];
    {
        *(LAS u32x4*)(As + aoff0) = ra[0]; *(LAS u32x4*)(As + aoff1) = ra[1]; *(LAS u32x4*)(As + aoff2) = ra[2]; *(LAS u32x4*)(As + aoff3) = ra[3];
        u32x4 w0, w1;
        w0.x = cvt_pk_bf16(rb[0], rb[1]); w0.y = cvt_pk_bf16(rb[2], rb[3]); w0.z = cvt_pk_bf16(rb[4], rb[5]); w0.w = cvt_pk_bf16(rb[6], rb[7]);
        w1.x = cvt_pk_bf16(rb[8], rb[9]); w1.y = cvt_pk_bf16(rb[10], rb[11]); w1.z = cvt_pk_bf16(rb[12], rb[13]); w1.w = cvt_pk_bf16(rb[14], rb[15]);
        *(LAS u32x4*)(Bs + boff0) = w0; *(LAS u32x4*)(Bs + boff1) = w1;
    }
    __syncthreads();
#pragma unroll 1
    for (int kt = 0; kt < NKT; ++kt) {
        const int buf = kt & 1;
        if (kt + 1 < NKT) {
            const int ko = (kt + 1) * 64;
            ra[0] = *(const u32x4*)(a0 + ko); ra[1] = *(const u32x4*)(a1 + ko); ra[2] = *(const u32x4*)(a2 + ko); ra[3] = *(const u32x4*)(a3 + ko);
            const float* wq = wp + (size_t)ko * ldw;
#pragma unroll
            for (int j = 0; j < 16; ++j) rb[j] = wq[(size_t)j * ldw];
        }
        LAS unsigned char* Ab = As + buf * 32768; LAS unsigned char* Bb = Bs + buf * 16384;
#pragma unroll
        for (int kk = 0; kk < 2; ++kk) {
            const int ch = ((kk * 4 + q4) ^ sw) << 4;
            bf16x8 xf[4], wf[4];
#pragma unroll
            for (int mt = 0; mt < 4; ++mt) xf[mt] = *(LAS bf16x8*)(Ab + xoff[mt] + ch);
#pragma unroll
            for (int nt = 0; nt < 4; ++nt) wf[nt] = *(LAS bf16x8*)(Bb + woff[nt] + ch);
#pragma unroll
            for (int mt = 0; mt < 4; ++mt)
#pragma unroll
                for (int nt = 0; nt < 4; ++nt) acc[mt][nt] = mfma16(wf[nt], xf[mt], acc[mt][nt]);
        }
        if (kt + 1 < NKT) {
            LAS unsigned char* An = As + (buf ^ 1) * 32768; LAS unsigned char* Bn = Bs + (buf ^ 1) * 16384;
            *(LAS u32x4*)(An + aoff0) = ra[0]; *(LAS u32x4*)(An + aoff1) = ra[1]; *(LAS u32x4*)(An + aoff2) = ra[2]; *(LAS u32x4*)(An + aoff3) = ra[3];
            u32x4 w0, w1;
            w0.x = cvt_pk_bf16(rb[0], rb[1]); w0.y = cvt_pk_bf16(rb[2], rb[3]); w0.z = cvt_pk_bf16(rb[4], rb[5]); w0.w = cvt_pk_bf16(rb[6], rb[7]);
            w1.x = cvt_pk_bf16(rb[8], rb[9]); w1.y = cvt_pk_bf16(rb[10], rb[11]); w1.z = cvt_pk_bf16(rb[12], rb[13]); w1.w = cvt_pk_bf16(rb[14], rb[15]);
            *(LAS u32x4*)(Bn + boff0) = w0; *(LAS u32x4*)(Bn + boff1) = w1;
        }
        __syncthreads();
    }
}

__device__ __forceinline__ void dense_rows(const bf16_t* A, int lda, int m0, int M, const bf16_t* (&ap)[4]) {
    const int ar = opaque_tid() >> 3, akc = opaque_tid() & 7;
#pragma unroll
    for (int i = 0; i < 4; ++i) { int r = m0 + ar + 64 * i; r = r < M ? r : M - 1; ap[i] = A + (size_t)r * lda + akc * 8; }
}
__device__ __forceinline__ int virt_wg() { return (blockIdx.x & 7) * (GRID / 8) + (blockIdx.x >> 3); }

struct cplx { float re, im; };
__device__ __forceinline__ cplx cmul(cplx a, cplx b) { return {a.re * b.re - a.im * b.im, a.re * b.im + a.im * b.re}; }

__device__ void s5_tables(const Args& a, int layer, int g, LAS unsigned char* lds) {
    LAS f32x2* pw = (LAS f32x2*)lds;
    LAS f32x2* bb = (LAS f32x2*)(lds + 64 * 17 * 8);
    LAS f32x2* cc = bb + 64 * 16;
    const int tid = opaque_tid();
    const float* a_re = a.in[6] + ((size_t)layer * 64 + g) * 64; const float* a_im = a.in[7] + ((size_t)layer * 64 + g) * 64;
    const float dt = expf(a.in[8][layer * 64 + g]);
    for (int idx = tid; idx < 64 * 17; idx += NTHREADS) {
        const int p = idx / 17, d = idx % 17;
        const float mag = expf(a_re[p] * dt * (float)d), ang = a_im[p] * dt * (float)d;
        float s, c; sincosf(ang, &s, &c);
        pw[idx] = (f32x2){mag * c, mag * s};
    }
    const float* b_re = a.in[9] + ((size_t)layer * 64 + g) * 1024; const float* b_im = a.in[10] + ((size_t)layer * 64 + g) * 1024;
    const float* c_re = a.in[11] + ((size_t)layer * 64 + g) * 1024; const float* c_im = a.in[12] + ((size_t)layer * 64 + g) * 1024;
    for (int idx = tid; idx < 1024; idx += NTHREADS) {
        const int p = idx >> 4;
        const float lr = a_re[p], li = a_im[p];
        const float mag = expf(lr * dt), ang = li * dt; float s, c; sincosf(ang, &s, &c);
        const float nr = mag * c - 1.0f, ni = mag * s;
        const float den = 1.0f / (lr * lr + li * li);
        const cplx f = {(nr * lr + ni * li) * den, (ni * lr - nr * li) * den};
        const cplx r = cmul(f, (cplx){b_re[idx], b_im[idx]});
        bb[idx] = (f32x2){r.re, r.im};
        cc[idx] = (f32x2){c_re[idx], c_im[idx]};
    }
    __syncthreads();
    unsigned char* tbl = a.ws + WS_TBL + ((size_t)layer * 64 + g) * TBL_STRIDE;
    for (int idx = tid; idx < 16 * 64; idx += NTHREADS) {
        const int delta = idx >> 6, l = idx & 63, c1 = l & 15, q4 = l >> 4, d = delta - (q4 >> 1);
        float v[8];
#pragma unroll
        for (int j = 0; j < 8; ++j) v[j] = 0.f;
        if (d >= 0) {
            for (int p = 0; p < 64; ++p) {
                const f32x2 cw = cc[c1 * 64 + p], pp = pw[p * 17 + d];
                const cplx t = cmul((cplx){cw.x, cw.y}, (cplx){pp.x, pp.y});
#pragma unroll
                for (int j = 0; j < 8; ++j) { const f32x2 bw = bb[p * 16 + 8 * (q4 & 1) + j]; v[j] += t.re * bw.x - t.im * bw.y; }
            }
        }
        u32x4 w; w.x = cvt_pk_bf16(v[0], v[1]); w.y = cvt_pk_bf16(v[2], v[3]); w.z = cvt_pk_bf16(v[4], v[5]); w.w = cvt_pk_bf16(v[6], v[7]);
        *(u32x4*)(tbl + TBL_K + (size_t)idx * 16) = w;
    }
    for (int idx = tid; idx < 64 * 64; idx += NTHREADS) {
        const int f = idx >> 6, l = idx & 63, rt = f >> 3, ks = f & 7, q4 = l >> 4, rho = 16 * rt + (l & 15), p = rho & 63, im = rho >> 6;
        const int k0 = 32 * ks + 8 * q4, jpos = k0 >> 4, c20 = k0 & 15;
        const f32x2 pp = pw[p * 17 + (15 - jpos)];
        float v[8];
#pragma unroll
        for (int j = 0; j < 8; ++j) { const f32x2 bw = bb[p * 16 + c20 + j]; const cplx t = cmul((cplx){pp.x, pp.y}, (cplx){bw.x, bw.y}); v[j] = im ? t.im : t.re; }
        u32x4 w; w.x = cvt_pk_bf16(v[0], v[1]); w.y = cvt_pk_bf16(v[2], v[3]); w.z = cvt_pk_bf16(v[4], v[5]); w.w = cvt_pk_bf16(v[6], v[7]);
        *(u32x4*)(tbl + TBL_M + (size_t)idx * 16) = w;
    }
    for (int idx = tid; idx < 64 * 64; idx += NTHREADS) {
        const int f = idx >> 6, l = idx & 63, i = f >> 2, ks = f & 3, q4 = l >> 4, c1 = l & 15;
        const int s0 = 32 * ks + 8 * q4;
        float v[8];
#pragma unroll
        for (int j = 0; j < 8; ++j) { const int sg = s0 + j, p = sg & 63; const f32x2 cw = cc[c1 * 64 + p], pp = pw[p * 17 + i + 1];
            const cplx t = cmul((cplx){cw.x, cw.y}, (cplx){pp.x, pp.y}); v[j] = (sg >> 6) ? -t.im : t.re; }
        u32x4 w; w.x = cvt_pk_bf16(v[0], v[1]); w.y = cvt_pk_bf16(v[2], v[3]); w.z = cvt_pk_bf16(v[4], v[5]); w.w = cvt_pk_bf16(v[6], v[7]);
        *(u32x4*)(tbl + TBL_N + (size_t)idx * 16) = w;
    }
    if (tid < 64) *(f32x2*)(tbl + TBL_A16 + tid * 8) = pw[tid * 17 + 16];
    __syncthreads();
}

__device__ __forceinline__ void row_norm_store(const f32x4 (&v)[4], float ssq, int lane, const float* g0, bf16_t* o0, const float* g1, bf16_t* o1) {
    const float rstd = 1.0f / sqrtf(ssq * (1.0f / D) + RMS_EPS);
#pragma unroll
    for (int j = 0; j < 4; ++j) {
        const int c = 4 * lane + 256 * j;
        const f32x4 g = *(const f32x4*)(g0 + c);
        u32x2 w; w.x = cvt_pk_bf16(v[j][0] * rstd * g[0], v[j][1] * rstd * g[1]); w.y = cvt_pk_bf16(v[j][2] * rstd * g[2], v[j][3] * rstd * g[3]);
        *(u32x2*)(o0 + c) = w;
        if (o1) { const f32x4 h = *(const f32x4*)(g1 + c);
            u32x2 w2; w2.x = cvt_pk_bf16(v[j][0] * rstd * h[0], v[j][1] * rstd * h[1]); w2.y = cvt_pk_bf16(v[j][2] * rstd * h[2], v[j][3] * rstd * h[3]);
            *(u32x2*)(o1 + c) = w2; }
    }
}

__device__ void phase_prep(const Args& a, LAS unsigned char* lds) {
    if (blockIdx.x < 128) s5_tables(a, blockIdx.x >> 6, blockIdx.x & 63, lds);
    const int lane = opaque_tid() & 63, gw = blockIdx.x * 8 + (opaque_tid() >> 6);
    float* H = (float*)(a.ws + WS_H); bf16_t* U = (bf16_t*)(a.ws + WS_U);
    for (int tok = gw; tok < T; tok += GRID * 8) {
        const int b = tok / LT, pos = tok - b * LT;
        const float* src = pos < NMETA ? a.in[1] + (size_t)pos * D : a.in[0] + ((size_t)b * SEQ + (pos - NMETA)) * D;
        f32x4 v[4]; float ssq = 0.f;
#pragma unroll
        for (int j = 0; j < 4; ++j) { v[j] = *(const f32x4*)(src + 4 * lane + 256 * j); ssq += v[j][0] * v[j][0] + v[j][1] * v[j][1] + v[j][2] * v[j][2] + v[j][3] * v[j][3];
            *(f32x4*)(H + (size_t)tok * D + 4 * lane + 256 * j) = v[j]; }
        ssq = wave_sum(ssq);
        row_norm_store(v, ssq, lane, a.in[2], U + (size_t)tok * D, nullptr, nullptr);
    }
}

constexpr int S5_CH = 528;
constexpr int S5_NCH = 129, S5_NCHP = 144;
__device__ void phase_s5(const Args& a, int layer, LAS unsigned char* lds) {
    LAS unsigned char* Ul = lds; LAS unsigned char* Sl = lds + S5_NCHP * S5_CH;
    const int tid = opaque_tid(), lane = tid & 63, w = __builtin_amdgcn_readfirstlane(tid >> 6), tc = lane & 15, q4 = lane >> 4;
    const bf16_t* U = (const bf16_t*)(a.ws + WS_U); bf16_t* Z = (bf16_t*)(a.ws + WS_Z);
    for (int ui = 0; ui < 2; ++ui) {
        const int unit = blockIdx.x * 2 + ui, b = unit >> 6, g = unit & 63;
        const unsigned char* tbl = a.ws + WS_TBL + ((size_t)layer * 64 + g) * TBL_STRIDE;
        for (int idx = tid; idx < LT * 2; idx += NTHREADS) {
            const int tok = idx >> 1, half = idx & 1;
            const u32x4 v = *(const u32x4*)(U + ((size_t)(b * LT + tok)) * D + 16 * g + 8 * half);
            *(LAS u32x4*)(Ul + (tok >> 4) * S5_CH + (tok & 15) * 32 + half * 16) = v;
        }
        __syncthreads();
        {
            bf16x8 mf[8];
#pragma unroll
            for (int ks = 0; ks < 8; ++ks) mf[ks] = as_bf16x8(*(const u32x4*)(tbl + TBL_M + ((size_t)(w * 8 + ks) * 64 + lane) * 16));
#pragma unroll 1
            for (int cg = 0; cg < 9; ++cg) {
                const int n = 16 * cg + tc;
                f32x4 acc = {0.f, 0.f, 0.f, 0.f};
#pragma unroll
                for (int ks = 0; ks < 8; ++ks) { const bf16x8 ub = *(LAS bf16x8*)(Ul + n * S5_CH + ks * 64 + q4 * 16); acc = mfma16(mf[ks], ub, acc); }
                *(LAS f32x4*)(Sl + n * S5_CH + (16 * w + 4 * q4) * 4) = acc;
            }
        }
        __syncthreads();
        if (w == 0) {
            const f32x2 a16 = *(const f32x2*)(tbl + TBL_A16 + lane * 8);
            float sr = 0.f, si = 0.f;
#pragma unroll 1
            for (int nb = 0; nb < 17; ++nb) {
                float xr[8], xi[8];
#pragma unroll
                for (int j = 0; j < 8; ++j) { xr[j] = *(LAS float*)(Sl + (nb * 8 + j) * S5_CH + lane * 4); xi[j] = *(LAS float*)(Sl + (nb * 8 + j) * S5_CH + 256 + lane * 4); }
                asm volatile("s_waitcnt lgkmcnt(0)" ::: "memory");
#pragma unroll
                for (int j = 0; j < 8; ++j) {
                    const unsigned pr = cvt_pk_bf16(sr, si);
                    *(LAS unsigned short*)(Sl + (nb * 8 + j) * S5_CH + lane * 2) = (unsigned short)(pr & 0xffffu);
                    *(LAS unsigned short*)(Sl + (nb * 8 + j) * S5_CH + 128 + lane * 2) = (unsigned short)(pr >> 16);
                    const float nr = a16.x * sr - a16.y * si + xr[j], ni = a16.x * si + a16.y * sr + xi[j];
                    sr = nr; si = ni;
                }
                asm volatile("" ::: "memory");
            }
        }
        __syncthreads();
        {
            const int i0 = w, i1 = 15 - w;
            bf16x8 kf0[8], kf1[8], nf0[4], nf1[4];
#pragma unroll
            for (int jj = 0; jj < 8; ++jj) {
                const int d0 = i0 - 2 * jj, d1 = i1 - 2 * jj;
                kf0[jj] = as_bf16x8(*(const u32x4*)(tbl + TBL_K + ((size_t)(d0 >= 0 ? d0 : 0) * 64 + lane) * 16));
                kf1[jj] = as_bf16x8(*(const u32x4*)(tbl + TBL_K + ((size_t)(d1 >= 0 ? d1 : 0) * 64 + lane) * 16));
            }
#pragma unroll
            for (int ks = 0; ks < 4; ++ks) {
                nf0[ks] = as_bf16x8(*(const u32x4*)(tbl + TBL_N + ((size_t)(i0 * 4 + ks) * 64 + lane) * 16));
                nf1[ks] = as_bf16x8(*(const u32x4*)(tbl + TBL_N + ((size_t)(i1 * 4 + ks) * 64 + lane) * 16));
            }
            const f32x4 dsk = *(const f32x4*)(a.in[13] + (size_t)layer * D + 16 * g + 4 * q4);
#pragma unroll 1
            for (int cg = 0; cg < 9; ++cg) {
                const int n = 16 * cg + tc;
                f32x4 acc0 = {0.f, 0.f, 0.f, 0.f}, acc1 = {0.f, 0.f, 0.f, 0.f};
#pragma unroll
                for (int jj = 0; jj < 8; ++jj) {
                    const bf16x8 ub = *(LAS bf16x8*)(Ul + n * S5_CH + jj * 64 + q4 * 16);
                    if (2 * jj <= i0) acc0 = mfma16(kf0[jj], ub, acc0);
                    if (2 * jj <= i1) acc1 = mfma16(kf1[jj], ub, acc1);
                }
#pragma unroll
                for (int ks = 0; ks < 4; ++ks) {
                    const bf16x8 sb = *(LAS bf16x8*)(Sl + n * S5_CH + ks * 64 + q4 * 16);
                    acc0 = mfma16(nf0[ks], sb, acc0); acc1 = mfma16(nf1[ks], sb, acc1);
                }
                if (n < S5_NCH) {
#pragma unroll
                    for (int h = 0; h < 2; ++h) {
                        const int i = h ? i1 : i0; const f32x4 y = h ? acc1 : acc0;
                        const u32x2 uw = *(LAS u32x2*)(Ul + n * S5_CH + i * 32 + q4 * 8);
                        const float z0 = gelu_tanh(y[0] + dsk[0] * bf16_lo(uw.x)), z1 = gelu_tanh(y[1] + dsk[1] * bf16_hi(uw.x));
                        const float z2 = gelu_tanh(y[2] + dsk[2] * bf16_lo(uw.y)), z3 = gelu_tanh(y[3] + dsk[3] * bf16_hi(uw.y));
                        u32x2 o; o.x = cvt_pk_bf16(z0, z1); o.y = cvt_pk_bf16(z2, z3);
                        *(u32x2*)(Z + ((size_t)(b * LT + 16 * n + i)) * D + 16 * g + 4 * q4) = o;
                    }
                }
            }
        }
        __syncthreads();
    }
}

__device__ __forceinline__ float resid_update(float* hp, f32x4 delta) {
    f32x4 h = *(f32x4*)hp; h += delta; *(f32x4*)hp = h;
    return h[0] * h[0] + h[1] * h[1] + h[2] * h[2] + h[3] * h[3];
}

__device__ void phase_glu(const Args& a, int layer, LAS unsigned char* lds) {
    const bf16_t* Zb = (const bf16_t*)(a.ws + WS_Z); float* H = (float*)(a.ws + WS_H); float* SSQ = (float*)(a.ws + WS_SSQ);
    const float* W = a.in[14] + (size_t)layer * D * 2 * D;
    const int tid = opaque_tid(), lane = tid & 63, wid = tid >> 6, wm = wid >> 1, wn = wid & 1, tc = lane & 15, q4 = lane >> 4;
    constexpr int NMT = (T + 255) / 256, NNT = 16;
    for (int t = virt_wg(); t < NMT * NNT; t += GRID) {
        const int mt_ = t % NMT, nt_ = t / NMT, m0 = mt_ * 256, n0 = nt_ * 64;
        const bf16_t* ap[4]; dense_rows(Zb, D, m0, T, ap);
        const int bn = tid & 127, bkg = tid >> 7;
        const float* wp = W + (size_t)(16 * bkg) * (2 * D) + (bn < 64 ? n0 + bn : D + n0 + (bn - 64));
        f32x4 acc[4][4];
        gemm_mainloop<16, true>(lds, ap[0], ap[1], ap[2], ap[3], wp, 2 * D, acc);
#pragma unroll
        for (int mt = 0; mt < 4; ++mt) {
            const int tok = m0 + wm * 64 + mt * 16 + tc;
            float ss = 0.f;
            if (tok < T) {
#pragma unroll
                for (int p = 0; p < 2; ++p) {
                    const f32x4 v = acc[mt][p], gt = acc[mt][p + 2];
                    f32x4 o; o[0] = v[0] * sigmoidf_(gt[0]); o[1] = v[1] * sigmoidf_(gt[1]); o[2] = v[2] * sigmoidf_(gt[2]); o[3] = v[3] * sigmoidf_(gt[3]);
                    ss += resid_update(H + (size_t)tok * D + n0 + wn * 32 + p * 16 + 4 * q4, o);
                }
            }
            ss += __shfl_xor(ss, 16); ss += __shfl_xor(ss, 32);
            if (q4 == 0 && tok < T) SSQ[(size_t)tok * 32 + nt_ * 2 + wn] = ss;
        }
    }
}

__device__ __forceinline__ void dense_tile(LAS unsigned char* lds, const bf16_t* A, int m0, const float* W, int ldw, int n0, f32x4 (&acc)[4][4]) {
    const bf16_t* ap[4]; dense_rows(A, D, m0, T, ap);
    const int bn = opaque_tid() & 127, bkg = opaque_tid() >> 7;
    const float* wp = W + (size_t)(16 * bkg) * ldw + n0 + bn;
    gemm_mainloop<16, false>(lds, ap[0], ap[1], ap[2], ap[3], wp, ldw, acc);
}

__device__ __forceinline__ void q_tile(const Args& a, int j, int t, LAS unsigned char* lds) {
    constexpr int NMT = (T + 255) / 256;
    const int lane = opaque_tid() & 63, wid = opaque_tid() >> 6, wm = wid >> 1, wn = wid & 1, tc = lane & 15, q4 = lane >> 4;
    const int mt_ = t % NMT, nt_ = t / NMT, m0 = mt_ * 256, n0 = nt_ * 128;
    f32x4 acc[4][4];
    dense_tile(lds, (const bf16_t*)(a.ws + WS_U), m0, a.in[17] + (size_t)j * D * D, D, n0, acc);
    bf16_t* Q = (bf16_t*)(a.ws + WS_Q); const float* bq = a.in[18] + (size_t)j * D;
#pragma unroll
    for (int mt = 0; mt < 4; ++mt) {
        const int tok = m0 + wm * 64 + mt * 16 + tc;
        if (tok < T) {
#pragma unroll
            for (int nt = 0; nt < 4; ++nt) {
                const int c = n0 + wn * 64 + nt * 16 + 4 * q4; const f32x4 bv = *(const f32x4*)(bq + c); const f32x4 v = (acc[mt][nt] + bv) * 0.125f;
                u32x2 o; o.x = cvt_pk_bf16(v[0], v[1]); o.y = cvt_pk_bf16(v[2], v[3]);
                *(u32x2*)(Q + (size_t)tok * D + c) = o;
            }
        }
    }
}
__device__ __forceinline__ void kv_tile(const Args& a, int t, LAS unsigned char* lds) {
    constexpr int NMT = (T + 255) / 256;
    const int lane = opaque_tid() & 63, wid = opaque_tid() >> 6, wm = wid >> 1, wn = wid & 1, tc = lane & 15, q4 = lane >> 4;
    const int mt_ = t % NMT, nt_ = t / NMT, m0 = mt_ * 256, n0 = nt_ * 128;
    f32x4 acc[4][4];
    dense_tile(lds, (const bf16_t*)(a.ws + WS_KVN), m0, a.in[15], 512, n0, acc);
    bf16_t* K = (bf16_t*)(a.ws + WS_K); bf16_t* VT = (bf16_t*)(a.ws + WS_VT); const float* bkv = a.in[16];
#pragma unroll
    for (int mt = 0; mt < 4; ++mt) {
        const int tok = m0 + wm * 64 + mt * 16 + tc;
        if (tok < T) {
            const int b = tok / LT, pos = tok - b * LT;
#pragma unroll
            for (int nt = 0; nt < 4; ++nt) {
                const int c = n0 + wn * 64 + nt * 16 + 4 * q4; const f32x4 v = acc[mt][nt] + *(const f32x4*)(bkv + c);
                if (c < 256) { u32x2 o; o.x = cvt_pk_bf16(v[0], v[1]); o.y = cvt_pk_bf16(v[2], v[3]); *(u32x2*)(K + (size_t)tok * 256 + c) = o; }
                else {
                    const int cv = c - 256;
                    const unsigned p01 = cvt_pk_bf16(v[0], v[1]), p23 = cvt_pk_bf16(v[2], v[3]);
                    bf16_t* vp = VT + ((size_t)b * 256 + cv) * LT + pos;
                    vp[0] = (bf16_t)(p01 & 0xffffu); vp[LT] = (bf16_t)(p01 >> 16); vp[2 * LT] = (bf16_t)(p23 & 0xffffu); vp[3 * LT] = (bf16_t)(p23 >> 16);
                }
            }
        }
    }
}
__device__ void phase_kvq(const Args& a, LAS unsigned char* lds) {
    constexpr int NMT = (T + 255) / 256, NKV = NMT * 4, NQ = NMT * 8;
    for (int t = virt_wg(); t < NKV + NQ; t += GRID) { if (t < NKV) kv_tile(a, t, lds); else q_tile(a, 0, t - NKV, lds); }
}
__device__ void phase_qg(const Args& a, int j, LAS unsigned char* lds) {
    constexpr int NMT = (T + 255) / 256, NQ = NMT * 8;
    for (int t = virt_wg(); t < NQ; t += GRID) q_tile(a, j, t, lds);
}
__device__ void phase_oproj(const Args& a, int j, LAS unsigned char* lds) {
    constexpr int NMT = (T + 255) / 256, NNT = 8;
    const int lane = opaque_tid() & 63, wid = opaque_tid() >> 6, wm = wid >> 1, wn = wid & 1, tc = lane & 15, q4 = lane >> 4;
    float* H = (float*)(a.ws + WS_H); float* SSQ = (float*)(a.ws + WS_SSQ); const float* bo = a.in[21] + (size_t)j * D;
    for (int t = virt_wg(); t < NMT * NNT; t += GRID) {
        const int mt_ = t % NMT, nt_ = t / NMT, m0 = mt_ * 256, n0 = nt_ * 128;
        f32x4 acc[4][4];
        dense_tile(lds, (const bf16_t*)(a.ws + WS_Z), m0, a.in[20] + (size_t)j * D * D, D, n0, acc);
#pragma unroll
        for (int mt = 0; mt < 4; ++mt) {
            const int tok = m0 + wm * 64 + mt * 16 + tc;
            float ss = 0.f;
            if (tok < T) {
#pragma unroll
                for (int nt = 0; nt < 4; ++nt) { const int c = n0 + wn * 64 + nt * 16 + 4 * q4; ss += resid_update(H + (size_t)tok * D + c, acc[mt][nt] + *(const f32x4*)(bo + c)); }
            }
            ss += __shfl_xor(ss, 16); ss += __shfl_xor(ss, 32);
            if (q4 == 0 && tok < T) SSQ[(size_t)tok * 32 + nt_ * 2 + wn] = ss;
        }
    }
}

__device__ void phase_attn(const Args& a, int j, LAS unsigned char* lds) {
    const int lane = opaque_tid() & 63, wid = opaque_tid() >> 6, tc = lane & 15, q4 = lane >> 4;
    const bf16_t* Q = (const bf16_t*)(a.ws + WS_Q); const bf16_t* K = (const bf16_t*)(a.ws + WS_K); const bf16_t* VT = (const bf16_t*)(a.ws + WS_VT);
    bf16_t* O = (bf16_t*)(a.ws + WS_Z);
    constexpr int NQT = (LT + 31) / 32;
    for (int unit = blockIdx.x; unit < NB * 4 * NQT; unit += GRID) {
        const int qt = unit % NQT, kvh = (unit / NQT) & 3, b = unit / (NQT * 4);
        const int gq = wid & 3, st = wid >> 2, hq = kvh * 4 + gq;
        const int l0 = qt * 32 + st * 16;
        if (l0 >= LT) continue;
        const int t16 = l0 >> 4, l = l0 + tc;
        const float sink = a.in[19][j * 16 + hq];
        const bf16_t* qp = Q + ((size_t)(b * LT + l)) * D + hq * 64 + 8 * q4;
        const bf16x8 qf0 = as_bf16x8(*(const u32x4*)qp), qf1 = as_bf16x8(*(const u32x4*)(qp + 32));
        const int kb_lo = t16 == 0 ? 1 : (t16 - 8 > 1 ? t16 - 8 : 1);
        const int nband = t16 == 0 ? 0 : t16 - kb_lo + 1;
        f32x4 s[10];
#pragma unroll
        for (int bi = 0; bi < 10; ++bi) {
            s[bi] = (f32x4){-1e30f, -1e30f, -1e30f, -1e30f};
            if (bi <= nband) {
                const int kb = bi == 0 ? 0 : kb_lo + bi - 1;
                const bf16_t* kp = K + ((size_t)(b * LT + 16 * kb + tc)) * 256 + kvh * 64 + 8 * q4;
                const bf16x8 kf0 = as_bf16x8(*(const u32x4*)kp), kf1 = as_bf16x8(*(const u32x4*)(kp + 32));
                f32x4 acc = {0.f, 0.f, 0.f, 0.f};
                acc = mfma16(kf0, qf0, acc); acc = mfma16(kf1, qf1, acc);
#pragma unroll
                for (int r = 0; r < 4; ++r) {
                    const int key = 16 * kb + 4 * q4 + r;
                    const bool ok = bi == 0 ? (key <= l) : (key <= l && key >= l - 127);
                    s[bi][r] = ok ? acc[r] : -1e30f;
                }
            }
        }
        float m = sink;
#pragma unroll
        for (int bi = 0; bi < 10; ++bi) m = fmaxf(m, fmaxf(fmaxf(s[bi][0], s[bi][1]), fmaxf(s[bi][2], s[bi][3])));
        m = fmaxf(m, __shfl_xor(m, 16)); m = fmaxf(m, __shfl_xor(m, 32));
        float den = 0.f;
        unsigned pk[10][2];
#pragma unroll
        for (int bi = 0; bi < 10; ++bi) {
            float p[4];
#pragma unroll
            for (int r = 0; r < 4; ++r) { p[r] = s[bi][r] > -1e29f ? fast_exp(s[bi][r] - m) : 0.f; den += p[r]; }
            pk[bi][0] = cvt_pk_bf16(p[0], p[1]); pk[bi][1] = cvt_pk_bf16(p[2], p[3]);
        }
        den += __shfl_xor(den, 16); den += __shfl_xor(den, 32);
        den += fast_exp(sink - m);
        const float inv = 1.0f / den;
        f32x4 o[4];
#pragma unroll
        for (int dt = 0; dt < 4; ++dt) o[dt] = (f32x4){0.f, 0.f, 0.f, 0.f};
#pragma unroll
        for (int pp = 0; pp < 5; ++pp) {
            if (2 * pp <= nband) {
                const int biA = 2 * pp, biB = 2 * pp + 1;
                const int kbA = biA == 0 ? 0 : kb_lo + biA - 1;
                const int kbB = biB <= nband ? kb_lo + biB - 1 : kbA;
                u32x4 pw; pw.x = pk[biA][0]; pw.y = pk[biA][1]; pw.z = pk[biB][0]; pw.w = pk[biB][1];
                const bf16x8 pf = as_bf16x8(pw);
#pragma unroll
                for (int dt = 0; dt < 4; ++dt) {
                    const bf16_t* vp = VT + ((size_t)(b * 4 + kvh) * 64 + 16 * dt + tc) * LT + 4 * q4;
                    const u32x2 va = *(const u32x2*)(vp + 16 * kbA), vb = *(const u32x2*)(vp + 16 * kbB);
                    u32x4 vw; vw.x = va.x; vw.y = va.y; vw.z = vb.x; vw.w = vb.y;
                    o[dt] = mfma16(as_bf16x8(vw), pf, o[dt]);
                }
            }
        }
        bf16_t* op = O + ((size_t)(b * LT + l)) * D + hq * 64 + 4 * q4;
#pragma unroll
        for (int dt = 0; dt < 4; ++dt) { u32x2 w; w.x = cvt_pk_bf16(o[dt][0] * inv, o[dt][1] * inv); w.y = cvt_pk_bf16(o[dt][2] * inv, o[dt][3] * inv); *(u32x2*)(op + 16 * dt) = w; }
    }
}

__device__ void phase_route(const Args& a, int layer, int nslots, LAS unsigned char* lds) {
    LAS unsigned char* Wf = lds; LAS float* LG = (LAS float*)(lds + 98304); LAS int* hist = (LAS int*)(lds + 98304 + 24576); LAS int* hbase = hist + 32;
    const int tid = opaque_tid(), lane = tid & 63, wid = tid >> 6, tc = lane & 15, q4 = lane >> 4;
    const float* wg = a.in[22] + (size_t)layer * D * NGRP; const float* we = a.in[24] + (size_t)layer * D * NEXP;
    for (int idx = tid; idx < 3 * 32 * 64; idx += NTHREADS) {
        const int l = idx & 63, ks = (idx >> 6) & 31, rt = idx >> 11, o = 16 * rt + (l & 15), k0 = 32 * ks + 8 * (l >> 4);
        float v[8];
#pragma unroll
        for (int jq = 0; jq < 8; ++jq) v[jq] = o < 4 ? wg[(size_t)(k0 + jq) * NGRP + o] : (o < 36 ? we[(size_t)(k0 + jq) * NEXP + (o - 4)] : 0.f);
        u32x4 w; w.x = cvt_pk_bf16(v[0], v[1]); w.y = cvt_pk_bf16(v[2], v[3]); w.z = cvt_pk_bf16(v[4], v[5]); w.w = cvt_pk_bf16(v[6], v[7]);
        *(LAS u32x4*)(Wf + (size_t)idx * 16) = w;
    }
    if (tid < 32) hist[tid] = 0;
    __syncthreads();
    const float* H = (const float*)(a.ws + WS_H); const float* SSQ = (const float*)(a.ws + WS_SSQ); bf16_t* XN = (bf16_t*)(a.ws + WS_XN);
    const float* gain = a.in[3] + (size_t)layer * D;
    int* cnt = (int*)(a.ws + WS_CTL) + CW_CNT + layer * 32; int* LTOK = (int*)(a.ws + WS_LTOK); float* LGATE = (float*)(a.ws + WS_LGATE);
    const int tile = wid * GRID + blockIdx.x;
    const bool active = tile < T / 16;
    int e1 = 0, e2 = 0, r1 = 0, r2 = 0; float g1 = 0.f, g2 = 0.f;
    if (active) {
        const int tok = tile * 16 + tc;
        float ss = 0.f;
        { const float* sp = SSQ + (size_t)tok * 32; for (int s_ = q4; s_ < nslots; s_ += 4) ss += sp[s_]; }
        ss += __shfl_xor(ss, 16); ss += __shfl_xor(ss, 32);
        const float rstd = 1.0f / sqrtf(ss * (1.0f / D) + RMS_EPS);
        f32x4 acc[3];
#pragma unroll
        for (int rt = 0; rt < 3; ++rt) acc[rt] = (f32x4){0.f, 0.f, 0.f, 0.f};
        const float* hp = H + (size_t)tok * D + 8 * q4; bf16_t* xp = XN + (size_t)tok * D + 8 * q4;
#pragma unroll 4
        for (int ks = 0; ks < 32; ++ks) {
            const f32x4 h0 = *(const f32x4*)(hp + 32 * ks), h1 = *(const f32x4*)(hp + 32 * ks + 4);
            const f32x4 g0 = *(const f32x4*)(gain + 32 * ks + 8 * q4), g1v = *(const f32x4*)(gain + 32 * ks + 8 * q4 + 4);
            u32x4 xw; xw.x = cvt_pk_bf16(h0[0] * rstd * g0[0], h0[1] * rstd * g0[1]); xw.y = cvt_pk_bf16(h0[2] * rstd * g0[2], h0[3] * rstd * g0[3]);
            xw.z = cvt_pk_bf16(h1[0] * rstd * g1v[0], h1[1] * rstd * g1v[1]); xw.w = cvt_pk_bf16(h1[2] * rstd * g1v[2], h1[3] * rstd * g1v[3]);
            *(u32x4*)(xp + 32 * ks) = xw;
            const bf16x8 xf = as_bf16x8(xw);
#pragma unroll
            for (int rt = 0; rt < 3; ++rt) acc[rt] = mfma16(*(LAS bf16x8*)(Wf + ((size_t)(rt * 32 + ks) * 64 + lane) * 16), xf, acc[rt]);
        }
        LAS float* lg = LG + wid * 16 * 48;
#pragma unroll
        for (int rt = 0; rt < 3; ++rt)
#pragma unroll
            for (int r = 0; r < 4; ++r) lg[tc * 48 + 16 * rt + 4 * q4 + r] = acc[rt][r];
        asm volatile("s_waitcnt lgkmcnt(0)" ::: "memory");
        if (lane < 16) {
            const LAS float* mylg = lg + lane * 48;
            float gl[4]; int gi = 0; float gm;
#pragma unroll
            for (int i = 0; i < 4; ++i) gl[i] = mylg[i] + a.in[23][layer * NGRP + i];
            gm = gl[0];
#pragma unroll
            for (int i = 1; i < 4; ++i) if (gl[i] > gm) { gm = gl[i]; gi = i; }
            float gz = 0.f;
#pragma unroll
            for (int i = 0; i < 4; ++i) gz += expf(gl[i] - gm);
            const float pg = 1.0f / gz;
            float el[8];
#pragma unroll
            for (int i = 0; i < 8; ++i) el[i] = mylg[4 + gi * 8 + i] + a.in[25][layer * NEXP + gi * 8 + i];
            int i1 = 0; float m1 = el[0];
#pragma unroll
            for (int i = 1; i < 8; ++i) if (el[i] > m1) { m1 = el[i]; i1 = i; }
            int i2 = -1; float m2 = -3.0e38f;
#pragma unroll
            for (int i = 0; i < 8; ++i) if (i != i1 && el[i] > m2) { m2 = el[i]; i2 = i; }
            const float x2 = expf(m2 - m1), q1 = 1.0f / (1.0f + x2);
            g1 = pg * q1; g2 = pg * x2 * q1; e1 = gi * 8 + i1; e2 = gi * 8 + i2;
            r1 = __hip_atomic_fetch_add(&hist[e1], 1, __ATOMIC_RELAXED, __HIP_MEMORY_SCOPE_WORKGROUP); r2 = __hip_atomic_fetch_add(&hist[e2], 1, __ATOMIC_RELAXED, __HIP_MEMORY_SCOPE_WORKGROUP);
        }
    }
    __syncthreads();
    if (tid < 32) hbase[tid] = hist[tid] ? atomicAdd(&cnt[tid], hist[tid]) : 0;
    __syncthreads();
    if (active && lane < 16) {
        const int tok = tile * 16 + lane;
        const int s1 = hbase[e1] + r1, s2 = hbase[e2] + r2;
        LTOK[(size_t)e1 * T + s1] = tok; LGATE[(size_t)e1 * T + s1] = g1;
        LTOK[(size_t)e2 * T + s2] = tok | (1 << 30); LGATE[(size_t)e2 * T + s2] = g2;
    }
}

__device__ __forceinline__ void moe_scan(const int* cnt, LAS int* sh  , LAS int* hb  , int& total_mt) {
    if (opaque_tid() == 0) { int acc = 0; for (int e = 0; e < 32; ++e) { sh[e] = acc; hb[e] = acc * 256; acc += (cnt[e] + 255) >> 8; } sh[32] = acc; }
    __syncthreads();
    total_mt = sh[32];
}
__device__ void phase_moe1(const Args& a, int layer, LAS unsigned char* lds) {
    LAS int* sh = (LAS int*)(lds + 98304); LAS int* hb = sh + 40; LAS int* rowtok = sh + 128;
    const int tid = opaque_tid(), lane = tid & 63, wid = tid >> 6, wm = wid >> 1, wn = wid & 1, tc = lane & 15, q4 = lane >> 4;
    const int* cnt = (const int*)(a.ws + WS_CTL) + CW_CNT + layer * 32; const int* LTOK = (const int*)(a.ws + WS_LTOK);
    const bf16_t* XN = (const bf16_t*)(a.ws + WS_XN); bf16_t* HB = (bf16_t*)(a.ws + WS_HB);
    int total_mt; moe_scan(cnt, sh, hb, total_mt);
    const int ntiles = total_mt * 8;
    for (int t = virt_wg(); t < ntiles; t += GRID) {
        int e = 0; { const int gm = t / 8; (void)gm; }
        for (int q = 0; q < 32; ++q) if (t >= 8 * sh[q]) e = q;
        const int nmt = sh[e + 1] - sh[e], local = t - 8 * sh[e], nt_ = local / nmt, mt_ = local - nt_ * nmt;
        const int ne = cnt[e];
        __syncthreads();
        if (tid < 256) { const int idx = mt_ * 256 + tid; rowtok[tid] = LTOK[(size_t)e * T + (idx < ne ? idx : ne - 1)] & 0x3fffffff; }
        __syncthreads();
        const int ar = tid >> 3, akc = tid & 7;
        const bf16_t* ap[4];
#pragma unroll
        for (int i = 0; i < 4; ++i) ap[i] = XN + (size_t)rowtok[ar + 64 * i] * D + akc * 8;
        const int bn = tid & 127, bkg = tid >> 7, n0 = nt_ * 64;
        const float* wbase = (bn < 64 ? a.in[26] : a.in[27]) + ((size_t)layer * NEXP + e) * D * DEXP;
        const float* wp = wbase + (size_t)(16 * bkg) * DEXP + n0 + (bn & 63);
        f32x4 acc[4][4];
        gemm_mainloop<16, true>(lds, ap[0], ap[1], ap[2], ap[3], wp, DEXP, acc);
#pragma unroll
        for (int mt = 0; mt < 4; ++mt) {
            const int row = wm * 64 + mt * 16 + tc, idx = mt_ * 256 + row;
            if (idx < ne) {
                bf16_t* hp = HB + ((size_t)hb[e] + idx) * DEXP + n0 + wn * 32 + 4 * q4;
#pragma unroll
                for (int p = 0; p < 2; ++p) {
                    const f32x4 gt = acc[mt][p], up = acc[mt][p + 2];
                    u32x2 o; o.x = cvt_pk_bf16(gt[0] * sigmoidf_(gt[0]) * up[0], gt[1] * sigmoidf_(gt[1]) * up[1]);
                    o.y = cvt_pk_bf16(gt[2] * sigmoidf_(gt[2]) * up[2], gt[3] * sigmoidf_(gt[3]) * up[3]);
                    *(u32x2*)(hp + p * 16) = o;
                }
            }
        }
    }
}
__device__ void phase_moe2(const Args& a, int layer, LAS unsigned char* lds) {
    LAS int* sh = (LAS int*)(lds + 98304); LAS int* hb = sh + 40; LAS int* rowtok = sh + 128; LAS float* rowgate = (LAS float*)(rowtok + 256);
    const int tid = opaque_tid(), lane = tid & 63, wid = tid >> 6, wm = wid >> 1, wn = wid & 1, tc = lane & 15, q4 = lane >> 4;
    const int* cnt = (const int*)(a.ws + WS_CTL) + CW_CNT + layer * 32; const int* LTOK = (const int*)(a.ws + WS_LTOK); const float* LGATE = (const float*)(a.ws + WS_LGATE);
    const bf16_t* HB = (const bf16_t*)(a.ws + WS_HB); bf16_t* YB = (bf16_t*)(a.ws + WS_YB);
    int total_mt; moe_scan(cnt, sh, hb, total_mt);
    const int ntiles = total_mt * 8;
    for (int t = virt_wg(); t < ntiles; t += GRID) {
        int e = 0;
        for (int q = 0; q < 32; ++q) if (t >= 8 * sh[q]) e = q;
        const int nmt = sh[e + 1] - sh[e], local = t - 8 * sh[e], nt_ = local / nmt, mt_ = local - nt_ * nmt;
        const int ne = cnt[e];
        __syncthreads();
        if (tid < 256) { const int idx = mt_ * 256 + tid; const int ci = idx < ne ? idx : ne - 1; rowtok[tid] = LTOK[(size_t)e * T + ci]; rowgate[tid] = LGATE[(size_t)e * T + ci]; }
        __syncthreads();
        const int ar = tid >> 3, akc = tid & 7;
        const bf16_t* ap[4];
#pragma unroll
        for (int i = 0; i < 4; ++i) { int idx = mt_ * 256 + ar + 64 * i; idx = idx < ne ? idx : ne - 1; ap[i] = HB + ((size_t)hb[e] + idx) * DEXP + akc * 8; }
        const int bn = tid & 127, bkg = tid >> 7, n0 = nt_ * 128;
        const float* wp = a.in[28] + ((size_t)layer * NEXP + e) * DEXP * D + (size_t)(16 * bkg) * D + n0 + bn;
        f32x4 acc[4][4];
        gemm_mainloop<8, false>(lds, ap[0], ap[1], ap[2], ap[3], wp, D, acc);
#pragma unroll
        for (int mt = 0; mt < 4; ++mt) {
            const int row = wm * 64 + mt * 16 + tc, idx = mt_ * 256 + row;
            if (idx < ne) {
                const int rt = rowtok[row]; const float gsc = rowgate[row];
                bf16_t* yp = YB + ((size_t)(rt & 0x3fffffff) * 2 + (rt >> 30)) * D + n0 + wn * 64 + 4 * q4;
#pragma unroll
                for (int nt = 0; nt < 4; ++nt) { const f32x4 v = acc[mt][nt] * gsc; u32x2 o; o.x = cvt_pk_bf16(v[0], v[1]); o.y = cvt_pk_bf16(v[2], v[3]); *(u32x2*)(yp + nt * 16) = o; }
            }
        }
    }
}

__device__ void phase_combine(const Args& a, int layer) {
    const int lane = opaque_tid() & 63, gw = blockIdx.x * 8 + (opaque_tid() >> 6);
    float* H = (float*)(a.ws + WS_H); const bf16_t* YB = (const bf16_t*)(a.ws + WS_YB);
    for (int tok = gw; tok < T; tok += GRID * 8) {
        f32x4 v[4]; float ssq = 0.f;
        float* hp = H + (size_t)tok * D; const bf16_t* y0 = YB + (size_t)tok * 2 * D; const bf16_t* y1 = y0 + D;
#pragma unroll
        for (int j = 0; j < 4; ++j) {
            const int c = 4 * lane + 256 * j;
            v[j] = *(const f32x4*)(hp + c);
            const u32x2 p0 = *(const u32x2*)(y0 + c), p1 = *(const u32x2*)(y1 + c);
            v[j][0] += bf16_lo(p0.x) + bf16_lo(p1.x); v[j][1] += bf16_hi(p0.x) + bf16_hi(p1.x); v[j][2] += bf16_lo(p0.y) + bf16_lo(p1.y); v[j][3] += bf16_hi(p0.y) + bf16_hi(p1.y);
            ssq += v[j][0] * v[j][0] + v[j][1] * v[j][1] + v[j][2] * v[j][2] + v[j][3] * v[j][3];
        }
        ssq = wave_sum(ssq);
        if (layer < 3) {
#pragma unroll
            for (int j = 0; j < 4; ++j) *(f32x4*)(hp + 4 * lane + 256 * j) = v[j];
            bf16_t* U = (bf16_t*)(a.ws + WS_U) + (size_t)tok * D;
            if (layer == 1) row_norm_store(v, ssq, lane, a.in[2] + 2 * D, U, a.in[4], (bf16_t*)(a.ws + WS_KVN) + (size_t)tok * D);
            else row_norm_store(v, ssq, lane, a.in[2] + (size_t)(layer + 1) * D, U, nullptr, nullptr);
        } else {
            const int b = tok / LT, pos = tok - b * LT;
            if (pos >= NMETA) {
                const float rstd = 1.0f / sqrtf(ssq * (1.0f / D) + RMS_EPS);
                float* op = a.out + ((size_t)b * SEQ + (pos - NMETA)) * D;
#pragma unroll
                for (int j = 0; j < 4; ++j) { const int c = 4 * lane + 256 * j; const f32x4 g = *(const f32x4*)(a.in[5] + c);
                    f32x4 o; o[0] = v[j][0] * rstd * g[0]; o[1] = v[j][1] * rstd * g[1]; o[2] = v[j][2] * rstd * g[2]; o[3] = v[j][3] * rstd * g[3];
                    *(f32x4*)(op + c) = o; }
            }
        }
    }
}

enum { PH_PREP = 0, PH_S5, PH_GLU, PH_ROUTE, PH_G1, PH_G2, PH_COMB, PH_KVQ, PH_ATT, PH_OPROJ, PH_QG };
constexpr int NPH = 27;
__constant__ int c_prog[NPH][2] = {
    {PH_PREP, 0},
    {PH_S5, 0}, {PH_GLU, 0}, {PH_ROUTE, 0}, {PH_G1, 0}, {PH_G2, 0}, {PH_COMB, 0},
    {PH_S5, 1}, {PH_GLU, 1}, {PH_ROUTE, 1}, {PH_G1, 1}, {PH_G2, 1}, {PH_COMB, 1},
    {PH_KVQ, 2}, {PH_ATT, 2}, {PH_OPROJ, 2}, {PH_ROUTE, 2}, {PH_G1, 2}, {PH_G2, 2}, {PH_COMB, 2},
    {PH_QG, 3}, {PH_ATT, 3}, {PH_OPROJ, 3}, {PH_ROUTE, 3}, {PH_G1, 3}, {PH_G2, 3}, {PH_COMB, 3},
};

__global__ void __launch_bounds__(NTHREADS) yoco_fwd(Args a) {
    extern __shared__ __attribute__((aligned(16))) unsigned char smem_raw[];
    LAS unsigned char* lds = (LAS unsigned char*)smem_raw;
    XcdBarrier xb;
    if (a.ph_hi - a.ph_lo > 1) {
        volatile LAS unsigned* st = (volatile LAS unsigned*)(lds + LDS_BYTES - 16);
        if (threadIdx.x == 0) { st[0] = 0u; st[1] = 0u; }
        __syncthreads();
        xb = xcd_barrier_post((unsigned*)(a.ws + WS_CTL) + CW_BAR, st);
    }
    for (int ph = a.ph_lo; ph < a.ph_hi; ++ph) {
        const int type = c_prog[ph][0], layer = c_prog[ph][1];
        switch (type) {
            case PH_PREP: phase_prep(a, lds); break;
            case PH_S5: phase_s5(a, layer, lds); break;
            case PH_GLU: phase_glu(a, layer, lds); break;
            case PH_ROUTE: phase_route(a, layer, layer < 2 ? 32 : 16, lds); break;
            case PH_G1: phase_moe1(a, layer, lds); break;
            case PH_G2: phase_moe2(a, layer, lds); break;
            case PH_COMB: phase_combine(a, layer); break;
            case PH_KVQ: phase_kvq(a, lds); break;
            case PH_ATT: phase_attn(a, layer - 2, lds); break;
            case PH_OPROJ: phase_oproj(a, layer - 2, lds); break;
            case PH_QG: phase_qg(a, layer - 2, lds); break;
        }
        if (ph + 1 < a.ph_hi) xcd_barrier(xb);
    }
}

extern "C" void kernel_launch(void* const* d_in, const int* in_sizes, int n_in, void* d_out, int out_size, void* d_ws, size_t ws_size, hipStream_t stream) {
    static int ready = 0;
    if (ready == 0) {
        if (n_in != 29 || ws_size < WS_END) { fprintf(stderr, "kernel_launch: expected 29 inputs and >= %zu bytes of workspace (got %d, %zu)\n", (size_t)WS_END, n_in, ws_size); ready = -1; return; }
        if (hipFuncSetAttribute((const void*)yoco_fwd, hipFuncAttributeMaxDynamicSharedMemorySize, LDS_BYTES) != hipSuccess) { fprintf(stderr, "kernel_launch: hipFuncSetAttribute failed\n"); ready = -1; return; }
        ready = 1;
    }
    if (ready < 0) return;
    (void)hipMemsetAsync((char*)d_ws + WS_CTL, 0, CTL_BYTES, stream);
    Args a{};
    for (int i = 0; i < 29; ++i) a.in[i] = (const float*)d_in[i];
    a.out = (float*)d_out; a.ws = (unsigned char*)d_ws;
#if MK_N_LAUNCHES == 1
    a.ph_lo = 0; a.ph_hi = NPH;
    hipLaunchKernelGGL(yoco_fwd, dim3(GRID), dim3(NTHREADS), LDS_BYTES, stream, a);
#else
    for (int ph = 0; ph < NPH; ++ph) { a.ph_lo = ph; a.ph_hi = ph + 1; hipLaunchKernelGGL(yoco_fwd, dim3(GRID), dim3(NTHREADS), LDS_BYTES, stream, a); }
#endif
}
```

```cpp
#include <hip/hip_runtime.h>
#include <cstdio>
#include <cstdint>

#ifndef MK_N_LAUNCHES
#define MK_N_LAUNCHES 1
#endif

#define LAS __attribute__((address_space(3)))
typedef unsigned short bf16_t;
typedef short bf16x8 __attribute__((ext_vector_type(8)));
typedef float f32x4 __attribute__((ext_vector_type(4)));
typedef float f32x2 __attribute__((ext_vector_type(2)));
typedef unsigned u32x4 __attribute__((ext_vector_type(4)));
typedef unsigned u32x2 __attribute__((ext_vector_type(2)));

constexpr int D = 1024, NB = 8, SEQ = 2048, NMETA = 16, LT = SEQ + NMETA  , T = NB * LT  ;
constexpr int NEXP = 32, DEXP = 512, NGRP = 4, EPG = 8;
constexpr int NTHREADS = 512, GRID = 256;
constexpr int LDS_BYTES = 155648;
constexpr float RMS_EPS = 1e-6f;

constexpr size_t al256(size_t x) { return (x + 255) & ~(size_t)255; }
constexpr size_t WS_CTL = 0;
constexpr size_t CTL_BYTES = 32768;
constexpr int CW_BAR = 0;
constexpr int CW_CNT = 4096;
constexpr size_t WS_H = WS_CTL + CTL_BYTES;
constexpr size_t WS_U = WS_H + al256((size_t)T * D * 4);
constexpr size_t WS_Z = WS_U + al256((size_t)T * D * 2);
constexpr size_t WS_XN = WS_Z + al256((size_t)T * D * 2);
constexpr size_t WS_KVN = WS_XN + al256((size_t)T * D * 2);
constexpr size_t WS_Q = WS_KVN + al256((size_t)T * D * 2);
constexpr size_t WS_K = WS_Q + al256((size_t)T * D * 2);
constexpr size_t WS_VT = WS_K + al256((size_t)T * 256 * 2);
constexpr size_t WS_SSQ = WS_VT + al256((size_t)T * 256 * 2);
constexpr size_t WS_LTOK = WS_SSQ + al256((size_t)T * 32 * 4);
constexpr size_t WS_LGATE = WS_LTOK + al256((size_t)NEXP * T * 4);
constexpr int HB_ROWS = 2 * T + NEXP * 256;
constexpr size_t WS_HB = WS_LGATE + al256((size_t)NEXP * T * 4);
constexpr size_t WS_YB = WS_HB + al256((size_t)HB_ROWS * DEXP * 2);
constexpr size_t TBL_K = 0, TBL_M = 16 * 1024, TBL_N = TBL_M + 64 * 1024, TBL_A16 = TBL_N + 64 * 1024, TBL_STRIDE = TBL_A16 + 512;
constexpr size_t WS_TBL = WS_YB + al256((size_t)T * 2 * D * 2);
constexpr size_t WS_END = WS_TBL + al256((size_t)2 * 64 * TBL_STRIDE);

struct Args {
    const float* in[29];
    float* out;
    unsigned char* ws;
    int ph_lo, ph_hi;
};

__device__ __forceinline__ unsigned cvt_pk_bf16(float lo, float hi) { unsigned r; asm volatile("v_cvt_pk_bf16_f32 %0, %1, %2" : "=v"(r) : "v"(lo), "v"(hi)); return r; }
__device__ __forceinline__ float bf16_lo(unsigned w) { return __uint_as_float(w << 16); }
__device__ __forceinline__ float bf16_hi(unsigned w) { return __uint_as_float(w & 0xffff0000u); }
__device__ __forceinline__ float fast_rcp(float x) { return __builtin_amdgcn_rcpf(x); }
__device__ __forceinline__ float fast_exp(float x) { return __builtin_amdgcn_exp2f(x * 1.4426950408889634f); }
__device__ __forceinline__ float sigmoidf_(float x) { return fast_rcp(1.0f + fast_exp(-x)); }
__device__ __forceinline__ float gelu_tanh(float x) { const float v = 0.7978845608028654f * (x + 0.044715f * x * x * x); return x * sigmoidf_(2.0f * v); }
__device__ __forceinline__ bf16x8 as_bf16x8(u32x4 v) { return __builtin_bit_cast(bf16x8, v); }
__device__ __forceinline__ f32x4 mfma16(bf16x8 a, bf16x8 b, f32x4 c) { return __builtin_amdgcn_mfma_f32_16x16x32_bf16(a, b, c, 0, 0, 0); }
__device__ __forceinline__ float wave_sum(float v) {
#pragma unroll
    for (int o = 32; o >= 1; o >>= 1) v += __shfl_xor(v, o);
    return v;
}

__device__ __forceinline__ int opaque_tid() { int t = threadIdx.x; asm volatile("" : "+v"(t)); return t; }

#define XB_TMO      128
#define XB_XCNT(j)  (256  + 64 * (j))
#define XB_XSUB(j)  (1280 + 64 * (j))
#define XB_XGEN(j)  (2304 + 64 * (j))
#define XB_TOP      3328
#define XB_TOPGEN   3392
#define XCD_BAR_WORDS 3456
#define XB_SPIN_CAP (1u << 22)
__device__ __forceinline__ unsigned xb_ld(unsigned* p)              { return __hip_atomic_load(p, __ATOMIC_RELAXED, __HIP_MEMORY_SCOPE_AGENT); }
__device__ __forceinline__ unsigned xb_add(unsigned* p, unsigned v) { return __hip_atomic_fetch_add(p, v, __ATOMIC_RELAXED, __HIP_MEMORY_SCOPE_AGENT); }
__device__ __forceinline__ unsigned xb_xcc_id() { return (unsigned)__builtin_amdgcn_s_getreg((3 << 11) | 20) & 0xFu; }
#define XB_SPIN(cond, bar) do { unsigned _sp = 0; while (cond) { __builtin_amdgcn_s_sleep(1); \
    if ((++_sp & 255u) == 0u) { if (xb_ld(&(bar)[XB_TMO])) break; if (_sp > XB_SPIN_CAP) { atomicAdd(&(bar)[XB_TMO], 1u); break; } } } } while (0)
struct XcdBarrier { unsigned* bar; unsigned x; volatile LAS unsigned* st; };
__device__ __forceinline__ XcdBarrier xcd_barrier_post(unsigned* bar, volatile LAS unsigned* st) {
    XcdBarrier b; b.bar = bar; b.x = xb_xcc_id(); b.st = st;
    if (threadIdx.x == 0) (void)xb_add(&bar[XB_XCNT(b.x)], 1u);
    return b;
}
__device__ __forceinline__ void xcd_barrier_complete(unsigned* bar, unsigned x, unsigned& nloc, unsigned& nx) {
    const unsigned G = gridDim.x;
    unsigned sum, cnt, mine, sp = 0u;
    for (;;) {
        sum = 0u; cnt = 0u; mine = 0u;
#pragma unroll
        for (unsigned j = 0; j < 16; ++j) { const unsigned c = xb_ld(&bar[XB_XCNT(j)]); sum += c; cnt += (c > 0u) ? 1u : 0u; mine = (j == x) ? c : mine; }
        if (sum == G) break;
        __builtin_amdgcn_s_sleep(1);
        if ((++sp & 255u) == 0u) { if (xb_ld(&bar[XB_TMO])) break; if (sp > XB_SPIN_CAP) { atomicAdd(&bar[XB_TMO], 1u); break; } }
    }
    nloc = mine > 0u ? mine : 1u; nx = cnt > 0u ? cnt : 1u;
}
__device__ __forceinline__ void xcd_barrier(const XcdBarrier& b) {
    asm volatile("s_waitcnt vmcnt(0)" ::: "memory");
    __syncthreads();
    if (threadIdx.x == 0) {
        unsigned* bar = b.bar;
        __builtin_amdgcn_s_waitcnt(0);
        unsigned nloc = b.st[0], nx = b.st[1];
        if (nloc == 0u) { xcd_barrier_complete(bar, b.x, nloc, nx); b.st[0] = nloc; b.st[1] = nx; }
        const unsigned old = xb_add(&bar[XB_XSUB(b.x)], 1u);
        const unsigned gen = old / nloc;
        if (old + 1u == (gen + 1u) * nloc) {
            __builtin_amdgcn_fence(__ATOMIC_RELEASE, "agent");
            asm volatile("s_waitcnt vmcnt(0)" ::: "memory");
            const unsigned og = xb_add(&bar[XB_TOP], 1u);
            const unsigned tg = og / nx;
            if (og + 1u == (tg + 1u) * nx) xb_add(&bar[XB_TOPGEN], 1u);
            else XB_SPIN(xb_ld(&bar[XB_TOPGEN]) == tg, bar);
            __builtin_amdgcn_fence(__ATOMIC_ACQUIRE, "agent");
            xb_add(&bar[XB_XGEN(b.x)], 1u);
            asm volatile("s_waitcnt vmcnt(0)" ::: "memory");
        } else {
            XB_SPIN(xb_ld(&bar[XB_XGEN(b.x)]) == gen, bar);
            __builtin_amdgcn_fence(__ATOMIC_ACQUIRE, "agent");
            asm volatile("s_waitcnt vmcnt(0)" ::: "memory");
        }
    }
    __syncthreads();
}

__device__ __forceinline__ int tile_off(int row, int chunk) { return row * 128 + ((chunk ^ (row & 7)) << 4); }
template <bool PAIRED> __device__ __forceinline__ int brow_of(int wn, int nt) { return PAIRED ? ((nt >> 1) * 64 + wn * 32 + (nt & 1) * 16) : (wn * 64 + nt * 16); }

template <int NKT, bool PAIRED>
__device__ __forceinline__ void gemm_mainloop(LAS unsigned char* lds, const bf16_t* a0, const bf16_t* a1, const bf16_t* a2, const bf16_t* a3,
                                              const float* wp, int ldw, f32x4 (&acc)[4][4]) {
    const int tid = opaque_tid(), lane = tid & 63, wid = tid >> 6, wm = wid >> 1, wn = wid & 1, tc = lane & 15, q4 = lane >> 4;
    const int ar = tid >> 3, akc = tid & 7, bn = tid & 127, bkg = tid >> 7;
    LAS unsigned char* As = lds; LAS unsigned char* Bs = lds + 65536;
    u32x4 ra[4]; float rb[16];
#pragma unroll
    for (int mt = 0; mt < 4; ++mt)
#pragma unroll
        for (int nt = 0; nt < 4; ++nt) acc[mt][nt] = (f32x4){0.f, 0.f, 0.f, 0.f};
    const int aoff0 = tile_off(ar, akc), aoff1 = tile_off(ar + 64, akc), aoff2 = tile_off(ar + 128, akc), aoff3 = tile_off(ar + 192, akc);
    const int boff0 = tile_off(bn, 2 * bkg), boff1 = tile_off(bn, 2 * bkg + 1);
    int xoff[4], woff[4];
#pragma unroll
    for (int mt = 0; mt < 4; ++mt) xoff[mt] = (wm * 64 + mt * 16 + tc) * 128;
#pragma unroll
    for (int nt = 0; nt < 4; ++nt) woff[nt] = (brow_of<PAIRED>(wn, nt) + tc) * 128;
    const int sw = tc & 7;
    ra[0] = *(const u32x4*)a0; ra[1] = *(const u32x4*)a1; ra[2] = *(const u32x4*)a2; ra[3] = *(const u32x4*)a3;
#pragma unroll
    for (int j = 0; j < 16; ++j) rb[j] = wp[(size_t)j * ldw];
    {
        *(LAS u32x4*)(As + aoff0) = ra[0]; *(LAS u32x4*)(As + aoff1) = ra[1]; *(LAS u32x4*)(As + aoff2) = ra[2]; *(LAS u32x4*)(As + aoff3) = ra[3];
        u32x4 w0, w1;
        w0.x = cvt_pk_bf16(rb[0], rb[1]); w0.y = cvt_pk_bf16(rb[2], rb[3]); w0.z = cvt_pk_bf16(rb[4], rb[5]); w0.w = cvt_pk_bf16(rb[6], rb[7]);
        w1.x = cvt_pk_bf16(rb[8], rb[9]); w1.y = cvt_pk_bf16(rb[10], rb[11]); w1.z = cvt_pk_bf16(rb[12], rb[13]); w1.w = cvt_pk_bf16(rb[14], rb[15]);
        *(LAS u32x4*)(Bs + boff0) = w0; *(LAS u32x4*)(Bs + boff1) = w1;
    }
    __syncthreads();
#pragma unroll 1
    for (int kt = 0; kt < NKT; ++kt) {
        const int buf = kt & 1;
        if (kt + 1 < NKT) {
            const int ko = (kt + 1) * 64;
            ra[0] = *(const u32x4*)(a0 + ko); ra[1] = *(const u32x4*)(a1 + ko); ra[2] = *(const u32x4*)(a2 + ko); ra[3] = *(const u32x4*)(a3 + ko);
            const float* wq = wp + (size_t)ko * ldw;
#pragma unroll
            for (int j = 0; j < 16; ++j) rb[j] = wq[(size_t)j * ldw];
        }
        LAS unsigned char* Ab = As + buf * 32768; LAS unsigned char* Bb = Bs + buf * 16384;
#pragma unroll
        for (int kk = 0; kk < 2; ++kk) {
            const int ch = ((kk * 4 + q4) ^ sw) << 4;
            bf16x8 xf[4], wf[4];
#pragma unroll
            for (int mt = 0; mt < 4; ++mt) xf[mt] = *(LAS bf16x8*)(Ab + xoff[mt] + ch);
#pragma unroll
            for (int nt = 0; nt < 4; ++nt) wf[nt] = *(LAS bf16x8*)(Bb + woff[nt] + ch);
#pragma unroll
            for (int mt = 0; mt < 4; ++mt)
#pragma unroll
                for (int nt = 0; nt < 4; ++nt) acc[mt][nt] = mfma16(wf[nt], xf[mt], acc[mt][nt]);
        }
        if (kt + 1 < NKT) {
            LAS unsigned char* An = As + (buf ^ 1) * 32768; LAS unsigned char* Bn = Bs + (buf ^ 1) * 16384;
            *(LAS u32x4*)(An + aoff0) = ra[0]; *(LAS u32x4*)(An + aoff1) = ra[1]; *(LAS u32x4*)(An + aoff2) = ra[2]; *(LAS u32x4*)(An + aoff3) = ra[3];
            u32x4 w0, w1;
            w0.x = cvt_pk_bf16(rb[0], rb[1]); w0.y = cvt_pk_bf16(rb[2], rb[3]); w0.z = cvt_pk_bf16(rb[4], rb[5]); w0.w = cvt_pk_bf16(rb[6], rb[7]);
            w1.x = cvt_pk_bf16(rb[8], rb[9]); w1.y = cvt_pk_bf16(rb[10], rb[11]); w1.z = cvt_pk_bf16(rb[12], rb[13]); w1.w = cvt_pk_bf16(rb[14], rb[15]);
            *(LAS u32x4*)(Bn + boff0) = w0; *(LAS u32x4*)(Bn + boff1) = w1;
        }
        __syncthreads();
    }
}

__device__ __forceinline__ void dense_rows(const bf16_t* A, int lda, int m0, int M, const bf16_t* (&ap)[4]) {
    const int ar = opaque_tid() >> 3, akc = opaque_tid() & 7;
#pragma unroll
    for (int i = 0; i < 4; ++i) { int r = m0 + ar + 64 * i; r = r < M ? r : M - 1; ap[i] = A + (size_t)r * lda + akc * 8; }
}
__device__ __forceinline__ int virt_wg() { return (blockIdx.x & 7) * (GRID / 8) + (blockIdx.x >> 3); }

struct cplx { float re, im; };
__device__ __forceinline__ cplx cmul(cplx a, cplx b) { return {a.re * b.re - a.im * b.im, a.re * b.im + a.im * b.re}; }

__device__ void s5_tables(const Args& a, int layer, int g, LAS unsigned char* lds) {
    LAS f32x2* pw = (LAS f32x2*)lds;
    LAS f32x2* bb = (LAS f32x2*)(lds + 64 * 17 * 8);
    LAS f32x2* cc = bb + 64 * 16;
    const int tid = opaque_tid();
    const float* a_re = a.in[6] + ((size_t)layer * 64 + g) * 64; const float* a_im = a.in[7] + ((size_t)layer * 64 + g) * 64;
    const float dt = expf(a.in[8][layer * 64 + g]);
    for (int idx = tid; idx < 64 * 17; idx += NTHREADS) {
        const int p = idx / 17, d = idx % 17;
        const float mag = expf(a_re[p] * dt * (float)d), ang = a_im[p] * dt * (float)d;
        float s, c; sincosf(ang, &s, &c);
        pw[idx] = (f32x2){mag * c, mag * s};
    }
    const float* b_re = a.in[9] + ((size_t)layer * 64 + g) * 1024; const float* b_im = a.in[10] + ((size_t)layer * 64 + g) * 1024;
    const float* c_re = a.in[11] + ((size_t)layer * 64 + g) * 1024; const float* c_im = a.in[12] + ((size_t)layer * 64 + g) * 1024;
    for (int idx = tid; idx < 1024; idx += NTHREADS) {
        const int p = idx >> 4;
        const float lr = a_re[p], li = a_im[p];
        const float mag = expf(lr * dt), ang = li * dt; float s, c; sincosf(ang, &s, &c);
        const float nr = mag * c - 1.0f, ni = mag * s;
        const float den = 1.0f / (lr * lr + li * li);
        const cplx f = {(nr * lr + ni * li) * den, (ni * lr - nr * li) * den};
        const cplx r = cmul(f, (cplx){b_re[idx], b_im[idx]});
        bb[idx] = (f32x2){r.re, r.im};
        cc[idx] = (f32x2){c_re[idx], c_im[idx]};
    }
    __syncthreads();
    unsigned char* tbl = a.ws + WS_TBL + ((size_t)layer * 64 + g) * TBL_STRIDE;
    for (int idx = tid; idx < 16 * 64; idx += NTHREADS) {
        const int delta = idx >> 6, l = idx & 63, c1 = l & 15, q4 = l >> 4, d = delta - (q4 >> 1);
        float v[8];
#pragma unroll
        for (int j = 0; j < 8; ++j) v[j] = 0.f;
        if (d >= 0) {
            for (int p = 0; p < 64; ++p) {
                const f32x2 cw = cc[c1 * 64 + p], pp = pw[p * 17 + d];
                const cplx t = cmul((cplx){cw.x, cw.y}, (cplx){pp.x, pp.y});
#pragma unroll
                for (int j = 0; j < 8; ++j) { const f32x2 bw = bb[p * 16 + 8 * (q4 & 1) + j]; v[j] += t.re * bw.x - t.im * bw.y; }
            }
        }
        u32x4 w; w.x = cvt_pk_bf16(v[0], v[1]); w.y = cvt_pk_bf16(v[2], v[3]); w.z = cvt_pk_bf16(v[4], v[5]); w.w = cvt_pk_bf16(v[6], v[7]);
        *(u32x4*)(tbl + TBL_K + (size_t)idx * 16) = w;
    }
    for (int idx = tid; idx < 64 * 64; idx += NTHREADS) {
        const int f = idx >> 6, l = idx & 63, rt = f >> 3, ks = f & 7, q4 = l >> 4, rho = 16 * rt + (l & 15), p = rho & 63, im = rho >> 6;
        const int k0 = 32 * ks + 8 * q4, jpos = k0 >> 4, c20 = k0 & 15;
        const f32x2 pp = pw[p * 17 + (15 - jpos)];
        float v[8];
#pragma unroll
        for (int j = 0; j < 8; ++j) { const f32x2 bw = bb[p * 16 + c20 + j]; const cplx t = cmul((cplx){pp.x, pp.y}, (cplx){bw.x, bw.y}); v[j] = im ? t.im : t.re; }
        u32x4 w; w.x = cvt_pk_bf16(v[0], v[1]); w.y = cvt_pk_bf16(v[2], v[3]); w.z = cvt_pk_bf16(v[4], v[5]); w.w = cvt_pk_bf16(v[6], v[7]);
        *(u32x4*)(tbl + TBL_M + (size_t)idx * 16) = w;
    }
    for (int idx = tid; idx < 64 * 64; idx += NTHREADS) {
        const int f = idx >> 6, l = idx & 63, i = f >> 2, ks = f & 3, q4 = l >> 4, c1 = l & 15;
        const int s0 = 32 * ks + 8 * q4;
        float v[8];
#pragma unroll
        for (int j = 0; j < 8; ++j) { const int sg = s0 + j, p = sg & 63; const f32x2 cw = cc[c1 * 64 + p], pp = pw[p * 17 + i + 1];
            const cplx t = cmul((cplx){cw.x, cw.y}, (cplx){pp.x, pp.y}); v[j] = (sg >> 6) ? -t.im : t.re; }
        u32x4 w; w.x = cvt_pk_bf16(v[0], v[1]); w.y = cvt_pk_bf16(v[2], v[3]); w.z = cvt_pk_bf16(v[4], v[5]); w.w = cvt_pk_bf16(v[6], v[7]);
        *(u32x4*)(tbl + TBL_N + (size_t)idx * 16) = w;
    }
    if (tid < 64) *(f32x2*)(tbl + TBL_A16 + tid * 8) = pw[tid * 17 + 16];
    __syncthreads();
}

__device__ __forceinline__ void row_norm_store(const f32x4 (&v)[4], float ssq, int lane, const float* g0, bf16_t* o0, const float* g1, bf16_t* o1) {
    const float rstd = 1.0f / sqrtf(ssq * (1.0f / D) + RMS_EPS);
#pragma unroll
    for (int j = 0; j < 4; ++j) {
        const int c = 4 * lane + 256 * j;
        const f32x4 g = *(const f32x4*)(g0 + c);
        u32x2 w; w.x = cvt_pk_bf16(v[j][0] * rstd * g[0], v[j][1] * rstd * g[1]); w.y = cvt_pk_bf16(v[j][2] * rstd * g[2], v[j][3] * rstd * g[3]);
        *(u32x2*)(o0 + c) = w;
        if (o1) { const f32x4 h = *(const f32x4*)(g1 + c);
            u32x2 w2; w2.x = cvt_pk_bf16(v[j][0] * rstd * h[0], v[j][1] * rstd * h[1]); w2.y = cvt_pk_bf16(v[j][2] * rstd * h[2], v[j][3] * rstd * h[3]);
            *(u32x2*)(o1 + c) = w2; }
    }
}

__device__ void phase_prep(const Args& a, LAS unsigned char* lds) {
    if (blockIdx.x < 128) s5_tables(a, blockIdx.x >> 6, blockIdx.x & 63, lds);
    const int lane = opaque_tid() & 63, gw = blockIdx.x * 8 + (opaque_tid() >> 6);
    float* H = (float*)(a.ws + WS_H); bf16_t* U = (bf16_t*)(a.ws + WS_U);
    for (int tok = gw; tok < T; tok += GRID * 8) {
        const int b = tok / LT, pos = tok - b * LT;
        const float* src = pos < NMETA ? a.in[1] + (size_t)pos * D : a.in[0] + ((size_t)b * SEQ + (pos - NMETA)) * D;
        f32x4 v[4]; float ssq = 0.f;
#pragma unroll
        for (int j = 0; j < 4; ++j) { v[j] = *(const f32x4*)(src + 4 * lane + 256 * j); ssq += v[j][0] * v[j][0] + v[j][1] * v[j][1] + v[j][2] * v[j][2] + v[j][3] * v[j][3];
            *(f32x4*)(H + (size_t)tok * D + 4 * lane + 256 * j) = v[j]; }
        ssq = wave_sum(ssq);
        row_norm_store(v, ssq, lane, a.in[2], U + (size_t)tok * D, nullptr, nullptr);
    }
}

constexpr int S5_CH = 528;
constexpr int S5_NCH = 129, S5_NCHP = 144;
__device__ void phase_s5(const Args& a, int layer, LAS unsigned char* lds) {
    LAS unsigned char* Ul = lds; LAS unsigned char* Sl = lds + S5_NCHP * S5_CH;
    const int tid = opaque_tid(), lane = tid & 63, w = __builtin_amdgcn_readfirstlane(tid >> 6), tc = lane & 15, q4 = lane >> 4;
    const bf16_t* U = (const bf16_t*)(a.ws + WS_U); bf16_t* Z = (bf16_t*)(a.ws + WS_Z);
    for (int ui = 0; ui < 2; ++ui) {
        const int unit = blockIdx.x * 2 + ui, b = unit >> 6, g = unit & 63;
        const unsigned char* tbl = a.ws + WS_TBL + ((size_t)layer * 64 + g) * TBL_STRIDE;
        for (int idx = tid; idx < LT * 2; idx += NTHREADS) {
            const int tok = idx >> 1, half = idx & 1;
            const u32x4 v = *(const u32x4*)(U + ((size_t)(b * LT + tok)) * D + 16 * g + 8 * half);
            *(LAS u32x4*)(Ul + (tok >> 4) * S5_CH + (tok & 15) * 32 + half * 16) = v;
        }
        __syncthreads();
        {
            bf16x8 mf[8];
#pragma unroll
            for (int ks = 0; ks < 8; ++ks) mf[ks] = as_bf16x8(*(const u32x4*)(tbl + TBL_M + ((size_t)(w * 8 + ks) * 64 + lane) * 16));
#pragma unroll 1
            for (int cg = 0; cg < 9; ++cg) {
                const int n = 16 * cg + tc;
                f32x4 acc = {0.f, 0.f, 0.f, 0.f};
#pragma unroll
                for (int ks = 0; ks < 8; ++ks) { const bf16x8 ub = *(LAS bf16x8*)(Ul + n * S5_CH + ks * 64 + q4 * 16); acc = mfma16(mf[ks], ub, acc); }
                *(LAS f32x4*)(Sl + n * S5_CH + (16 * w + 4 * q4) * 4) = acc;
            }
        }
        __syncthreads();
        if (w == 0) {
            const f32x2 a16 = *(const f32x2*)(tbl + TBL_A16 + lane * 8);
            float sr = 0.f, si = 0.f;
#pragma unroll 1
            for (int nb = 0; nb < 17; ++nb) {
                float xr[8], xi[8];
#pragma unroll
                for (int j = 0; j < 8; ++j) { xr[j] = *(LAS float*)(Sl + (nb * 8 + j) * S5_CH + lane * 4); xi[j] = *(LAS float*)(Sl + (nb * 8 + j) * S5_CH + 256 + lane * 4); }
                asm volatile("s_waitcnt lgkmcnt(0)" ::: "memory");
#pragma unroll
                for (int j = 0; j < 8; ++j) {
                    const unsigned pr = cvt_pk_bf16(sr, si);
                    *(LAS unsigned short*)(Sl + (nb * 8 + j) * S5_CH + lane * 2) = (unsigned short)(pr & 0xffffu);
                    *(LAS unsigned short*)(Sl + (nb * 8 + j) * S5_CH + 128 + lane * 2) = (unsigned short)(pr >> 16);
                    const float nr = a16.x * sr - a16.y * si + xr[j], ni = a16.x * si + a16.y * sr + xi[j];
                    sr = nr; si = ni;
                }
                asm volatile("" ::: "memory");
            }
        }
        __syncthreads();
        {
            const int i0 = w, i1 = 15 - w;
            bf16x8 kf0[8], kf1[8], nf0[4], nf1[4];
#pragma unroll
            for (int jj = 0; jj < 8; ++jj) {
                const int d0 = i0 - 2 * jj, d1 = i1 - 2 * jj;
                kf0[jj] = as_bf16x8(*(const u32x4*)(tbl + TBL_K + ((size_t)(d0 >= 0 ? d0 : 0) * 64 + lane) * 16));
                kf1[jj] = as_bf16x8(*(const u32x4*)(tbl + TBL_K + ((size_t)(d1 >= 0 ? d1 : 0) * 64 + lane) * 16));
            }
#pragma unroll
            for (int ks = 0; ks < 4; ++ks) {
                nf0[ks] = as_bf16x8(*(const u32x4*)(tbl + TBL_N + ((size_t)(i0 * 4 + ks) * 64 + lane) * 16));
                nf1[ks] = as_bf16x8(*(const u32x4*)(tbl + TBL_N + ((size_t)(i1 * 4 + ks) * 64 + lane) * 16));
            }
            const f32x4 dsk = *(const f32x4*)(a.in[13] + (size_t)layer * D + 16 * g + 4 * q4);
#pragma unroll 1
            for (int cg = 0; cg < 9; ++cg) {
                const int n = 16 * cg + tc;
                f32x4 acc0 = {0.f, 0.f, 0.f, 0.f}, acc1 = {0.f, 0.f, 0.f, 0.f};
#pragma unroll
                for (int jj = 0; jj < 8; ++jj) {
                    const bf16x8 ub = *(LAS bf16x8*)(Ul + n * S5_CH + jj * 64 + q4 * 16);
                    if (2 * jj <= i0) acc0 = mfma16(kf0[jj], ub, acc0);
                    if (2 * jj <= i1) acc1 = mfma16(kf1[jj], ub, acc1);
                }
#pragma unroll
                for (int ks = 0; ks < 4; ++ks) {
                    const bf16x8 sb = *(LAS bf16x8*)(Sl + n * S5_CH + ks * 64 + q4 * 16);
                    acc0 = mfma16(nf0[ks], sb, acc0); acc1 = mfma16(nf1[ks], sb, acc1);
                }
                if (n < S5_NCH) {
#pragma unroll
                    for (int h = 0; h < 2; ++h) {
                        const int i = h ? i1 : i0; const f32x4 y = h ? acc1 : acc0;
                        const u32x2 uw = *(LAS u32x2*)(Ul + n * S5_CH + i * 32 + q4 * 8);
                        const float z0 = gelu_tanh(y[0] + dsk[0] * bf16_lo(uw.x)), z1 = gelu_tanh(y[1] + dsk[1] * bf16_hi(uw.x));
                        const float z2 = gelu_tanh(y[2] + dsk[2] * bf16_lo(uw.y)), z3 = gelu_tanh(y[3] + dsk[3] * bf16_hi(uw.y));
                        u32x2 o; o.x = cvt_pk_bf16(z0, z1); o.y = cvt_pk_bf16(z2, z3);
                        *(u32x2*)(Z + ((size_t)(b * LT + 16 * n + i)) * D + 16 * g + 4 * q4) = o;
                    }
                }
            }
        }
        __syncthreads();
    }
}

__device__ __forceinline__ float resid_update(float* hp, f32x4 delta) {
    f32x4 h = *(f32x4*)hp; h += delta; *(f32x4*)hp = h;
    return h[0] * h[0] + h[1] * h[1] + h[2] * h[2] + h[3] * h[3];
}

__device__ void phase_glu(const Args& a, int layer, LAS unsigned char* lds) {
    const bf16_t* Zb = (const bf16_t*)(a.ws + WS_Z); float* H = (float*)(a.ws + WS_H); float* SSQ = (float*)(a.ws + WS_SSQ);
    const float* W = a.in[14] + (size_t)layer * D * 2 * D;
    const int tid = opaque_tid(), lane = tid & 63, wid = tid >> 6, wm = wid >> 1, wn = wid & 1, tc = lane & 15, q4 = lane >> 4;
    constexpr int NMT = (T + 255) / 256, NNT = 16;
    for (int t = virt_wg(); t < NMT * NNT; t += GRID) {
        const int mt_ = t % NMT, nt_ = t / NMT, m0 = mt_ * 256, n0 = nt_ * 64;
        const bf16_t* ap[4]; dense_rows(Zb, D, m0, T, ap);
        const int bn = tid & 127, bkg = tid >> 7;
        const float* wp = W + (size_t)(16 * bkg) * (2 * D) + (bn < 64 ? n0 + bn : D + n0 + (bn - 64));
        f32x4 acc[4][4];
        gemm_mainloop<16, true>(lds, ap[0], ap[1], ap[2], ap[3], wp, 2 * D, acc);
#pragma unroll
        for (int mt = 0; mt < 4; ++mt) {
            const int tok = m0 + wm * 64 + mt * 16 + tc;
            float ss = 0.f;
            if (tok < T) {
#pragma unroll
                for (int p = 0; p < 2; ++p) {
                    const f32x4 v = acc[mt][p], gt = acc[mt][p + 2];
                    f32x4 o; o[0] = v[0] * sigmoidf_(gt[0]); o[1] = v[1] * sigmoidf_(gt[1]); o[2] = v[2] * sigmoidf_(gt[2]); o[3] = v[3] * sigmoidf_(gt[3]);
                    ss += resid_update(H + (size_t)tok * D + n0 + wn * 32 + p * 16 + 4 * q4, o);
                }
            }
            ss += __shfl_xor(ss, 16); ss += __shfl_xor(ss, 32);
            if (q4 == 0 && tok < T) SSQ[(size_t)tok * 32 + nt_ * 2 + wn] = ss;
        }
    }
}

__device__ __forceinline__ void dense_tile(LAS unsigned char* lds, const bf16_t* A, int m0, const float* W, int ldw, int n0, f32x4 (&acc)[4][4]) {
    const bf16_t* ap[4]; dense_rows(A, D, m0, T, ap);
    const int bn = opaque_tid() & 127, bkg = opaque_tid() >> 7;
    const float* wp = W + (size_t)(16 * bkg) * ldw + n0 + bn;
    gemm_mainloop<16, false>(lds, ap[0], ap[1], ap[2], ap[3], wp, ldw, acc);
}

__device__ __forceinline__ void q_tile(const Args& a, int j, int t, LAS unsigned char* lds) {
    constexpr int NMT = (T + 255) / 256;
    const int lane = opaque_tid() & 63, wid = opaque_tid() >> 6, wm = wid >> 1, wn = wid & 1, tc = lane & 15, q4 = lane >> 4;
    const int mt_ = t % NMT, nt_ = t / NMT, m0 = mt_ * 256, n0 = nt_ * 128;
    f32x4 acc[4][4];
    dense_tile(lds, (const bf16_t*)(a.ws + WS_U), m0, a.in[17] + (size_t)j * D * D, D, n0, acc);
    bf16_t* Q = (bf16_t*)(a.ws + WS_Q); const float* bq = a.in[18] + (size_t)j * D;
#pragma unroll
    for (int mt = 0; mt < 4; ++mt) {
        const int tok = m0 + wm * 64 + mt * 16 + tc;
        if (tok < T) {
#pragma unroll
            for (int nt = 0; nt < 4; ++nt) {
                const int c = n0 + wn * 64 + nt * 16 + 4 * q4; const f32x4 bv = *(const f32x4*)(bq + c); const f32x4 v = (acc[mt][nt] + bv) * 0.125f;
                u32x2 o; o.x = cvt_pk_bf16(v[0], v[1]); o.y = cvt_pk_bf16(v[2], v[3]);
                *(u32x2*)(Q + (size_t)tok * D + c) = o;
            }
        }
    }
}
__device__ __forceinline__ void kv_tile(const Args& a, int t, LAS unsigned char* lds) {
    constexpr int NMT = (T + 255) / 256;
    const int lane = opaque_tid() & 63, wid = opaque_tid() >> 6, wm = wid >> 1, wn = wid & 1, tc = lane & 15, q4 = lane >> 4;
    const int mt_ = t % NMT, nt_ = t / NMT, m0 = mt_ * 256, n0 = nt_ * 128;
    f32x4 acc[4][4];
    dense_tile(lds, (const bf16_t*)(a.ws + WS_KVN), m0, a.in[15], 512, n0, acc);
    bf16_t* K = (bf16_t*)(a.ws + WS_K); bf16_t* VT = (bf16_t*)(a.ws + WS_VT); const float* bkv = a.in[16];
#pragma unroll
    for (int mt = 0; mt < 4; ++mt) {
        const int tok = m0 + wm * 64 + mt * 16 + tc;
        if (tok < T) {
            const int b = tok / LT, pos = tok - b * LT;
#pragma unroll
            for (int nt = 0; nt < 4; ++nt) {
                const int c = n0 + wn * 64 + nt * 16 + 4 * q4; const f32x4 v = acc[mt][nt] + *(const f32x4*)(bkv + c);
                if (c < 256) { u32x2 o; o.x = cvt_pk_bf16(v[0], v[1]); o.y = cvt_pk_bf16(v[2], v[3]); *(u32x2*)(K + (size_t)tok * 256 + c) = o; }
                else {
                    const int cv = c - 256;
                    const unsigned p01 = cvt_pk_bf16(v[0], v[1]), p23 = cvt_pk_bf16(v[2], v[3]);
                    bf16_t* vp = VT + ((size_t)b * 256 + cv) * LT + pos;
                    vp[0] = (bf16_t)(p01 & 0xffffu); vp[LT] = (bf16_t)(p01 >> 16); vp[2 * LT] = (bf16_t)(p23 & 0xffffu); vp[3 * LT] = (bf16_t)(p23 >> 16);
                }
            }
        }
    }
}
__device__ void phase_kvq(const Args& a, LAS unsigned char* lds) {
    constexpr int NMT = (T + 255) / 256, NKV = NMT * 4, NQ = NMT * 8;
    for (int t = virt_wg(); t < NKV + NQ; t += GRID) { if (t < NKV) kv_tile(a, t, lds); else q_tile(a, 0, t - NKV, lds); }
}
__device__ void phase_qg(const Args& a, int j, LAS unsigned char* lds) {
    constexpr int NMT = (T + 255) / 256, NQ = NMT * 8;
    for (int t = virt_wg(); t < NQ; t += GRID) q_tile(a, j, t, lds);
}
__device__ void phase_oproj(const Args& a, int j, LAS unsigned char* lds) {
    constexpr int NMT = (T + 255) / 256, NNT = 8;
    const int lane = opaque_tid() & 63, wid = opaque_tid() >> 6, wm = wid >> 1, wn = wid & 1, tc = lane & 15, q4 = lane >> 4;
    float* H = (float*)(a.ws + WS_H); float* SSQ = (float*)(a.ws + WS_SSQ); const float* bo = a.in[21] + (size_t)j * D;
    for (int t = virt_wg(); t < NMT * NNT; t += GRID) {
        const int mt_ = t % NMT, nt_ = t / NMT, m0 = mt_ * 256, n0 = nt_ * 128;
        f32x4 acc[4][4];
        dense_tile(lds, (const bf16_t*)(a.ws + WS_Z), m0, a.in[20] + (size_t)j * D * D, D, n0, acc);
#pragma unroll
        for (int mt = 0; mt < 4; ++mt) {
            const int tok = m0 + wm * 64 + mt * 16 + tc;
            float ss = 0.f;
            if (tok < T) {
#pragma unroll
                for (int nt = 0; nt < 4; ++nt) { const int c = n0 + wn * 64 + nt * 16 + 4 * q4; ss += resid_update(H + (size_t)tok * D + c, acc[mt][nt] + *(const f32x4*)(bo + c)); }
            }
            ss += __shfl_xor(ss, 16); ss += __shfl_xor(ss, 32);
            if (q4 == 0 && tok < T) SSQ[(size_t)tok * 32 + nt_ * 2 + wn] = ss;
        }
    }
}

__device__ void phase_attn(const Args& a, int j, LAS unsigned char* lds) {
    const int lane = opaque_tid() & 63, wid = opaque_tid() >> 6, tc = lane & 15, q4 = lane >> 4;
    const bf16_t* Q = (const bf16_t*)(a.ws + WS_Q); const bf16_t* K = (const bf16_t*)(a.ws + WS_K); const bf16_t* VT = (const bf16_t*)(a.ws + WS_VT);
    bf16_t* O = (bf16_t*)(a.ws + WS_Z);
    constexpr int NQT = (LT + 31) / 32;
    for (int unit = blockIdx.x; unit < NB * 4 * NQT; unit += GRID) {
        const int qt = unit % NQT, kvh = (unit / NQT) & 3, b = unit / (NQT * 4);
        const int gq = wid & 3, st = wid >> 2, hq = kvh * 4 + gq;
        const int l0 = qt * 32 + st * 16;
        if (l0 >= LT) continue;
        const int t16 = l0 >> 4, l = l0 + tc;
        const float sink = a.in[19][j * 16 + hq];
        const bf16_t* qp = Q + ((size_t)(b * LT + l)) * D + hq * 64 + 8 * q4;
        const bf16x8 qf0 = as_bf16x8(*(const u32x4*)qp), qf1 = as_bf16x8(*(const u32x4*)(qp + 32));
        const int kb_lo = t16 == 0 ? 1 : (t16 - 8 > 1 ? t16 - 8 : 1);
        const int nband = t16 == 0 ? 0 : t16 - kb_lo + 1;
        f32x4 s[10];
#pragma unroll
        for (int bi = 0; bi < 10; ++bi) {
            s[bi] = (f32x4){-1e30f, -1e30f, -1e30f, -1e30f};
            if (bi <= nband) {
                const int kb = bi == 0 ? 0 : kb_lo + bi - 1;
                const bf16_t* kp = K + ((size_t)(b * LT + 16 * kb + tc)) * 256 + kvh * 64 + 8 * q4;
                const bf16x8 kf0 = as_bf16x8(*(const u32x4*)kp), kf1 = as_bf16x8(*(const u32x4*)(kp + 32));
                f32x4 acc = {0.f, 0.f, 0.f, 0.f};
                acc = mfma16(kf0, qf0, acc); acc = mfma16(kf1, qf1, acc);
#pragma unroll
                for (int r = 0; r < 4; ++r) {
                    const int key = 16 * kb + 4 * q4 + r;
                    const bool ok = bi == 0 ? (key <= l) : (key <= l && key >= l - 127);
                    s[bi][r] = ok ? acc[r] : -1e30f;
                }
            }
        }
        float m = sink;
#pragma unroll
        for (int bi = 0; bi < 10; ++bi) m = fmaxf(m, fmaxf(fmaxf(s[bi][0], s[bi][1]), fmaxf(s[bi][2], s[bi][3])));
        m = fmaxf(m, __shfl_xor(m, 16)); m = fmaxf(m, __shfl_xor(m, 32));
        float den = 0.f;
        unsigned pk[10][2];
#pragma unroll
        for (int bi = 0; bi < 10; ++bi) {
            float p[4];
#pragma unroll
            for (int r = 0; r < 4; ++r) { p[r] = s[bi][r] > -1e29f ? fast_exp(s[bi][r] - m) : 0.f; den += p[r]; }
            pk[bi][0] = cvt_pk_bf16(p[0], p[1]); pk[bi][1] = cvt_pk_bf16(p[2], p[3]);
        }
        den += __shfl_xor(den, 16); den += __shfl_xor(den, 32);
        den += fast_exp(sink - m);
        const float inv = 1.0f / den;
        f32x4 o[4];
#pragma unroll
        for (int dt = 0; dt < 4; ++dt) o[dt] = (f32x4){0.f, 0.f, 0.f, 0.f};
#pragma unroll
        for (int pp = 0; pp < 5; ++pp) {
            if (2 * pp <= nband) {
                const int biA = 2 * pp, biB = 2 * pp + 1;
                const int kbA = biA == 0 ? 0 : kb_lo + biA - 1;
                const int kbB = biB <= nband ? kb_lo + biB - 1 : kbA;
                u32x4 pw; pw.x = pk[biA][0]; pw.y = pk[biA][1]; pw.z = pk[biB][0]; pw.w = pk[biB][1];
                const bf16x8 pf = as_bf16x8(pw);
#pragma unroll
                for (int dt = 0; dt < 4; ++dt) {
                    const bf16_t* vp = VT + ((size_t)(b * 4 + kvh) * 64 + 16 * dt + tc) * LT + 4 * q4;
                    const u32x2 va = *(const u32x2*)(vp + 16 * kbA), vb = *(const u32x2*)(vp + 16 * kbB);
                    u32x4 vw; vw.x = va.x; vw.y = va.y; vw.z = vb.x; vw.w = vb.y;
                    o[dt] = mfma16(as_bf16x8(vw), pf, o[dt]);
                }
            }
        }
        bf16_t* op = O + ((size_t)(b * LT + l)) * D + hq * 64 + 4 * q4;
#pragma unroll
        for (int dt = 0; dt < 4; ++dt) { u32x2 w; w.x = cvt_pk_bf16(o[dt][0] * inv, o[dt][1] * inv); w.y = cvt_pk_bf16(o[dt][2] * inv, o[dt][3] * inv); *(u32x2*)(op + 16 * dt) = w; }
    }
}

__device__ void phase_route(const Args& a, int layer, int nslots, LAS unsigned char* lds) {
    LAS unsigned char* Wf = lds; LAS float* LG = (LAS float*)(lds + 98304); LAS int* hist = (LAS int*)(lds + 98304 + 24576); LAS int* hbase = hist + 32;
    const int tid = opaque_tid(), lane = tid & 63, wid = tid >> 6, tc = lane & 15, q4 = lane >> 4;
    const float* wg = a.in[22] + (size_t)layer * D * NGRP; const float* we = a.in[24] + (size_t)layer * D * NEXP;
    for (int idx = tid; idx < 3 * 32 * 64; idx += NTHREADS) {
        const int l = idx & 63, ks = (idx >> 6) & 31, rt = idx >> 11, o = 16 * rt + (l & 15), k0 = 32 * ks + 8 * (l >> 4);
        float v[8];
#pragma unroll
        for (int jq = 0; jq < 8; ++jq) v[jq] = o < 4 ? wg[(size_t)(k0 + jq) * NGRP + o] : (o < 36 ? we[(size_t)(k0 + jq) * NEXP + (o - 4)] : 0.f);
        u32x4 w; w.x = cvt_pk_bf16(v[0], v[1]); w.y = cvt_pk_bf16(v[2], v[3]); w.z = cvt_pk_bf16(v[4], v[5]); w.w = cvt_pk_bf16(v[6], v[7]);
        *(LAS u32x4*)(Wf + (size_t)idx * 16) = w;
    }
    if (tid < 32) hist[tid] = 0;
    __syncthreads();
    const float* H = (const float*)(a.ws + WS_H); const float* SSQ = (const float*)(a.ws + WS_SSQ); bf16_t* XN = (bf16_t*)(a.ws + WS_XN);
    const float* gain = a.in[3] + (size_t)layer * D;
    int* cnt = (int*)(a.ws + WS_CTL) + CW_CNT + layer * 32; int* LTOK = (int*)(a.ws + WS_LTOK); float* LGATE = (float*)(a.ws + WS_LGATE);
    const int tile = wid * GRID + blockIdx.x;
    const bool active = tile < T / 16;
    int e1 = 0, e2 = 0, r1 = 0, r2 = 0; float g1 = 0.f, g2 = 0.f;
    if (active) {
        const int tok = tile * 16 + tc;
        float ss = 0.f;
        { const float* sp = SSQ + (size_t)tok * 32; for (int s_ = q4; s_ < nslots; s_ += 4) ss += sp[s_]; }
        ss += __shfl_xor(ss, 16); ss += __shfl_xor(ss, 32);
        const float rstd = 1.0f / sqrtf(ss * (1.0f / D) + RMS_EPS);
        f32x4 acc[3];
#pragma unroll
        for (int rt = 0; rt < 3; ++rt) acc[rt] = (f32x4){0.f, 0.f, 0.f, 0.f};
        const float* hp = H + (size_t)tok * D + 8 * q4; bf16_t* xp = XN + (size_t)tok * D + 8 * q4;
#pragma unroll 4
        for (int ks = 0; ks < 32; ++ks) {
            const f32x4 h0 = *(const f32x4*)(hp + 32 * ks), h1 = *(const f32x4*)(hp + 32 * ks + 4);
            const f32x4 g0 = *(const f32x4*)(gain + 32 * ks + 8 * q4), g1v = *(const f32x4*)(gain + 32 * ks + 8 * q4 + 4);
            u32x4 xw; xw.x = cvt_pk_bf16(h0[0] * rstd * g0[0], h0[1] * rstd * g0[1]); xw.y = cvt_pk_bf16(h0[2] * rstd * g0[2], h0[3] * rstd * g0[3]);
            xw.z = cvt_pk_bf16(h1[0] * rstd * g1v[0], h1[1] * rstd * g1v[1]); xw.w = cvt_pk_bf16(h1[2] * rstd * g1v[2], h1[3] * rstd * g1v[3]);
            *(u32x4*)(xp + 32 * ks) = xw;
            const bf16x8 xf = as_bf16x8(xw);
#pragma unroll
            for (int rt = 0; rt < 3; ++rt) acc[rt] = mfma16(*(LAS bf16x8*)(Wf + ((size_t)(rt * 32 + ks) * 64 + lane) * 16), xf, acc[rt]);
        }
        LAS float* lg = LG + wid * 16 * 48;
#pragma unroll
        for (int rt = 0; rt < 3; ++rt)
#pragma unroll
            for (int r = 0; r < 4; ++r) lg[tc * 48 + 16 * rt + 4 * q4 + r] = acc[rt][r];
        asm volatile("s_waitcnt lgkmcnt(0)" ::: "memory");
        if (lane < 16) {
            const LAS float* mylg = lg + lane * 48;
            float gl[4]; int gi = 0; float gm;
#pragma unroll
            for (int i = 0; i < 4; ++i) gl[i] = mylg[i] + a.in[23][layer * NGRP + i];
            gm = gl[0];
#pragma unroll
            for (int i = 1; i < 4; ++i) if (gl[i] > gm) { gm = gl[i]; gi = i; }
            float gz = 0.f;
#pragma unroll
            for (int i = 0; i < 4; ++i) gz += expf(gl[i] - gm);
            const float pg = 1.0f / gz;
            float el[8];
#pragma unroll
            for (int i = 0; i < 8; ++i) el[i] = mylg[4 + gi * 8 + i] + a.in[25][layer * NEXP + gi * 8 + i];
            int i1 = 0; float m1 = el[0];
#pragma unroll
            for (int i = 1; i < 8; ++i) if (el[i] > m1) { m1 = el[i]; i1 = i; }
            int i2 = -1; float m2 = -3.0e38f;
#pragma unroll
            for (int i = 0; i < 8; ++i) if (i != i1 && el[i] > m2) { m2 = el[i]; i2 = i; }
            const float x2 = expf(m2 - m1), q1 = 1.0f / (1.0f + x2);
            g1 = pg * q1; g2 = pg * x2 * q1; e1 = gi * 8 + i1; e2 = gi * 8 + i2;
            r1 = __hip_atomic_fetch_add(&hist[e1], 1, __ATOMIC_RELAXED, __HIP_MEMORY_SCOPE_WORKGROUP); r2 = __hip_atomic_fetch_add(&hist[e2], 1, __ATOMIC_RELAXED, __HIP_MEMORY_SCOPE_WORKGROUP);
        }
    }
    __syncthreads();
    if (tid < 32) hbase[tid] = hist[tid] ? atomicAdd(&cnt[tid], hist[tid]) : 0;
    __syncthreads();
    if (active && lane < 16) {
        const int tok = tile * 16 + lane;
        const int s1 = hbase[e1] + r1, s2 = hbase[e2] + r2;
        LTOK[(size_t)e1 * T + s1] = tok; LGATE[(size_t)e1 * T + s1] = g1;
        LTOK[(size_t)e2 * T + s2] = tok | (1 << 30); LGATE[(size_t)e2 * T + s2] = g2;
    }
}

__device__ __forceinline__ void moe_scan(const int* cnt, LAS int* sh  , LAS int* hb  , int& total_mt) {
    if (opaque_tid() == 0) { int acc = 0; for (int e = 0; e < 32; ++e) { sh[e] = acc; hb[e] = acc * 256; acc += (cnt[e] + 255) >> 8; } sh[32] = acc; }
    __syncthreads();
    total_mt = sh[32];
}
__device__ void phase_moe1(const Args& a, int layer, LAS unsigned char* lds) {
    LAS int* sh = (LAS int*)(lds + 98304); LAS int* hb = sh + 40; LAS int* rowtok = sh + 128;
    const int tid = opaque_tid(), lane = tid & 63, wid = tid >> 6, wm = wid >> 1, wn = wid & 1, tc = lane & 15, q4 = lane >> 4;
    const int* cnt = (const int*)(a.ws + WS_CTL) + CW_CNT + layer * 32; const int* LTOK = (const int*)(a.ws + WS_LTOK);
    const bf16_t* XN = (const bf16_t*)(a.ws + WS_XN); bf16_t* HB = (bf16_t*)(a.ws + WS_HB);
    int total_mt; moe_scan(cnt, sh, hb, total_mt);
    const int ntiles = total_mt * 8;
    for (int t = virt_wg(); t < ntiles; t += GRID) {
        int e = 0; { const int gm = t / 8; (void)gm; }
        for (int q = 0; q < 32; ++q) if (t >= 8 * sh[q]) e = q;
        const int nmt = sh[e + 1] - sh[e], local = t - 8 * sh[e], nt_ = local / nmt, mt_ = local - nt_ * nmt;
        const int ne = cnt[e];
        __syncthreads();
        if (tid < 256) { const int idx = mt_ * 256 + tid; rowtok[tid] = LTOK[(size_t)e * T + (idx < ne ? idx : ne - 1)] & 0x3fffffff; }
        __syncthreads();
        const int ar = tid >> 3, akc = tid & 7;
        const bf16_t* ap[4];
#pragma unroll
        for (int i = 0; i < 4; ++i) ap[i] = XN + (size_t)rowtok[ar + 64 * i] * D + akc * 8;
        const int bn = tid & 127, bkg = tid >> 7, n0 = nt_ * 64;
        const float* wbase = (bn < 64 ? a.in[26] : a.in[27]) + ((size_t)layer * NEXP + e) * D * DEXP;
        const float* wp = wbase + (size_t)(16 * bkg) * DEXP + n0 + (bn & 63);
        f32x4 acc[4][4];
        gemm_mainloop<16, true>(lds, ap[0], ap[1], ap[2], ap[3], wp, DEXP, acc);
#pragma unroll
        for (int mt = 0; mt < 4; ++mt) {
            const int row = wm * 64 + mt * 16 + tc, idx = mt_ * 256 + row;
            if (idx < ne) {
                bf16_t* hp = HB + ((size_t)hb[e] + idx) * DEXP + n0 + wn * 32 + 4 * q4;
#pragma unroll
                for (int p = 0; p < 2; ++p) {
                    const f32x4 gt = acc[mt][p], up = acc[mt][p + 2];
                    u32x2 o; o.x = cvt_pk_bf16(gt[0] * sigmoidf_(gt[0]) * up[0], gt[1] * sigmoidf_(gt[1]) * up[1]);
                    o.y = cvt_pk_bf16(gt[2] * sigmoidf_(gt[2]) * up[2], gt[3] * sigmoidf_(gt[3]) * up[3]);
                    *(u32x2*)(hp + p * 16) = o;
                }
            }
        }
    }
}
__device__ void phase_moe2(const Args& a, int layer, LAS unsigned char* lds) {
    LAS int* sh = (LAS int*)(lds + 98304); LAS int* hb = sh + 40; LAS int* rowtok = sh + 128; LAS float* rowgate = (LAS float*)(rowtok + 256);
    const int tid = opaque_tid(), lane = tid & 63, wid = tid >> 6, wm = wid >> 1, wn = wid & 1, tc = lane & 15, q4 = lane >> 4;
    const int* cnt = (const int*)(a.ws + WS_CTL) + CW_CNT + layer * 32; const int* LTOK = (const int*)(a.ws + WS_LTOK); const float* LGATE = (const float*)(a.ws + WS_LGATE);
    const bf16_t* HB = (const bf16_t*)(a.ws + WS_HB); bf16_t* YB = (bf16_t*)(a.ws + WS_YB);
    int total_mt; moe_scan(cnt, sh, hb, total_mt);
    const int ntiles = total_mt * 8;
    for (int t = virt_wg(); t < ntiles; t += GRID) {
        int e = 0;
        for (int q = 0; q < 32; ++q) if (t >= 8 * sh[q]) e = q;
        const int nmt = sh[e + 1] - sh[e], local = t - 8 * sh[e], nt_ = local / nmt, mt_ = local - nt_ * nmt;
        const int ne = cnt[e];
        __syncthreads();
        if (tid < 256) { const int idx = mt_ * 256 + tid; const int ci = idx < ne ? idx : ne - 1; rowtok[tid] = LTOK[(size_t)e * T + ci]; rowgate[tid] = LGATE[(size_t)e * T + ci]; }
        __syncthreads();
        const int ar = tid >> 3, akc = tid & 7;
        const bf16_t* ap[4];
#pragma unroll
        for (int i = 0; i < 4; ++i) { int idx = mt_ * 256 + ar + 64 * i; idx = idx < ne ? idx : ne - 1; ap[i] = HB + ((size_t)hb[e] + idx) * DEXP + akc * 8; }
        const int bn = tid & 127, bkg = tid >> 7, n0 = nt_ * 128;
        const float* wp = a.in[28] + ((size_t)layer * NEXP + e) * DEXP * D + (size_t)(16 * bkg) * D + n0 + bn;
        f32x4 acc[4][4];
        gemm_mainloop<8, false>(lds, ap[0], ap[1], ap[2], ap[3], wp, D, acc);
#pragma unroll
        for (int mt = 0; mt < 4; ++mt) {
            const int row = wm * 64 + mt * 16 + tc, idx = mt_ * 256 + row;
            if (idx < ne) {
                const int rt = rowtok[row]; const float gsc = rowgate[row];
                bf16_t* yp = YB + ((size_t)(rt & 0x3fffffff) * 2 + (rt >> 30)) * D + n0 + wn * 64 + 4 * q4;
#pragma unroll
                for (int nt = 0; nt < 4; ++nt) { const f32x4 v = acc[mt][nt] * gsc; u32x2 o; o.x = cvt_pk_bf16(v[0], v[1]); o.y = cvt_pk_bf16(v[2], v[3]); *(u32x2*)(yp + nt * 16) = o; }
            }
        }
    }
}

__device__ void phase_combine(const Args& a, int layer) {
    const int lane = opaque_tid() & 63, gw = blockIdx.x * 8 + (opaque_tid() >> 6);
    float* H = (float*)(a.ws + WS_H); const bf16_t* YB = (const bf16_t*)(a.ws + WS_YB);
    for (int tok = gw; tok < T; tok += GRID * 8) {
        f32x4 v[4]; float ssq = 0.f;
        float* hp = H + (size_t)tok * D; const bf16_t* y0 = YB + (size_t)tok * 2 * D; const bf16_t* y1 = y0 + D;
#pragma unroll
        for (int j = 0; j < 4; ++j) {
            const int c = 4 * lane + 256 * j;
            v[j] = *(const f32x4*)(hp + c);
            const u32x2 p0 = *(const u32x2*)(y0 + c), p1 = *(const u32x2*)(y1 + c);
            v[j][0] += bf16_lo(p0.x) + bf16_lo(p1.x); v[j][1] += bf16_hi(p0.x) + bf16_hi(p1.x); v[j][2] += bf16_lo(p0.y) + bf16_lo(p1.y); v[j][3] += bf16_hi(p0.y) + bf16_hi(p1.y);
            ssq += v[j][0] * v[j][0] + v[j][1] * v[j][1] + v[j][2] * v[j][2] + v[j][3] * v[j][3];
        }
        ssq = wave_sum(ssq);
        if (layer < 3) {
#pragma unroll
            for (int j = 0; j < 4; ++j) *(f32x4*)(hp + 4 * lane + 256 * j) = v[j];
            bf16_t* U = (bf16_t*)(a.ws + WS_U) + (size_t)tok * D;
            if (layer == 1) row_norm_store(v, ssq, lane, a.in[2] + 2 * D, U, a.in[4], (bf16_t*)(a.ws + WS_KVN) + (size_t)tok * D);
            else row_norm_store(v, ssq, lane, a.in[2] + (size_t)(layer + 1) * D, U, nullptr, nullptr);
        } else {
            const int b = tok / LT, pos = tok - b * LT;
            if (pos >= NMETA) {
                const float rstd = 1.0f / sqrtf(ssq * (1.0f / D) + RMS_EPS);
                float* op = a.out + ((size_t)b * SEQ + (pos - NMETA)) * D;
#pragma unroll
                for (int j = 0; j < 4; ++j) { const int c = 4 * lane + 256 * j; const f32x4 g = *(const f32x4*)(a.in[5] + c);
                    f32x4 o; o[0] = v[j][0] * rstd * g[0]; o[1] = v[j][1] * rstd * g[1]; o[2] = v[j][2] * rstd * g[2]; o[3] = v[j][3] * rstd * g[3];
                    *(f32x4*)(op + c) = o; }
            }
        }
    }
}

enum { PH_PREP = 0, PH_S5, PH_GLU, PH_ROUTE, PH_G1, PH_G2, PH_COMB, PH_KVQ, PH_ATT, PH_OPROJ, PH_QG };
constexpr int NPH = 27;
__constant__ int c_prog[NPH][2] = {
    {PH_PREP, 0},
    {PH_S5, 0}, {PH_GLU, 0}, {PH_ROUTE, 0}, {PH_G1, 0}, {PH_G2, 0}, {PH_COMB, 0},
    {PH_S5, 1}, {PH_GLU, 1}, {PH_ROUTE, 1}, {PH_G1, 1}, {PH_G2, 1}, {PH_COMB, 1},
    {PH_KVQ, 2}, {PH_ATT, 2}, {PH_OPROJ, 2}, {PH_ROUTE, 2}, {PH_G1, 2}, {PH_G2, 2}, {PH_COMB, 2},
    {PH_QG, 3}, {PH_ATT, 3}, {PH_OPROJ, 3}, {PH_ROUTE, 3}, {PH_G1, 3}, {PH_G2, 3}, {PH_COMB, 3},
};

__global__ void __launch_bounds__(NTHREADS) yoco_fwd(Args a) {
    extern __shared__ __attribute__((aligned(16))) unsigned char smem_raw[];
    LAS unsigned char* lds = (LAS unsigned char*)smem_raw;
    XcdBarrier xb;
    if (a.ph_hi - a.ph_lo > 1) {
        volatile LAS unsigned* st = (volatile LAS unsigned*)(lds + LDS_BYTES - 16);
        if (threadIdx.x == 0) { st[0] = 0u; st[1] = 0u; }
        __syncthreads();
        xb = xcd_barrier_post((unsigned*)(a.ws + WS_CTL) + CW_BAR, st);
    }
    for (int ph = a.ph_lo; ph < a.ph_hi; ++ph) {
        const int type = c_prog[ph][0], layer = c_prog[ph][1];
        switch (type) {
            case PH_PREP: phase_prep(a, lds); break;
            case PH_S5: phase_s5(a, layer, lds); break;
            case PH_GLU: phase_glu(a, layer, lds); break;
            case PH_ROUTE: phase_route(a, layer, layer < 2 ? 32 : 16, lds); break;
            case PH_G1: phase_moe1(a, layer, lds); break;
            case PH_G2: phase_moe2(a, layer, lds); break;
            case PH_COMB: phase_combine(a, layer); break;
            case PH_KVQ: phase_kvq(a, lds); break;
            case PH_ATT: phase_attn(a, layer - 2, lds); break;
            case PH_OPROJ: phase_oproj(a, layer - 2, lds); break;
            case PH_QG: phase_qg(a, layer - 2, lds); break;
        }
        if (ph + 1 < a.ph_hi) xcd_barrier(xb);
    }
}

extern "C" void kernel_launch(void* const* d_in, const int* in_sizes, int n_in, void* d_out, int out_size, void* d_ws, size_t ws_size, hipStream_t stream) {
    static int ready = 0;
    if (ready == 0) {
        if (n_in != 29 || ws_size < WS_END) { fprintf(stderr, "kernel_launch: expected 29 inputs and >= %zu bytes of workspace (got %d, %zu)\n", (size_t)WS_END, n_in, ws_size); ready = -1; return; }
        if (hipFuncSetAttribute((const void*)yoco_fwd, hipFuncAttributeMaxDynamicSharedMemorySize, LDS_BYTES) != hipSuccess) { fprintf(stderr, "kernel_launch: hipFuncSetAttribute failed\n"); ready = -1; return; }
        ready = 1;
    }
    if (ready < 0) return;
    (void)hipMemsetAsync((char*)d_ws + WS_CTL, 0, CTL_BYTES, stream);
    Args a{};
    for (int i = 0; i < 29; ++i) a.in[i] = (const float*)d_in[i];
    a.out = (float*)d_out; a.ws = (unsigned char*)d_ws;
#if MK_N_LAUNCHES == 1
    a.ph_lo = 0; a.ph_hi = NPH;
    hipLaunchKernelGGL(yoco_fwd, dim3(GRID), dim3(NTHREADS), LDS_BYTES, stream, a);
#else
    for (int ph = 0; ph < NPH; ++ph) { a.ph_lo = ph; a.ph_hi = ph + 1; hipLaunchKernelGGL(yoco_fwd, dim3(GRID), dim3(NTHREADS), LDS_BYTES, stream, a); }
#endif
}
```

```cpp
#include <hip/hip_runtime.h>
#include <cstdio>
#include <cstdint>

#ifndef MK_N_LAUNCHES
#define MK_N_LAUNCHES 1
#endif

#define LAS __attribute__((address_space(3)))
typedef unsigned short bf16_t;
typedef short bf16x8 __attribute__((ext_vector_type(8)));
typedef float f32x4 __attribute__((ext_vector_type(4)));
typedef float f32x2 __attribute__((ext_vector_type(2)));
typedef unsigned u32x4 __attribute__((ext_vector_type(4)));
typedef unsigned u32x2 __attribute__((ext_vector_type(2)));

constexpr int D = 1024, NB = 8, SEQ = 2048, NMETA = 16, LT = SEQ + NMETA  ;
constexpr int NREAL = NB * SEQ  , RT = NREAL + NMETA  , RPAD = 16640;
constexpr int NEXP = 32, DEXP = 512, NGRP = 4, EPG = 8;
constexpr int NTHREADS = 512, GRID = 256;
constexpr int LDS_BYTES = 155648;
constexpr float RMS_EPS = 1e-6f;
__device__ __forceinline__ int row_of(int b, int pos) { return pos < NMETA ? NREAL + pos : b * SEQ + (pos - NMETA); }

constexpr size_t al256(size_t x) { return (x + 255) & ~(size_t)255; }
constexpr size_t WS_CTL = 0;
constexpr size_t CTL_BYTES = 32768;
constexpr int CW_BAR = 0;
constexpr int CW_CNT = 4096;
constexpr int CW_DUMCNT = 4096 + 256;
constexpr size_t WS_H = WS_CTL + CTL_BYTES;
constexpr size_t WS_U = WS_H + al256((size_t)RPAD * D * 4);
constexpr size_t WS_Z = WS_U + al256((size_t)RPAD * D * 2);
constexpr size_t WS_XN = WS_Z + al256((size_t)RPAD * D * 2);
constexpr size_t WS_Q = WS_XN + al256((size_t)RPAD * D * 2);
constexpr size_t WS_K = WS_Q + al256((size_t)RPAD * D * 2);
constexpr size_t WS_VT = WS_K + al256((size_t)RPAD * 256 * 2);
constexpr size_t VT_META = (size_t)NB * 256 * SEQ;
constexpr size_t WS_SSQ = WS_VT + al256((size_t)RPAD * 256 * 2);
constexpr size_t WS_LTOK = WS_SSQ + al256((size_t)RPAD * 32 * 4);
constexpr size_t WS_LGATE = WS_LTOK + al256((size_t)NEXP * RT * 4);
constexpr int HB_ROWS = 2 * RT + NEXP * 256;
constexpr size_t WS_HB = WS_LGATE + al256((size_t)NEXP * RT * 4);
constexpr size_t WS_YB = WS_HB + al256((size_t)HB_ROWS * DEXP * 2);
constexpr size_t TBL_K = 0, TBL_M = 16 * 1024, TBL_N = TBL_M + 64 * 1024, TBL_A16 = TBL_N + 64 * 1024, TBL_STRIDE = TBL_A16 + 512;
constexpr size_t WS_TBL = WS_YB + al256((size_t)RT * 2 * D * 2);
constexpr size_t WS_WGLU = WS_TBL + al256((size_t)2 * 64 * TBL_STRIDE);
constexpr size_t WS_WKVQ = WS_WGLU + (size_t)2 * 2048 * 1024 * 2;
constexpr size_t WS_WQ1 = WS_WKVQ + (size_t)1536 * 1024 * 2;
constexpr size_t WS_WO = WS_WQ1 + (size_t)1024 * 1024 * 2;
constexpr size_t WS_W1 = WS_WO + (size_t)2 * 1024 * 1024 * 2;
constexpr size_t WS_W2 = WS_W1 + (size_t)4 * 32 * 1024 * 1024 * 2;
constexpr size_t WS_DUMH = WS_W2 + (size_t)4 * 32 * 1024 * 512 * 2;
constexpr size_t WS_DUMSSQ = WS_DUMH + al256((size_t)RT * D * 4);
constexpr size_t WS_DUMLT = WS_DUMSSQ + al256((size_t)RT * 32 * 4);
constexpr size_t WS_DUMLG = WS_DUMLT + al256((size_t)NEXP * RT * 4);
#if defined(PROBE_TYPE)
constexpr size_t WS_END = WS_DUMLG + al256((size_t)NEXP * RT * 4);
#else
constexpr size_t WS_END = WS_DUMH;
#endif

struct Args {
    const float* in[29];
    float* out;
    unsigned char* ws;
    int ph_lo, ph_hi;
    int rep_type, rep_n;
};
typedef const __attribute__((address_space(4))) Args CArgs;

__device__ __forceinline__ unsigned cvt_pk_bf16(float lo, float hi) { unsigned r; asm volatile("v_cvt_pk_bf16_f32 %0, %1, %2" : "=v"(r) : "v"(lo), "v"(hi)); return r; }
__device__ __forceinline__ float bf16_lo(unsigned w) { return __uint_as_float(w << 16); }
__device__ __forceinline__ float bf16_hi(unsigned w) { return __uint_as_float(w & 0xffff0000u); }
__device__ __forceinline__ float fast_rcp(float x) { return __builtin_amdgcn_rcpf(x); }
__device__ __forceinline__ float fast_exp(float x) { return __builtin_amdgcn_exp2f(x * 1.4426950408889634f); }
__device__ __forceinline__ float sigmoidf_(float x) { return fast_rcp(1.0f + fast_exp(-x)); }
__device__ __forceinline__ float gelu_tanh(float x) { const float v = 0.7978845608028654f * (x + 0.044715f * x * x * x); return x * sigmoidf_(2.0f * v); }
__device__ __forceinline__ bf16x8 as_bf16x8(u32x4 v) { return __builtin_bit_cast(bf16x8, v); }
__device__ __forceinline__ f32x4 mfma16(bf16x8 a, bf16x8 b, f32x4 c) { return __builtin_amdgcn_mfma_f32_16x16x32_bf16(a, b, c, 0, 0, 0); }
__device__ __forceinline__ float xor32_sum(float v) { auto r = __builtin_amdgcn_permlane32_swap(__float_as_uint(v), __float_as_uint(v), false, false); return __uint_as_float(r[0]) + __uint_as_float(r[1]); }
__device__ __forceinline__ float xor16_sum(float v) { auto r = __builtin_amdgcn_permlane16_swap(__float_as_uint(v), __float_as_uint(v), false, false); return __uint_as_float(r[0]) + __uint_as_float(r[1]); }
__device__ __forceinline__ float xor32_max(float v) { auto r = __builtin_amdgcn_permlane32_swap(__float_as_uint(v), __float_as_uint(v), false, false); return fmaxf(__uint_as_float(r[0]), __uint_as_float(r[1])); }
__device__ __forceinline__ float xor16_max(float v) { auto r = __builtin_amdgcn_permlane16_swap(__float_as_uint(v), __float_as_uint(v), false, false); return fmaxf(__uint_as_float(r[0]), __uint_as_float(r[1])); }
__device__ __forceinline__ float quad_sum(float v) { return xor32_sum(xor16_sum(v)); }
template <int X> __device__ __forceinline__ float swz_xor(float v) { return __uint_as_float((unsigned)__builtin_amdgcn_ds_swizzle((int)__float_as_uint(v), (X << 10) | 0x1f)); }
__device__ __forceinline__ float wave_sum(float v) {
    v += swz_xor<1>(v); v += swz_xor<2>(v); v += swz_xor<4>(v); v += swz_xor<8>(v);
    return quad_sum(v);
}
__device__ __forceinline__ int opaque_bid() { int b = blockIdx.x; asm volatile("" : "+s"(b)); return b; }
__device__ __forceinline__ int opaque_tid() { int t = threadIdx.x; asm volatile("" : "+v"(t)); return t; }

#define XB_TMO      128
#define XB_XCNT(j)  (256  + 64 * (j))
#define XB_XSUB(j)  (1280 + 64 * (j))
#define XB_XGEN(j)  (2304 + 64 * (j))
#define XB_TOP      3328
#define XB_TOPGEN   3392
#define XCD_BAR_WORDS 3456
#define XB_SPIN_CAP (1u << 22)
__device__ __forceinline__ unsigned xb_ld(unsigned* p)              { return __hip_atomic_load(p, __ATOMIC_RELAXED, __HIP_MEMORY_SCOPE_AGENT); }
__device__ __forceinline__ unsigned xb_add(unsigned* p, unsigned v) { return __hip_atomic_fetch_add(p, v, __ATOMIC_RELAXED, __HIP_MEMORY_SCOPE_AGENT); }
__device__ __forceinline__ unsigned xb_xcc_id() { return (unsigned)__builtin_amdgcn_s_getreg((3 << 11) | 20) & 0xFu; }
#define XB_SPIN(cond, bar) do { unsigned _sp = 0; while (cond) { __builtin_amdgcn_s_sleep(1); \
    if ((++_sp & 255u) == 0u) { if (xb_ld(&(bar)[XB_TMO])) break; if (_sp > XB_SPIN_CAP) { atomicAdd(&(bar)[XB_TMO], 1u); break; } } } } while (0)
__device__ __forceinline__ void xcd_barrier_post(unsigned* bar) { if (threadIdx.x == 0) (void)xb_add(&bar[XB_XCNT(xb_xcc_id())], 1u); }
__device__ __forceinline__ void xcd_barrier_complete(unsigned* bar, unsigned x, unsigned& nloc, unsigned& nx) {
    const unsigned G = gridDim.x;
    unsigned sum, cnt, mine, sp = 0u;
    for (;;) {
        sum = 0u; cnt = 0u; mine = 0u;
#pragma unroll
        for (unsigned j = 0; j < 16; ++j) { const unsigned c = xb_ld(&bar[XB_XCNT(j)]); sum += c; cnt += (c > 0u) ? 1u : 0u; mine = (j == x) ? c : mine; }
        if (sum == G) break;
        __builtin_amdgcn_s_sleep(1);
        if ((++sp & 255u) == 0u) { if (xb_ld(&bar[XB_TMO])) break; if (sp > XB_SPIN_CAP) { atomicAdd(&bar[XB_TMO], 1u); break; } }
    }
    nloc = mine > 0u ? mine : 1u; nx = cnt > 0u ? cnt : 1u;
}
__device__ __forceinline__ void xcd_barrier(unsigned* bar_, volatile LAS unsigned* st) {
    asm volatile("s_waitcnt vmcnt(0)" ::: "memory");
    __syncthreads();
    if (threadIdx.x == 0) {
        unsigned* bar = bar_; asm volatile("" : "+v"(bar));
        const unsigned bx = xb_xcc_id();
        __builtin_amdgcn_s_waitcnt(0);
        unsigned nloc = st[0], nx = st[1];
        if (nloc == 0u) { xcd_barrier_complete(bar, bx, nloc, nx); st[0] = nloc; st[1] = nx; }
        const unsigned old = xb_add(&bar[XB_XSUB(bx)], 1u);
        const unsigned gen = old / nloc;
        if (old + 1u == (gen + 1u) * nloc) {
            __builtin_amdgcn_fence(__ATOMIC_RELEASE, "agent");
            asm volatile("s_waitcnt vmcnt(0)" ::: "memory");
            const unsigned og = xb_add(&bar[XB_TOP], 1u);
            const unsigned tg = og / nx;
            if (og + 1u == (tg + 1u) * nx) xb_add(&bar[XB_TOPGEN], 1u);
            else XB_SPIN(xb_ld(&bar[XB_TOPGEN]) == tg, bar);
            __builtin_amdgcn_fence(__ATOMIC_ACQUIRE, "agent");
            xb_add(&bar[XB_XGEN(bx)], 1u);
            asm volatile("s_waitcnt vmcnt(0)" ::: "memory");
        } else {
            XB_SPIN(xb_ld(&bar[XB_XGEN(bx)]) == gen, bar);
            __builtin_amdgcn_fence(__ATOMIC_ACQUIRE, "agent");
            asm volatile("s_waitcnt vmcnt(0)" ::: "memory");
        }
    }
    __syncthreads();
}

constexpr int BM = 256, BK = 64, HALF = 128, HTB = HALF * BK * 2, STAGE_BYTES = 8 * HTB, NXCD = 8, WGM = 8;
constexpr int LDS_TABO = STAGE_BYTES;
constexpr int LDS_TABT = LDS_TABO + 3072;
constexpr int LDS_TABG = LDS_TABT + 3072;
constexpr int LDS_SH = LDS_TABG + 3072;
__host__ __device__ __forceinline__ int lds_byte(int r, int c) { const int st = (r >> 4) * 2 + (c >> 5), rr = r & 15, cc = c & 31, ob = rr * 64 + cc * 2; return st * 1024 + (ob ^ (((ob >> 9) & 1) << 5)); }
__host__ __device__ __forceinline__ void stage_rc(int b, int& R, int& C) { const int st = b / 1024, sb = b % 1024, swz = sb ^ (((sb >> 9) & 1) << 5); R = (st >> 1) * 16 + swz / 64; C = (st & 1) * 32 + (swz % 64) / 2; }
__host__ __device__ __forceinline__ int perm32(int rho) { const int n = rho >> 4, i = rho & 15; return 8 * (i >> 2) + 4 * n + (i & 3); }
struct Unit { int pm, pn, e, slot; };
__device__ __forceinline__ int xcd_chunk(int wgid, int nwg) { const int q = nwg / NXCD, r = nwg % NXCD, xcd = wgid % NXCD, off = wgid / NXCD; return (xcd < r ? xcd * (q + 1) : r * (q + 1) + (xcd - r) * q) + off; }

enum { EPI_GLU = 0, EPI_OPROJ, EPI_KVQ, EPI_MOE1, EPI_MOE2 };
struct GemmDesc {
    int kind, K, perm, gather, moe;
    int nM, nN, nwg, npn; const char* A; const char* Bt; size_t tstepA, tstepB, wstride; const int* cnt; const int* LTOK; const float* LGATE;
    const float* res; float* Hout; float* SSQ; const float* bias; const float* bias2; bf16_t* O1; bf16_t* O2; bf16_t* O3; int jq, cbase;
};
__device__ __forceinline__ bool order_next(const GemmDesc& g, LAS unsigned char* lds, int i, Unit& u) {
    const int L = i * GRID + opaque_bid(); if (L >= g.nwg) return false;
    const int wgid = xcd_chunk(L, g.nwg);
    if (g.moe) {
        const LAS int* sh = (const LAS int*)(lds + LDS_SH);
        int e = 0;
        for (int q = 1; q < 32; ++q) if (wgid >= g.npn * sh[q]) e = q;
        const int nmt = sh[e + 1] - sh[e], local = wgid - g.npn * sh[e];
        u.pn = local / nmt; u.pm = sh[e] + (local - u.pn * nmt); u.e = e; u.slot = i % 3;
    } else {
        const int nig = WGM * g.nN, gid = wgid / nig, fm = gid * WGM, gsz = (g.nM - fm) < WGM ? (g.nM - fm) : WGM;
        u.pm = fm + ((wgid % nig) % gsz); u.pn = (wgid % nig) / gsz; u.e = 0; u.slot = 0;
    }
    return true;
}
__device__ __forceinline__ const char* order_a(const GemmDesc& g, const Unit& u) { return g.gather ? g.A : g.A + (size_t)u.pm * g.tstepA; }
__device__ __forceinline__ const char* order_b(const GemmDesc& g, const Unit& u) { return g.Bt + (size_t)u.e * g.wstride + (size_t)u.pn * g.tstepB; }
__device__ __forceinline__ void order_fill(const GemmDesc& g, LAS unsigned char* lds, const Unit& u) {
    const int t = opaque_tid();
    if (t < 256) {
        const LAS int* sh = (const LAS int*)(lds + LDS_SH);
        const int ne = g.cnt[u.e], idx = (u.pm - sh[u.e]) * 256 + t, ci = idx < ne ? idx : ne - 1;
        const int v = g.LTOK[(size_t)u.e * RT + ci];
        ((LAS unsigned*)(lds + LDS_TABO))[u.slot * 256 + t] = (unsigned)(v & 0x3fffffff) * (unsigned)(D * 2);
        ((LAS int*)(lds + LDS_TABT))[u.slot * 256 + t] = idx < ne ? v : -1;
        ((LAS float*)(lds + LDS_TABG))[u.slot * 256 + t] = g.LGATE[(size_t)u.e * RT + ci];
    }
}
__device__ __forceinline__ void gemm_epilogue(const GemmDesc& g, LAS unsigned char* lds, const f32x4 (&acc)[2][2][4][2], const Unit& u, int wr, int wc, int fr, int fq);

__device__ __forceinline__ void gemm_run(LAS unsigned char* lds, const GemmDesc& g) {
    const int tid = opaque_tid(), wid = __builtin_amdgcn_readfirstlane(tid >> 6), lane = tid & 63, wr = wid >> 2, wc = wid & 3, fr = lane & 15, fq = lane >> 4;
    const int K = g.K, nt = K / BK;
    unsigned voffA[2], voffB[2]; int Rr[2], Cc[2];
#pragma unroll
    for (int i = 0; i < 2; ++i) { int R, C; stage_rc(tid * 16 + i * 8192, R, C); const int Rb = g.perm ? ((R & ~31) + perm32(R & 31)) : R;
        voffA[i] = (unsigned)(R * K + C) * 2u; voffB[i] = (unsigned)(Rb * K + C) * 2u; Rr[i] = R * 4; Cc[i] = C * 2; }
    const size_t kstep = (size_t)(BK * 2);
    const size_t hstep = (size_t)HALF * K * 2;
    const unsigned ldsw = (unsigned)wid * 1024u;
    const int aoff = lds_byte(wr * 64 + fr, fq * 8), boff = lds_byte(wc * 32 + fr, fq * 8);
#define PG8_SA(b, h) (((b) * 2 + (h)) * HTB)
#define PG8_SB(b, h) ((4 + (b) * 2 + (h)) * HTB)
#define PG8_GLDS(src, dstoff) __builtin_amdgcn_global_load_lds((const unsigned*)(src), (LAS unsigned*)(lds + (dstoff)), 16, 0, 0)
#define PG8_STAGE_B(bufoff, gbase) do { _Pragma("unroll") for (int _i = 0; _i < 2; ++_i) PG8_GLDS((const char*)(gbase) + voffB[_i], (bufoff) + ldsw + _i * 8192); } while (0)
#define PG8_STAGE_A(bufoff, gbase, tsel, kt, h) do { if (g.gather) { \
            const unsigned _o0 = *(const LAS unsigned*)(lds + LDS_TABO + (tsel) * 1024 + (h) * 512 + Rr[0]), _o1 = *(const LAS unsigned*)(lds + LDS_TABO + (tsel) * 1024 + (h) * 512 + Rr[1]); \
            PG8_GLDS((const char*)(gbase) + (size_t)(kt) * kstep + _o0 + Cc[0], (bufoff) + ldsw); PG8_GLDS((const char*)(gbase) + (size_t)(kt) * kstep + _o1 + Cc[1], (bufoff) + ldsw + 8192); \
        } else { _Pragma("unroll") for (int _i = 0; _i < 2; ++_i) PG8_GLDS((const char*)(gbase) + (size_t)(kt) * kstep + (size_t)(h) * hstep + voffA[_i], (bufoff) + ldsw + _i * 8192); } } while (0)
#define PG8_LDA(dst, b, h) do { _Pragma("unroll") for (int m = 0; m < 4; ++m) _Pragma("unroll") for (int k = 0; k < 2; ++k) dst[m][k] = *(const LAS bf16x8*)(lds + PG8_SA(b, h) + aoff + m * 2048 + k * 1024); } while (0)
#define PG8_LDB(dst, b, h) do { _Pragma("unroll") for (int n = 0; n < 2; ++n) _Pragma("unroll") for (int k = 0; k < 2; ++k) dst[n][k] = *(const LAS bf16x8*)(lds + PG8_SB(b, h) + boff + n * 2048 + k * 1024); } while (0)
#define PG8_MMA(ai, bj, At, Bt) do { __builtin_amdgcn_s_setprio(1); _Pragma("unroll") for (int m = 0; m < 4; ++m) _Pragma("unroll") for (int n = 0; n < 2; ++n) _Pragma("unroll") for (int k = 0; k < 2; ++k) \
        acc[ai][bj][m][n] = __builtin_amdgcn_mfma_f32_16x16x32_bf16(Bt[n][k], At[m][k], acc[ai][bj][m][n], 0, 0, 0); __builtin_amdgcn_s_setprio(0); } while (0)
#define PG8_WAIT_V(n) asm volatile("s_waitcnt vmcnt(" #n ")" ::: "memory")
#define PG8_WAIT_L(n) asm volatile("s_waitcnt lgkmcnt(" #n ")" ::: "memory")
#define PG8_BAR __builtin_amdgcn_s_barrier()
#define PG8_SCHED __builtin_amdgcn_sched_barrier(0)
    Unit cur, nxt; int ui = 0;
    if (!order_next(g, lds, 0, cur)) return;
    f32x4 acc[2][2][4][2];
#pragma unroll
    for (int a = 0; a < 2; ++a)
#pragma unroll
        for (int b = 0; b < 2; ++b)
#pragma unroll
            for (int m = 0; m < 4; ++m)
#pragma unroll
                for (int n = 0; n < 2; ++n) acc[a][b][m][n] = (f32x4){0.f, 0.f, 0.f, 0.f};
    bf16x8 At[4][2], B0[2][2], B1[2][2];
    if (g.moe) { order_fill(g, lds, cur); __syncthreads(); }
    const char* cA = order_a(g, cur); const char* cB = order_b(g, cur); int cT = cur.slot;
    PG8_STAGE_B(PG8_SB(0, 0), cB); PG8_STAGE_B(PG8_SB(0, 1), cB + hstep); PG8_STAGE_A(PG8_SA(0, 0), cA, cT, 0, 0); PG8_STAGE_A(PG8_SA(0, 1), cA, cT, 0, 1);
    if (wr == 1) PG8_BAR;
    PG8_WAIT_V(2); PG8_BAR;
    PG8_STAGE_B(PG8_SB(1, 0), cB + kstep); PG8_STAGE_A(PG8_SA(1, 0), cA, cT, 1, 0); PG8_STAGE_B(PG8_SB(1, 1), cB + hstep + kstep);
    PG8_WAIT_V(6); PG8_BAR;
    for (;;) {
        const bool has_next = order_next(g, lds, ui + 1, nxt);
        if (g.moe && has_next) order_fill(g, lds, nxt);
        const char* nA = has_next ? order_a(g, nxt) : cA; const char* nB = has_next ? order_b(g, nxt) : cB; const int nT = has_next ? nxt.slot : cT;
        for (int t = 0; t < nt; t += 2) {
            const bool last = (t == nt - 2);
            const char* a2b = last ? nA : cA; const int a2T = last ? nT : cT, a2k = last ? 0 : t + 2, a3k = a2k + 1;
            const char* b2 = last ? nB : cB + (size_t)(t + 2) * kstep; const char* b3 = b2 + kstep;
            PG8_LDB(B0, 0, 0); PG8_LDB(B1, 0, 1); PG8_SCHED; PG8_LDA(At, 0, 0); PG8_STAGE_A(PG8_SA(1, 1), cA, cT, t + 1, 1);
            PG8_WAIT_V(8); PG8_WAIT_L(0); PG8_BAR; PG8_MMA(0, 0, At, B0); PG8_MMA(0, 1, At, B1); PG8_BAR; PG8_SCHED;
            PG8_LDA(At, 0, 1); PG8_STAGE_B(PG8_SB(0, 0), b2); PG8_STAGE_B(PG8_SB(0, 1), b2 + hstep); PG8_STAGE_A(PG8_SA(0, 0), a2b, a2T, a2k, 0);
            PG8_WAIT_V(8); PG8_WAIT_L(0); PG8_BAR; PG8_MMA(1, 0, At, B0); PG8_MMA(1, 1, At, B1); PG8_BAR; PG8_SCHED;
            PG8_LDB(B0, 1, 0); PG8_LDB(B1, 1, 1); PG8_SCHED; PG8_LDA(At, 1, 0); PG8_STAGE_A(PG8_SA(0, 1), a2b, a2T, a2k, 1);
            PG8_WAIT_V(8); PG8_WAIT_L(0); PG8_BAR; PG8_MMA(0, 0, At, B0); PG8_MMA(0, 1, At, B1); PG8_BAR; PG8_SCHED;
            PG8_LDA(At, 1, 1); PG8_STAGE_B(PG8_SB(1, 0), b3); PG8_STAGE_B(PG8_SB(1, 1), b3 + hstep); PG8_STAGE_A(PG8_SA(1, 0), a2b, a2T, a3k, 0);
            PG8_WAIT_V(8); PG8_WAIT_L(0); PG8_BAR; PG8_MMA(1, 0, At, B0); PG8_MMA(1, 1, At, B1); PG8_BAR; PG8_SCHED;
        }
        if (wr == 0) PG8_BAR;
        gemm_epilogue(g, lds, acc, cur, wr, wc, fr, fq);
        if (!has_next) break;
#pragma unroll
        for (int a = 0; a < 2; ++a)
#pragma unroll
            for (int b = 0; b < 2; ++b)
#pragma unroll
                for (int m = 0; m < 4; ++m)
#pragma unroll
                    for (int n = 0; n < 2; ++n) acc[a][b][m][n] = (f32x4){0.f, 0.f, 0.f, 0.f};
        cur = nxt; cA = nA; cB = nB; cT = nT; ++ui;
        if (wr == 1) PG8_BAR;
    }
    PG8_WAIT_V(0);
    PG8_BAR;
#undef PG8_SA
#undef PG8_SB
#undef PG8_GLDS
#undef PG8_STAGE_A
#undef PG8_STAGE_B
#undef PG8_LDA
#undef PG8_LDB
#undef PG8_MMA
#undef PG8_WAIT_V
#undef PG8_WAIT_L
#undef PG8_BAR
#undef PG8_SCHED
}
__device__ __forceinline__ f32x4 meta_dot(const bf16_t* Am, const bf16_t* Brow0, int K, int fr, int fq) {
    f32x4 acc = {0.f, 0.f, 0.f, 0.f};
    const bf16_t* ap = Am + (size_t)fr * K + 8 * fq; const bf16_t* bp = Brow0 + (size_t)fr * K + 8 * fq;
#pragma unroll 4
    for (int ks = 0; ks < K / 32; ++ks) acc = mfma16(as_bf16x8(*(const u32x4*)(bp + 32 * ks)), as_bf16x8(*(const u32x4*)(ap + 32 * ks)), acc);
    return acc;
}

struct ConvDesc { const float* src; const float* gain; bf16_t* dst; int ld, K, mode, kt, ntile; };
__device__ __forceinline__ void conv_load(const ConvDesc& d, f32x4 (&v)[4]) {
    const int tid = opaque_tid(), k0 = d.kt * 128, n0 = d.ntile * 64;
#pragma unroll
    for (int i = 0; i < 4; ++i) { const int idx = tid + i * NTHREADS, k = idx >> 4, n4 = idx & 15; v[i] = *(const f32x4*)(d.src + (size_t)(k0 + k) * d.ld + n0 + 4 * n4);
        if (d.gain) { const float g = d.gain[k0 + k]; v[i] *= g; } }
}
__device__ __forceinline__ void conv_store(const ConvDesc& d, const f32x4 (&v)[4], LAS unsigned char* lds) {
    LAS float* T = (LAS float*)lds;
    const int tid = opaque_tid(), k0 = d.kt * 128, n0 = d.ntile * 64;
    __syncthreads();
#pragma unroll
    for (int i = 0; i < 4; ++i) { const int idx = tid + i * NTHREADS, k = idx >> 4, n4 = idx & 15; LAS float* p = T + k * 65 + 4 * n4; p[0] = v[i][0]; p[1] = v[i][1]; p[2] = v[i][2]; p[3] = v[i][3]; }
    __syncthreads();
#pragma unroll
    for (int i = 0; i < 2; ++i) {
        const int idx = tid + i * NTHREADS, n = idx >> 4, kc = idx & 15;
        const LAS float* p = T + (8 * kc) * 65 + n;
        u32x4 w; w.x = cvt_pk_bf16(p[0], p[65]); w.y = cvt_pk_bf16(p[130], p[195]); w.z = cvt_pk_bf16(p[260], p[325]); w.w = cvt_pk_bf16(p[390], p[455]);
        const int ng = n0 + n, row = d.mode == 0 ? ng : (256 * (ng >> 7) + (ng & 127) + (d.mode == 2 ? 128 : 0));
        *(u32x4*)(d.dst + (size_t)row * d.K + k0 + 8 * kc) = w;
    }
}
constexpr int NT_MOE = 4 * 32 * 192, NT_DENSE = 512 + 64 + 256 + 256;
__device__ __forceinline__ ConvDesc conv_decode(CArgs& a, int ti) {
    ConvDesc d;
    if (ti < NT_MOE) {
        const int le = ti / 192, r = ti % 192, which = r >> 6, tt = r & 63, layer = le >> 5;
        if (which < 2) { d.src = a.in[26 + which] + (size_t)le * D * DEXP; d.ld = DEXP; d.K = D; d.gain = a.in[3] + (size_t)layer * D; d.dst = (bf16_t*)(a.ws + WS_W1) + (size_t)le * 1024 * 1024; d.mode = 1 + which; d.kt = tt & 7; d.ntile = tt >> 3; }
        else { d.src = a.in[28] + (size_t)le * DEXP * D; d.ld = D; d.K = DEXP; d.gain = nullptr; d.dst = (bf16_t*)(a.ws + WS_W2) + (size_t)le * 1024 * 512; d.mode = 0; d.kt = tt & 3; d.ntile = tt >> 2; }
    } else {
        int r = ti - NT_MOE;
        if (r < 512) { const int layer = r >> 8, half = (r >> 7) & 1, tt = r & 127;
            d.src = a.in[14] + (size_t)layer * D * 2 * D + half * D; d.ld = 2 * D; d.K = D; d.gain = nullptr; d.dst = (bf16_t*)(a.ws + WS_WGLU) + (size_t)layer * 2048 * 1024; d.mode = 1 + half; d.kt = tt & 7; d.ntile = tt >> 3; }
        else if ((r -= 512) < 64) { d.src = a.in[15]; d.ld = 512; d.K = D; d.gain = a.in[4]; d.dst = (bf16_t*)(a.ws + WS_WKVQ); d.mode = 0; d.kt = r & 7; d.ntile = r >> 3; }
        else if ((r -= 64) < 256) { const int j = r >> 7, tt = r & 127;
            d.src = a.in[17] + (size_t)j * D * D; d.ld = D; d.K = D; d.gain = a.in[2] + (size_t)(2 + j) * D; d.dst = j == 0 ? (bf16_t*)(a.ws + WS_WKVQ) + (size_t)512 * 1024 : (bf16_t*)(a.ws + WS_WQ1); d.mode = 0; d.kt = tt & 7; d.ntile = tt >> 3; }
        else { r -= 256; const int j = r >> 7, tt = r & 127;
            d.src = a.in[20] + (size_t)j * D * D; d.ld = D; d.K = D; d.gain = nullptr; d.dst = (bf16_t*)(a.ws + WS_WO) + (size_t)j * 1024 * 1024; d.mode = 0; d.kt = tt & 7; d.ntile = tt >> 3; }
    }
    return d;
}
__device__ __forceinline__ void convert_weights(CArgs& a, LAS unsigned char* lds) {
    int ti = opaque_bid();
    if (ti >= NT_MOE + NT_DENSE) return;
    ConvDesc cur = conv_decode(a, ti); f32x4 v[4]; conv_load(cur, v);
    for (;;) {
        const int tn = ti + GRID; const bool more = tn < NT_MOE + NT_DENSE;
        ConvDesc nxt = cur; f32x4 vn[4];
        if (more) { nxt = conv_decode(a, tn); conv_load(nxt, vn); }
        conv_store(cur, v, lds);
        if (!more) break;
        cur = nxt; ti = tn;
#pragma unroll
        for (int i = 0; i < 4; ++i) v[i] = vn[i];
    }
    __syncthreads();
}

struct cplx { float re, im; };
__device__ __forceinline__ cplx cmul(cplx a, cplx b) { return {a.re * b.re - a.im * b.im, a.re * b.im + a.im * b.re}; }

__device__ __forceinline__ void s5_tables(CArgs& a, int layer, int g, LAS unsigned char* lds) {
    LAS f32x2* pw = (LAS f32x2*)lds;
    LAS f32x2* bb = (LAS f32x2*)(lds + 64 * 17 * 8);
    LAS f32x2* cc = bb + 64 * 16;
    const int tid = opaque_tid();
    const float* a_re = a.in[6] + ((size_t)layer * 64 + g) * 64; const float* a_im = a.in[7] + ((size_t)layer * 64 + g) * 64;
    const float dt = expf(a.in[8][layer * 64 + g]);
    for (int idx = tid; idx < 64 * 17; idx += NTHREADS) {
        const int p = idx / 17, d = idx % 17;
        const float mag = expf(a_re[p] * dt * (float)d), ang = a_im[p] * dt * (float)d;
        float s, c; sincosf(ang, &s, &c);
        pw[idx] = (f32x2){mag * c, mag * s};
    }
    const float* b_re = a.in[9] + ((size_t)layer * 64 + g) * 1024; const float* b_im = a.in[10] + ((size_t)layer * 64 + g) * 1024;
    const float* c_re = a.in[11] + ((size_t)layer * 64 + g) * 1024; const float* c_im = a.in[12] + ((size_t)layer * 64 + g) * 1024;
    for (int idx = tid; idx < 1024; idx += NTHREADS) {
        const int p = idx >> 4;
        const float lr = a_re[p], li = a_im[p];
        const float mag = expf(lr * dt), ang = li * dt; float s, c; sincosf(ang, &s, &c);
        const float nr = mag * c - 1.0f, ni = mag * s;
        const float den = 1.0f / (lr * lr + li * li);
        const cplx f = {(nr * lr + ni * li) * den, (ni * lr - nr * li) * den};
        const cplx r = cmul(f, (cplx){b_re[idx], b_im[idx]});
        bb[idx] = (f32x2){r.re, r.im};
        cc[idx] = (f32x2){c_re[idx], c_im[idx]};
    }
    __syncthreads();
    unsigned char* tbl = a.ws + WS_TBL + ((size_t)layer * 64 + g) * TBL_STRIDE;
    for (int idx = tid; idx < 16 * 64; idx += NTHREADS) {
        const int delta = idx >> 6, l = idx & 63, c1 = l & 15, q4 = l >> 4, d = delta - (q4 >> 1);
        float v[8];
#pragma unroll
        for (int j = 0; j < 8; ++j) v[j] = 0.f;
        if (d >= 0) {
            for (int p = 0; p < 64; ++p) {
                const f32x2 cw = cc[c1 * 64 + p], pp = pw[p * 17 + d];
                const cplx t = cmul((cplx){cw.x, cw.y}, (cplx){pp.x, pp.y});
#pragma unroll
                for (int j = 0; j < 8; ++j) { const f32x2 bw = bb[p * 16 + 8 * (q4 & 1) + j]; v[j] += t.re * bw.x - t.im * bw.y; }
            }
        }
        u32x4 w; w.x = cvt_pk_bf16(v[0], v[1]); w.y = cvt_pk_bf16(v[2], v[3]); w.z = cvt_pk_bf16(v[4], v[5]); w.w = cvt_pk_bf16(v[6], v[7]);
        *(u32x4*)(tbl + TBL_K + (size_t)idx * 16) = w;
    }
    for (int idx = tid; idx < 64 * 64; idx += NTHREADS) {
        const int f = idx >> 6, l = idx & 63, rt = f >> 3, ks = f & 7, q4 = l >> 4, rho = 16 * rt + (l & 15), p = rho & 63, im = rho >> 6;
        const int k0 = 32 * ks + 8 * q4, jpos = k0 >> 4, c20 = k0 & 15;
        const f32x2 pp = pw[p * 17 + (15 - jpos)];
        float v[8];
#pragma unroll
        for (int j = 0; j < 8; ++j) { const f32x2 bw = bb[p * 16 + c20 + j]; const cplx t = cmul((cplx){pp.x, pp.y}, (cplx){bw.x, bw.y}); v[j] = im ? t.im : t.re; }
        u32x4 w; w.x = cvt_pk_bf16(v[0], v[1]); w.y = cvt_pk_bf16(v[2], v[3]); w.z = cvt_pk_bf16(v[4], v[5]); w.w = cvt_pk_bf16(v[6], v[7]);
        *(u32x4*)(tbl + TBL_M + (size_t)idx * 16) = w;
    }
    for (int idx = tid; idx < 64 * 64; idx += NTHREADS) {
        const int f = idx >> 6, l = idx & 63, i = f >> 2, ks = f & 3, q4 = l >> 4, c1 = l & 15;
        const int s0 = 32 * ks + 8 * q4;
        float v[8];
#pragma unroll
        for (int j = 0; j < 8; ++j) { const int sg = s0 + j, p = sg & 63; const f32x2 cw = cc[c1 * 64 + p], pp = pw[p * 17 + i + 1];
            const cplx t = cmul((cplx){cw.x, cw.y}, (cplx){pp.x, pp.y}); v[j] = (sg >> 6) ? -t.im : t.re; }
        u32x4 w; w.x = cvt_pk_bf16(v[0], v[1]); w.y = cvt_pk_bf16(v[2], v[3]); w.z = cvt_pk_bf16(v[4], v[5]); w.w = cvt_pk_bf16(v[6], v[7]);
        *(u32x4*)(tbl + TBL_N + (size_t)idx * 16) = w;
    }
    if (tid < 64) *(f32x2*)(tbl + TBL_A16 + tid * 8) = pw[tid * 17 + 16];
    __syncthreads();
}

__device__ __forceinline__ void row_norm_store(const f32x4 (&v)[4], float ssq, int lane, const float* g0, bf16_t* o0) {
    const float rstd = 1.0f / sqrtf(ssq * (1.0f / D) + RMS_EPS);
#pragma unroll
    for (int j = 0; j < 4; ++j) {
        const int c = 4 * lane + 256 * j;
        f32x4 g = {1.f, 1.f, 1.f, 1.f}; if (g0) g = *(const f32x4*)(g0 + c);
        u32x2 w; w.x = cvt_pk_bf16(v[j][0] * rstd * g[0], v[j][1] * rstd * g[1]); w.y = cvt_pk_bf16(v[j][2] * rstd * g[2], v[j][3] * rstd * g[3]);
        *(u32x2*)(o0 + c) = w;
    }
}
__device__ __forceinline__ void phase_prep(CArgs& a, LAS unsigned char* lds) {
    if (opaque_bid() < 128) s5_tables(a, opaque_bid() >> 6, opaque_bid() & 63, lds);
    convert_weights(a, lds);
    const int lane = opaque_tid() & 63, gw = opaque_bid() * 8 + (opaque_tid() >> 6);
    bf16_t* U = (bf16_t*)(a.ws + WS_U);
    for (int row = gw; row < RT; row += GRID * 8) {
        const float* src = row < NREAL ? a.in[0] + (size_t)row * D : a.in[1] + (size_t)(row - NREAL) * D;
        f32x4 v[4]; float ssq = 0.f;
#pragma unroll
        for (int j = 0; j < 4; ++j) { v[j] = *(const f32x4*)(src + 4 * lane + 256 * j); ssq += v[j][0] * v[j][0] + v[j][1] * v[j][1] + v[j][2] * v[j][2] + v[j][3] * v[j][3]; }
        ssq = wave_sum(ssq);
        row_norm_store(v, ssq, lane, a.in[2], U + (size_t)row * D);
    }
}

constexpr int S5_CH = 528;
constexpr int S5_NCH = 129, S5_NCHP = 144;
__device__ __forceinline__ void phase_s5(CArgs& a, int layer, LAS unsigned char* lds) {
    LAS unsigned char* Ul = lds; LAS unsigned char* Sl = lds + S5_NCHP * S5_CH;
    const int tid = opaque_tid(), lane = tid & 63, w = __builtin_amdgcn_readfirstlane(tid >> 6), tc = lane & 15, q4 = lane >> 4;
    const bf16_t* U = (const bf16_t*)(a.ws + WS_U); bf16_t* Z = (bf16_t*)(a.ws + WS_Z);
    for (int ui = 0; ui < 2; ++ui) {
        const int unit = opaque_bid() * 2 + ui, b = unit >> 6, g = unit & 63;
        const unsigned char* tbl = a.ws + WS_TBL + ((size_t)layer * 64 + g) * TBL_STRIDE;
        for (int idx = tid; idx < LT * 2; idx += NTHREADS) {
            const int tok = idx >> 1, half = idx & 1;
            const u32x4 v = *(const u32x4*)(U + (size_t)row_of(b, tok) * D + 16 * g + 8 * half);
            *(LAS u32x4*)(Ul + (tok >> 4) * S5_CH + (tok & 15) * 32 + half * 16) = v;
        }
        __syncthreads();
        {
            bf16x8 mf[8];
#pragma unroll
            for (int ks = 0; ks < 8; ++ks) mf[ks] = as_bf16x8(*(const u32x4*)(tbl + TBL_M + ((size_t)(w * 8 + ks) * 64 + lane) * 16));
#pragma unroll 1
            for (int cg = 0; cg < 9; ++cg) {
                const int n = 16 * cg + tc;
                f32x4 acc = {0.f, 0.f, 0.f, 0.f};
#pragma unroll
                for (int ks = 0; ks < 8; ++ks) { const bf16x8 ub = *(LAS bf16x8*)(Ul + n * S5_CH + ks * 64 + q4 * 16); acc = mfma16(mf[ks], ub, acc); }
                *(LAS f32x4*)(Sl + n * S5_CH + (16 * w + 4 * q4) * 4) = acc;
            }
        }
        __syncthreads();
        if (w == 0) {
            const f32x2 a16 = *(const f32x2*)(tbl + TBL_A16 + lane * 8);
            float sr = 0.f, si = 0.f;
#pragma unroll 1
            for (int nb = 0; nb < 17; ++nb) {
                float xr[8], xi[8];
#pragma unroll
                for (int j = 0; j < 8; ++j) { xr[j] = *(LAS float*)(Sl + (nb * 8 + j) * S5_CH + lane * 4); xi[j] = *(LAS float*)(Sl + (nb * 8 + j) * S5_CH + 256 + lane * 4); }
                asm volatile("s_waitcnt lgkmcnt(0)" ::: "memory");
#pragma unroll
                for (int j = 0; j < 8; ++j) {
                    const unsigned pr = cvt_pk_bf16(sr, si);
                    *(LAS unsigned short*)(Sl + (nb * 8 + j) * S5_CH + lane * 2) = (unsigned short)(pr & 0xffffu);
                    *(LAS unsigned short*)(Sl + (nb * 8 + j) * S5_CH + 128 + lane * 2) = (unsigned short)(pr >> 16);
                    const float nr = a16.x * sr - a16.y * si + xr[j], ni = a16.x * si + a16.y * sr + xi[j];
                    sr = nr; si = ni;
                }
                asm volatile("" ::: "memory");
            }
        }
        __syncthreads();
        {
            const int i0 = w, i1 = 15 - w;
            bf16x8 kf0[8], kf1[8], nf0[4], nf1[4];
#pragma unroll
            for (int jj = 0; jj < 8; ++jj) {
                const int d0 = i0 - 2 * jj, d1 = i1 - 2 * jj;
                kf0[jj] = as_bf16x8(*(const u32x4*)(tbl + TBL_K + ((size_t)(d0 >= 0 ? d0 : 0) * 64 + lane) * 16));
                kf1[jj] = as_bf16x8(*(const u32x4*)(tbl + TBL_K + ((size_t)(d1 >= 0 ? d1 : 0) * 64 + lane) * 16));
            }
#pragma unroll
            for (int ks = 0; ks < 4; ++ks) {
                nf0[ks] = as_bf16x8(*(const u32x4*)(tbl + TBL_N + ((size_t)(i0 * 4 + ks) * 64 + lane) * 16));
                nf1[ks] = as_bf16x8(*(const u32x4*)(tbl + TBL_N + ((size_t)(i1 * 4 + ks) * 64 + lane) * 16));
            }
            const f32x4 dsk = *(const f32x4*)(a.in[13] + (size_t)layer * D + 16 * g + 4 * q4);
#pragma unroll 1
            for (int cg = 0; cg < 9; ++cg) {
                const int n = 16 * cg + tc;
                f32x4 acc0 = {0.f, 0.f, 0.f, 0.f}, acc1 = {0.f, 0.f, 0.f, 0.f};
#pragma unroll
                for (int jj = 0; jj < 8; ++jj) {
                    const bf16x8 ub = *(LAS bf16x8*)(Ul + n * S5_CH + jj * 64 + q4 * 16);
                    if (2 * jj <= i0) acc0 = mfma16(kf0[jj], ub, acc0);
                    if (2 * jj <= i1) acc1 = mfma16(kf1[jj], ub, acc1);
                }
#pragma unroll
                for (int ks = 0; ks < 4; ++ks) {
                    const bf16x8 sb = *(LAS bf16x8*)(Sl + n * S5_CH + ks * 64 + q4 * 16);
                    acc0 = mfma16(nf0[ks], sb, acc0); acc1 = mfma16(nf1[ks], sb, acc1);
                }
                if (n < S5_NCH && (n > 0 || b == 0)) {
#pragma unroll
                    for (int h = 0; h < 2; ++h) {
                        const int i = h ? i1 : i0; const f32x4 y = h ? acc1 : acc0;
                        const u32x2 uw = *(LAS u32x2*)(Ul + n * S5_CH + i * 32 + q4 * 8);
                        const float z0 = gelu_tanh(y[0] + dsk[0] * bf16_lo(uw.x)), z1 = gelu_tanh(y[1] + dsk[1] * bf16_hi(uw.x));
                        const float z2 = gelu_tanh(y[2] + dsk[2] * bf16_lo(uw.y)), z3 = gelu_tanh(y[3] + dsk[3] * bf16_hi(uw.y));
                        u32x2 o; o.x = cvt_pk_bf16(z0, z1); o.y = cvt_pk_bf16(z2, z3);
                        *(u32x2*)(Z + (size_t)row_of(b, 16 * n + i) * D + 16 * g + 4 * q4) = o;
                    }
                }
            }
        }
        __syncthreads();
    }
}

__device__ __forceinline__ float ssq4(f32x4 h) { return h[0] * h[0] + h[1] * h[1] + h[2] * h[2] + h[3] * h[3]; }
__device__ __forceinline__ int gwave() { return opaque_bid() * 8 + (opaque_tid() >> 6); }
template <int NACC> __device__ __forceinline__ bool meta_block(LAS unsigned char* lds, const bf16_t* Am, const bf16_t* const (&brow)[NACC], int K, f32x4 (&out)[NACC]) {
    const int tid = opaque_tid(), lane = tid & 63, wid = tid >> 6, fr = lane & 15, fq = lane >> 4, ksl = K / 8;
#pragma unroll
    for (int i = 0; i < NACC; ++i) {
        f32x4 acc = {0.f, 0.f, 0.f, 0.f};
        const bf16_t* ap = Am + (size_t)fr * K + wid * ksl + 8 * fq; const bf16_t* bp = brow[i] + (size_t)fr * K + wid * ksl + 8 * fq;
        for (int ks = 0; ks < ksl / 32; ++ks) acc = mfma16(as_bf16x8(*(const u32x4*)(bp + 32 * ks)), as_bf16x8(*(const u32x4*)(ap + 32 * ks)), acc);
        ((LAS f32x4*)lds)[(wid * NACC + i) * 64 + lane] = acc;
    }
    __syncthreads();
    if (wid == 0) {
#pragma unroll
        for (int i = 0; i < NACC; ++i) { f32x4 s = {0.f, 0.f, 0.f, 0.f};
#pragma unroll
            for (int w = 0; w < 8; ++w) s += ((LAS f32x4*)lds)[(w * NACC + i) * 64 + lane];
            out[i] = s; }
    }
    __syncthreads();
    return wid == 0;
}

__device__ __forceinline__ void epi_glu(const GemmDesc& g, const f32x4 (&acc)[2][2][4][2], const Unit& u, int wr, int wc, int fr, int fq) {
    { const float* res = g.res; float* Hout = g.Hout; float* SSQ = g.SSQ;
#pragma unroll
        for (int ai = 0; ai < 2; ++ai)
#pragma unroll
            for (int m = 0; m < 4; ++m) {
                const int row = u.pm * BM + ai * HALF + wr * 64 + m * 16 + fr; const size_t off = (size_t)row * D + u.pn * 128 + wc * 32 + 4 * fq;
                float ss = 0.f;
#pragma unroll
                for (int n = 0; n < 2; ++n) {
                    const f32x4 v = acc[ai][0][m][n], gt = acc[ai][1][m][n]; f32x4 h = *(const f32x4*)(res + off + 16 * n);
                    h[0] += v[0] * sigmoidf_(gt[0]); h[1] += v[1] * sigmoidf_(gt[1]); h[2] += v[2] * sigmoidf_(gt[2]); h[3] += v[3] * sigmoidf_(gt[3]);
                    *(f32x4*)(Hout + off + 16 * n) = h; ss += ssq4(h);
                }
                ss = quad_sum(ss);
                if (fq == 0) SSQ[(size_t)row * 32 + u.pn * 4 + wc] = ss;
                asm volatile("" ::: "memory");
            }
    }
}
__device__ __forceinline__ void phase_glu(CArgs& a, int layer, bool dry, LAS unsigned char* lds, GemmDesc& g) {
    const bf16_t* Zb = (const bf16_t*)(a.ws + WS_Z); const bf16_t* W = (const bf16_t*)(a.ws + WS_WGLU) + (size_t)layer * 2048 * 1024;
    float* H = (float*)(a.ws + WS_H); float* Hout = (float*)(a.ws + (dry ? WS_DUMH : WS_H)); float* SSQ = (float*)(a.ws + (dry ? WS_DUMSSQ : WS_SSQ));
    const float* res = layer == 0 ? a.in[0] : H; const float* resm = layer == 0 ? a.in[1] : H + (size_t)NREAL * D;
    if (opaque_bid() < 32) {
        const int lane = opaque_tid() & 63, fr = lane & 15, fq = lane >> 4, task = opaque_bid();
        const int c0 = 32 * task, rv = 256 * (c0 >> 7) + (c0 & 127);
        const bf16_t* const br[4] = {W + (size_t)rv * D, W + (size_t)(rv + 16) * D, W + (size_t)(rv + 128) * D, W + (size_t)(rv + 144) * D};
        f32x4 o[4];
        if (meta_block<4>(lds, Zb + (size_t)NREAL * D, br, D, o)) {
            float ss = 0.f;
#pragma unroll
            for (int n = 0; n < 2; ++n) {
                const f32x4 v = o[n], gt = o[2 + n];
                f32x4 h = *(const f32x4*)(resm + (size_t)fr * D + c0 + 16 * n + 4 * fq);
                h[0] += v[0] * sigmoidf_(gt[0]); h[1] += v[1] * sigmoidf_(gt[1]); h[2] += v[2] * sigmoidf_(gt[2]); h[3] += v[3] * sigmoidf_(gt[3]);
                *(f32x4*)(Hout + (size_t)(NREAL + fr) * D + c0 + 16 * n + 4 * fq) = h; ss += ssq4(h);
            }
            ss = quad_sum(ss);
            if (fq == 0) SSQ[(size_t)(NREAL + fr) * 32 + task] = ss;
        }
    }
    g.kind = EPI_GLU; g.K = D; g.perm = 0; g.gather = 0; g.moe = 0; g.nM = NREAL / BM; g.nN = 2048 / BM; g.nwg = g.nM * g.nN; g.A = (const char*)Zb; g.Bt = (const char*)W;
    g.tstepA = g.tstepB = (size_t)BM * D * 2; g.wstride = 0; g.res = res; g.Hout = Hout; g.SSQ = SSQ;
}

__device__ __forceinline__ void epi_oproj(const GemmDesc& g, const f32x4 (&acc)[2][2][4][2], const Unit& u, int wr, int wc, int fr, int fq) {
    { const float* res = g.res; float* Hout = g.Hout; float* SSQ = g.SSQ; const float* bias = g.bias;
#pragma unroll
        for (int ai = 0; ai < 2; ++ai)
#pragma unroll
            for (int m = 0; m < 4; ++m) {
                const int row = u.pm * BM + ai * HALF + wr * 64 + m * 16 + fr;
#pragma unroll
                for (int bj = 0; bj < 2; ++bj) {
                    const int c0 = u.pn * BM + bj * HALF + wc * 32 + 4 * fq; const size_t off = (size_t)row * D + c0;
                    float ss = 0.f;
#pragma unroll
                    for (int n = 0; n < 2; ++n) { f32x4 h = *(const f32x4*)(res + off + 16 * n); h += acc[ai][bj][m][n] + *(const f32x4*)(bias + c0 + 16 * n); *(f32x4*)(Hout + off + 16 * n) = h; ss += ssq4(h); }
                    ss = quad_sum(ss);
                    if (fq == 0) SSQ[(size_t)row * 32 + u.pn * 8 + bj * 4 + wc] = ss;
                    asm volatile("" ::: "memory");
                }
            }
    }
}
__device__ __forceinline__ void phase_oproj(CArgs& a, int j, bool dry, LAS unsigned char* lds, GemmDesc& g) {
    const bf16_t* Ob = (const bf16_t*)(a.ws + WS_Z); const bf16_t* W = (const bf16_t*)(a.ws + WS_WO) + (size_t)j * 1024 * 1024;
    float* H = (float*)(a.ws + WS_H); float* Hout = (float*)(a.ws + (dry ? WS_DUMH : WS_H)); float* SSQ = (float*)(a.ws + (dry ? WS_DUMSSQ : WS_SSQ));
    const float* bo = a.in[21] + (size_t)j * D;
    if (opaque_bid() < 32) {
        const int lane = opaque_tid() & 63, fr = lane & 15, fq = lane >> 4, task = opaque_bid(), c0 = 32 * task;
        const bf16_t* const br[2] = {W + (size_t)c0 * D, W + (size_t)(c0 + 16) * D};
        f32x4 o[2];
        if (meta_block<2>(lds, Ob + (size_t)NREAL * D, br, D, o)) {
            float ss = 0.f;
#pragma unroll
            for (int n = 0; n < 2; ++n) {
                const size_t off = (size_t)(NREAL + fr) * D + c0 + 16 * n + 4 * fq;
                f32x4 h = *(const f32x4*)(H + off); h += o[n] + *(const f32x4*)(bo + c0 + 16 * n + 4 * fq); *(f32x4*)(Hout + off) = h; ss += ssq4(h);
            }
            ss = quad_sum(ss);
            if (fq == 0) SSQ[(size_t)(NREAL + fr) * 32 + task] = ss;
        }
    }
    g.kind = EPI_OPROJ; g.K = D; g.perm = 0; g.gather = 0; g.moe = 0; g.nM = NREAL / BM; g.nN = 1024 / BM; g.nwg = g.nM * g.nN; g.A = (const char*)Ob; g.Bt = (const char*)W;
    g.tstepA = g.tstepB = (size_t)BM * D * 2; g.wstride = 0; g.res = H; g.Hout = Hout; g.SSQ = SSQ; g.bias = bo;
}

__device__ __forceinline__ void kvq_store8(const GemmDesc& g, int row, int c, const float (&v)[8]) {
    if (c < 256) {
        const float* b = g.bias + c; u32x4 w; w.x = cvt_pk_bf16(v[0] + b[0], v[1] + b[1]); w.y = cvt_pk_bf16(v[2] + b[2], v[3] + b[3]); w.z = cvt_pk_bf16(v[4] + b[4], v[5] + b[5]); w.w = cvt_pk_bf16(v[6] + b[6], v[7] + b[7]);
        *(u32x4*)(g.O1 + (size_t)row * 256 + c) = w;
    } else if (c < 512) {
        const int cv = c - 256; const float* b = g.bias + c;
        bf16_t* vp = g.O2 + (row < NREAL ? ((size_t)(row >> 11) * 256 + cv) * SEQ + (row & (SEQ - 1)) : VT_META + (size_t)cv * 16 + (row - NREAL));
        const size_t st = row < NREAL ? SEQ : 16;
#pragma unroll
        for (int i = 0; i < 4; ++i) { const unsigned p = cvt_pk_bf16(v[2 * i] + b[2 * i], v[2 * i + 1] + b[2 * i + 1]); vp[(size_t)(2 * i) * st] = (bf16_t)(p & 0xffffu); vp[(size_t)(2 * i + 1) * st] = (bf16_t)(p >> 16); }
    } else {
        const int cq = c - 512; const float* b = g.bias2 + cq;
        u32x4 w; w.x = cvt_pk_bf16((v[0] + b[0]) * 0.125f, (v[1] + b[1]) * 0.125f); w.y = cvt_pk_bf16((v[2] + b[2]) * 0.125f, (v[3] + b[3]) * 0.125f);
        w.z = cvt_pk_bf16((v[4] + b[4]) * 0.125f, (v[5] + b[5]) * 0.125f); w.w = cvt_pk_bf16((v[6] + b[6]) * 0.125f, (v[7] + b[7]) * 0.125f);
        *(u32x4*)(g.O3 + (size_t)row * D + cq) = w;
    }
}
__device__ __forceinline__ void epi_kvq(const GemmDesc& g, const f32x4 (&acc)[2][2][4][2], const Unit& u, int wr, int wc, int fr, int fq) {
    { const int cbase = g.cbase;
#pragma unroll
        for (int ai = 0; ai < 2; ++ai)
#pragma unroll
            for (int m = 0; m < 4; ++m) {
                const int row = u.pm * BM + ai * HALF + wr * 64 + m * 16 + fr;
#pragma unroll
                for (int bj = 0; bj < 2; ++bj) {
                    const int c = cbase + u.pn * BM + bj * HALF + wc * 32 + 8 * fq;
                    const f32x4 v0 = acc[ai][bj][m][0], v1 = acc[ai][bj][m][1];
                    const float v[8] = {v0[0], v0[1], v0[2], v0[3], v1[0], v1[1], v1[2], v1[3]};
                    kvq_store8(g, row, c, v);
                    asm volatile("" ::: "memory");
                }
            }
    }
}
__device__ __forceinline__ void phase_kvq_q(CArgs& a, int jq, LAS unsigned char* lds, GemmDesc& g) {
    const bf16_t* Ub = (const bf16_t*)(a.ws + WS_U); const bf16_t* W = jq == 0 ? (const bf16_t*)(a.ws + WS_WKVQ) : (const bf16_t*)(a.ws + WS_WQ1);
    const int N = jq == 0 ? 1536 : 1024, cbase = jq == 0 ? 0 : 512;
    if (opaque_bid() < N / 32) {
        const int lane = opaque_tid() & 63, fr = lane & 15, fq = lane >> 4, task = opaque_bid();
        const bf16_t* const br[2] = {W + (size_t)(32 * task) * D, W + (size_t)(32 * task + 16) * D};
        f32x4 o[2];
        if (meta_block<2>(lds, Ub + (size_t)NREAL * D, br, D, o)) {
#pragma unroll
            for (int h = 0; h < 2; ++h) {
                const int c = cbase + 32 * task + 16 * h + 4 * fq; const f32x4 v = o[h]; const int row = NREAL + fr;
                if (c < 256) { const float* b = a.in[16] + c; u32x2 w; w.x = cvt_pk_bf16(v[0] + b[0], v[1] + b[1]); w.y = cvt_pk_bf16(v[2] + b[2], v[3] + b[3]); *(u32x2*)((bf16_t*)(a.ws + WS_K) + (size_t)row * 256 + c) = w; }
                else if (c < 512) { const int cv = c - 256; const float* b = a.in[16] + c; bf16_t* vp = (bf16_t*)(a.ws + WS_VT) + VT_META + (size_t)cv * 16 + fr;
                    const unsigned p0 = cvt_pk_bf16(v[0] + b[0], v[1] + b[1]), p1 = cvt_pk_bf16(v[2] + b[2], v[3] + b[3]);
                    vp[0] = (bf16_t)(p0 & 0xffffu); vp[16] = (bf16_t)(p0 >> 16); vp[32] = (bf16_t)(p1 & 0xffffu); vp[48] = (bf16_t)(p1 >> 16); }
                else { const int cq = c - 512; const float* b = a.in[18] + (size_t)jq * D + cq; u32x2 w; w.x = cvt_pk_bf16((v[0] + b[0]) * 0.125f, (v[1] + b[1]) * 0.125f); w.y = cvt_pk_bf16((v[2] + b[2]) * 0.125f, (v[3] + b[3]) * 0.125f);
                    *(u32x2*)((bf16_t*)(a.ws + WS_Q) + (size_t)row * D + cq) = w; }
            }
        }
    }
    g.kind = EPI_KVQ; g.K = D; g.perm = 1; g.gather = 0; g.moe = 0; g.nM = NREAL / BM; g.nN = N / BM; g.nwg = g.nM * g.nN; g.A = (const char*)Ub; g.Bt = (const char*)W;
    g.tstepA = g.tstepB = (size_t)BM * D * 2; g.wstride = 0; g.bias = a.in[16]; g.bias2 = a.in[18] + (size_t)jq * D; g.O1 = (bf16_t*)(a.ws + WS_K); g.O2 = (bf16_t*)(a.ws + WS_VT); g.O3 = (bf16_t*)(a.ws + WS_Q);
    g.jq = jq; g.cbase = cbase;
}

__device__ __forceinline__ void moe_scan(const int* cnt, LAS int* sh) {
    if (opaque_tid() == 0) { int acc = 0; for (int e = 0; e < 32; ++e) { sh[e] = acc; acc += (cnt[e] + 255) >> 8; } sh[32] = acc; }
    __syncthreads();
}
__device__ __forceinline__ void epi_moe1(const GemmDesc& g, LAS unsigned char* lds, const f32x4 (&acc)[2][2][4][2], const Unit& u, int wr, int wc, int fr, int fq) {
    { bf16_t* HB = g.O1;
        const LAS int* tabt = (const LAS int*)(lds + LDS_TABT) + u.slot * 256;
#pragma unroll
        for (int ai = 0; ai < 2; ++ai)
#pragma unroll
            for (int m = 0; m < 4; ++m) {
                const int rl = ai * HALF + wr * 64 + m * 16 + fr;
                if (tabt[rl] >= 0) {
                    const f32x4 g0 = acc[ai][0][m][0], g1 = acc[ai][0][m][1], u0 = acc[ai][1][m][0], u1 = acc[ai][1][m][1];
                    u32x4 w; w.x = cvt_pk_bf16(g0[0] * sigmoidf_(g0[0]) * u0[0], g0[1] * sigmoidf_(g0[1]) * u0[1]); w.y = cvt_pk_bf16(g0[2] * sigmoidf_(g0[2]) * u0[2], g0[3] * sigmoidf_(g0[3]) * u0[3]);
                    w.z = cvt_pk_bf16(g1[0] * sigmoidf_(g1[0]) * u1[0], g1[1] * sigmoidf_(g1[1]) * u1[1]); w.w = cvt_pk_bf16(g1[2] * sigmoidf_(g1[2]) * u1[2], g1[3] * sigmoidf_(g1[3]) * u1[3]);
                    *(u32x4*)(HB + ((size_t)u.pm * 256 + rl) * DEXP + u.pn * 128 + wc * 32 + 8 * fq) = w;
                }
                asm volatile("" ::: "memory");
            }
    }
}
__device__ __forceinline__ void phase_moe1(CArgs& a, int layer, LAS unsigned char* lds, GemmDesc& g) {
    LAS int* sh = (LAS int*)(lds + LDS_SH);
    const int* cnt = (const int*)(a.ws + WS_CTL) + CW_CNT + layer * 32;
    moe_scan(cnt, sh);
    g.kind = EPI_MOE1; g.K = D; g.perm = 1; g.gather = 1; g.moe = 1; g.npn = 4; g.nwg = sh[32] * 4; g.nM = 0; g.nN = 4;
    g.A = (const char*)(a.ws + WS_XN); g.Bt = (const char*)(a.ws + WS_W1) + (size_t)layer * 32 * 1024 * 1024 * 2; g.wstride = (size_t)1024 * 1024 * 2;
    g.tstepA = 0; g.tstepB = (size_t)256 * 1024 * 2; g.cnt = cnt; g.LTOK = (const int*)(a.ws + WS_LTOK); g.LGATE = (const float*)(a.ws + WS_LGATE); g.O1 = (bf16_t*)(a.ws + WS_HB);
}
__device__ __forceinline__ void epi_moe2(const GemmDesc& g, LAS unsigned char* lds, const f32x4 (&acc)[2][2][4][2], const Unit& u, int wr, int wc, int fr, int fq) {
    { bf16_t* YB = g.O1;
        const LAS int* tabt = (const LAS int*)(lds + LDS_TABT) + u.slot * 256; const LAS float* tabg = (const LAS float*)(lds + LDS_TABG) + u.slot * 256;
#pragma unroll
        for (int ai = 0; ai < 2; ++ai)
#pragma unroll
            for (int m = 0; m < 4; ++m) {
                const int rl = ai * HALF + wr * 64 + m * 16 + fr; const int rt = tabt[rl];
                if (rt >= 0) {
                    const float gs = tabg[rl];
                    bf16_t* yp = YB + ((size_t)(rt & 0x3fffffff) * 2 + (rt >> 30)) * D + u.pn * BM + wc * 32 + 8 * fq;
#pragma unroll
                    for (int bj = 0; bj < 2; ++bj) { const f32x4 v0 = acc[ai][bj][m][0] * gs, v1 = acc[ai][bj][m][1] * gs;
                        u32x4 w; w.x = cvt_pk_bf16(v0[0], v0[1]); w.y = cvt_pk_bf16(v0[2], v0[3]); w.z = cvt_pk_bf16(v1[0], v1[1]); w.w = cvt_pk_bf16(v1[2], v1[3]);
                        *(u32x4*)(yp + bj * HALF) = w; }
                }
                asm volatile("" ::: "memory");
            }
    }
}
__device__ __forceinline__ void phase_moe2(CArgs& a, int layer, LAS unsigned char* lds, GemmDesc& g) {
    LAS int* sh = (LAS int*)(lds + LDS_SH);
    const int* cnt = (const int*)(a.ws + WS_CTL) + CW_CNT + layer * 32;
    moe_scan(cnt, sh);
    g.kind = EPI_MOE2; g.K = DEXP; g.perm = 1; g.gather = 0; g.moe = 1; g.npn = 4; g.nwg = sh[32] * 4; g.nM = 0; g.nN = 4;
    g.A = (const char*)(a.ws + WS_HB); g.Bt = (const char*)(a.ws + WS_W2) + (size_t)layer * 32 * 1024 * 512 * 2; g.wstride = (size_t)1024 * 512 * 2;
    g.tstepA = (size_t)256 * DEXP * 2; g.tstepB = (size_t)256 * DEXP * 2; g.cnt = cnt; g.LTOK = (const int*)(a.ws + WS_LTOK); g.LGATE = (const float*)(a.ws + WS_LGATE); g.O1 = (bf16_t*)(a.ws + WS_YB);
}
__device__ __forceinline__ void gemm_epilogue(const GemmDesc& g, LAS unsigned char* lds, const f32x4 (&acc)[2][2][4][2], const Unit& u, int wr, int wc, int fr, int fq) {
    asm volatile("" : "+v"(fr), "+v"(fq));
    switch (g.kind) {
        case EPI_GLU: epi_glu(g, acc, u, wr, wc, fr, fq); break;
        case EPI_OPROJ: epi_oproj(g, acc, u, wr, wc, fr, fq); break;
        case EPI_KVQ: epi_kvq(g, acc, u, wr, wc, fr, fq); break;
        case EPI_MOE1: epi_moe1(g, lds, acc, u, wr, wc, fr, fq); break;
        default: epi_moe2(g, lds, acc, u, wr, wc, fr, fq); break;
    }
}

__device__ __forceinline__ void phase_attn(CArgs& a, int j, LAS unsigned char* lds) {
    const int lane = opaque_tid() & 63, wid = opaque_tid() >> 6, tc = lane & 15, q4 = lane >> 4;
    const bf16_t* Q = (const bf16_t*)(a.ws + WS_Q); const bf16_t* K = (const bf16_t*)(a.ws + WS_K); const bf16_t* VT = (const bf16_t*)(a.ws + WS_VT);
    bf16_t* O = (bf16_t*)(a.ws + WS_Z);
    constexpr int NU_REAL = NB * 4 * 64;
    for (int unit = opaque_bid(); unit < NU_REAL + 4; unit += GRID) {
        int b, kvh, l0;
        const int gq = wid & 3, st = wid >> 2;
        if (unit < NU_REAL) { const int qt = unit & 63; kvh = (unit >> 6) & 3; b = unit >> 8; l0 = NMETA + qt * 32 + st * 16; }
        else { kvh = unit - NU_REAL; b = 0; l0 = 0; if (st) continue; }
        const int hq = kvh * 4 + gq;
        const int t16 = l0 >> 4, l = l0 + tc;
        const float sink = a.in[19][j * 16 + hq];
        const size_t qrow = (size_t)row_of(b, l);
        const bf16_t* qp = Q + qrow * D + hq * 64 + 8 * q4;
        const bf16x8 qf0 = as_bf16x8(*(const u32x4*)qp), qf1 = as_bf16x8(*(const u32x4*)(qp + 32));
        const int kb_lo = t16 == 0 ? 1 : (t16 - 8 > 1 ? t16 - 8 : 1);
        const int nband = t16 == 0 ? 0 : t16 - kb_lo + 1;
        f32x4 s[10];
#pragma unroll
        for (int bi = 0; bi < 10; ++bi) {
            s[bi] = (f32x4){-1e30f, -1e30f, -1e30f, -1e30f};
            if (bi <= nband) {
                const int kb = bi == 0 ? 0 : kb_lo + bi - 1;
                const size_t krow = bi == 0 ? (size_t)(NREAL + tc) : (size_t)(b * SEQ + 16 * (kb - 1) + tc);
                const bf16_t* kp = K + krow * 256 + kvh * 64 + 8 * q4;
                const bf16x8 kf0 = as_bf16x8(*(const u32x4*)kp), kf1 = as_bf16x8(*(const u32x4*)(kp + 32));
                f32x4 acc = {0.f, 0.f, 0.f, 0.f};
                acc = mfma16(kf0, qf0, acc); acc = mfma16(kf1, qf1, acc);
#pragma unroll
                for (int r = 0; r < 4; ++r) {
                    const int key = 16 * kb + 4 * q4 + r;
                    const bool ok = bi == 0 ? (key <= l) : (key <= l && key >= l - 127);
                    s[bi][r] = ok ? acc[r] : -1e30f;
                }
            }
        }
        float m = sink;
#pragma unroll
        for (int bi = 0; bi < 10; ++bi) m = fmaxf(m, fmaxf(fmaxf(s[bi][0], s[bi][1]), fmaxf(s[bi][2], s[bi][3])));
        m = xor32_max(xor16_max(m));
        float den = 0.f;
        unsigned pk[10][2];
#pragma unroll
        for (int bi = 0; bi < 10; ++bi) {
            float p[4];
#pragma unroll
            for (int r = 0; r < 4; ++r) { p[r] = s[bi][r] > -1e29f ? fast_exp(s[bi][r] - m) : 0.f; den += p[r]; }
            pk[bi][0] = cvt_pk_bf16(p[0], p[1]); pk[bi][1] = cvt_pk_bf16(p[2], p[3]);
        }
        den = quad_sum(den);
        den += fast_exp(sink - m);
        const float inv = 1.0f / den;
        f32x4 o[4];
#pragma unroll
        for (int dt = 0; dt < 4; ++dt) o[dt] = (f32x4){0.f, 0.f, 0.f, 0.f};
        const bf16_t* vreal = VT + ((size_t)(b * 4 + kvh) * 64 + tc) * SEQ + 4 * q4;
        const bf16_t* vmeta = VT + VT_META + ((size_t)kvh * 64 + tc) * 16 + 4 * q4;
#pragma unroll
        for (int pp = 0; pp < 5; ++pp) {
            if (2 * pp <= nband) {
                const int biA = 2 * pp, biB = 2 * pp + 1;
                const int kbB = biB <= nband ? kb_lo + biB - 1 : (kb_lo > 0 ? kb_lo : 1);
                const int kbA = biA == 0 ? 0 : kb_lo + biA - 1;
                u32x4 pw; pw.x = pk[biA][0]; pw.y = pk[biA][1]; pw.z = pk[biB][0]; pw.w = pk[biB][1];
                const bf16x8 pf = as_bf16x8(pw);
#pragma unroll
                for (int dt = 0; dt < 4; ++dt) {
                    const u32x2 va = biA == 0 ? *(const u32x2*)(vmeta + (size_t)dt * 16 * 16) : *(const u32x2*)(vreal + (size_t)dt * 16 * SEQ + 16 * (kbA - 1));
                    const u32x2 vb = *(const u32x2*)(vreal + (size_t)dt * 16 * SEQ + 16 * (kbB - 1));
                    u32x4 vw; vw.x = va.x; vw.y = va.y; vw.z = vb.x; vw.w = vb.y;
                    o[dt] = mfma16(as_bf16x8(vw), pf, o[dt]);
                }
            }
        }
        bf16_t* op = O + qrow * D + hq * 64 + 4 * q4;
#pragma unroll
        for (int dt = 0; dt < 4; ++dt) { u32x2 w; w.x = cvt_pk_bf16(o[dt][0] * inv, o[dt][1] * inv); w.y = cvt_pk_bf16(o[dt][2] * inv, o[dt][3] * inv); *(u32x2*)(op + 16 * dt) = w; }
    }
}

__device__ __forceinline__ void phase_route(CArgs& a, int layer, bool dry, LAS unsigned char* lds) {
    LAS unsigned char* Wf = lds; LAS float* LG = (LAS float*)(lds + 98304); LAS int* hist = (LAS int*)(lds + 98304 + 24576); LAS int* hbase = hist + 32;
    const int tid = opaque_tid(), lane = tid & 63, wid = tid >> 6, tc = lane & 15, q4 = lane >> 4;
    const float* wg = a.in[22] + (size_t)layer * D * NGRP; const float* we = a.in[24] + (size_t)layer * D * NEXP;
    const float* gain = a.in[3] + (size_t)layer * D;
    for (int idx = tid; idx < 3 * 32 * 64; idx += NTHREADS) {
        const int l = idx & 63, ks = (idx >> 6) & 31, rt = idx >> 11, o = 16 * rt + (l & 15), k0 = 32 * ks + 8 * (l >> 4);
        float v[8];
#pragma unroll
        for (int jq = 0; jq < 8; ++jq) v[jq] = (o < 4 ? wg[(size_t)(k0 + jq) * NGRP + o] : (o < 36 ? we[(size_t)(k0 + jq) * NEXP + (o - 4)] : 0.f)) * gain[k0 + jq];
        u32x4 w; w.x = cvt_pk_bf16(v[0], v[1]); w.y = cvt_pk_bf16(v[2], v[3]); w.z = cvt_pk_bf16(v[4], v[5]); w.w = cvt_pk_bf16(v[6], v[7]);
        *(LAS u32x4*)(Wf + (size_t)idx * 16) = w;
    }
    if (tid < 32) hist[tid] = 0;
    __syncthreads();
    const float* H = (const float*)(a.ws + WS_H); const float* SSQ = (const float*)(a.ws + WS_SSQ); bf16_t* XN = (bf16_t*)(a.ws + WS_XN);
    int* cnt = (int*)(a.ws + WS_CTL) + (dry ? CW_DUMCNT : CW_CNT) + layer * 32; int* LTOK = (int*)(a.ws + (dry ? WS_DUMLT : WS_LTOK)); float* LGATE = (float*)(a.ws + (dry ? WS_DUMLG : WS_LGATE));
    const int tile = wid * GRID + opaque_bid();
    const bool active = tile < RT / 16;
    int e1, e2, r1, r2; float g1, g2;
    asm volatile("" : "=v"(e1), "=v"(e2), "=v"(r1), "=v"(r2), "=v"(g1), "=v"(g2));
    if (active) {
        const int row = tile * 16 + tc;
        float ss = 0.f;
        { const f32x4* sp = (const f32x4*)(SSQ + (size_t)row * 32 + 8 * q4); const f32x4 s0 = sp[0], s1 = sp[1]; ss = (s0[0] + s0[1]) + (s0[2] + s0[3]) + (s1[0] + s1[1]) + (s1[2] + s1[3]); }
        ss = quad_sum(ss);
        const float rstd = 1.0f / sqrtf(ss * (1.0f / D) + RMS_EPS);
        f32x4 acc[3];
#pragma unroll
        for (int rt = 0; rt < 3; ++rt) acc[rt] = (f32x4){0.f, 0.f, 0.f, 0.f};
        const float* hp = H + (size_t)row * D + 8 * q4; bf16_t* xp = XN + (size_t)row * D + 8 * q4;
#pragma unroll 4
        for (int ks = 0; ks < 32; ++ks) {
            const f32x4 h0 = *(const f32x4*)(hp + 32 * ks), h1 = *(const f32x4*)(hp + 32 * ks + 4);
            u32x4 xw; xw.x = cvt_pk_bf16(h0[0] * rstd, h0[1] * rstd); xw.y = cvt_pk_bf16(h0[2] * rstd, h0[3] * rstd);
            xw.z = cvt_pk_bf16(h1[0] * rstd, h1[1] * rstd); xw.w = cvt_pk_bf16(h1[2] * rstd, h1[3] * rstd);
            *(u32x4*)(xp + 32 * ks) = xw;
            const bf16x8 xf = as_bf16x8(xw);
#pragma unroll
            for (int rt = 0; rt < 3; ++rt) acc[rt] = mfma16(*(LAS bf16x8*)(Wf + ((size_t)(rt * 32 + ks) * 64 + lane) * 16), xf, acc[rt]);
        }
        LAS float* lg = LG + wid * 16 * 48;
#pragma unroll
        for (int rt = 0; rt < 3; ++rt)
#pragma unroll
            for (int r = 0; r < 4; ++r) lg[tc * 48 + 16 * rt + 4 * q4 + r] = acc[rt][r];
        asm volatile("s_waitcnt lgkmcnt(0)" ::: "memory");
        if (lane < 16) {
            const LAS float* mylg = lg + lane * 48;
            float gl[4]; int gi = 0; float gm;
#pragma unroll
            for (int i = 0; i < 4; ++i) gl[i] = mylg[i] + a.in[23][layer * NGRP + i];
            gm = gl[0];
#pragma unroll
            for (int i = 1; i < 4; ++i) if (gl[i] > gm) { gm = gl[i]; gi = i; }
            float gz = 0.f;
#pragma unroll
            for (int i = 0; i < 4; ++i) gz += expf(gl[i] - gm);
            const float pg = 1.0f / gz;
            float el[8];
#pragma unroll
            for (int i = 0; i < 8; ++i) el[i] = mylg[4 + gi * 8 + i] + a.in[25][layer * NEXP + gi * 8 + i];
            int i1 = 0; float m1 = el[0];
#pragma unroll
            for (int i = 1; i < 8; ++i) if (el[i] > m1) { m1 = el[i]; i1 = i; }
            int i2 = -1; float m2 = -3.0e38f;
#pragma unroll
            for (int i = 0; i < 8; ++i) if (i != i1 && el[i] > m2) { m2 = el[i]; i2 = i; }
            float one = 1.0f; asm volatile("" : "+v"(one));
            const float x2 = expf(m2 - m1), q1 = one / (one + x2);
            g1 = pg * q1; g2 = pg * x2 * q1; e1 = gi * 8 + i1; e2 = gi * 8 + i2;
            r1 = __hip_atomic_fetch_add(&hist[e1], 1, __ATOMIC_RELAXED, __HIP_MEMORY_SCOPE_WORKGROUP); r2 = __hip_atomic_fetch_add(&hist[e2], 1, __ATOMIC_RELAXED, __HIP_MEMORY_SCOPE_WORKGROUP);
        }
    }
    __syncthreads();
    if (tid < 32) hbase[tid] = hist[tid] ? atomicAdd(&cnt[tid], hist[tid]) : 0;
    __syncthreads();
    if (active && lane < 16) {
        const int row = tile * 16 + lane;
        const int s1 = hbase[e1] + r1, s2 = hbase[e2] + r2;
        LTOK[(size_t)e1 * RT + s1] = row; LGATE[(size_t)e1 * RT + s1] = g1;
        LTOK[(size_t)e2 * RT + s2] = row | (1 << 30); LGATE[(size_t)e2 * RT + s2] = g2;
    }
}

__device__ __forceinline__ void phase_combine(CArgs& a, int layer, bool dry) {
    const int lane = opaque_tid() & 63, gw = opaque_bid() * 8 + (opaque_tid() >> 6);
    float* H = (float*)(a.ws + WS_H); const bf16_t* YB = (const bf16_t*)(a.ws + WS_YB);
    for (int row = gw; row < RT; row += GRID * 8) {
        f32x4 v[4]; float ssq = 0.f;
        float* hp = H + (size_t)row * D; const bf16_t* y0 = YB + (size_t)row * 2 * D; const bf16_t* y1 = y0 + D;
#pragma unroll
        for (int j = 0; j < 4; ++j) {
            const int c = 4 * lane + 256 * j;
            v[j] = *(const f32x4*)(hp + c);
            const u32x2 p0 = *(const u32x2*)(y0 + c), p1 = *(const u32x2*)(y1 + c);
            v[j][0] += bf16_lo(p0.x) + bf16_lo(p1.x); v[j][1] += bf16_hi(p0.x) + bf16_hi(p1.x); v[j][2] += bf16_lo(p0.y) + bf16_lo(p1.y); v[j][3] += bf16_hi(p0.y) + bf16_hi(p1.y);
            ssq += ssq4(v[j]);
        }
        ssq = wave_sum(ssq);
        if (layer < 3) {
            if (!dry) {
#pragma unroll
                for (int j = 0; j < 4; ++j) *(f32x4*)(hp + 4 * lane + 256 * j) = v[j];
                row_norm_store(v, ssq, lane, layer == 0 ? a.in[2] + D : nullptr, (bf16_t*)(a.ws + WS_U) + (size_t)row * D);
            } else {
                float* dp = (float*)(a.ws + WS_DUMH) + (size_t)row * D;
#pragma unroll
                for (int j = 0; j < 4; ++j) *(f32x4*)(dp + 4 * lane + 256 * j) = v[j];
                row_norm_store(v, ssq, lane, layer == 0 ? a.in[2] + D : nullptr, (bf16_t*)(a.ws + WS_DUMSSQ) + (size_t)(row & 1023) * D);
            }
        } else if (row < NREAL) {
            const float rstd = 1.0f / sqrtf(ssq * (1.0f / D) + RMS_EPS);
            float* op = a.out + (size_t)row * D;
#pragma unroll
            for (int j = 0; j < 4; ++j) { const int c = 4 * lane + 256 * j; const f32x4 g = *(const f32x4*)(a.in[5] + c);
                f32x4 o; o[0] = v[j][0] * rstd * g[0]; o[1] = v[j][1] * rstd * g[1]; o[2] = v[j][2] * rstd * g[2]; o[3] = v[j][3] * rstd * g[3];
                *(f32x4*)(op + c) = o; }
        }
    }
}

enum { PH_PREP = 0, PH_S5, PH_GLU, PH_ROUTE, PH_G1, PH_G2, PH_COMB, PH_KVQ, PH_ATT, PH_OPROJ, PH_QG };
constexpr int NPH = 27;
__constant__ int c_prog[NPH][2] = {
    {PH_PREP, 0},
    {PH_S5, 0}, {PH_GLU, 0}, {PH_ROUTE, 0}, {PH_G1, 0}, {PH_G2, 0}, {PH_COMB, 0},
    {PH_S5, 1}, {PH_GLU, 1}, {PH_ROUTE, 1}, {PH_G1, 1}, {PH_G2, 1}, {PH_COMB, 1},
    {PH_KVQ, 2}, {PH_ATT, 2}, {PH_OPROJ, 2}, {PH_ROUTE, 2}, {PH_G1, 2}, {PH_G2, 2}, {PH_COMB, 2},
    {PH_QG, 3}, {PH_ATT, 3}, {PH_OPROJ, 3}, {PH_ROUTE, 3}, {PH_G1, 3}, {PH_G2, 3}, {PH_COMB, 3},
};

__global__ void __launch_bounds__(NTHREADS) yoco_fwd(Args a) {
    extern __shared__ __attribute__((aligned(16))) unsigned char smem_raw[];
    LAS unsigned char* lds = (LAS unsigned char*)smem_raw;
    volatile LAS unsigned* const st = (volatile LAS unsigned*)(lds + LDS_BYTES - 16);
    if (a.ph_hi - a.ph_lo > 1) {
        if (threadIdx.x == 0) { st[0] = 0u; st[1] = 0u; }
        __syncthreads();
        xcd_barrier_post((unsigned*)(a.ws + WS_CTL) + CW_BAR);
    }
    CArgs* const kp = (CArgs*)__builtin_amdgcn_kernarg_segment_ptr();
    for (int ph = a.ph_lo; ph < a.ph_hi; ++ph) {
        const int type = c_prog[ph][0], layer = c_prog[ph][1];
        const int reps = type == a.rep_type ? a.rep_n : 0;
        for (int r = 0; r <= reps; ++r) {
            const bool dry = r > 0;
            CArgs* lp = kp; asm volatile("" : "+s"(lp));
            CArgs& la = *lp;
            GemmDesc g; bool is_gemm = true;
            switch (type) {
                case PH_GLU: phase_glu(la, layer, dry, lds, g); break;
                case PH_G1: phase_moe1(la, layer, lds, g); break;
                case PH_G2: phase_moe2(la, layer, lds, g); break;
                case PH_KVQ: case PH_QG: phase_kvq_q(la, type == PH_QG ? 1 : 0, lds, g); break;
                case PH_OPROJ: phase_oproj(la, layer - 2, dry, lds, g); break;
                default: is_gemm = false; break;
            }
            if (is_gemm) gemm_run(lds, g);
            else switch (type) {
                case PH_PREP: phase_prep(la, lds); break;
                case PH_S5: phase_s5(la, layer, lds); break;
                case PH_ROUTE: phase_route(la, layer, dry, lds); break;
                case PH_COMB: phase_combine(la, layer, dry); break;
                default: phase_attn(la, layer - 2, lds); break;
            }
            if (r < reps || ph + 1 < a.ph_hi) { if (a.ph_hi - a.ph_lo > 1) xcd_barrier((unsigned*)(la.ws + WS_CTL) + CW_BAR, st); }
        }
        if (a.rep_type == 100 && ph + 1 < a.ph_hi) for (int r = 0; r < a.rep_n; ++r) xcd_barrier((unsigned*)(a.ws + WS_CTL) + CW_BAR, st);
    }
}

extern "C" void kernel_launch(void* const* d_in, const int* in_sizes, int n_in, void* d_out, int out_size, void* d_ws, size_t ws_size, hipStream_t stream) {
    static int ready = 0;
    if (ready == 0) {
        if (n_in != 29 || ws_size < WS_END) { fprintf(stderr, "kernel_launch: expected 29 inputs and >= %zu bytes of workspace (got %d, %zu)\n", (size_t)WS_END, n_in, ws_size); ready = -1; return; }
        if (hipFuncSetAttribute((const void*)yoco_fwd, hipFuncAttributeMaxDynamicSharedMemorySize, LDS_BYTES) != hipSuccess) { fprintf(stderr, "kernel_launch: hipFuncSetAttribute failed\n"); ready = -1; return; }
        ready = 1;
    }
    if (ready < 0) return;
    (void)hipMemsetAsync((char*)d_ws + WS_CTL, 0, CTL_BYTES, stream);
    Args a{};
    for (int i = 0; i < 29; ++i) a.in[i] = (const float*)d_in[i];
    a.out = (float*)d_out; a.ws = (unsigned char*)d_ws;
#if defined(PROBE_TYPE)
    a.rep_type = PROBE_TYPE; a.rep_n = PROBE_N;
#else
    a.rep_type = -1; a.rep_n = 0;
#endif
#if MK_N_LAUNCHES == 1
    a.ph_lo = 0; a.ph_hi = NPH;
    hipLaunchKernelGGL(yoco_fwd, dim3(GRID), dim3(NTHREADS), LDS_BYTES, stream, a);
#else
    for (int ph = 0; ph < NPH; ++ph) { a.ph_lo = ph; a.ph_hi = ph + 1; hipLaunchKernelGGL(yoco_fwd, dim3(GRID), dim3(NTHREADS), LDS_BYTES, stream, a); }
#endif
}
```

```cpp
#include <hip/hip_runtime.h>
#include <cstdio>
#include <cstdint>

#ifndef MK_N_LAUNCHES
#define MK_N_LAUNCHES 1
#endif

#define LAS __attribute__((address_space(3)))
typedef unsigned short bf16_t;
typedef short bf16x8 __attribute__((ext_vector_type(8)));
typedef float f32x4 __attribute__((ext_vector_type(4)));
typedef float f32x2 __attribute__((ext_vector_type(2)));
typedef unsigned u32x4 __attribute__((ext_vector_type(4)));
typedef unsigned u32x2 __attribute__((ext_vector_type(2)));

constexpr int D = 1024, NB = 8, SEQ = 2048, NMETA = 16, LT = SEQ + NMETA  ;
constexpr int NREAL = NB * SEQ  , RT = NREAL + NMETA  , RPAD = 16640;
constexpr int NEXP = 32, DEXP = 512, NGRP = 4, EPG = 8;
constexpr int NTHREADS = 512, GRID = 256;
constexpr int LDS_BYTES = 155648;
constexpr float RMS_EPS = 1e-6f;
__device__ __forceinline__ int row_of(int b, int pos) { return pos < NMETA ? NREAL + pos : b * SEQ + (pos - NMETA); }

constexpr size_t al256(size_t x) { return (x + 255) & ~(size_t)255; }
constexpr size_t WS_CTL = 0;
constexpr size_t CTL_BYTES = 32768;
constexpr int CW_BAR = 0;
constexpr int CW_CNT = 4096;
constexpr int CW_DUMCNT = 4096 + 256;
constexpr size_t WS_H = WS_CTL + CTL_BYTES;
constexpr size_t WS_U = WS_H + al256((size_t)RPAD * D * 4);
constexpr size_t WS_Z = WS_U + al256((size_t)RPAD * D * 2);
constexpr size_t WS_XN = WS_Z + al256((size_t)RPAD * D * 2);
constexpr size_t WS_Q = WS_XN + al256((size_t)RPAD * D * 2);
constexpr size_t WS_K = WS_Q + al256((size_t)RPAD * D * 2);
constexpr size_t WS_VT = WS_K + al256((size_t)RPAD * 256 * 2);
constexpr size_t VT_META = (size_t)NB * 256 * SEQ;
constexpr size_t WS_SSQ = WS_VT + al256((size_t)RPAD * 256 * 2);
constexpr size_t WS_LTOK = WS_SSQ + al256((size_t)RPAD * 32 * 4);
constexpr size_t WS_LGATE = WS_LTOK + al256((size_t)NEXP * RT * 4);
constexpr int HB_ROWS = 2 * RT + NEXP * 256;
constexpr size_t WS_HB = WS_LGATE + al256((size_t)NEXP * RT * 4);
constexpr size_t WS_YB = WS_HB + al256((size_t)HB_ROWS * DEXP * 2);
constexpr size_t TBL_K = 0, TBL_M = 16 * 1024, TBL_N = TBL_M + 64 * 1024, TBL_A16 = TBL_N + 64 * 1024, TBL_STRIDE = TBL_A16 + 512;
constexpr size_t WS_TBL = WS_YB + al256((size_t)RT * 2 * D * 2);
constexpr size_t WS_WGLU = WS_TBL + al256((size_t)2 * 64 * TBL_STRIDE);
constexpr size_t WS_WKVQ = WS_WGLU + (size_t)2 * 2048 * 1024 * 2;
constexpr size_t WS_WQ1 = WS_WKVQ + (size_t)1536 * 1024 * 2;
constexpr size_t WS_WO = WS_WQ1 + (size_t)1024 * 1024 * 2;
constexpr size_t WS_W1 = WS_WO + (size_t)2 * 1024 * 1024 * 2;
constexpr size_t WS_W2 = WS_W1 + (size_t)4 * 32 * 1024 * 1024 * 2;
constexpr size_t WS_DUMH = WS_W2 + (size_t)4 * 32 * 1024 * 512 * 2;
constexpr size_t WS_DUMSSQ = WS_DUMH + al256((size_t)RT * D * 4);
constexpr size_t WS_DUMLT = WS_DUMSSQ + al256((size_t)RT * 32 * 4);
constexpr size_t WS_DUMLG = WS_DUMLT + al256((size_t)NEXP * RT * 4);
#if defined(PROBE_TYPE)
constexpr size_t WS_END = WS_DUMLG + al256((size_t)NEXP * RT * 4);
#else
constexpr size_t WS_END = WS_DUMH;
#endif

struct Args {
    const float* in[29];
    float* out;
    unsigned char* ws;
    int ph_lo, ph_hi;
    int rep_type, rep_n;
};
typedef const __attribute__((address_space(4))) Args CArgs;

__device__ __forceinline__ unsigned cvt_pk_bf16(float lo, float hi) { unsigned r; asm volatile("v_cvt_pk_bf16_f32 %0, %1, %2" : "=v"(r) : "v"(lo), "v"(hi)); return r; }
__device__ __forceinline__ float bf16_lo(unsigned w) { return __uint_as_float(w << 16); }
__device__ __forceinline__ float bf16_hi(unsigned w) { return __uint_as_float(w & 0xffff0000u); }
__device__ __forceinline__ float fast_rcp(float x) { return __builtin_amdgcn_rcpf(x); }
__device__ __forceinline__ float fast_exp(float x) { return __builtin_amdgcn_exp2f(x * 1.4426950408889634f); }
__device__ __forceinline__ float sigmoidf_(float x) { return fast_rcp(1.0f + fast_exp(-x)); }
__device__ __forceinline__ float gelu_tanh(float x) { const float v = 0.7978845608028654f * (x + 0.044715f * x * x * x); return x * sigmoidf_(2.0f * v); }
__device__ __forceinline__ bf16x8 as_bf16x8(u32x4 v) { return __builtin_bit_cast(bf16x8, v); }
__device__ __forceinline__ f32x4 mfma16(bf16x8 a, bf16x8 b, f32x4 c) { return __builtin_amdgcn_mfma_f32_16x16x32_bf16(a, b, c, 0, 0, 0); }
__device__ __forceinline__ float xor32_sum(float v) { auto r = __builtin_amdgcn_permlane32_swap(__float_as_uint(v), __float_as_uint(v), false, false); return __uint_as_float(r[0]) + __uint_as_float(r[1]); }
__device__ __forceinline__ float xor16_sum(float v) { auto r = __builtin_amdgcn_permlane16_swap(__float_as_uint(v), __float_as_uint(v), false, false); return __uint_as_float(r[0]) + __uint_as_float(r[1]); }
__device__ __forceinline__ float xor32_max(float v) { auto r = __builtin_amdgcn_permlane32_swap(__float_as_uint(v), __float_as_uint(v), false, false); return fmaxf(__uint_as_float(r[0]), __uint_as_float(r[1])); }
__device__ __forceinline__ float xor16_max(float v) { auto r = __builtin_amdgcn_permlane16_swap(__float_as_uint(v), __float_as_uint(v), false, false); return fmaxf(__uint_as_float(r[0]), __uint_as_float(r[1])); }
__device__ __forceinline__ float quad_sum(float v) { return xor32_sum(xor16_sum(v)); }
template <int X> __device__ __forceinline__ float swz_xor(float v) { return __uint_as_float((unsigned)__builtin_amdgcn_ds_swizzle((int)__float_as_uint(v), (X << 10) | 0x1f)); }
__device__ __forceinline__ float wave_sum(float v) {
    v += swz_xor<1>(v); v += swz_xor<2>(v); v += swz_xor<4>(v); v += swz_xor<8>(v);
    return quad_sum(v);
}
__device__ __forceinline__ int opaque_bid() { int b = blockIdx.x; asm volatile("" : "+s"(b)); return b; }
__device__ __forceinline__ int opaque_tid() { int t = threadIdx.x; asm volatile("" : "+v"(t)); return t; }

#define XB_TMO      128
#define XB_XCNT(j)  (256  + 64 * (j))
#define XB_XSUB(j)  (1280 + 64 * (j))
#define XB_XGEN(j)  (2304 + 64 * (j))
#define XB_TOP      3328
#define XB_TOPGEN   3392
#define XCD_BAR_WORDS 3456
#define XB_SPIN_CAP (1u << 22)
__device__ __forceinline__ unsigned xb_ld(unsigned* p)              { return __hip_atomic_load(p, __ATOMIC_RELAXED, __HIP_MEMORY_SCOPE_AGENT); }
__device__ __forceinline__ unsigned xb_add(unsigned* p, unsigned v) { return __hip_atomic_fetch_add(p, v, __ATOMIC_RELAXED, __HIP_MEMORY_SCOPE_AGENT); }
__device__ __forceinline__ unsigned xb_xcc_id() { return (unsigned)__builtin_amdgcn_s_getreg((3 << 11) | 20) & 0xFu; }
#define XB_SPIN(cond, bar) do { unsigned _sp = 0; while (cond) { __builtin_amdgcn_s_sleep(1); \
    if ((++_sp & 255u) == 0u) { if (xb_ld(&(bar)[XB_TMO])) break; if (_sp > XB_SPIN_CAP) { atomicAdd(&(bar)[XB_TMO], 1u); break; } } } } while (0)
__device__ __forceinline__ void xcd_barrier_post(unsigned* bar) { if (threadIdx.x == 0) (void)xb_add(&bar[XB_XCNT(xb_xcc_id())], 1u); }
__device__ __forceinline__ void xcd_barrier_complete(unsigned* bar, unsigned x, unsigned& nloc, unsigned& nx) {
    const unsigned G = gridDim.x;
    unsigned sum, cnt, mine, sp = 0u;
    for (;;) {
        sum = 0u; cnt = 0u; mine = 0u;
#pragma unroll
        for (unsigned j = 0; j < 16; ++j) { const unsigned c = xb_ld(&bar[XB_XCNT(j)]); sum += c; cnt += (c > 0u) ? 1u : 0u; mine = (j == x) ? c : mine; }
        if (sum == G) break;
        __builtin_amdgcn_s_sleep(1);
        if ((++sp & 255u) == 0u) { if (xb_ld(&bar[XB_TMO])) break; if (sp > XB_SPIN_CAP) { atomicAdd(&bar[XB_TMO], 1u); break; } }
    }
    nloc = mine > 0u ? mine : 1u; nx = cnt > 0u ? cnt : 1u;
}
__device__ __forceinline__ void xcd_barrier(unsigned* bar_, volatile LAS unsigned* st) {
    asm volatile("s_waitcnt vmcnt(0)" ::: "memory");
    __syncthreads();
    if (threadIdx.x == 0) {
        unsigned* bar = bar_; asm volatile("" : "+v"(bar));
        const unsigned bx = xb_xcc_id();
        __builtin_amdgcn_s_waitcnt(0);
        unsigned nloc = st[0], nx = st[1];
        if (nloc == 0u) { xcd_barrier_complete(bar, bx, nloc, nx); st[0] = nloc; st[1] = nx; }
        const unsigned old = xb_add(&bar[XB_XSUB(bx)], 1u);
        const unsigned gen = old / nloc;
        if (old + 1u == (gen + 1u) * nloc) {
            __builtin_amdgcn_fence(__ATOMIC_RELEASE, "agent");
            asm volatile("s_waitcnt vmcnt(0)" ::: "memory");
            const unsigned og = xb_add(&bar[XB_TOP], 1u);
            const unsigned tg = og / nx;
            if (og + 1u == (tg + 1u) * nx) xb_add(&bar[XB_TOPGEN], 1u);
            else XB_SPIN(xb_ld(&bar[XB_TOPGEN]) == tg, bar);
            __builtin_amdgcn_fence(__ATOMIC_ACQUIRE, "agent");
            xb_add(&bar[XB_XGEN(bx)], 1u);
            asm volatile("s_waitcnt vmcnt(0)" ::: "memory");
        } else {
            XB_SPIN(xb_ld(&bar[XB_XGEN(bx)]) == gen, bar);
            __builtin_amdgcn_fence(__ATOMIC_ACQUIRE, "agent");
            asm volatile("s_waitcnt vmcnt(0)" ::: "memory");
        }
    }
    __syncthreads();
}

constexpr int BM = 256, BK = 64, HALF = 128, HTB = HALF * BK * 2, STAGE_BYTES = 8 * HTB, NXCD = 8, WGM = 8;
constexpr int LDS_TABO = STAGE_BYTES;
constexpr int LDS_TABT = LDS_TABO + 3072;
constexpr int LDS_TABG = LDS_TABT + 3072;
constexpr int LDS_SH = LDS_TABG + 3072;
__host__ __device__ __forceinline__ int lds_byte(int r, int c) { const int st = (r >> 4) * 2 + (c >> 5), rr = r & 15, cc = c & 31, ob = rr * 64 + cc * 2; return st * 1024 + (ob ^ (((ob >> 9) & 1) << 5)); }
__host__ __device__ __forceinline__ void stage_rc(int b, int& R, int& C) { const int st = b / 1024, sb = b % 1024, swz = sb ^ (((sb >> 9) & 1) << 5); R = (st >> 1) * 16 + swz / 64; C = (st & 1) * 32 + (swz % 64) / 2; }
__host__ __device__ __forceinline__ int perm32(int rho) { const int n = rho >> 4, i = rho & 15; return 8 * (i >> 2) + 4 * n + (i & 3); }
struct Unit { int pm, pn, e, slot; };
__device__ __forceinline__ int xcd_chunk(int wgid, int nwg) { const int q = nwg / NXCD, r = nwg % NXCD, xcd = wgid % NXCD, off = wgid / NXCD; return (xcd < r ? xcd * (q + 1) : r * (q + 1) + (xcd - r) * q) + off; }

enum { EPI_GLU = 0, EPI_OPROJ, EPI_KVQ, EPI_MOE1, EPI_MOE2 };
struct GemmDesc {
    int kind, K, perm, gather, moe;
    int nM, nN, nwg, npn; const char* A; const char* Bt; size_t tstepA, tstepB, wstride; const int* cnt; const int* LTOK; const float* LGATE;
    const float* res; float* Hout; float* SSQ; const float* bias; const float* bias2; bf16_t* O1; bf16_t* O2; bf16_t* O3; int jq, cbase;
};
__device__ __forceinline__ bool order_next(const GemmDesc& g, LAS unsigned char* lds, int i, Unit& u) {
    const int L = i * GRID + opaque_bid(); if (L >= g.nwg) return false;
    const int wgid = xcd_chunk(L, g.nwg);
    if (g.moe) {
        const LAS int* sh = (const LAS int*)(lds + LDS_SH);
        int e = 0;
        for (int q = 1; q < 32; ++q) if (wgid >= g.npn * sh[q]) e = q;
        const int nmt = sh[e + 1] - sh[e], local = wgid - g.npn * sh[e];
        u.pn = local / nmt; u.pm = sh[e] + (local - u.pn * nmt); u.e = e; u.slot = i % 3;
    } else {
        const int nig = WGM * g.nN, gid = wgid / nig, fm = gid * WGM, gsz = (g.nM - fm) < WGM ? (g.nM - fm) : WGM;
        u.pm = fm + ((wgid % nig) % gsz); u.pn = (wgid % nig) / gsz; u.e = 0; u.slot = 0;
    }
    return true;
}
__device__ __forceinline__ const char* order_a(const GemmDesc& g, const Unit& u) { return g.gather ? g.A : g.A + (size_t)u.pm * g.tstepA; }
__device__ __forceinline__ const char* order_b(const GemmDesc& g, const Unit& u) { return g.Bt + (size_t)u.e * g.wstride + (size_t)u.pn * g.tstepB; }
__device__ __forceinline__ void order_fill(const GemmDesc& g, LAS unsigned char* lds, const Unit& u) {
    const int t = opaque_tid();
    if (t < 256) {
        const LAS int* sh = (const LAS int*)(lds + LDS_SH);
        const int ne = g.cnt[u.e], idx = (u.pm - sh[u.e]) * 256 + t, ci = idx < ne ? idx : ne - 1;
        const int v = g.LTOK[(size_t)u.e * RT + ci];
        ((LAS unsigned*)(lds + LDS_TABO))[u.slot * 256 + t] = (unsigned)(v & 0x3fffffff) * (unsigned)(D * 2);
        ((LAS int*)(lds + LDS_TABT))[u.slot * 256 + t] = idx < ne ? v : -1;
        ((LAS float*)(lds + LDS_TABG))[u.slot * 256 + t] = g.LGATE[(size_t)u.e * RT + ci];
    }
}
__device__ __forceinline__ void gemm_epilogue(const GemmDesc& g, LAS unsigned char* lds, const f32x4 (&acc)[2][2][4][2], const Unit& u, int wr, int wc, int fr, int fq);

__device__ __forceinline__ void gemm_run(LAS unsigned char* lds, const GemmDesc& g) {
    const int tid = opaque_tid(), wid = __builtin_amdgcn_readfirstlane(tid >> 6), lane = tid & 63, wr = wid >> 2, wc = wid & 3, fr = lane & 15, fq = lane >> 4;
    const int K = g.K, nt = K / BK;
    unsigned voffA[2], voffB[2]; int Rr[2], Cc[2];
#pragma unroll
    for (int i = 0; i < 2; ++i) { int R, C; stage_rc(tid * 16 + i * 8192, R, C); const int Rb = g.perm ? ((R & ~31) + perm32(R & 31)) : R;
        voffA[i] = (unsigned)(R * K + C) * 2u; voffB[i] = (unsigned)(Rb * K + C) * 2u; Rr[i] = R * 4; Cc[i] = C * 2; }
    const size_t kstep = (size_t)(BK * 2);
    const size_t hstep = (size_t)HALF * K * 2;
    const unsigned ldsw = (unsigned)wid * 1024u;
    const int aoff = lds_byte(wr * 64 + fr, fq * 8), boff = lds_byte(wc * 32 + fr, fq * 8);
#define PG8_SA(b, h) (((b) * 2 + (h)) * HTB)
#define PG8_SB(b, h) ((4 + (b) * 2 + (h)) * HTB)
#define PG8_GLDS(src, dstoff) __builtin_amdgcn_global_load_lds((const unsigned*)(src), (LAS unsigned*)(lds + (dstoff)), 16, 0, 0)
#define PG8_STAGE_B(bufoff, gbase) do { _Pragma("unroll") for (int _i = 0; _i < 2; ++_i) PG8_GLDS((const char*)(gbase) + voffB[_i], (bufoff) + ldsw + _i * 8192); } while (0)
#define PG8_STAGE_A(bufoff, gbase, tsel, kt, h) do { if (g.gather) { \
            const unsigned _o0 = *(const LAS unsigned*)(lds + LDS_TABO + (tsel) * 1024 + (h) * 512 + Rr[0]), _o1 = *(const LAS unsigned*)(lds + LDS_TABO + (tsel) * 1024 + (h) * 512 + Rr[1]); \
            PG8_GLDS((const char*)(gbase) + (size_t)(kt) * kstep + _o0 + Cc[0], (bufoff) + ldsw); PG8_GLDS((const char*)(gbase) + (size_t)(kt) * kstep + _o1 + Cc[1], (bufoff) + ldsw + 8192); \
        } else { _Pragma("unroll") for (int _i = 0; _i < 2; ++_i) PG8_GLDS((const char*)(gbase) + (size_t)(kt) * kstep + (size_t)(h) * hstep + voffA[_i], (bufoff) + ldsw + _i * 8192); } } while (0)
#define PG8_LDA(dst, b, h) do { _Pragma("unroll") for (int m = 0; m < 4; ++m) _Pragma("unroll") for (int k = 0; k < 2; ++k) dst[m][k] = *(const LAS bf16x8*)(lds + PG8_SA(b, h) + aoff + m * 2048 + k * 1024); } while (0)
#define PG8_LDB(dst, b, h) do { _Pragma("unroll") for (int n = 0; n < 2; ++n) _Pragma("unroll") for (int k = 0; k < 2; ++k) dst[n][k] = *(const LAS bf16x8*)(lds + PG8_SB(b, h) + boff + n * 2048 + k * 1024); } while (0)
#define PG8_MMA(ai, bj, At, Bt) do { __builtin_amdgcn_s_setprio(1); _Pragma("unroll") for (int m = 0; m < 4; ++m) _Pragma("unroll") for (int n = 0; n < 2; ++n) _Pragma("unroll") for (int k = 0; k < 2; ++k) \
        acc[ai][bj][m][n] = __builtin_amdgcn_mfma_f32_16x16x32_bf16(Bt[n][k], At[m][k], acc[ai][bj][m][n], 0, 0, 0); __builtin_amdgcn_s_setprio(0); } while (0)
#define PG8_WAIT_V(n) asm volatile("s_waitcnt vmcnt(" #n ")" ::: "memory")
#define PG8_WAIT_L(n) asm volatile("s_waitcnt lgkmcnt(" #n ")" ::: "memory")
#define PG8_BAR __builtin_amdgcn_s_barrier()
#define PG8_SCHED __builtin_amdgcn_sched_barrier(0)
    Unit cur, nxt; int ui = 0;
    if (!order_next(g, lds, 0, cur)) return;
    f32x4 acc[2][2][4][2];
#pragma unroll
    for (int a = 0; a < 2; ++a)
#pragma unroll
        for (int b = 0; b < 2; ++b)
#pragma unroll
            for (int m = 0; m < 4; ++m)
#pragma unroll
                for (int n = 0; n < 2; ++n) acc[a][b][m][n] = (f32x4){0.f, 0.f, 0.f, 0.f};
    bf16x8 At[4][2], B0[2][2], B1[2][2];
    if (g.moe) { order_fill(g, lds, cur); __syncthreads(); }
    const char* cA = order_a(g, cur); const char* cB = order_b(g, cur); int cT = cur.slot;
    PG8_STAGE_B(PG8_SB(0, 0), cB); PG8_STAGE_B(PG8_SB(0, 1), cB + hstep); PG8_STAGE_A(PG8_SA(0, 0), cA, cT, 0, 0); PG8_STAGE_A(PG8_SA(0, 1), cA, cT, 0, 1);
    if (wr == 1) PG8_BAR;
    PG8_WAIT_V(2); PG8_BAR;
    PG8_STAGE_B(PG8_SB(1, 0), cB + kstep); PG8_STAGE_A(PG8_SA(1, 0), cA, cT, 1, 0); PG8_STAGE_B(PG8_SB(1, 1), cB + hstep + kstep);
    PG8_WAIT_V(6); PG8_BAR;
    for (;;) {
        const bool has_next = order_next(g, lds, ui + 1, nxt);
        if (g.moe && has_next) order_fill(g, lds, nxt);
        const char* nA = has_next ? order_a(g, nxt) : cA; const char* nB = has_next ? order_b(g, nxt) : cB; const int nT = has_next ? nxt.slot : cT;
        for (int t = 0; t < nt; t += 2) {
            const bool last = (t == nt - 2);
            const char* a2b = last ? nA : cA; const int a2T = last ? nT : cT, a2k = last ? 0 : t + 2, a3k = a2k + 1;
            const char* b2 = last ? nB : cB + (size_t)(t + 2) * kstep; const char* b3 = b2 + kstep;
            PG8_LDB(B0, 0, 0); PG8_LDB(B1, 0, 1); PG8_SCHED; PG8_LDA(At, 0, 0); PG8_STAGE_A(PG8_SA(1, 1), cA, cT, t + 1, 1);
            PG8_WAIT_V(8); PG8_WAIT_L(0); PG8_BAR; PG8_MMA(0, 0, At, B0); PG8_MMA(0, 1, At, B1); PG8_BAR; PG8_SCHED;
            PG8_LDA(At, 0, 1); PG8_STAGE_B(PG8_SB(0, 0), b2); PG8_STAGE_B(PG8_SB(0, 1), b2 + hstep); PG8_STAGE_A(PG8_SA(0, 0), a2b, a2T, a2k, 0);
            PG8_WAIT_V(8); PG8_WAIT_L(0); PG8_BAR; PG8_MMA(1, 0, At, B0); PG8_MMA(1, 1, At, B1); PG8_BAR; PG8_SCHED;
            PG8_LDB(B0, 1, 0); PG8_LDB(B1, 1, 1); PG8_SCHED; PG8_LDA(At, 1, 0); PG8_STAGE_A(PG8_SA(0, 1), a2b, a2T, a2k, 1);
            PG8_WAIT_V(8); PG8_WAIT_L(0); PG8_BAR; PG8_MMA(0, 0, At, B0); PG8_MMA(0, 1, At, B1); PG8_BAR; PG8_SCHED;
            PG8_LDA(At, 1, 1); PG8_STAGE_B(PG8_SB(1, 0), b3); PG8_STAGE_B(PG8_SB(1, 1), b3 + hstep); PG8_STAGE_A(PG8_SA(1, 0), a2b, a2T, a3k, 0);
            PG8_WAIT_V(8); PG8_WAIT_L(0); PG8_BAR; PG8_MMA(1, 0, At, B0); PG8_MMA(1, 1, At, B1); PG8_BAR; PG8_SCHED;
        }
        if (wr == 0) PG8_BAR;
        gemm_epilogue(g, lds, acc, cur, wr, wc, fr, fq);
        if (!has_next) break;
#pragma unroll
        for (int a = 0; a < 2; ++a)
#pragma unroll
            for (int b = 0; b < 2; ++b)
#pragma unroll
                for (int m = 0; m < 4; ++m)
#pragma unroll
                    for (int n = 0; n < 2; ++n) acc[a][b][m][n] = (f32x4){0.f, 0.f, 0.f, 0.f};
        cur = nxt; cA = nA; cB = nB; cT = nT; ++ui;
        if (wr == 1) PG8_BAR;
    }
    PG8_WAIT_V(0);
    PG8_BAR;
#undef PG8_SA
#undef PG8_SB
#undef PG8_GLDS
#undef PG8_STAGE_A
#undef PG8_STAGE_B
#undef PG8_LDA
#undef PG8_LDB
#undef PG8_MMA
#undef PG8_WAIT_V
#undef PG8_WAIT_L
#undef PG8_BAR
#undef PG8_SCHED
}
__device__ __forceinline__ f32x4 meta_dot(const bf16_t* Am, const bf16_t* Brow0, int K, int fr, int fq) {
    f32x4 acc = {0.f, 0.f, 0.f, 0.f};
    const bf16_t* ap = Am + (size_t)fr * K + 8 * fq; const bf16_t* bp = Brow0 + (size_t)fr * K + 8 * fq;
#pragma unroll 4
    for (int ks = 0; ks < K / 32; ++ks) acc = mfma16(as_bf16x8(*(const u32x4*)(bp + 32 * ks)), as_bf16x8(*(const u32x4*)(ap + 32 * ks)), acc);
    return acc;
}

struct ConvDesc { const float* src; const float* gain; bf16_t* dst; int ld, K, mode, kblk, nblk; };
constexpr int NWT_E = 768;
constexpr int NWT_MOE = 4 * 32 * NWT_E, NWT_DENSE = 2 * 1024 + 256 + 2 * 512 + 2 * 512;
__device__ __forceinline__ ConvDesc conv_decode(CArgs& a, int ti) {
    ConvDesc d;
    if (ti < NWT_MOE) {
        const int le = ti / NWT_E, r = ti % NWT_E, which = r >> 8, tt = r & 255, layer = le >> 5;
        if (which < 2) { d.src = a.in[26 + which] + (size_t)le * D * DEXP; d.ld = DEXP; d.K = D; d.gain = a.in[3] + (size_t)layer * D; d.dst = (bf16_t*)(a.ws + WS_W1) + (size_t)le * 1024 * 1024; d.mode = 1 + which; d.nblk = tt & 15; d.kblk = tt >> 4; }
        else { d.src = a.in[28] + (size_t)le * DEXP * D; d.ld = D; d.K = DEXP; d.gain = nullptr; d.dst = (bf16_t*)(a.ws + WS_W2) + (size_t)le * 1024 * 512; d.mode = 0; d.nblk = tt & 31; d.kblk = tt >> 5; }
    } else {
        int r = ti - NWT_MOE;
        if (r < 2048) { const int layer = r >> 10, tt = r & 1023, nb = tt & 63, half = nb >> 5;
            d.src = a.in[14] + (size_t)layer * D * 2 * D + half * D; d.ld = 2 * D; d.K = D; d.gain = nullptr; d.dst = (bf16_t*)(a.ws + WS_WGLU) + (size_t)layer * 2048 * 1024; d.mode = 1 + half; d.nblk = nb & 31; d.kblk = tt >> 6; }
        else if ((r -= 2048) < 256) { d.src = a.in[15]; d.ld = 512; d.K = D; d.gain = a.in[4]; d.dst = (bf16_t*)(a.ws + WS_WKVQ); d.mode = 0; d.nblk = r & 15; d.kblk = r >> 4; }
        else if ((r -= 256) < 1024) { const int j = r >> 9, tt = r & 511;
            d.src = a.in[17] + (size_t)j * D * D; d.ld = D; d.K = D; d.gain = a.in[2] + (size_t)(2 + j) * D; d.dst = j == 0 ? (bf16_t*)(a.ws + WS_WKVQ) + (size_t)512 * 1024 : (bf16_t*)(a.ws + WS_WQ1); d.mode = 0; d.nblk = tt & 31; d.kblk = tt >> 5; }
        else { r -= 1024; const int j = r >> 9, tt = r & 511;
            d.src = a.in[20] + (size_t)j * D * D; d.ld = D; d.K = D; d.gain = nullptr; d.dst = (bf16_t*)(a.ws + WS_WO) + (size_t)j * 1024 * 1024; d.mode = 0; d.nblk = tt & 31; d.kblk = tt >> 5; }
    }
    return d;
}
__device__ __forceinline__ void conv_load(const ConvDesc& d, int lane, f32x4 (&v)[8]) {
    const float* p = d.src + (size_t)(d.kblk * 64 + 8 * (lane >> 3)) * d.ld + d.nblk * 32 + 4 * (lane & 7);
#pragma unroll
    for (int j = 0; j < 8; ++j) v[j] = __builtin_nontemporal_load((const f32x4*)(p + (size_t)j * d.ld));
}
__device__ __forceinline__ void conv_store(const ConvDesc& d, int lane, f32x4 (&v)[8]) {
    const int k0 = d.kblk * 64 + 8 * (lane >> 3);
    if (d.gain) { const f32x4 g0 = *(const f32x4*)(d.gain + k0), g1 = *(const f32x4*)(d.gain + k0 + 4);
        v[0] *= g0[0]; v[1] *= g0[1]; v[2] *= g0[2]; v[3] *= g0[3]; v[4] *= g1[0]; v[5] *= g1[1]; v[6] *= g1[2]; v[7] *= g1[3]; }
    const int n = d.nblk * 32 + 4 * (lane & 7), row = d.mode == 0 ? n : (256 * (n >> 7) + (n & 127) + (d.mode == 2 ? 128 : 0));
    bf16_t* q = d.dst + (size_t)row * d.K + k0;
#pragma unroll
    for (int c = 0; c < 4; ++c) {
        u32x4 w; w.x = cvt_pk_bf16(v[0][c], v[1][c]); w.y = cvt_pk_bf16(v[2][c], v[3][c]); w.z = cvt_pk_bf16(v[4][c], v[5][c]); w.w = cvt_pk_bf16(v[6][c], v[7][c]);
        *(u32x4*)(q + (size_t)c * d.K) = w;
    }
}
__device__ __forceinline__ void convert_weights(CArgs& a) {
    const int lane = opaque_tid() & 63, gw = (opaque_tid() >> 6) * GRID + opaque_bid();
    constexpr int NT = NWT_MOE + NWT_DENSE, STEP = GRID * 8;
    int ti = gw;
    if (ti >= NT) return;
    ConvDesc d0 = conv_decode(a, ti); f32x4 va[8], vb[8];
    conv_load(d0, lane, va);
#pragma unroll 1
    for (;;) {
        const bool m1 = ti + STEP < NT; ConvDesc d1 = d0;
        if (m1) { d1 = conv_decode(a, ti + STEP); conv_load(d1, lane, vb); }
        conv_store(d0, lane, va);
        if (!m1) break;
        const bool m2 = ti + 2 * STEP < NT;
        if (m2) { d0 = conv_decode(a, ti + 2 * STEP); conv_load(d0, lane, va); }
        conv_store(d1, lane, vb);
        if (!m2) break;
        ti += 2 * STEP;
    }
}

struct cplx { float re, im; };
__device__ __forceinline__ cplx cmul(cplx a, cplx b) { return {a.re * b.re - a.im * b.im, a.re * b.im + a.im * b.re}; }

__device__ __forceinline__ void s5_tables(CArgs& a, int layer, int g, LAS unsigned char* lds) {
    LAS f32x2* pw = (LAS f32x2*)lds;
    LAS f32x2* bb = (LAS f32x2*)(lds + 64 * 17 * 8);
    LAS f32x2* cc = bb + 64 * 16;
    const int tid = opaque_tid();
    const float* a_re = a.in[6] + ((size_t)layer * 64 + g) * 64; const float* a_im = a.in[7] + ((size_t)layer * 64 + g) * 64;
    const float dt = expf(a.in[8][layer * 64 + g]);
    for (int idx = tid; idx < 64 * 17; idx += NTHREADS) {
        const int p = idx / 17, d = idx % 17;
        const float mag = expf(a_re[p] * dt * (float)d), ang = a_im[p] * dt * (float)d;
        float s, c; sincosf(ang, &s, &c);
        pw[idx] = (f32x2){mag * c, mag * s};
    }
    const float* b_re = a.in[9] + ((size_t)layer * 64 + g) * 1024; const float* b_im = a.in[10] + ((size_t)layer * 64 + g) * 1024;
    const float* c_re = a.in[11] + ((size_t)layer * 64 + g) * 1024; const float* c_im = a.in[12] + ((size_t)layer * 64 + g) * 1024;
    for (int idx = tid; idx < 1024; idx += NTHREADS) {
        const int p = idx >> 4;
        const float lr = a_re[p], li = a_im[p];
        const float mag = expf(lr * dt), ang = li * dt; float s, c; sincosf(ang, &s, &c);
        const float nr = mag * c - 1.0f, ni = mag * s;
        const float den = 1.0f / (lr * lr + li * li);
        const cplx f = {(nr * lr + ni * li) * den, (ni * lr - nr * li) * den};
        const cplx r = cmul(f, (cplx){b_re[idx], b_im[idx]});
        bb[idx] = (f32x2){r.re, r.im};
        cc[idx] = (f32x2){c_re[idx], c_im[idx]};
    }
    __syncthreads();
    unsigned char* tbl = a.ws + WS_TBL + ((size_t)layer * 64 + g) * TBL_STRIDE;
    for (int idx = tid; idx < 16 * 64; idx += NTHREADS) {
        const int delta = idx >> 6, l = idx & 63, c1 = l & 15, q4 = l >> 4, d = delta - (q4 >> 1);
        float v[8];
#pragma unroll
        for (int j = 0; j < 8; ++j) v[j] = 0.f;
        if (d >= 0) {
            for (int p = 0; p < 64; ++p) {
                const f32x2 cw = cc[c1 * 64 + p], pp = pw[p * 17 + d];
                const cplx t = cmul((cplx){cw.x, cw.y}, (cplx){pp.x, pp.y});
#pragma unroll
                for (int j = 0; j < 8; ++j) { const f32x2 bw = bb[p * 16 + 8 * (q4 & 1) + j]; v[j] += t.re * bw.x - t.im * bw.y; }
            }
        }
        u32x4 w; w.x = cvt_pk_bf16(v[0], v[1]); w.y = cvt_pk_bf16(v[2], v[3]); w.z = cvt_pk_bf16(v[4], v[5]); w.w = cvt_pk_bf16(v[6], v[7]);
        *(u32x4*)(tbl + TBL_K + (size_t)idx * 16) = w;
    }
    for (int idx = tid; idx < 64 * 64; idx += NTHREADS) {
        const int f = idx >> 6, l = idx & 63, rt = f >> 3, ks = f & 7, q4 = l >> 4, rho = 16 * rt + (l & 15), p = rho & 63, im = rho >> 6;
        const int k0 = 32 * ks + 8 * q4, jpos = k0 >> 4, c20 = k0 & 15;
        const f32x2 pp = pw[p * 17 + (15 - jpos)];
        float v[8];
#pragma unroll
        for (int j = 0; j < 8; ++j) { const f32x2 bw = bb[p * 16 + c20 + j]; const cplx t = cmul((cplx){pp.x, pp.y}, (cplx){bw.x, bw.y}); v[j] = im ? t.im : t.re; }
        u32x4 w; w.x = cvt_pk_bf16(v[0], v[1]); w.y = cvt_pk_bf16(v[2], v[3]); w.z = cvt_pk_bf16(v[4], v[5]); w.w = cvt_pk_bf16(v[6], v[7]);
        *(u32x4*)(tbl + TBL_M + (size_t)idx * 16) = w;
    }
    for (int idx = tid; idx < 64 * 64; idx += NTHREADS) {
        const int f = idx >> 6, l = idx & 63, i = f >> 2, ks = f & 3, q4 = l >> 4, c1 = l & 15;
        const int s0 = 32 * ks + 8 * q4;
        float v[8];
#pragma unroll
        for (int j = 0; j < 8; ++j) { const int sg = s0 + j, p = sg & 63; const f32x2 cw = cc[c1 * 64 + p], pp = pw[p * 17 + i + 1];
            const cplx t = cmul((cplx){cw.x, cw.y}, (cplx){pp.x, pp.y}); v[j] = (sg >> 6) ? -t.im : t.re; }
        u32x4 w; w.x = cvt_pk_bf16(v[0], v[1]); w.y = cvt_pk_bf16(v[2], v[3]); w.z = cvt_pk_bf16(v[4], v[5]); w.w = cvt_pk_bf16(v[6], v[7]);
        *(u32x4*)(tbl + TBL_N + (size_t)idx * 16) = w;
    }
    if (tid < 64) *(f32x2*)(tbl + TBL_A16 + tid * 8) = pw[tid * 17 + 16];
    __syncthreads();
}

__device__ __forceinline__ void row_norm_store(const f32x4 (&v)[4], float ssq, int lane, const float* g0, bf16_t* o0) {
    const float rstd = 1.0f / sqrtf(ssq * (1.0f / D) + RMS_EPS);
#pragma unroll
    for (int j = 0; j < 4; ++j) {
        const int c = 4 * lane + 256 * j;
        f32x4 g = {1.f, 1.f, 1.f, 1.f}; if (g0) g = *(const f32x4*)(g0 + c);
        u32x2 w; w.x = cvt_pk_bf16(v[j][0] * rstd * g[0], v[j][1] * rstd * g[1]); w.y = cvt_pk_bf16(v[j][2] * rstd * g[2], v[j][3] * rstd * g[3]);
        *(u32x2*)(o0 + c) = w;
    }
}
__device__ __forceinline__ void phase_prep(CArgs& a, LAS unsigned char* lds) {
    if (opaque_bid() < 128) s5_tables(a, opaque_bid() >> 6, opaque_bid() & 63, lds);
    convert_weights(a);
    const int lane = opaque_tid() & 63, gw = opaque_bid() * 8 + (opaque_tid() >> 6);
    bf16_t* U = (bf16_t*)(a.ws + WS_U);
    for (int row = gw; row < RT; row += GRID * 8) {
        const float* src = row < NREAL ? a.in[0] + (size_t)row * D : a.in[1] + (size_t)(row - NREAL) * D;
        f32x4 v[4]; float ssq = 0.f;
#pragma unroll
        for (int j = 0; j < 4; ++j) { v[j] = *(const f32x4*)(src + 4 * lane + 256 * j); ssq += v[j][0] * v[j][0] + v[j][1] * v[j][1] + v[j][2] * v[j][2] + v[j][3] * v[j][3]; }
        ssq = wave_sum(ssq);
        row_norm_store(v, ssq, lane, a.in[2], U + (size_t)row * D);
    }
}

constexpr int S5_CH = 528;
constexpr int S5_NCH = 129, S5_NCHP = 144;
__device__ __forceinline__ void phase_s5(CArgs& a, int layer, LAS unsigned char* lds) {
    LAS unsigned char* Ul = lds; LAS unsigned char* Sl = lds + S5_NCHP * S5_CH;
    const int tid = opaque_tid(), lane = tid & 63, w = __builtin_amdgcn_readfirstlane(tid >> 6), tc = lane & 15, q4 = lane >> 4;
    const bf16_t* U = (const bf16_t*)(a.ws + WS_U); bf16_t* Z = (bf16_t*)(a.ws + WS_Z);
    for (int ui = 0; ui < 2; ++ui) {
        const int unit = opaque_bid() * 2 + ui, b = unit >> 6, g = unit & 63;
        const unsigned char* tbl = a.ws + WS_TBL + ((size_t)layer * 64 + g) * TBL_STRIDE;
        for (int idx = tid; idx < LT * 2; idx += NTHREADS) {
            const int tok = idx >> 1, half = idx & 1;
            const u32x4 v = *(const u32x4*)(U + (size_t)row_of(b, tok) * D + 16 * g + 8 * half);
            *(LAS u32x4*)(Ul + (tok >> 4) * S5_CH + (tok & 15) * 32 + half * 16) = v;
        }
        __syncthreads();
        {
            bf16x8 mf[8];
#pragma unroll
            for (int ks = 0; ks < 8; ++ks) mf[ks] = as_bf16x8(*(const u32x4*)(tbl + TBL_M + ((size_t)(w * 8 + ks) * 64 + lane) * 16));
#pragma unroll 1
            for (int cg = 0; cg < 9; ++cg) {
                const int n = 16 * cg + tc;
                f32x4 acc = {0.f, 0.f, 0.f, 0.f};
#pragma unroll
                for (int ks = 0; ks < 8; ++ks) { const bf16x8 ub = *(LAS bf16x8*)(Ul + n * S5_CH + ks * 64 + q4 * 16); acc = mfma16(mf[ks], ub, acc); }
                *(LAS f32x4*)(Sl + n * S5_CH + (16 * w + 4 * q4) * 4) = acc;
            }
        }
        __syncthreads();
        if (w == 0) {
            const f32x2 a16 = *(const f32x2*)(tbl + TBL_A16 + lane * 8);
            float sr = 0.f, si = 0.f;
#pragma unroll 1
            for (int nb = 0; nb < 17; ++nb) {
                float xr[8], xi[8];
#pragma unroll
                for (int j = 0; j < 8; ++j) { xr[j] = *(LAS float*)(Sl + (nb * 8 + j) * S5_CH + lane * 4); xi[j] = *(LAS float*)(Sl + (nb * 8 + j) * S5_CH + 256 + lane * 4); }
                asm volatile("s_waitcnt lgkmcnt(0)" ::: "memory");
#pragma unroll
                for (int j = 0; j < 8; ++j) {
                    const unsigned pr = cvt_pk_bf16(sr, si);
                    *(LAS unsigned short*)(Sl + (nb * 8 + j) * S5_CH + lane * 2) = (unsigned short)(pr & 0xffffu);
                    *(LAS unsigned short*)(Sl + (nb * 8 + j) * S5_CH + 128 + lane * 2) = (unsigned short)(pr >> 16);
                    const float nr = a16.x * sr - a16.y * si + xr[j], ni = a16.x * si + a16.y * sr + xi[j];
                    sr = nr; si = ni;
                }
                asm volatile("" ::: "memory");
            }
        }
        __syncthreads();
        {
            const int i0 = w, i1 = 15 - w;
            bf16x8 kf0[8], kf1[8], nf0[4], nf1[4];
#pragma unroll
            for (int jj = 0; jj < 8; ++jj) {
                const int d0 = i0 - 2 * jj, d1 = i1 - 2 * jj;
                kf0[jj] = as_bf16x8(*(const u32x4*)(tbl + TBL_K + ((size_t)(d0 >= 0 ? d0 : 0) * 64 + lane) * 16));
                kf1[jj] = as_bf16x8(*(const u32x4*)(tbl + TBL_K + ((size_t)(d1 >= 0 ? d1 : 0) * 64 + lane) * 16));
            }
#pragma unroll
            for (int ks = 0; ks < 4; ++ks) {
                nf0[ks] = as_bf16x8(*(const u32x4*)(tbl + TBL_N + ((size_t)(i0 * 4 + ks) * 64 + lane) * 16));
                nf1[ks] = as_bf16x8(*(const u32x4*)(tbl + TBL_N + ((size_t)(i1 * 4 + ks) * 64 + lane) * 16));
            }
            const f32x4 dsk = *(const f32x4*)(a.in[13] + (size_t)layer * D + 16 * g + 4 * q4);
#pragma unroll 1
            for (int cg = 0; cg < 9; ++cg) {
                const int n = 16 * cg + tc;
                f32x4 acc0 = {0.f, 0.f, 0.f, 0.f}, acc1 = {0.f, 0.f, 0.f, 0.f};
#pragma unroll
                for (int jj = 0; jj < 8; ++jj) {
                    const bf16x8 ub = *(LAS bf16x8*)(Ul + n * S5_CH + jj * 64 + q4 * 16);
                    if (2 * jj <= i0) acc0 = mfma16(kf0[jj], ub, acc0);
                    if (2 * jj <= i1) acc1 = mfma16(kf1[jj], ub, acc1);
                }
#pragma unroll
                for (int ks = 0; ks < 4; ++ks) {
                    const bf16x8 sb = *(LAS bf16x8*)(Sl + n * S5_CH + ks * 64 + q4 * 16);
                    acc0 = mfma16(nf0[ks], sb, acc0); acc1 = mfma16(nf1[ks], sb, acc1);
                }
                if (n < S5_NCH && (n > 0 || b == 0)) {
#pragma unroll
                    for (int h = 0; h < 2; ++h) {
                        const int i = h ? i1 : i0; const f32x4 y = h ? acc1 : acc0;
                        const u32x2 uw = *(LAS u32x2*)(Ul + n * S5_CH + i * 32 + q4 * 8);
                        const float z0 = gelu_tanh(y[0] + dsk[0] * bf16_lo(uw.x)), z1 = gelu_tanh(y[1] + dsk[1] * bf16_hi(uw.x));
                        const float z2 = gelu_tanh(y[2] + dsk[2] * bf16_lo(uw.y)), z3 = gelu_tanh(y[3] + dsk[3] * bf16_hi(uw.y));
                        u32x2 o; o.x = cvt_pk_bf16(z0, z1); o.y = cvt_pk_bf16(z2, z3);
                        *(u32x2*)(Z + (size_t)row_of(b, 16 * n + i) * D + 16 * g + 4 * q4) = o;
                    }
                }
            }
        }
        __syncthreads();
    }
}

__device__ __forceinline__ float ssq4(f32x4 h) { return h[0] * h[0] + h[1] * h[1] + h[2] * h[2] + h[3] * h[3]; }
__device__ __forceinline__ int gwave() { return opaque_bid() * 8 + (opaque_tid() >> 6); }
template <int NACC> __device__ __forceinline__ bool meta_block(LAS unsigned char* lds, const bf16_t* Am, const bf16_t* const (&brow)[NACC], int K, f32x4 (&out)[NACC]) {
    const int tid = opaque_tid(), lane = tid & 63, wid = tid >> 6, fr = lane & 15, fq = lane >> 4, ksl = K / 8;
#pragma unroll
    for (int i = 0; i < NACC; ++i) {
        f32x4 acc = {0.f, 0.f, 0.f, 0.f};
        const bf16_t* ap = Am + (size_t)fr * K + wid * ksl + 8 * fq; const bf16_t* bp = brow[i] + (size_t)fr * K + wid * ksl + 8 * fq;
        for (int ks = 0; ks < ksl / 32; ++ks) acc = mfma16(as_bf16x8(*(const u32x4*)(bp + 32 * ks)), as_bf16x8(*(const u32x4*)(ap + 32 * ks)), acc);
        ((LAS f32x4*)lds)[(wid * NACC + i) * 64 + lane] = acc;
    }
    __syncthreads();
    if (wid == 0) {
#pragma unroll
        for (int i = 0; i < NACC; ++i) { f32x4 s = {0.f, 0.f, 0.f, 0.f};
#pragma unroll
            for (int w = 0; w < 8; ++w) s += ((LAS f32x4*)lds)[(w * NACC + i) * 64 + lane];
            out[i] = s; }
    }
    __syncthreads();
    return wid == 0;
}

__device__ __forceinline__ void epi_glu(const GemmDesc& g, const f32x4 (&acc)[2][2][4][2], const Unit& u, int wr, int wc, int fr, int fq) {
    { const float* res = g.res; float* Hout = g.Hout; float* SSQ = g.SSQ;
#pragma unroll
        for (int ai = 0; ai < 2; ++ai)
#pragma unroll
            for (int m = 0; m < 4; ++m) {
                const int row = u.pm * BM + ai * HALF + wr * 64 + m * 16 + fr; const size_t off = (size_t)row * D + u.pn * 128 + wc * 32 + 4 * fq;
                float ss = 0.f;
#pragma unroll
                for (int n = 0; n < 2; ++n) {
                    const f32x4 v = acc[ai][0][m][n], gt = acc[ai][1][m][n]; f32x4 h = *(const f32x4*)(res + off + 16 * n);
                    h[0] += v[0] * sigmoidf_(gt[0]); h[1] += v[1] * sigmoidf_(gt[1]); h[2] += v[2] * sigmoidf_(gt[2]); h[3] += v[3] * sigmoidf_(gt[3]);
                    *(f32x4*)(Hout + off + 16 * n) = h; ss += ssq4(h);
                }
                ss = quad_sum(ss);
                if (fq == 0) SSQ[(size_t)row * 32 + u.pn * 4 + wc] = ss;
                asm volatile("" ::: "memory");
            }
    }
}
__device__ __forceinline__ void phase_glu(CArgs& a, int layer, bool dry, LAS unsigned char* lds, GemmDesc& g) {
    const bf16_t* Zb = (const bf16_t*)(a.ws + WS_Z); const bf16_t* W = (const bf16_t*)(a.ws + WS_WGLU) + (size_t)layer * 2048 * 1024;
    float* H = (float*)(a.ws + WS_H); float* Hout = (float*)(a.ws + (dry ? WS_DUMH : WS_H)); float* SSQ = (float*)(a.ws + (dry ? WS_DUMSSQ : WS_SSQ));
    const float* res = layer == 0 ? a.in[0] : H; const float* resm = layer == 0 ? a.in[1] : H + (size_t)NREAL * D;
    if (opaque_bid() < 32) {
        const int lane = opaque_tid() & 63, fr = lane & 15, fq = lane >> 4, task = opaque_bid();
        const int c0 = 32 * task, rv = 256 * (c0 >> 7) + (c0 & 127);
        const bf16_t* const br[4] = {W + (size_t)rv * D, W + (size_t)(rv + 16) * D, W + (size_t)(rv + 128) * D, W + (size_t)(rv + 144) * D};
        f32x4 o[4];
        if (meta_block<4>(lds, Zb + (size_t)NREAL * D, br, D, o)) {
            float ss = 0.f;
#pragma unroll
            for (int n = 0; n < 2; ++n) {
                const f32x4 v = o[n], gt = o[2 + n];
                f32x4 h = *(const f32x4*)(resm + (size_t)fr * D + c0 + 16 * n + 4 * fq);
                h[0] += v[0] * sigmoidf_(gt[0]); h[1] += v[1] * sigmoidf_(gt[1]); h[2] += v[2] * sigmoidf_(gt[2]); h[3] += v[3] * sigmoidf_(gt[3]);
                *(f32x4*)(Hout + (size_t)(NREAL + fr) * D + c0 + 16 * n + 4 * fq) = h; ss += ssq4(h);
            }
            ss = quad_sum(ss);
            if (fq == 0) SSQ[(size_t)(NREAL + fr) * 32 + task] = ss;
        }
    }
    g.kind = EPI_GLU; g.K = D; g.perm = 0; g.gather = 0; g.moe = 0; g.nM = NREAL / BM; g.nN = 2048 / BM; g.nwg = g.nM * g.nN; g.A = (const char*)Zb; g.Bt = (const char*)W;
    g.tstepA = g.tstepB = (size_t)BM * D * 2; g.wstride = 0; g.res = res; g.Hout = Hout; g.SSQ = SSQ;
}

__device__ __forceinline__ void epi_oproj(const GemmDesc& g, const f32x4 (&acc)[2][2][4][2], const Unit& u, int wr, int wc, int fr, int fq) {
    { const float* res = g.res; float* Hout = g.Hout; float* SSQ = g.SSQ; const float* bias = g.bias;
#pragma unroll
        for (int ai = 0; ai < 2; ++ai)
#pragma unroll
            for (int m = 0; m < 4; ++m) {
                const int row = u.pm * BM + ai * HALF + wr * 64 + m * 16 + fr;
#pragma unroll
                for (int bj = 0; bj < 2; ++bj) {
                    const int c0 = u.pn * BM + bj * HALF + wc * 32 + 4 * fq; const size_t off = (size_t)row * D + c0;
                    float ss = 0.f;
#pragma unroll
                    for (int n = 0; n < 2; ++n) { f32x4 h = *(const f32x4*)(res + off + 16 * n); h += acc[ai][bj][m][n] + *(const f32x4*)(bias + c0 + 16 * n); *(f32x4*)(Hout + off + 16 * n) = h; ss += ssq4(h); }
                    ss = quad_sum(ss);
                    if (fq == 0) SSQ[(size_t)row * 32 + u.pn * 8 + bj * 4 + wc] = ss;
                    asm volatile("" ::: "memory");
                }
            }
    }
}
__device__ __forceinline__ void phase_oproj(CArgs& a, int j, bool dry, LAS unsigned char* lds, GemmDesc& g) {
    const bf16_t* Ob = (const bf16_t*)(a.ws + WS_Z); const bf16_t* W = (const bf16_t*)(a.ws + WS_WO) + (size_t)j * 1024 * 1024;
    float* H = (float*)(a.ws + WS_H); float* Hout = (float*)(a.ws + (dry ? WS_DUMH : WS_H)); float* SSQ = (float*)(a.ws + (dry ? WS_DUMSSQ : WS_SSQ));
    const float* bo = a.in[21] + (size_t)j * D;
    if (opaque_bid() < 32) {
        const int lane = opaque_tid() & 63, fr = lane & 15, fq = lane >> 4, task = opaque_bid(), c0 = 32 * task;
        const bf16_t* const br[2] = {W + (size_t)c0 * D, W + (size_t)(c0 + 16) * D};
        f32x4 o[2];
        if (meta_block<2>(lds, Ob + (size_t)NREAL * D, br, D, o)) {
            float ss = 0.f;
#pragma unroll
            for (int n = 0; n < 2; ++n) {
                const size_t off = (size_t)(NREAL + fr) * D + c0 + 16 * n + 4 * fq;
                f32x4 h = *(const f32x4*)(H + off); h += o[n] + *(const f32x4*)(bo + c0 + 16 * n + 4 * fq); *(f32x4*)(Hout + off) = h; ss += ssq4(h);
            }
            ss = quad_sum(ss);
            if (fq == 0) SSQ[(size_t)(NREAL + fr) * 32 + task] = ss;
        }
    }
    g.kind = EPI_OPROJ; g.K = D; g.perm = 0; g.gather = 0; g.moe = 0; g.nM = NREAL / BM; g.nN = 1024 / BM; g.nwg = g.nM * g.nN; g.A = (const char*)Ob; g.Bt = (const char*)W;
    g.tstepA = g.tstepB = (size_t)BM * D * 2; g.wstride = 0; g.res = H; g.Hout = Hout; g.SSQ = SSQ; g.bias = bo;
}

__device__ __forceinline__ void kvq_store8(const GemmDesc& g, int row, int c, const float (&v)[8]) {
    if (c < 256) {
        const float* b = g.bias + c; u32x4 w; w.x = cvt_pk_bf16(v[0] + b[0], v[1] + b[1]); w.y = cvt_pk_bf16(v[2] + b[2], v[3] + b[3]); w.z = cvt_pk_bf16(v[4] + b[4], v[5] + b[5]); w.w = cvt_pk_bf16(v[6] + b[6], v[7] + b[7]);
        *(u32x4*)(g.O1 + (size_t)row * 256 + c) = w;
    } else if (c < 512) {
        const int cv = c - 256; const float* b = g.bias + c;
        bf16_t* vp = g.O2 + (row < NREAL ? ((size_t)(row >> 11) * 256 + cv) * SEQ + (row & (SEQ - 1)) : VT_META + (size_t)cv * 16 + (row - NREAL));
        const size_t st = row < NREAL ? SEQ : 16;
#pragma unroll
        for (int i = 0; i < 4; ++i) { const unsigned p = cvt_pk_bf16(v[2 * i] + b[2 * i], v[2 * i + 1] + b[2 * i + 1]); vp[(size_t)(2 * i) * st] = (bf16_t)(p & 0xffffu); vp[(size_t)(2 * i + 1) * st] = (bf16_t)(p >> 16); }
    } else {
        const int cq = c - 512; const float* b = g.bias2 + cq;
        u32x4 w; w.x = cvt_pk_bf16((v[0] + b[0]) * 0.125f, (v[1] + b[1]) * 0.125f); w.y = cvt_pk_bf16((v[2] + b[2]) * 0.125f, (v[3] + b[3]) * 0.125f);
        w.z = cvt_pk_bf16((v[4] + b[4]) * 0.125f, (v[5] + b[5]) * 0.125f); w.w = cvt_pk_bf16((v[6] + b[6]) * 0.125f, (v[7] + b[7]) * 0.125f);
        *(u32x4*)(g.O3 + (size_t)row * D + cq) = w;
    }
}
__device__ __forceinline__ void epi_kvq(const GemmDesc& g, const f32x4 (&acc)[2][2][4][2], const Unit& u, int wr, int wc, int fr, int fq) {
    { const int cbase = g.cbase;
#pragma unroll
        for (int ai = 0; ai < 2; ++ai)
#pragma unroll
            for (int m = 0; m < 4; ++m) {
                const int row = u.pm * BM + ai * HALF + wr * 64 + m * 16 + fr;
#pragma unroll
                for (int bj = 0; bj < 2; ++bj) {
                    const int c = cbase + u.pn * BM + bj * HALF + wc * 32 + 8 * fq;
                    const f32x4 v0 = acc[ai][bj][m][0], v1 = acc[ai][bj][m][1];
                    const float v[8] = {v0[0], v0[1], v0[2], v0[3], v1[0], v1[1], v1[2], v1[3]};
                    kvq_store8(g, row, c, v);
                    asm volatile("" ::: "memory");
                }
            }
    }
}
__device__ __forceinline__ void phase_kvq_q(CArgs& a, int jq, LAS unsigned char* lds, GemmDesc& g) {
    const bf16_t* Ub = (const bf16_t*)(a.ws + WS_U); const bf16_t* W = jq == 0 ? (const bf16_t*)(a.ws + WS_WKVQ) : (const bf16_t*)(a.ws + WS_WQ1);
    const int N = jq == 0 ? 1536 : 1024, cbase = jq == 0 ? 0 : 512;
    if (opaque_bid() < N / 32) {
        const int lane = opaque_tid() & 63, fr = lane & 15, fq = lane >> 4, task = opaque_bid();
        const bf16_t* const br[2] = {W + (size_t)(32 * task) * D, W + (size_t)(32 * task + 16) * D};
        f32x4 o[2];
        if (meta_block<2>(lds, Ub + (size_t)NREAL * D, br, D, o)) {
#pragma unroll
            for (int h = 0; h < 2; ++h) {
                const int c = cbase + 32 * task + 16 * h + 4 * fq; const f32x4 v = o[h]; const int row = NREAL + fr;
                if (c < 256) { const float* b = a.in[16] + c; u32x2 w; w.x = cvt_pk_bf16(v[0] + b[0], v[1] + b[1]); w.y = cvt_pk_bf16(v[2] + b[2], v[3] + b[3]); *(u32x2*)((bf16_t*)(a.ws + WS_K) + (size_t)row * 256 + c) = w; }
                else if (c < 512) { const int cv = c - 256; const float* b = a.in[16] + c; bf16_t* vp = (bf16_t*)(a.ws + WS_VT) + VT_META + (size_t)cv * 16 + fr;
                    const unsigned p0 = cvt_pk_bf16(v[0] + b[0], v[1] + b[1]), p1 = cvt_pk_bf16(v[2] + b[2], v[3] + b[3]);
                    vp[0] = (bf16_t)(p0 & 0xffffu); vp[16] = (bf16_t)(p0 >> 16); vp[32] = (bf16_t)(p1 & 0xffffu); vp[48] = (bf16_t)(p1 >> 16); }
                else { const int cq = c - 512; const float* b = a.in[18] + (size_t)jq * D + cq; u32x2 w; w.x = cvt_pk_bf16((v[0] + b[0]) * 0.125f, (v[1] + b[1]) * 0.125f); w.y = cvt_pk_bf16((v[2] + b[2]) * 0.125f, (v[3] + b[3]) * 0.125f);
                    *(u32x2*)((bf16_t*)(a.ws + WS_Q) + (size_t)row * D + cq) = w; }
            }
        }
    }
    g.kind = EPI_KVQ; g.K = D; g.perm = 1; g.gather = 0; g.moe = 0; g.nM = NREAL / BM; g.nN = N / BM; g.nwg = g.nM * g.nN; g.A = (const char*)Ub; g.Bt = (const char*)W;
    g.tstepA = g.tstepB = (size_t)BM * D * 2; g.wstride = 0; g.bias = a.in[16]; g.bias2 = a.in[18] + (size_t)jq * D; g.O1 = (bf16_t*)(a.ws + WS_K); g.O2 = (bf16_t*)(a.ws + WS_VT); g.O3 = (bf16_t*)(a.ws + WS_Q);
    g.jq = jq; g.cbase = cbase;
}

__device__ __forceinline__ void moe_scan(const int* cnt, LAS int* sh) {
    if (opaque_tid() == 0) { int acc = 0; for (int e = 0; e < 32; ++e) { sh[e] = acc; acc += (cnt[e] + 255) >> 8; } sh[32] = acc; }
    __syncthreads();
}
__device__ __forceinline__ void epi_moe1(const GemmDesc& g, LAS unsigned char* lds, const f32x4 (&acc)[2][2][4][2], const Unit& u, int wr, int wc, int fr, int fq) {
    { bf16_t* HB = g.O1;
        const LAS int* tabt = (const LAS int*)(lds + LDS_TABT) + u.slot * 256;
#pragma unroll
        for (int ai = 0; ai < 2; ++ai)
#pragma unroll
            for (int m = 0; m < 4; ++m) {
                const int rl = ai * HALF + wr * 64 + m * 16 + fr;
                if (tabt[rl] >= 0) {
                    const f32x4 g0 = acc[ai][0][m][0], g1 = acc[ai][0][m][1], u0 = acc[ai][1][m][0], u1 = acc[ai][1][m][1];
                    u32x4 w; w.x = cvt_pk_bf16(g0[0] * sigmoidf_(g0[0]) * u0[0], g0[1] * sigmoidf_(g0[1]) * u0[1]); w.y = cvt_pk_bf16(g0[2] * sigmoidf_(g0[2]) * u0[2], g0[3] * sigmoidf_(g0[3]) * u0[3]);
                    w.z = cvt_pk_bf16(g1[0] * sigmoidf_(g1[0]) * u1[0], g1[1] * sigmoidf_(g1[1]) * u1[1]); w.w = cvt_pk_bf16(g1[2] * sigmoidf_(g1[2]) * u1[2], g1[3] * sigmoidf_(g1[3]) * u1[3]);
                    *(u32x4*)(HB + ((size_t)u.pm * 256 + rl) * DEXP + u.pn * 128 + wc * 32 + 8 * fq) = w;
                }
                asm volatile("" ::: "memory");
            }
    }
}
__device__ __forceinline__ void phase_moe1(CArgs& a, int layer, LAS unsigned char* lds, GemmDesc& g) {
    LAS int* sh = (LAS int*)(lds + LDS_SH);
    const int* cnt = (const int*)(a.ws + WS_CTL) + CW_CNT + layer * 32;
    moe_scan(cnt, sh);
    g.kind = EPI_MOE1; g.K = D; g.perm = 1; g.gather = 1; g.moe = 1; g.npn = 4; g.nwg = sh[32] * 4; g.nM = 0; g.nN = 4;
    g.A = (const char*)(a.ws + WS_XN); g.Bt = (const char*)(a.ws + WS_W1) + (size_t)layer * 32 * 1024 * 1024 * 2; g.wstride = (size_t)1024 * 1024 * 2;
    g.tstepA = 0; g.tstepB = (size_t)256 * 1024 * 2; g.cnt = cnt; g.LTOK = (const int*)(a.ws + WS_LTOK); g.LGATE = (const float*)(a.ws + WS_LGATE); g.O1 = (bf16_t*)(a.ws + WS_HB);
}
__device__ __forceinline__ void epi_moe2(const GemmDesc& g, LAS unsigned char* lds, const f32x4 (&acc)[2][2][4][2], const Unit& u, int wr, int wc, int fr, int fq) {
    { bf16_t* YB = g.O1;
        const LAS int* tabt = (const LAS int*)(lds + LDS_TABT) + u.slot * 256; const LAS float* tabg = (const LAS float*)(lds + LDS_TABG) + u.slot * 256;
#pragma unroll
        for (int ai = 0; ai < 2; ++ai)
#pragma unroll
            for (int m = 0; m < 4; ++m) {
                const int rl = ai * HALF + wr * 64 + m * 16 + fr; const int rt = tabt[rl];
                if (rt >= 0) {
                    const float gs = tabg[rl];
                    bf16_t* yp = YB + ((size_t)(rt & 0x3fffffff) * 2 + (rt >> 30)) * D + u.pn * BM + wc * 32 + 8 * fq;
#pragma unroll
                    for (int bj = 0; bj < 2; ++bj) { const f32x4 v0 = acc[ai][bj][m][0] * gs, v1 = acc[ai][bj][m][1] * gs;
                        u32x4 w; w.x = cvt_pk_bf16(v0[0], v0[1]); w.y = cvt_pk_bf16(v0[2], v0[3]); w.z = cvt_pk_bf16(v1[0], v1[1]); w.w = cvt_pk_bf16(v1[2], v1[3]);
                        *(u32x4*)(yp + bj * HALF) = w; }
                }
                asm volatile("" ::: "memory");
            }
    }
}
__device__ __forceinline__ void phase_moe2(CArgs& a, int layer, LAS unsigned char* lds, GemmDesc& g) {
    LAS int* sh = (LAS int*)(lds + LDS_SH);
    const int* cnt = (const int*)(a.ws + WS_CTL) + CW_CNT + layer * 32;
    moe_scan(cnt, sh);
    g.kind = EPI_MOE2; g.K = DEXP; g.perm = 1; g.gather = 0; g.moe = 1; g.npn = 4; g.nwg = sh[32] * 4; g.nM = 0; g.nN = 4;
    g.A = (const char*)(a.ws + WS_HB); g.Bt = (const char*)(a.ws + WS_W2) + (size_t)layer * 32 * 1024 * 512 * 2; g.wstride = (size_t)1024 * 512 * 2;
    g.tstepA = (size_t)256 * DEXP * 2; g.tstepB = (size_t)256 * DEXP * 2; g.cnt = cnt; g.LTOK = (const int*)(a.ws + WS_LTOK); g.LGATE = (const float*)(a.ws + WS_LGATE); g.O1 = (bf16_t*)(a.ws + WS_YB);
}
__device__ __forceinline__ void gemm_epilogue(const GemmDesc& g, LAS unsigned char* lds, const f32x4 (&acc)[2][2][4][2], const Unit& u, int wr, int wc, int fr, int fq) {
    asm volatile("" : "+v"(fr), "+v"(fq));
    switch (g.kind) {
        case EPI_GLU: epi_glu(g, acc, u, wr, wc, fr, fq); break;
        case EPI_OPROJ: epi_oproj(g, acc, u, wr, wc, fr, fq); break;
        case EPI_KVQ: epi_kvq(g, acc, u, wr, wc, fr, fq); break;
        case EPI_MOE1: epi_moe1(g, lds, acc, u, wr, wc, fr, fq); break;
        default: epi_moe2(g, lds, acc, u, wr, wc, fr, fq); break;
    }
}

constexpr int AT_NSLOT = 272, AT_VROW = 552, AT_KBYTES = AT_NSLOT * 128, AT_VBYTES = 64 * AT_VROW;
__device__ __forceinline__ void attn_tile(LAS unsigned char* Ks, LAS unsigned char* Vs, const bf16_t* qp, bf16_t* op, float sink, int nblk  , int kb0  , int srel  , int smin  , int lmeta  , int tc, int q4) {
    const bf16x8 qf0 = as_bf16x8(*(const u32x4*)qp), qf1 = as_bf16x8(*(const u32x4*)(qp + 32));
    f32x4 s[10];
#pragma unroll
    for (int bi = 0; bi < 10; ++bi) {
        s[bi] = (f32x4){-1e30f, -1e30f, -1e30f, -1e30f};
        if (bi < nblk) {
            const int sl = (bi == 0 ? 0 : 16 + 16 * (kb0 + bi - 1)) + tc;
            const LAS unsigned char* kr = Ks + sl * 128;
            const bf16x8 kf0 = *(const LAS bf16x8*)(kr + ((q4 ^ (sl & 7)) << 4)), kf1 = *(const LAS bf16x8*)(kr + (((4 + q4) ^ (sl & 7)) << 4));
            f32x4 acc = {0.f, 0.f, 0.f, 0.f};
            acc = mfma16(kf0, qf0, acc); acc = mfma16(kf1, qf1, acc);
#pragma unroll
            for (int r = 0; r < 4; ++r) {
                const int kk = 16 * (kb0 + bi - 1) + 4 * q4 + r;
                const bool ok = bi == 0 ? (4 * q4 + r <= lmeta) : (kk >= smin && kk <= srel && kk >= srel - 127);
                s[bi][r] = ok ? acc[r] : -1e30f;
            }
        }
    }
    float m = sink;
#pragma unroll
    for (int bi = 0; bi < 10; ++bi) m = fmaxf(m, fmaxf(fmaxf(s[bi][0], s[bi][1]), fmaxf(s[bi][2], s[bi][3])));
    m = xor32_max(xor16_max(m));
    float den = 0.f;
    unsigned pk[10][2];
#pragma unroll
    for (int bi = 0; bi < 10; ++bi) {
        float p[4];
#pragma unroll
        for (int r = 0; r < 4; ++r) { p[r] = s[bi][r] > -1e29f ? fast_exp(s[bi][r] - m) : 0.f; den += p[r]; }
        pk[bi][0] = cvt_pk_bf16(p[0], p[1]); pk[bi][1] = cvt_pk_bf16(p[2], p[3]);
    }
    den = quad_sum(den);
    den += fast_exp(sink - m);
    const float inv = 1.0f / den;
    f32x4 o[4];
#pragma unroll
    for (int dt = 0; dt < 4; ++dt) o[dt] = (f32x4){0.f, 0.f, 0.f, 0.f};
#pragma unroll
    for (int pp = 0; pp < 5; ++pp) {
        if (2 * pp < nblk) {
            const int biA = 2 * pp, biB = 2 * pp + 1;
            const int slA = biA == 0 ? 0 : 16 + 16 * (kb0 + biA - 1), slB = biB < nblk ? 16 + 16 * (kb0 + biB - 1) : slA;
            u32x4 pw; pw.x = pk[biA][0]; pw.y = pk[biA][1]; pw.z = pk[biB][0]; pw.w = pk[biB][1];
            const bf16x8 pf = as_bf16x8(pw);
#pragma unroll
            for (int dt = 0; dt < 4; ++dt) {
                const LAS unsigned char* vr = Vs + (16 * dt + tc) * AT_VROW + 8 * q4;
                const u32x2 va = *(const LAS u32x2*)(vr + slA * 2), vb = *(const LAS u32x2*)(vr + slB * 2);
                u32x4 vw; vw.x = va.x; vw.y = va.y; vw.z = vb.x; vw.w = vb.y;
                o[dt] = mfma16(as_bf16x8(vw), pf, o[dt]);
            }
        }
    }
#pragma unroll
    for (int dt = 0; dt < 4; ++dt) { u32x2 w; w.x = cvt_pk_bf16(o[dt][0] * inv, o[dt][1] * inv); w.y = cvt_pk_bf16(o[dt][2] * inv, o[dt][3] * inv); *(u32x2*)(op + 16 * dt) = w; }
}
__device__ __forceinline__ void phase_attn(CArgs& a, int j, LAS unsigned char* lds) {
    const int tid = opaque_tid(), lane = tid & 63, wid = tid >> 6, tc = lane & 15, q4 = lane >> 4;
    const bf16_t* Q = (const bf16_t*)(a.ws + WS_Q); const bf16_t* K = (const bf16_t*)(a.ws + WS_K); const bf16_t* VT = (const bf16_t*)(a.ws + WS_VT);
    bf16_t* O = (bf16_t*)(a.ws + WS_Z);
    LAS unsigned char* Ks = lds; LAS unsigned char* Vs = lds + AT_KBYTES;
    constexpr int NU_REAL = NB * 4 * 16;
    for (int unit = opaque_bid(); unit < NU_REAL + 4; unit += GRID) {
        const bool meta = unit >= NU_REAL;
        const int qt = meta ? 0 : (unit & 15), kvh = meta ? unit - NU_REAL : ((unit >> 4) & 3), b = meta ? 0 : (unit >> 6), s0 = qt * 128;
        __syncthreads();
        for (int idx = tid; idx < AT_NSLOT * 8; idx += NTHREADS) {
            const int sl = idx >> 3, c = idx & 7, sw = s0 - 128 + (sl - 16);
            u32x4 v = {0u, 0u, 0u, 0u};
            if (sl < 16) v = *(const u32x4*)(K + (size_t)(NREAL + sl) * 256 + kvh * 64 + c * 8);
            else if (!meta && sw >= 0) v = *(const u32x4*)(K + (size_t)(b * SEQ + sw) * 256 + kvh * 64 + c * 8);
            *(LAS u32x4*)(Ks + sl * 128 + ((c ^ (sl & 7)) << 4)) = v;
        }
        for (int idx = tid; idx < 64 * 34; idx += NTHREADS) {
            const int d = idx / 34, ch = idx - d * 34, sw = s0 - 128 + 8 * (ch - 2);
            u32x4 v = {0u, 0u, 0u, 0u};
            if (ch < 2) v = *(const u32x4*)(VT + VT_META + (size_t)(kvh * 64 + d) * 16 + ch * 8);
            else if (!meta && sw >= 0) v = *(const u32x4*)(VT + ((size_t)(b * 4 + kvh) * 64 + d) * SEQ + sw);
            *(LAS u32x2*)(Vs + d * AT_VROW + ch * 16) = (u32x2){v.x, v.y}; *(LAS u32x2*)(Vs + d * AT_VROW + ch * 16 + 8) = (u32x2){v.z, v.w};
        }
        __syncthreads();
        const int g = wid & 3, hq = kvh * 4 + g;
        const float sink = a.in[19][j * 16 + hq];
        if (meta) {
            if (wid < 4) { const size_t row = (size_t)(NREAL + tc); attn_tile(Ks, Vs, Q + row * D + hq * 64 + 8 * q4, O + row * D + hq * 64 + 4 * q4, sink, 1, 0, 0, 0, tc, tc, q4); }
        } else {
#pragma unroll 1
            for (int jt = wid >> 2; jt < 8; jt += 2) {
                const int s = s0 + 16 * jt + tc; const size_t row = (size_t)(b * SEQ + s);
                attn_tile(Ks, Vs, Q + row * D + hq * 64 + 8 * q4, O + row * D + hq * 64 + 4 * q4, sink, 10, jt, 128 + 16 * jt + tc, 128 - s0, 64, tc, q4);
            }
        }
    }
}

__device__ __forceinline__ void phase_route(CArgs& a, int layer, bool dry, LAS unsigned char* lds) {
    LAS unsigned char* Wf = lds; LAS float* LG = (LAS float*)(lds + 98304); LAS int* hist = (LAS int*)(lds + 98304 + 24576); LAS int* hbase = hist + 32;
    const int tid = opaque_tid(), lane = tid & 63, wid = tid >> 6, tc = lane & 15, q4 = lane >> 4;
    const float* wg = a.in[22] + (size_t)layer * D * NGRP; const float* we = a.in[24] + (size_t)layer * D * NEXP;
    const float* gain = a.in[3] + (size_t)layer * D;
    for (int idx = tid; idx < 3 * 32 * 64; idx += NTHREADS) {
        const int l = idx & 63, ks = (idx >> 6) & 31, rt = idx >> 11, o = 16 * rt + (l & 15), k0 = 32 * ks + 8 * (l >> 4);
        float v[8];
#pragma unroll
        for (int jq = 0; jq < 8; ++jq) v[jq] = (o < 4 ? wg[(size_t)(k0 + jq) * NGRP + o] : (o < 36 ? we[(size_t)(k0 + jq) * NEXP + (o - 4)] : 0.f)) * gain[k0 + jq];
        u32x4 w; w.x = cvt_pk_bf16(v[0], v[1]); w.y = cvt_pk_bf16(v[2], v[3]); w.z = cvt_pk_bf16(v[4], v[5]); w.w = cvt_pk_bf16(v[6], v[7]);
        *(LAS u32x4*)(Wf + (size_t)idx * 16) = w;
    }
    if (tid < 32) hist[tid] = 0;
    __syncthreads();
    const float* H = (const float*)(a.ws + WS_H); const float* SSQ = (const float*)(a.ws + WS_SSQ); bf16_t* XN = (bf16_t*)(a.ws + WS_XN);
    int* cnt = (int*)(a.ws + WS_CTL) + (dry ? CW_DUMCNT : CW_CNT) + layer * 32; int* LTOK = (int*)(a.ws + (dry ? WS_DUMLT : WS_LTOK)); float* LGATE = (float*)(a.ws + (dry ? WS_DUMLG : WS_LGATE));
    const int tile = wid * GRID + opaque_bid();
    const bool active = tile < RT / 16;
    int e1, e2, r1, r2; float g1, g2;
    asm volatile("" : "=v"(e1), "=v"(e2), "=v"(r1), "=v"(r2), "=v"(g1), "=v"(g2));
    if (active) {
        const int row = tile * 16 + tc;
        float ss = 0.f;
        { const f32x4* sp = (const f32x4*)(SSQ + (size_t)row * 32 + 8 * q4); const f32x4 s0 = sp[0], s1 = sp[1]; ss = (s0[0] + s0[1]) + (s0[2] + s0[3]) + (s1[0] + s1[1]) + (s1[2] + s1[3]); }
        ss = quad_sum(ss);
        const float rstd = 1.0f / sqrtf(ss * (1.0f / D) + RMS_EPS);
        f32x4 acc[3];
#pragma unroll
        for (int rt = 0; rt < 3; ++rt) acc[rt] = (f32x4){0.f, 0.f, 0.f, 0.f};
        const float* hp = H + (size_t)row * D + 8 * q4; bf16_t* xp = XN + (size_t)row * D + 8 * q4;
#pragma unroll 4
        for (int ks = 0; ks < 32; ++ks) {
            const f32x4 h0 = *(const f32x4*)(hp + 32 * ks), h1 = *(const f32x4*)(hp + 32 * ks + 4);
            u32x4 xw; xw.x = cvt_pk_bf16(h0[0] * rstd, h0[1] * rstd); xw.y = cvt_pk_bf16(h0[2] * rstd, h0[3] * rstd);
            xw.z = cvt_pk_bf16(h1[0] * rstd, h1[1] * rstd); xw.w = cvt_pk_bf16(h1[2] * rstd, h1[3] * rstd);
            *(u32x4*)(xp + 32 * ks) = xw;
            const bf16x8 xf = as_bf16x8(xw);
#pragma unroll
            for (int rt = 0; rt < 3; ++rt) acc[rt] = mfma16(*(LAS bf16x8*)(Wf + ((size_t)(rt * 32 + ks) * 64 + lane) * 16), xf, acc[rt]);
        }
        LAS float* lg = LG + wid * 16 * 48;
#pragma unroll
        for (int rt = 0; rt < 3; ++rt)
#pragma unroll
            for (int r = 0; r < 4; ++r) lg[tc * 48 + 16 * rt + 4 * q4 + r] = acc[rt][r];
        asm volatile("s_waitcnt lgkmcnt(0)" ::: "memory");
        if (lane < 16) {
            const LAS float* mylg = lg + lane * 48;
            float gl[4]; int gi = 0; float gm;
#pragma unroll
            for (int i = 0; i < 4; ++i) gl[i] = mylg[i] + a.in[23][layer * NGRP + i];
            gm = gl[0];
#pragma unroll
            for (int i = 1; i < 4; ++i) if (gl[i] > gm) { gm = gl[i]; gi = i; }
            float gz = 0.f;
#pragma unroll
            for (int i = 0; i < 4; ++i) gz += expf(gl[i] - gm);
            const float pg = 1.0f / gz;
            float el[8];
#pragma unroll
            for (int i = 0; i < 8; ++i) el[i] = mylg[4 + gi * 8 + i] + a.in[25][layer * NEXP + gi * 8 + i];
            int i1 = 0; float m1 = el[0];
#pragma unroll
            for (int i = 1; i < 8; ++i) if (el[i] > m1) { m1 = el[i]; i1 = i; }
            int i2 = -1; float m2 = -3.0e38f;
#pragma unroll
            for (int i = 0; i < 8; ++i) if (i != i1 && el[i] > m2) { m2 = el[i]; i2 = i; }
            float one = 1.0f; asm volatile("" : "+v"(one));
            const float x2 = expf(m2 - m1), q1 = one / (one + x2);
            g1 = pg * q1; g2 = pg * x2 * q1; e1 = gi * 8 + i1; e2 = gi * 8 + i2;
            r1 = __hip_atomic_fetch_add(&hist[e1], 1, __ATOMIC_RELAXED, __HIP_MEMORY_SCOPE_WORKGROUP); r2 = __hip_atomic_fetch_add(&hist[e2], 1, __ATOMIC_RELAXED, __HIP_MEMORY_SCOPE_WORKGROUP);
        }
    }
    __syncthreads();
    if (tid < 32) hbase[tid] = hist[tid] ? atomicAdd(&cnt[tid], hist[tid]) : 0;
    __syncthreads();
    if (active && lane < 16) {
        const int row = tile * 16 + lane;
        const int s1 = hbase[e1] + r1, s2 = hbase[e2] + r2;
        LTOK[(size_t)e1 * RT + s1] = row; LGATE[(size_t)e1 * RT + s1] = g1;
        LTOK[(size_t)e2 * RT + s2] = row | (1 << 30); LGATE[(size_t)e2 * RT + s2] = g2;
    }
}

__device__ __forceinline__ void phase_combine(CArgs& a, int layer, bool dry) {
    const int lane = opaque_tid() & 63, gw = opaque_bid() * 8 + (opaque_tid() >> 6);
    float* H = (float*)(a.ws + WS_H); const bf16_t* YB = (const bf16_t*)(a.ws + WS_YB);
    for (int row = gw; row < RT; row += GRID * 8) {
        f32x4 v[4]; float ssq = 0.f;
        float* hp = H + (size_t)row * D; const bf16_t* y0 = YB + (size_t)row * 2 * D; const bf16_t* y1 = y0 + D;
#pragma unroll
        for (int j = 0; j < 4; ++j) {
            const int c = 4 * lane + 256 * j;
            v[j] = *(const f32x4*)(hp + c);
            const u32x2 p0 = *(const u32x2*)(y0 + c), p1 = *(const u32x2*)(y1 + c);
            v[j][0] += bf16_lo(p0.x) + bf16_lo(p1.x); v[j][1] += bf16_hi(p0.x) + bf16_hi(p1.x); v[j][2] += bf16_lo(p0.y) + bf16_lo(p1.y); v[j][3] += bf16_hi(p0.y) + bf16_hi(p1.y);
            ssq += ssq4(v[j]);
        }
        ssq = wave_sum(ssq);
        if (layer < 3) {
            if (!dry) {
#pragma unroll
                for (int j = 0; j < 4; ++j) *(f32x4*)(hp + 4 * lane + 256 * j) = v[j];
                row_norm_store(v, ssq, lane, layer == 0 ? a.in[2] + D : nullptr, (bf16_t*)(a.ws + WS_U) + (size_t)row * D);
            } else {
                float* dp = (float*)(a.ws + WS_DUMH) + (size_t)row * D;
#pragma unroll
                for (int j = 0; j < 4; ++j) *(f32x4*)(dp + 4 * lane + 256 * j) = v[j];
                row_norm_store(v, ssq, lane, layer == 0 ? a.in[2] + D : nullptr, (bf16_t*)(a.ws + WS_DUMSSQ) + (size_t)(row & 1023) * D);
            }
        } else if (row < NREAL) {
            const float rstd = 1.0f / sqrtf(ssq * (1.0f / D) + RMS_EPS);
            float* op = a.out + (size_t)row * D;
#pragma unroll
            for (int j = 0; j < 4; ++j) { const int c = 4 * lane + 256 * j; const f32x4 g = *(const f32x4*)(a.in[5] + c);
                f32x4 o; o[0] = v[j][0] * rstd * g[0]; o[1] = v[j][1] * rstd * g[1]; o[2] = v[j][2] * rstd * g[2]; o[3] = v[j][3] * rstd * g[3];
                *(f32x4*)(op + c) = o; }
        }
    }
}

enum { PH_PREP = 0, PH_S5, PH_GLU, PH_ROUTE, PH_G1, PH_G2, PH_COMB, PH_KVQ, PH_ATT, PH_OPROJ, PH_QG };
constexpr int NPH = 27;
__constant__ int c_prog[NPH][2] = {
    {PH_PREP, 0},
    {PH_S5, 0}, {PH_GLU, 0}, {PH_ROUTE, 0}, {PH_G1, 0}, {PH_G2, 0}, {PH_COMB, 0},
    {PH_S5, 1}, {PH_GLU, 1}, {PH_ROUTE, 1}, {PH_G1, 1}, {PH_G2, 1}, {PH_COMB, 1},
    {PH_KVQ, 2}, {PH_ATT, 2}, {PH_OPROJ, 2}, {PH_ROUTE, 2}, {PH_G1, 2}, {PH_G2, 2}, {PH_COMB, 2},
    {PH_QG, 3}, {PH_ATT, 3}, {PH_OPROJ, 3}, {PH_ROUTE, 3}, {PH_G1, 3}, {PH_G2, 3}, {PH_COMB, 3},
};

__global__ void __launch_bounds__(NTHREADS) yoco_fwd(Args a) {
    extern __shared__ __attribute__((aligned(16))) unsigned char smem_raw[];
    LAS unsigned char* lds = (LAS unsigned char*)smem_raw;
    volatile LAS unsigned* const st = (volatile LAS unsigned*)(lds + LDS_BYTES - 16);
    if (a.ph_hi - a.ph_lo > 1) {
        if (threadIdx.x == 0) { st[0] = 0u; st[1] = 0u; }
        __syncthreads();
        xcd_barrier_post((unsigned*)(a.ws + WS_CTL) + CW_BAR);
    }
    CArgs* const kp = (CArgs*)__builtin_amdgcn_kernarg_segment_ptr();
    for (int ph = a.ph_lo; ph < a.ph_hi; ++ph) {
        const int type = c_prog[ph][0], layer = c_prog[ph][1];
        const int reps = type == a.rep_type ? a.rep_n : 0;
        for (int r = 0; r <= reps; ++r) {
            const bool dry = r > 0;
            CArgs* lp = kp; asm volatile("" : "+s"(lp));
            CArgs& la = *lp;
            GemmDesc g; bool is_gemm = true;
            switch (type) {
                case PH_GLU: phase_glu(la, layer, dry, lds, g); break;
                case PH_G1: phase_moe1(la, layer, lds, g); break;
                case PH_G2: phase_moe2(la, layer, lds, g); break;
                case PH_KVQ: case PH_QG: phase_kvq_q(la, type == PH_QG ? 1 : 0, lds, g); break;
                case PH_OPROJ: phase_oproj(la, layer - 2, dry, lds, g); break;
                default: is_gemm = false; break;
            }
            if (is_gemm) gemm_run(lds, g);
            else switch (type) {
                case PH_PREP: phase_prep(la, lds); break;
                case PH_S5: phase_s5(la, layer, lds); break;
                case PH_ROUTE: phase_route(la, layer, dry, lds); break;
                case PH_COMB: phase_combine(la, layer, dry); break;
                default: phase_attn(la, layer - 2, lds); break;
            }
            if (r < reps || ph + 1 < a.ph_hi) { if (a.ph_hi - a.ph_lo > 1) xcd_barrier((unsigned*)(la.ws + WS_CTL) + CW_BAR, st); }
        }
        if (a.rep_type == 100 && ph + 1 < a.ph_hi) for (int r = 0; r < a.rep_n; ++r) xcd_barrier((unsigned*)(a.ws + WS_CTL) + CW_BAR, st);
    }
}

extern "C" void kernel_launch(void* const* d_in, const int* in_sizes, int n_in, void* d_out, int out_size, void* d_ws, size_t ws_size, hipStream_t stream) {
    static int ready = 0;
    if (ready == 0) {
        if (n_in != 29 || ws_size < WS_END) { fprintf(stderr, "kernel_launch: expected 29 inputs and >= %zu bytes of workspace (got %d, %zu)\n", (size_t)WS_END, n_in, ws_size); ready = -1; return; }
        if (hipFuncSetAttribute((const void*)yoco_fwd, hipFuncAttributeMaxDynamicSharedMemorySize, LDS_BYTES) != hipSuccess) { fprintf(stderr, "kernel_launch: hipFuncSetAttribute failed\n"); ready = -1; return; }
        ready = 1;
    }
    if (ready < 0) return;
    (void)hipMemsetAsync((char*)d_ws + WS_CTL, 0, CTL_BYTES, stream);
    Args a{};
    for (int i = 0; i < 29; ++i) a.in[i] = (const float*)d_in[i];
    a.out = (float*)d_out; a.ws = (unsigned char*)d_ws;
#if defined(PROBE_TYPE)
    a.rep_type = PROBE_TYPE; a.rep_n = PROBE_N;
#else
    a.rep_type = -1; a.rep_n = 0;
#endif
#if MK_N_LAUNCHES == 1
    a.ph_lo = 0; a.ph_hi = NPH;
    hipLaunchKernelGGL(yoco_fwd, dim3(GRID), dim3(NTHREADS), LDS_BYTES, stream, a);
#else
    for (int ph = 0; ph < NPH; ++ph) { a.ph_lo = ph; a.ph_hi = ph + 1; hipLaunchKernelGGL(yoco_fwd, dim3(GRID), dim3(NTHREADS), LDS_BYTES, stream, a); }
#endif
}
```

```cpp
#include <hip/hip_runtime.h>
#include <cstdio>
#include <cstdint>

#ifndef MK_N_LAUNCHES
#define MK_N_LAUNCHES 1
#endif

#define LAS __attribute__((address_space(3)))
typedef unsigned short bf16_t;
typedef short bf16x8 __attribute__((ext_vector_type(8)));
typedef float f32x4 __attribute__((ext_vector_type(4)));
typedef float f32x2 __attribute__((ext_vector_type(2)));
typedef unsigned u32x4 __attribute__((ext_vector_type(4)));
typedef unsigned u32x2 __attribute__((ext_vector_type(2)));

constexpr int D = 1024, NB = 8, SEQ = 2048, NMETA = 16, LT = SEQ + NMETA  ;
constexpr int NREAL = NB * SEQ  , RT = NREAL + NMETA  , RPAD = 16640;
constexpr int NEXP = 32, DEXP = 512, NGRP = 4, EPG = 8;
constexpr int NTHREADS = 512, GRID = 256;
constexpr int LDS_BYTES = 155648;
constexpr float RMS_EPS = 1e-6f;
__device__ __forceinline__ int row_of(int b, int pos) { return pos < NMETA ? NREAL + pos : b * SEQ + (pos - NMETA); }

constexpr size_t al256(size_t x) { return (x + 255) & ~(size_t)255; }
constexpr size_t WS_CTL = 0;
constexpr size_t CTL_BYTES = 32768;
constexpr int CW_BAR = 0;
constexpr int CW_CNT = 4096;
constexpr int CW_DUMCNT = 4096 + 256;
constexpr size_t WS_H = WS_CTL + CTL_BYTES;
constexpr size_t WS_U = WS_H + al256((size_t)RPAD * D * 4);
constexpr size_t WS_Z = WS_U + al256((size_t)RPAD * D * 2);
constexpr size_t WS_XN = WS_Z + al256((size_t)RPAD * D * 2);
constexpr size_t WS_Q = WS_XN + al256((size_t)RPAD * D * 2);
constexpr size_t WS_K = WS_Q + al256((size_t)RPAD * D * 2);
constexpr size_t WS_VT = WS_K + al256((size_t)RPAD * 256 * 2);
constexpr size_t VT_META = (size_t)NB * 256 * SEQ;
constexpr size_t WS_SSQ = WS_VT + al256((size_t)RPAD * 256 * 2);
constexpr size_t WS_LTOK = WS_SSQ + al256((size_t)RPAD * 32 * 4);
constexpr size_t WS_LGATE = WS_LTOK + al256((size_t)NEXP * RT * 4);
constexpr int HB_ROWS = 2 * RT + NEXP * 256;
constexpr size_t WS_HB = WS_LGATE + al256((size_t)NEXP * RT * 4);
constexpr size_t WS_YB = WS_HB + al256((size_t)HB_ROWS * DEXP * 2);
constexpr size_t TBL_K = 0, TBL_M = 16 * 1024, TBL_N = TBL_M + 64 * 1024, TBL_A16 = TBL_N + 64 * 1024, TBL_STRIDE = TBL_A16 + 512;
constexpr size_t WS_TBL = WS_YB + al256((size_t)RT * 2 * D * 2);
constexpr size_t WS_WGLU = WS_TBL + al256((size_t)2 * 64 * TBL_STRIDE);
constexpr size_t WS_WKVQ = WS_WGLU + (size_t)2 * 2048 * 1024 * 2;
constexpr size_t WS_WQ1 = WS_WKVQ + (size_t)1536 * 1024 * 2;
constexpr size_t WS_WO = WS_WQ1 + (size_t)1024 * 1024 * 2;
constexpr size_t WS_W1 = WS_WO + (size_t)2 * 1024 * 1024 * 2;
constexpr size_t WS_W2 = WS_W1 + (size_t)4 * 32 * 1024 * 1024 * 2;
constexpr size_t WS_RW = WS_W2 + (size_t)4 * 32 * 1024 * 512 * 2;
constexpr size_t WS_DUMH = WS_RW + (size_t)4 * 98304;
constexpr size_t WS_DUMSSQ = WS_DUMH + al256((size_t)RT * D * 4);
constexpr size_t WS_DUMLT = WS_DUMSSQ + al256((size_t)RT * 32 * 4);
constexpr size_t WS_DUMLG = WS_DUMLT + al256((size_t)NEXP * RT * 4);
#if defined(PROBE_TYPE)
constexpr size_t WS_END = WS_DUMLG + al256((size_t)NEXP * RT * 4);
#else
constexpr size_t WS_END = WS_DUMH;
#endif

struct Args {
    const float* in[29];
    float* out;
    unsigned char* ws;
    int ph_lo, ph_hi;
    int rep_type, rep_n;
};
typedef const __attribute__((address_space(4))) Args CArgs;

__device__ __forceinline__ unsigned cvt_pk_bf16(float lo, float hi) { unsigned r; asm volatile("v_cvt_pk_bf16_f32 %0, %1, %2" : "=v"(r) : "v"(lo), "v"(hi)); return r; }
__device__ __forceinline__ float bf16_lo(unsigned w) { return __uint_as_float(w << 16); }
__device__ __forceinline__ float bf16_hi(unsigned w) { return __uint_as_float(w & 0xffff0000u); }
__device__ __forceinline__ float fast_rcp(float x) { return __builtin_amdgcn_rcpf(x); }
__device__ __forceinline__ float fast_exp(float x) { return __builtin_amdgcn_exp2f(x * 1.4426950408889634f); }
__device__ __forceinline__ float sigmoidf_(float x) { return fast_rcp(1.0f + fast_exp(-x)); }
__device__ __forceinline__ float gelu_tanh(float x) { const float v = 0.7978845608028654f * (x + 0.044715f * x * x * x); return x * sigmoidf_(2.0f * v); }
__device__ __forceinline__ bf16x8 as_bf16x8(u32x4 v) { return __builtin_bit_cast(bf16x8, v); }
__device__ __forceinline__ f32x4 mfma16(bf16x8 a, bf16x8 b, f32x4 c) { return __builtin_amdgcn_mfma_f32_16x16x32_bf16(a, b, c, 0, 0, 0); }
__device__ __forceinline__ float xor32_sum(float v) { auto r = __builtin_amdgcn_permlane32_swap(__float_as_uint(v), __float_as_uint(v), false, false); return __uint_as_float(r[0]) + __uint_as_float(r[1]); }
__device__ __forceinline__ float xor16_sum(float v) { auto r = __builtin_amdgcn_permlane16_swap(__float_as_uint(v), __float_as_uint(v), false, false); return __uint_as_float(r[0]) + __uint_as_float(r[1]); }
__device__ __forceinline__ float xor32_max(float v) { auto r = __builtin_amdgcn_permlane32_swap(__float_as_uint(v), __float_as_uint(v), false, false); return fmaxf(__uint_as_float(r[0]), __uint_as_float(r[1])); }
__device__ __forceinline__ float xor16_max(float v) { auto r = __builtin_amdgcn_permlane16_swap(__float_as_uint(v), __float_as_uint(v), false, false); return fmaxf(__uint_as_float(r[0]), __uint_as_float(r[1])); }
__device__ __forceinline__ float quad_sum(float v) { return xor32_sum(xor16_sum(v)); }
template <int X> __device__ __forceinline__ float swz_xor(float v) { return __uint_as_float((unsigned)__builtin_amdgcn_ds_swizzle((int)__float_as_uint(v), (X << 10) | 0x1f)); }
__device__ __forceinline__ float wave_sum(float v) {
    v += swz_xor<1>(v); v += swz_xor<2>(v); v += swz_xor<4>(v); v += swz_xor<8>(v);
    return quad_sum(v);
}
__device__ __forceinline__ int opaque_bid() { int b = blockIdx.x; asm volatile("" : "+s"(b)); return b; }
__device__ __forceinline__ int opaque_tid() { int t = threadIdx.x; asm volatile("" : "+v"(t)); return t; }

#define XB_TMO      128
#define XB_XCNT(j)  (256  + 64 * (j))
#define XB_XSUB(j)  (1280 + 64 * (j))
#define XB_XGEN(j)  (2304 + 64 * (j))
#define XB_TOP      3328
#define XB_TOPGEN   3392
#define XCD_BAR_WORDS 3456
#define XB_SPIN_CAP (1u << 22)
__device__ __forceinline__ unsigned xb_ld(unsigned* p)              { return __hip_atomic_load(p, __ATOMIC_RELAXED, __HIP_MEMORY_SCOPE_AGENT); }
__device__ __forceinline__ unsigned xb_add(unsigned* p, unsigned v) { return __hip_atomic_fetch_add(p, v, __ATOMIC_RELAXED, __HIP_MEMORY_SCOPE_AGENT); }
__device__ __forceinline__ unsigned xb_xcc_id() { return (unsigned)__builtin_amdgcn_s_getreg((3 << 11) | 20) & 0xFu; }
#define XB_SPIN(cond, bar) do { unsigned _sp = 0; while (cond) { __builtin_amdgcn_s_sleep(1); \
    if ((++_sp & 255u) == 0u) { if (xb_ld(&(bar)[XB_TMO])) break; if (_sp > XB_SPIN_CAP) { atomicAdd(&(bar)[XB_TMO], 1u); break; } } } } while (0)
__device__ __forceinline__ void xcd_barrier_post(unsigned* bar) { if (threadIdx.x == 0) (void)xb_add(&bar[XB_XCNT(xb_xcc_id())], 1u); }
__device__ __forceinline__ void xcd_barrier_complete(unsigned* bar, unsigned x, unsigned& nloc, unsigned& nx) {
    const unsigned G = gridDim.x;
    unsigned sum, cnt, mine, sp = 0u;
    for (;;) {
        sum = 0u; cnt = 0u; mine = 0u;
#pragma unroll
        for (unsigned j = 0; j < 16; ++j) { const unsigned c = xb_ld(&bar[XB_XCNT(j)]); sum += c; cnt += (c > 0u) ? 1u : 0u; mine = (j == x) ? c : mine; }
        if (sum == G) break;
        __builtin_amdgcn_s_sleep(1);
        if ((++sp & 255u) == 0u) { if (xb_ld(&bar[XB_TMO])) break; if (sp > XB_SPIN_CAP) { atomicAdd(&bar[XB_TMO], 1u); break; } }
    }
    nloc = mine > 0u ? mine : 1u; nx = cnt > 0u ? cnt : 1u;
}
template <class BG>
__device__ __forceinline__ void xcd_barrier(unsigned* bar_, volatile LAS unsigned* st, BG& bg) {
    asm volatile("s_waitcnt vmcnt(0)" ::: "memory");
    __syncthreads();
    const unsigned flag0 = st[2];
    if (threadIdx.x >= 64) {
        while (st[2] == flag0) bg.step();
        bg.park();
    } else if (threadIdx.x == 0) {
        unsigned* bar = bar_; asm volatile("" : "+v"(bar));
        const unsigned bx = xb_xcc_id();
        __builtin_amdgcn_s_waitcnt(0);
        unsigned nloc = st[0], nx = st[1];
        if (nloc == 0u) { xcd_barrier_complete(bar, bx, nloc, nx); st[0] = nloc; st[1] = nx; }
        const unsigned old = xb_add(&bar[XB_XSUB(bx)], 1u);
        const unsigned gen = old / nloc;
        if (old + 1u == (gen + 1u) * nloc) {
            __builtin_amdgcn_fence(__ATOMIC_RELEASE, "agent");
            asm volatile("s_waitcnt vmcnt(0)" ::: "memory");
            const unsigned og = xb_add(&bar[XB_TOP], 1u);
            const unsigned tg = og / nx;
            if (og + 1u == (tg + 1u) * nx) xb_add(&bar[XB_TOPGEN], 1u);
            else XB_SPIN(xb_ld(&bar[XB_TOPGEN]) == tg, bar);
            __builtin_amdgcn_fence(__ATOMIC_ACQUIRE, "agent");
            xb_add(&bar[XB_XGEN(bx)], 1u);
            asm volatile("s_waitcnt vmcnt(0)" ::: "memory");
        } else {
            XB_SPIN(xb_ld(&bar[XB_XGEN(bx)]) == gen, bar);
            __builtin_amdgcn_fence(__ATOMIC_ACQUIRE, "agent");
            asm volatile("s_waitcnt vmcnt(0)" ::: "memory");
        }
        st[2] = flag0 + 1u;
    }
    __syncthreads();
}
constexpr int BM = 256, BK = 64, HALF = 128, HTB = HALF * BK * 2, STAGE_BYTES = 8 * HTB, NXCD = 8, WGM = 8;
constexpr int LDS_TABO = STAGE_BYTES;
constexpr int LDS_TABT = LDS_TABO + 3072;
constexpr int LDS_TABG = LDS_TABT + 3072;
constexpr int LDS_SH = LDS_TABG + 3072;
__host__ __device__ __forceinline__ int lds_byte(int r, int c) { const int st = (r >> 4) * 2 + (c >> 5), rr = r & 15, cc = c & 31, ob = rr * 64 + cc * 2; return st * 1024 + (ob ^ (((ob >> 9) & 1) << 5)); }
__host__ __device__ __forceinline__ void stage_rc(int b, int& R, int& C) { const int st = b / 1024, sb = b % 1024, swz = sb ^ (((sb >> 9) & 1) << 5); R = (st >> 1) * 16 + swz / 64; C = (st & 1) * 32 + (swz % 64) / 2; }
__host__ __device__ __forceinline__ int perm32(int rho) { const int n = rho >> 4, i = rho & 15; return 8 * (i >> 2) + 4 * n + (i & 3); }
struct Unit { int pm, pn, e, slot; };
__device__ __forceinline__ int xcd_chunk(int wgid, int nwg) { const int q = nwg / NXCD, r = nwg % NXCD, xcd = wgid % NXCD, off = wgid / NXCD; return (xcd < r ? xcd * (q + 1) : r * (q + 1) + (xcd - r) * q) + off; }

enum { EPI_GLU = 0, EPI_OPROJ, EPI_KVQ, EPI_MOE1, EPI_MOE2 };
struct GemmDesc {
    int kind, K, perm, gather, moe, skip_epi;
    int nM, nN, nwg, npn; const char* A; const char* Bt; size_t tstepA, tstepB, wstride; const int* cnt; const int* LTOK; const float* LGATE;
    const float* res; float* Hout; float* SSQ; const float* bias; const float* bias2; bf16_t* O1; bf16_t* O2; bf16_t* O3; int jq, cbase;
};
__device__ __forceinline__ bool order_next(const GemmDesc& g, LAS unsigned char* lds, int i, Unit& u) {
    const int L = i * GRID + opaque_bid(); if (L >= g.nwg) return false;
    const int wgid = xcd_chunk(L, g.nwg);
    if (g.moe) {
        const LAS int* sh = (const LAS int*)(lds + LDS_SH);
        int e = 0;
        for (int q = 1; q < 32; ++q) if (wgid >= g.npn * sh[q]) e = q;
        const int nmt = sh[e + 1] - sh[e], local = wgid - g.npn * sh[e];
        u.pn = local / nmt; u.pm = sh[e] + (local - u.pn * nmt); u.e = e; u.slot = i % 3;
    } else {
        const int nig = WGM * g.nN, gid = wgid / nig, fm = gid * WGM, gsz = (g.nM - fm) < WGM ? (g.nM - fm) : WGM;
        u.pm = fm + ((wgid % nig) % gsz); u.pn = (wgid % nig) / gsz; u.e = 0; u.slot = 0;
    }
    return true;
}
__device__ __forceinline__ const char* order_a(const GemmDesc& g, const Unit& u) { return g.gather ? g.A : g.A + (size_t)u.pm * g.tstepA; }
__device__ __forceinline__ const char* order_b(const GemmDesc& g, const Unit& u) { return g.Bt + (size_t)u.e * g.wstride + (size_t)u.pn * g.tstepB; }
__device__ __forceinline__ void order_fill(const GemmDesc& g, LAS unsigned char* lds, const Unit& u) {
    const int t = opaque_tid();
    if (t < 256) {
        const LAS int* sh = (const LAS int*)(lds + LDS_SH);
        const int ne = g.cnt[u.e], idx = (u.pm - sh[u.e]) * 256 + t, ci = idx < ne ? idx : ne - 1;
        const int v = g.LTOK[(size_t)u.e * RT + ci];
        ((LAS unsigned*)(lds + LDS_TABO))[u.slot * 256 + t] = (unsigned)(v & 0x3fffffff) * (unsigned)(D * 2);
        ((LAS int*)(lds + LDS_TABT))[u.slot * 256 + t] = idx < ne ? v : -1;
        ((LAS float*)(lds + LDS_TABG))[u.slot * 256 + t] = g.LGATE[(size_t)u.e * RT + ci];
    }
}
__device__ __forceinline__ void gemm_epilogue(const GemmDesc& g, LAS unsigned char* lds, const f32x4 (&acc)[2][2][4][2], const Unit& u, int wr, int wc, int fr, int fq);

__device__ __forceinline__ void gemm_run(LAS unsigned char* lds, const GemmDesc& g) {
    const int tid = opaque_tid(), wid = __builtin_amdgcn_readfirstlane(tid >> 6), lane = tid & 63, wr = wid >> 2, wc = wid & 3, fr = lane & 15, fq = lane >> 4;
    const int K = g.K, nt = K / BK;
    unsigned voffA[2], voffB[2]; int Rr[2], Cc[2];
#pragma unroll
    for (int i = 0; i < 2; ++i) { int R, C; stage_rc(tid * 16 + i * 8192, R, C); const int Rb = g.perm ? ((R & ~31) + perm32(R & 31)) : R;
        voffA[i] = (unsigned)(R * K + C) * 2u; voffB[i] = (unsigned)(Rb * K + C) * 2u; Rr[i] = R * 4; Cc[i] = C * 2; }
    const size_t kstep = (size_t)(BK * 2);
    const size_t hstep = (size_t)HALF * K * 2;
    const unsigned ldsw = (unsigned)wid * 1024u;
    const int aoff = lds_byte(wr * 64 + fr, fq * 8), boff = lds_byte(wc * 32 + fr, fq * 8);
#define PG8_SA(b, h) (((b) * 2 + (h)) * HTB)
#define PG8_SB(b, h) ((4 + (b) * 2 + (h)) * HTB)
#define PG8_GLDS(src, dstoff) __builtin_amdgcn_global_load_lds((const unsigned*)(src), (LAS unsigned*)(lds + (dstoff)), 16, 0, 0)
#define PG8_STAGE_B(bufoff, gbase) do { _Pragma("unroll") for (int _i = 0; _i < 2; ++_i) PG8_GLDS((const char*)(gbase) + voffB[_i], (bufoff) + ldsw + _i * 8192); } while (0)
#define PG8_STAGE_A(bufoff, gbase, tsel, kt, h) do { if (g.gather) { \
            const unsigned _o0 = *(const LAS unsigned*)(lds + LDS_TABO + (tsel) * 1024 + (h) * 512 + Rr[0]), _o1 = *(const LAS unsigned*)(lds + LDS_TABO + (tsel) * 1024 + (h) * 512 + Rr[1]); \
            PG8_GLDS((const char*)(gbase) + (size_t)(kt) * kstep + _o0 + Cc[0], (bufoff) + ldsw); PG8_GLDS((const char*)(gbase) + (size_t)(kt) * kstep + _o1 + Cc[1], (bufoff) + ldsw + 8192); \
        } else { _Pragma("unroll") for (int _i = 0; _i < 2; ++_i) PG8_GLDS((const char*)(gbase) + (size_t)(kt) * kstep + (size_t)(h) * hstep + voffA[_i], (bufoff) + ldsw + _i * 8192); } } while (0)
#define PG8_LDA(dst, b, h) do { _Pragma("unroll") for (int m = 0; m < 4; ++m) _Pragma("unroll") for (int k = 0; k < 2; ++k) dst[m][k] = *(const LAS bf16x8*)(lds + PG8_SA(b, h) + aoff + m * 2048 + k * 1024); } while (0)
#define PG8_LDB(dst, b, h) do { _Pragma("unroll") for (int n = 0; n < 2; ++n) _Pragma("unroll") for (int k = 0; k < 2; ++k) dst[n][k] = *(const LAS bf16x8*)(lds + PG8_SB(b, h) + boff + n * 2048 + k * 1024); } while (0)
#define PG8_MMA(ai, bj, At, Bt) do { __builtin_amdgcn_s_setprio(1); _Pragma("unroll") for (int m = 0; m < 4; ++m) _Pragma("unroll") for (int n = 0; n < 2; ++n) _Pragma("unroll") for (int k = 0; k < 2; ++k) \
        acc[ai][bj][m][n] = __builtin_amdgcn_mfma_f32_16x16x32_bf16(Bt[n][k], At[m][k], acc[ai][bj][m][n], 0, 0, 0); __builtin_amdgcn_s_setprio(0); } while (0)
#define PG8_WAIT_V(n) asm volatile("s_waitcnt vmcnt(" #n ")" ::: "memory")
#define PG8_WAIT_L(n) asm volatile("s_waitcnt lgkmcnt(" #n ")" ::: "memory")
#define PG8_BAR __builtin_amdgcn_s_barrier()
#define PG8_SCHED __builtin_amdgcn_sched_barrier(0)
    Unit cur, nxt; int ui = 0;
    if (!order_next(g, lds, 0, cur)) return;
    f32x4 acc[2][2][4][2];
#pragma unroll
    for (int a = 0; a < 2; ++a)
#pragma unroll
        for (int b = 0; b < 2; ++b)
#pragma unroll
            for (int m = 0; m < 4; ++m)
#pragma unroll
                for (int n = 0; n < 2; ++n) acc[a][b][m][n] = (f32x4){0.f, 0.f, 0.f, 0.f};
    bf16x8 At[4][2], B0[2][2], B1[2][2];
    if (g.moe) { order_fill(g, lds, cur); __syncthreads(); }
    const char* cA = order_a(g, cur); const char* cB = order_b(g, cur); int cT = cur.slot;
    PG8_STAGE_B(PG8_SB(0, 0), cB); PG8_STAGE_B(PG8_SB(0, 1), cB + hstep); PG8_STAGE_A(PG8_SA(0, 0), cA, cT, 0, 0); PG8_STAGE_A(PG8_SA(0, 1), cA, cT, 0, 1);
    if (wr == 1) PG8_BAR;
    PG8_WAIT_V(2); PG8_BAR;
    PG8_STAGE_B(PG8_SB(1, 0), cB + kstep); PG8_STAGE_A(PG8_SA(1, 0), cA, cT, 1, 0); PG8_STAGE_B(PG8_SB(1, 1), cB + hstep + kstep);
    PG8_WAIT_V(6); PG8_BAR;
    for (;;) {
        const bool has_next = order_next(g, lds, ui + 1, nxt);
        if (g.moe && has_next) order_fill(g, lds, nxt);
        const char* nA = has_next ? order_a(g, nxt) : cA; const char* nB = has_next ? order_b(g, nxt) : cB; const int nT = has_next ? nxt.slot : cT;
        for (int t = 0; t < nt; t += 2) {
            const bool last = (t == nt - 2);
            const char* a2b = last ? nA : cA; const int a2T = last ? nT : cT, a2k = last ? 0 : t + 2, a3k = a2k + 1;
            const char* b2 = last ? nB : cB + (size_t)(t + 2) * kstep; const char* b3 = b2 + kstep;
            PG8_LDB(B0, 0, 0); PG8_LDB(B1, 0, 1); PG8_SCHED; PG8_LDA(At, 0, 0); PG8_STAGE_A(PG8_SA(1, 1), cA, cT, t + 1, 1);
            PG8_WAIT_V(8); PG8_WAIT_L(0); PG8_BAR; PG8_MMA(0, 0, At, B0); PG8_MMA(0, 1, At, B1); PG8_BAR; PG8_SCHED;
            PG8_LDA(At, 0, 1); PG8_STAGE_B(PG8_SB(0, 0), b2); PG8_STAGE_B(PG8_SB(0, 1), b2 + hstep); PG8_STAGE_A(PG8_SA(0, 0), a2b, a2T, a2k, 0);
            PG8_WAIT_V(8); PG8_WAIT_L(0); PG8_BAR; PG8_MMA(1, 0, At, B0); PG8_MMA(1, 1, At, B1); PG8_BAR; PG8_SCHED;
            PG8_LDB(B0, 1, 0); PG8_LDB(B1, 1, 1); PG8_SCHED; PG8_LDA(At, 1, 0); PG8_STAGE_A(PG8_SA(0, 1), a2b, a2T, a2k, 1);
            PG8_WAIT_V(8); PG8_WAIT_L(0); PG8_BAR; PG8_MMA(0, 0, At, B0); PG8_MMA(0, 1, At, B1); PG8_BAR; PG8_SCHED;
            PG8_LDA(At, 1, 1); PG8_STAGE_B(PG8_SB(1, 0), b3); PG8_STAGE_B(PG8_SB(1, 1), b3 + hstep); PG8_STAGE_A(PG8_SA(1, 0), a2b, a2T, a3k, 0);
            PG8_WAIT_V(8); PG8_WAIT_L(0); PG8_BAR; PG8_MMA(1, 0, At, B0); PG8_MMA(1, 1, At, B1); PG8_BAR; PG8_SCHED;
        }
        if (wr == 0) PG8_BAR;
        if (!g.skip_epi) gemm_epilogue(g, lds, acc, cur, wr, wc, fr, fq);
        if (!has_next) break;
#pragma unroll
        for (int a = 0; a < 2; ++a)
#pragma unroll
            for (int b = 0; b < 2; ++b)
#pragma unroll
                for (int m = 0; m < 4; ++m)
#pragma unroll
                    for (int n = 0; n < 2; ++n) acc[a][b][m][n] = (f32x4){0.f, 0.f, 0.f, 0.f};
        cur = nxt; cA = nA; cB = nB; cT = nT; ++ui;
        if (wr == 1) PG8_BAR;
    }
    PG8_WAIT_V(0);
    PG8_BAR;
#undef PG8_SA
#undef PG8_SB
#undef PG8_GLDS
#undef PG8_STAGE_A
#undef PG8_STAGE_B
#undef PG8_LDA
#undef PG8_LDB
#undef PG8_MMA
#undef PG8_WAIT_V
#undef PG8_WAIT_L
#undef PG8_BAR
#undef PG8_SCHED
}
__device__ __forceinline__ f32x4 meta_dot(const bf16_t* Am, const bf16_t* Brow0, int K, int fr, int fq) {
    f32x4 acc = {0.f, 0.f, 0.f, 0.f};
    const bf16_t* ap = Am + (size_t)fr * K + 8 * fq; const bf16_t* bp = Brow0 + (size_t)fr * K + 8 * fq;
#pragma unroll 4
    for (int ks = 0; ks < K / 32; ++ks) acc = mfma16(as_bf16x8(*(const u32x4*)(bp + 32 * ks)), as_bf16x8(*(const u32x4*)(ap + 32 * ks)), acc);
    return acc;
}

struct ConvDesc { const float* src; const float* gain; bf16_t* dst; int ld, K, mode, kblk, nblk; };
constexpr int NWT_E = 768;
constexpr int NWT_MOE = 4 * 32 * NWT_E, NWT_DENSE = 2 * 1024 + 256 + 2 * 512 + 2 * 512;
__device__ __forceinline__ ConvDesc conv_decode(CArgs& a, int ti) {
    ConvDesc d;
    if (ti < NWT_MOE) {
        const int le = ti / NWT_E, r = ti % NWT_E, which = r >> 8, tt = r & 255, layer = le >> 5;
        if (which < 2) { d.src = a.in[26 + which] + (size_t)le * D * DEXP; d.ld = DEXP; d.K = D; d.gain = a.in[3] + (size_t)layer * D; d.dst = (bf16_t*)(a.ws + WS_W1) + (size_t)le * 1024 * 1024; d.mode = 1 + which; d.nblk = tt & 15; d.kblk = tt >> 4; }
        else { d.src = a.in[28] + (size_t)le * DEXP * D; d.ld = D; d.K = DEXP; d.gain = nullptr; d.dst = (bf16_t*)(a.ws + WS_W2) + (size_t)le * 1024 * 512; d.mode = 0; d.nblk = tt & 31; d.kblk = tt >> 5; }
    } else {
        int r = ti - NWT_MOE;
        if (r < 2048) { const int layer = r >> 10, tt = r & 1023, nb = tt & 63, half = nb >> 5;
            d.src = a.in[14] + (size_t)layer * D * 2 * D + half * D; d.ld = 2 * D; d.K = D; d.gain = nullptr; d.dst = (bf16_t*)(a.ws + WS_WGLU) + (size_t)layer * 2048 * 1024; d.mode = 1 + half; d.nblk = nb & 31; d.kblk = tt >> 6; }
        else if ((r -= 2048) < 256) { d.src = a.in[15]; d.ld = 512; d.K = D; d.gain = a.in[4]; d.dst = (bf16_t*)(a.ws + WS_WKVQ); d.mode = 0; d.nblk = r & 15; d.kblk = r >> 4; }
        else if ((r -= 256) < 1024) { const int j = r >> 9, tt = r & 511;
            d.src = a.in[17] + (size_t)j * D * D; d.ld = D; d.K = D; d.gain = a.in[2] + (size_t)(2 + j) * D; d.dst = j == 0 ? (bf16_t*)(a.ws + WS_WKVQ) + (size_t)512 * 1024 : (bf16_t*)(a.ws + WS_WQ1); d.mode = 0; d.nblk = tt & 31; d.kblk = tt >> 5; }
        else { r -= 1024; const int j = r >> 9, tt = r & 511;
            d.src = a.in[20] + (size_t)j * D * D; d.ld = D; d.K = D; d.gain = nullptr; d.dst = (bf16_t*)(a.ws + WS_WO) + (size_t)j * 1024 * 1024; d.mode = 0; d.nblk = tt & 31; d.kblk = tt >> 5; }
    }
    return d;
}
__device__ __forceinline__ void conv_load(const ConvDesc& d, int lane, f32x4 (&v)[8]) {
    const float* p = d.src + (size_t)(d.kblk * 64 + 8 * (lane >> 3)) * d.ld + d.nblk * 32 + 4 * (lane & 7);
#pragma unroll
    for (int j = 0; j < 8; ++j) v[j] = __builtin_nontemporal_load((const f32x4*)(p + (size_t)j * d.ld));
}
__device__ __forceinline__ void conv_store(const ConvDesc& d, int lane, f32x4 (&v)[8]) {
    const int k0 = d.kblk * 64 + 8 * (lane >> 3);
    if (d.gain) { const f32x4 g0 = *(const f32x4*)(d.gain + k0), g1 = *(const f32x4*)(d.gain + k0 + 4);
        v[0] *= g0[0]; v[1] *= g0[1]; v[2] *= g0[2]; v[3] *= g0[3]; v[4] *= g1[0]; v[5] *= g1[1]; v[6] *= g1[2]; v[7] *= g1[3]; }
    const int n = d.nblk * 32 + 4 * (lane & 7), row = d.mode == 0 ? n : (256 * (n >> 7) + (n & 127) + (d.mode == 2 ? 128 : 0));
    bf16_t* q = d.dst + (size_t)row * d.K + k0;
#pragma unroll
    for (int c = 0; c < 4; ++c) {
        u32x4 w; w.x = cvt_pk_bf16(v[0][c], v[1][c]); w.y = cvt_pk_bf16(v[2][c], v[3][c]); w.z = cvt_pk_bf16(v[4][c], v[5][c]); w.w = cvt_pk_bf16(v[6][c], v[7][c]);
        *(u32x4*)(q + (size_t)c * d.K) = w;
    }
}
__device__ __forceinline__ void convert_weights(CArgs& a) {
    const int lane = opaque_tid() & 63, gw = (opaque_tid() >> 6) * GRID + opaque_bid();
    for (int ti = NWT_MOE + gw; ti < NWT_MOE + NWT_DENSE; ti += GRID * 8) {
        const ConvDesc d = conv_decode(a, ti); f32x4 v[8];
        conv_load(d, lane, v); conv_store(d, lane, v);
    }
}
constexpr int BG_WORKERS = GRID * 7;
struct BgConv {
    CArgs* a; volatile LAS unsigned* st;
    __device__ __forceinline__ int task_of(unsigned cursor, int wv) const { return (int)cursor * BG_WORKERS + opaque_bid() * 7 + wv; }
    __device__ __forceinline__ void run(int t) const { const int lane = opaque_tid() & 63; const ConvDesc d = conv_decode(*a, t); f32x4 v[8]; conv_load(d, lane, v); conv_store(d, lane, v); }
    __device__ __forceinline__ void step() {
        const int wv = (opaque_tid() >> 6) - 1; const unsigned cur = st[4 + wv]; const int t = task_of(cur, wv);
        if (t < NWT_MOE) { run(t); if ((opaque_tid() & 63) == 0) st[4 + wv] = cur + 1u; asm volatile("s_waitcnt lgkmcnt(0)" ::: "memory"); }
        else __builtin_amdgcn_s_sleep(8);
    }
    __device__ __forceinline__ void park() {}
    __device__ __forceinline__ void flush(int limit) {
        if (opaque_tid() >= 64) {
            const int wv = (opaque_tid() >> 6) - 1; unsigned cur = st[4 + wv];
            for (int t = task_of(cur, wv); t < limit; t = task_of(++cur, wv)) run(t);
            if ((opaque_tid() & 63) == 0) st[4 + wv] = cur;
        }
    }
};

struct cplx { float re, im; };
__device__ __forceinline__ cplx cmul(cplx a, cplx b) { return {a.re * b.re - a.im * b.im, a.re * b.im + a.im * b.re}; }

__device__ __forceinline__ void s5_tables(CArgs& a, int layer, int g, LAS unsigned char* lds) {
    LAS f32x2* pw = (LAS f32x2*)lds;
    LAS f32x2* bb = (LAS f32x2*)(lds + 64 * 17 * 8);
    LAS f32x2* cc = bb + 64 * 16;
    const int tid = opaque_tid();
    const float* a_re = a.in[6] + ((size_t)layer * 64 + g) * 64; const float* a_im = a.in[7] + ((size_t)layer * 64 + g) * 64;
    const float dt = expf(a.in[8][layer * 64 + g]);
    for (int idx = tid; idx < 64 * 17; idx += NTHREADS) {
        const int p = idx / 17, d = idx % 17;
        const float mag = expf(a_re[p] * dt * (float)d), ang = a_im[p] * dt * (float)d;
        float s, c; sincosf(ang, &s, &c);
        pw[idx] = (f32x2){mag * c, mag * s};
    }
    const float* b_re = a.in[9] + ((size_t)layer * 64 + g) * 1024; const float* b_im = a.in[10] + ((size_t)layer * 64 + g) * 1024;
    const float* c_re = a.in[11] + ((size_t)layer * 64 + g) * 1024; const float* c_im = a.in[12] + ((size_t)layer * 64 + g) * 1024;
    for (int idx = tid; idx < 1024; idx += NTHREADS) {
        const int p = idx >> 4;
        const float lr = a_re[p], li = a_im[p];
        const float mag = expf(lr * dt), ang = li * dt; float s, c; sincosf(ang, &s, &c);
        const float nr = mag * c - 1.0f, ni = mag * s;
        const float den = 1.0f / (lr * lr + li * li);
        const cplx f = {(nr * lr + ni * li) * den, (ni * lr - nr * li) * den};
        const cplx r = cmul(f, (cplx){b_re[idx], b_im[idx]});
        bb[idx] = (f32x2){r.re, r.im};
        cc[idx] = (f32x2){c_re[idx], c_im[idx]};
    }
    __syncthreads();
    unsigned char* tbl = a.ws + WS_TBL + ((size_t)layer * 64 + g) * TBL_STRIDE;
    for (int idx = tid; idx < 16 * 64; idx += NTHREADS) {
        const int delta = idx >> 6, l = idx & 63, c1 = l & 15, q4 = l >> 4, d = delta - (q4 >> 1);
        float v[8];
#pragma unroll
        for (int j = 0; j < 8; ++j) v[j] = 0.f;
        if (d >= 0) {
            for (int p = 0; p < 64; ++p) {
                const f32x2 cw = cc[c1 * 64 + p], pp = pw[p * 17 + d];
                const cplx t = cmul((cplx){cw.x, cw.y}, (cplx){pp.x, pp.y});
#pragma unroll
                for (int j = 0; j < 8; ++j) { const f32x2 bw = bb[p * 16 + 8 * (q4 & 1) + j]; v[j] += t.re * bw.x - t.im * bw.y; }
            }
        }
        u32x4 w; w.x = cvt_pk_bf16(v[0], v[1]); w.y = cvt_pk_bf16(v[2], v[3]); w.z = cvt_pk_bf16(v[4], v[5]); w.w = cvt_pk_bf16(v[6], v[7]);
        *(u32x4*)(tbl + TBL_K + (size_t)idx * 16) = w;
    }
    for (int idx = tid; idx < 64 * 64; idx += NTHREADS) {
        const int f = idx >> 6, l = idx & 63, rt = f >> 3, ks = f & 7, q4 = l >> 4, rho = 16 * rt + (l & 15), p = rho & 63, im = rho >> 6;
        const int k0 = 32 * ks + 8 * q4, jpos = k0 >> 4, c20 = k0 & 15;
        const f32x2 pp = pw[p * 17 + (15 - jpos)];
        float v[8];
#pragma unroll
        for (int j = 0; j < 8; ++j) { const f32x2 bw = bb[p * 16 + c20 + j]; const cplx t = cmul((cplx){pp.x, pp.y}, (cplx){bw.x, bw.y}); v[j] = im ? t.im : t.re; }
        u32x4 w; w.x = cvt_pk_bf16(v[0], v[1]); w.y = cvt_pk_bf16(v[2], v[3]); w.z = cvt_pk_bf16(v[4], v[5]); w.w = cvt_pk_bf16(v[6], v[7]);
        *(u32x4*)(tbl + TBL_M + (size_t)idx * 16) = w;
    }
    for (int idx = tid; idx < 64 * 64; idx += NTHREADS) {
        const int f = idx >> 6, l = idx & 63, i = f >> 2, ks = f & 3, q4 = l >> 4, c1 = l & 15;
        const int s0 = 32 * ks + 8 * q4;
        float v[8];
#pragma unroll
        for (int j = 0; j < 8; ++j) { const int sg = s0 + j, p = sg & 63; const f32x2 cw = cc[c1 * 64 + p], pp = pw[p * 17 + i + 1];
            const cplx t = cmul((cplx){cw.x, cw.y}, (cplx){pp.x, pp.y}); v[j] = (sg >> 6) ? -t.im : t.re; }
        u32x4 w; w.x = cvt_pk_bf16(v[0], v[1]); w.y = cvt_pk_bf16(v[2], v[3]); w.z = cvt_pk_bf16(v[4], v[5]); w.w = cvt_pk_bf16(v[6], v[7]);
        *(u32x4*)(tbl + TBL_N + (size_t)idx * 16) = w;
    }
    if (tid < 64) *(f32x2*)(tbl + TBL_A16 + tid * 8) = pw[tid * 17 + 16];
    __syncthreads();
}

__device__ __forceinline__ void row_norm_store(const f32x4 (&v)[4], float ssq, int lane, const float* g0, bf16_t* o0) {
    const float rstd = 1.0f / sqrtf(ssq * (1.0f / D) + RMS_EPS);
#pragma unroll
    for (int j = 0; j < 4; ++j) {
        const int c = 4 * lane + 256 * j;
        f32x4 g = {1.f, 1.f, 1.f, 1.f}; if (g0) g = *(const f32x4*)(g0 + c);
        u32x2 w; w.x = cvt_pk_bf16(v[j][0] * rstd * g[0], v[j][1] * rstd * g[1]); w.y = cvt_pk_bf16(v[j][2] * rstd * g[2], v[j][3] * rstd * g[3]);
        *(u32x2*)(o0 + c) = w;
    }
}
__device__ __forceinline__ void phase_prep(CArgs& a, LAS unsigned char* lds) {
    if (opaque_bid() < 128) s5_tables(a, opaque_bid() >> 6, opaque_bid() & 63, lds);
    else if (opaque_bid() < 128 + 48) {
        const int item = (opaque_bid() - 128) * NTHREADS + opaque_tid(), layer = item / 6144, idx = item % 6144;
        const float* wg = a.in[22] + (size_t)layer * D * NGRP; const float* we = a.in[24] + (size_t)layer * D * NEXP; const float* gain = a.in[3] + (size_t)layer * D;
        const int l = idx & 63, ks = (idx >> 6) & 31, rt = idx >> 11, o = 16 * rt + (l & 15), k0 = 32 * ks + 8 * (l >> 4);
        float v[8];
#pragma unroll
        for (int jq = 0; jq < 8; ++jq) v[jq] = (o < 4 ? wg[(size_t)(k0 + jq) * NGRP + o] : (o < 36 ? we[(size_t)(k0 + jq) * NEXP + (o - 4)] : 0.f)) * gain[k0 + jq];
        u32x4 w; w.x = cvt_pk_bf16(v[0], v[1]); w.y = cvt_pk_bf16(v[2], v[3]); w.z = cvt_pk_bf16(v[4], v[5]); w.w = cvt_pk_bf16(v[6], v[7]);
        *(u32x4*)(a.ws + WS_RW + (size_t)layer * 98304 + (size_t)idx * 16) = w;
    }
    convert_weights(a);
    const int lane = opaque_tid() & 63, gw = opaque_bid() * 8 + (opaque_tid() >> 6);
    bf16_t* U = (bf16_t*)(a.ws + WS_U);
    for (int row = gw; row < RT; row += GRID * 8) {
        const float* src = row < NREAL ? a.in[0] + (size_t)row * D : a.in[1] + (size_t)(row - NREAL) * D;
        f32x4 v[4]; float ssq = 0.f;
#pragma unroll
        for (int j = 0; j < 4; ++j) { v[j] = *(const f32x4*)(src + 4 * lane + 256 * j); ssq += v[j][0] * v[j][0] + v[j][1] * v[j][1] + v[j][2] * v[j][2] + v[j][3] * v[j][3]; }
        ssq = wave_sum(ssq);
        row_norm_store(v, ssq, lane, a.in[2], U + (size_t)row * D);
    }
}

constexpr int S5_CH = 528;
constexpr int S5_NCH = 129, S5_NCHP = 144;
__device__ __forceinline__ void phase_s5(CArgs& a, int layer, LAS unsigned char* lds) {
    LAS unsigned char* Ul = lds; LAS unsigned char* Sl = lds + S5_NCHP * S5_CH;
    const int tid = opaque_tid(), lane = tid & 63, w = __builtin_amdgcn_readfirstlane(tid >> 6), tc = lane & 15, q4 = lane >> 4;
    const bf16_t* U = (const bf16_t*)(a.ws + WS_U); bf16_t* Z = (bf16_t*)(a.ws + WS_Z);
    for (int ui = 0; ui < 2; ++ui) {
        const int unit = opaque_bid() * 2 + ui, b = unit >> 6, g = unit & 63;
        const unsigned char* tbl = a.ws + WS_TBL + ((size_t)layer * 64 + g) * TBL_STRIDE;
        for (int idx = tid; idx < LT * 2; idx += NTHREADS) {
            const int tok = idx >> 1, half = idx & 1;
            const u32x4 v = *(const u32x4*)(U + (size_t)row_of(b, tok) * D + 16 * g + 8 * half);
            *(LAS u32x4*)(Ul + (tok >> 4) * S5_CH + (tok & 15) * 32 + half * 16) = v;
        }
        __syncthreads();
        {
            bf16x8 mf[8];
#pragma unroll
            for (int ks = 0; ks < 8; ++ks) mf[ks] = as_bf16x8(*(const u32x4*)(tbl + TBL_M + ((size_t)(w * 8 + ks) * 64 + lane) * 16));
#pragma unroll 1
            for (int cg = 0; cg < 9; ++cg) {
                const int n = 16 * cg + tc;
                f32x4 acc = {0.f, 0.f, 0.f, 0.f};
#pragma unroll
                for (int ks = 0; ks < 8; ++ks) { const bf16x8 ub = *(LAS bf16x8*)(Ul + n * S5_CH + ks * 64 + q4 * 16); acc = mfma16(mf[ks], ub, acc); }
                *(LAS f32x4*)(Sl + n * S5_CH + (16 * w + 4 * q4) * 4) = acc;
            }
        }
        __syncthreads();
        if (w == 0) {
            const f32x2 a16 = *(const f32x2*)(tbl + TBL_A16 + lane * 8);
            float sr = 0.f, si = 0.f;
#pragma unroll 1
            for (int nb = 0; nb < 17; ++nb) {
                float xr[8], xi[8];
#pragma unroll
                for (int j = 0; j < 8; ++j) { xr[j] = *(LAS float*)(Sl + (nb * 8 + j) * S5_CH + lane * 4); xi[j] = *(LAS float*)(Sl + (nb * 8 + j) * S5_CH + 256 + lane * 4); }
                asm volatile("s_waitcnt lgkmcnt(0)" ::: "memory");
#pragma unroll
                for (int j = 0; j < 8; ++j) {
                    const unsigned pr = cvt_pk_bf16(sr, si);
                    *(LAS unsigned short*)(Sl + (nb * 8 + j) * S5_CH + lane * 2) = (unsigned short)(pr & 0xffffu);
                    *(LAS unsigned short*)(Sl + (nb * 8 + j) * S5_CH + 128 + lane * 2) = (unsigned short)(pr >> 16);
                    const float nr = a16.x * sr - a16.y * si + xr[j], ni = a16.x * si + a16.y * sr + xi[j];
                    sr = nr; si = ni;
                }
                asm volatile("" ::: "memory");
            }
        }
        __syncthreads();
        {
            const int i0 = w, i1 = 15 - w;
            bf16x8 kf0[8], kf1[8], nf0[4], nf1[4];
#pragma unroll
            for (int jj = 0; jj < 8; ++jj) {
                const int d0 = i0 - 2 * jj, d1 = i1 - 2 * jj;
                kf0[jj] = as_bf16x8(*(const u32x4*)(tbl + TBL_K + ((size_t)(d0 >= 0 ? d0 : 0) * 64 + lane) * 16));
                kf1[jj] = as_bf16x8(*(const u32x4*)(tbl + TBL_K + ((size_t)(d1 >= 0 ? d1 : 0) * 64 + lane) * 16));
            }
#pragma unroll
            for (int ks = 0; ks < 4; ++ks) {
                nf0[ks] = as_bf16x8(*(const u32x4*)(tbl + TBL_N + ((size_t)(i0 * 4 + ks) * 64 + lane) * 16));
                nf1[ks] = as_bf16x8(*(const u32x4*)(tbl + TBL_N + ((size_t)(i1 * 4 + ks) * 64 + lane) * 16));
            }
            const f32x4 dsk = *(const f32x4*)(a.in[13] + (size_t)layer * D + 16 * g + 4 * q4);
#pragma unroll 1
            for (int cg = 0; cg < 9; ++cg) {
                const int n = 16 * cg + tc;
                f32x4 acc0 = {0.f, 0.f, 0.f, 0.f}, acc1 = {0.f, 0.f, 0.f, 0.f};
#pragma unroll
                for (int jj = 0; jj < 8; ++jj) {
                    const bf16x8 ub = *(LAS bf16x8*)(Ul + n * S5_CH + jj * 64 + q4 * 16);
                    if (2 * jj <= i0) acc0 = mfma16(kf0[jj], ub, acc0);
                    if (2 * jj <= i1) acc1 = mfma16(kf1[jj], ub, acc1);
                }
#pragma unroll
                for (int ks = 0; ks < 4; ++ks) {
                    const bf16x8 sb = *(LAS bf16x8*)(Sl + n * S5_CH + ks * 64 + q4 * 16);
                    acc0 = mfma16(nf0[ks], sb, acc0); acc1 = mfma16(nf1[ks], sb, acc1);
                }
                if (n < S5_NCH && (n > 0 || b == 0)) {
#pragma unroll
                    for (int h = 0; h < 2; ++h) {
                        const int i = h ? i1 : i0; const f32x4 y = h ? acc1 : acc0;
                        const u32x2 uw = *(LAS u32x2*)(Ul + n * S5_CH + i * 32 + q4 * 8);
                        const float z0 = gelu_tanh(y[0] + dsk[0] * bf16_lo(uw.x)), z1 = gelu_tanh(y[1] + dsk[1] * bf16_hi(uw.x));
                        const float z2 = gelu_tanh(y[2] + dsk[2] * bf16_lo(uw.y)), z3 = gelu_tanh(y[3] + dsk[3] * bf16_hi(uw.y));
                        u32x2 o; o.x = cvt_pk_bf16(z0, z1); o.y = cvt_pk_bf16(z2, z3);
                        *(u32x2*)(Z + (size_t)row_of(b, 16 * n + i) * D + 16 * g + 4 * q4) = o;
                    }
                }
            }
        }
        __syncthreads();
    }
}

__device__ __forceinline__ float ssq4(f32x4 h) { return h[0] * h[0] + h[1] * h[1] + h[2] * h[2] + h[3] * h[3]; }
__device__ __forceinline__ int gwave() { return opaque_bid() * 8 + (opaque_tid() >> 6); }
template <int NACC> __device__ __forceinline__ bool meta_block(LAS unsigned char* lds, const bf16_t* Am, const bf16_t* const (&brow)[NACC], int K, f32x4 (&out)[NACC]) {
    const int tid = opaque_tid(), lane = tid & 63, wid = tid >> 6, fr = lane & 15, fq = lane >> 4, ksl = K / 8;
#pragma unroll
    for (int i = 0; i < NACC; ++i) {
        f32x4 acc = {0.f, 0.f, 0.f, 0.f};
        const bf16_t* ap = Am + (size_t)fr * K + wid * ksl + 8 * fq; const bf16_t* bp = brow[i] + (size_t)fr * K + wid * ksl + 8 * fq;
        for (int ks = 0; ks < ksl / 32; ++ks) acc = mfma16(as_bf16x8(*(const u32x4*)(bp + 32 * ks)), as_bf16x8(*(const u32x4*)(ap + 32 * ks)), acc);
        ((LAS f32x4*)lds)[(wid * NACC + i) * 64 + lane] = acc;
    }
    __syncthreads();
    if (wid == 0) {
#pragma unroll
        for (int i = 0; i < NACC; ++i) { f32x4 s = {0.f, 0.f, 0.f, 0.f};
#pragma unroll
            for (int w = 0; w < 8; ++w) s += ((LAS f32x4*)lds)[(w * NACC + i) * 64 + lane];
            out[i] = s; }
    }
    __syncthreads();
    return wid == 0;
}

__device__ __forceinline__ void epi_glu(const GemmDesc& g, const f32x4 (&acc)[2][2][4][2], const Unit& u, int wr, int wc, int fr, int fq) {
    const float* res = g.res; float* Hout = g.Hout; float* SSQ = g.SSQ;
#pragma unroll
    for (int ai = 0; ai < 2; ++ai) {
        const int row0 = u.pm * BM + ai * HALF + wr * 64 + fr; const size_t off0 = (size_t)row0 * D + u.pn * 128 + wc * 32 + 4 * fq;
        f32x4 h[4][2];
#pragma unroll
        for (int m = 0; m < 4; ++m)
#pragma unroll
            for (int n = 0; n < 2; ++n) h[m][n] = *(const f32x4*)(res + off0 + (size_t)m * 16 * D + 16 * n);
#pragma unroll
        for (int m = 0; m < 4; ++m) {
            float ss = 0.f;
#pragma unroll
            for (int n = 0; n < 2; ++n) {
                const f32x4 v = acc[ai][0][m][n], gt = acc[ai][1][m][n]; f32x4 hh = h[m][n];
                hh[0] += v[0] * sigmoidf_(gt[0]); hh[1] += v[1] * sigmoidf_(gt[1]); hh[2] += v[2] * sigmoidf_(gt[2]); hh[3] += v[3] * sigmoidf_(gt[3]);
                *(f32x4*)(Hout + off0 + (size_t)m * 16 * D + 16 * n) = hh; ss += ssq4(hh);
            }
            ss = quad_sum(ss);
            if (fq == 0) SSQ[(size_t)(row0 + 16 * m) * 32 + u.pn * 4 + wc] = ss;
        }
        asm volatile("" ::: "memory");
    }
}
__device__ __forceinline__ void phase_glu(CArgs& a, int layer, bool dry, LAS unsigned char* lds, GemmDesc& g) {
    const bf16_t* Zb = (const bf16_t*)(a.ws + WS_Z); const bf16_t* W = (const bf16_t*)(a.ws + WS_WGLU) + (size_t)layer * 2048 * 1024;
    float* H = (float*)(a.ws + WS_H); float* Hout = (float*)(a.ws + (dry ? WS_DUMH : WS_H)); float* SSQ = (float*)(a.ws + (dry ? WS_DUMSSQ : WS_SSQ));
    const float* res = layer == 0 ? a.in[0] : H; const float* resm = layer == 0 ? a.in[1] : H + (size_t)NREAL * D;
    if (opaque_bid() < 32) {
        const int lane = opaque_tid() & 63, fr = lane & 15, fq = lane >> 4, task = opaque_bid();
        const int c0 = 32 * task, rv = 256 * (c0 >> 7) + (c0 & 127);
        const bf16_t* const br[4] = {W + (size_t)rv * D, W + (size_t)(rv + 16) * D, W + (size_t)(rv + 128) * D, W + (size_t)(rv + 144) * D};
        f32x4 o[4];
        if (meta_block<4>(lds, Zb + (size_t)NREAL * D, br, D, o)) {
            float ss = 0.f;
#pragma unroll
            for (int n = 0; n < 2; ++n) {
                const f32x4 v = o[n], gt = o[2 + n];
                f32x4 h = *(const f32x4*)(resm + (size_t)fr * D + c0 + 16 * n + 4 * fq);
                h[0] += v[0] * sigmoidf_(gt[0]); h[1] += v[1] * sigmoidf_(gt[1]); h[2] += v[2] * sigmoidf_(gt[2]); h[3] += v[3] * sigmoidf_(gt[3]);
                *(f32x4*)(Hout + (size_t)(NREAL + fr) * D + c0 + 16 * n + 4 * fq) = h; ss += ssq4(h);
            }
            ss = quad_sum(ss);
            if (fq == 0) SSQ[(size_t)(NREAL + fr) * 32 + task] = ss;
        }
    }
    g.kind = EPI_GLU; g.K = D; g.perm = 0; g.gather = 0; g.moe = 0; g.nM = NREAL / BM; g.nN = 2048 / BM; g.nwg = g.nM * g.nN; g.A = (const char*)Zb; g.Bt = (const char*)W;
    g.tstepA = g.tstepB = (size_t)BM * D * 2; g.wstride = 0; g.res = res; g.Hout = Hout; g.SSQ = SSQ;
}

__device__ __forceinline__ void epi_oproj(const GemmDesc& g, const f32x4 (&acc)[2][2][4][2], const Unit& u, int wr, int wc, int fr, int fq) {
    const float* res = g.res; float* Hout = g.Hout; float* SSQ = g.SSQ; const float* bias = g.bias;
#pragma unroll
    for (int ai = 0; ai < 2; ++ai)
#pragma unroll
        for (int bj = 0; bj < 2; ++bj) {
            const int row0 = u.pm * BM + ai * HALF + wr * 64 + fr, c0 = u.pn * BM + bj * HALF + wc * 32 + 4 * fq; const size_t off0 = (size_t)row0 * D + c0;
            const f32x4 b0 = *(const f32x4*)(bias + c0), b1 = *(const f32x4*)(bias + c0 + 16);
            f32x4 h[4][2];
#pragma unroll
            for (int m = 0; m < 4; ++m)
#pragma unroll
                for (int n = 0; n < 2; ++n) h[m][n] = *(const f32x4*)(res + off0 + (size_t)m * 16 * D + 16 * n);
#pragma unroll
            for (int m = 0; m < 4; ++m) {
                float ss = 0.f;
#pragma unroll
                for (int n = 0; n < 2; ++n) { f32x4 hh = h[m][n]; hh += acc[ai][bj][m][n] + (n ? b1 : b0); *(f32x4*)(Hout + off0 + (size_t)m * 16 * D + 16 * n) = hh; ss += ssq4(hh); }
                ss = quad_sum(ss);
                if (fq == 0) SSQ[(size_t)(row0 + 16 * m) * 32 + u.pn * 8 + bj * 4 + wc] = ss;
            }
            asm volatile("" ::: "memory");
        }
}
__device__ __forceinline__ void phase_oproj(CArgs& a, int j, bool dry, LAS unsigned char* lds, GemmDesc& g) {
    const bf16_t* Ob = (const bf16_t*)(a.ws + WS_Z); const bf16_t* W = (const bf16_t*)(a.ws + WS_WO) + (size_t)j * 1024 * 1024;
    float* H = (float*)(a.ws + WS_H); float* Hout = (float*)(a.ws + (dry ? WS_DUMH : WS_H)); float* SSQ = (float*)(a.ws + (dry ? WS_DUMSSQ : WS_SSQ));
    const float* bo = a.in[21] + (size_t)j * D;
    if (opaque_bid() < 32) {
        const int lane = opaque_tid() & 63, fr = lane & 15, fq = lane >> 4, task = opaque_bid(), c0 = 32 * task;
        const bf16_t* const br[2] = {W + (size_t)c0 * D, W + (size_t)(c0 + 16) * D};
        f32x4 o[2];
        if (meta_block<2>(lds, Ob + (size_t)NREAL * D, br, D, o)) {
            float ss = 0.f;
#pragma unroll
            for (int n = 0; n < 2; ++n) {
                const size_t off = (size_t)(NREAL + fr) * D + c0 + 16 * n + 4 * fq;
                f32x4 h = *(const f32x4*)(H + off); h += o[n] + *(const f32x4*)(bo + c0 + 16 * n + 4 * fq); *(f32x4*)(Hout + off) = h; ss += ssq4(h);
            }
            ss = quad_sum(ss);
            if (fq == 0) SSQ[(size_t)(NREAL + fr) * 32 + task] = ss;
        }
    }
    g.kind = EPI_OPROJ; g.K = D; g.perm = 0; g.gather = 0; g.moe = 0; g.nM = NREAL / BM; g.nN = 1024 / BM; g.nwg = g.nM * g.nN; g.A = (const char*)Ob; g.Bt = (const char*)W;
    g.tstepA = g.tstepB = (size_t)BM * D * 2; g.wstride = 0; g.res = H; g.Hout = Hout; g.SSQ = SSQ; g.bias = bo;
}

__device__ __forceinline__ void kvq_store8(const GemmDesc& g, int row, int c, const float (&v)[8]) {
    if (c < 256) {
        const float* b = g.bias + c; u32x4 w; w.x = cvt_pk_bf16(v[0] + b[0], v[1] + b[1]); w.y = cvt_pk_bf16(v[2] + b[2], v[3] + b[3]); w.z = cvt_pk_bf16(v[4] + b[4], v[5] + b[5]); w.w = cvt_pk_bf16(v[6] + b[6], v[7] + b[7]);
        *(u32x4*)(g.O1 + (size_t)row * 256 + c) = w;
    } else if (c < 512) {
        const int cv = c - 256; const float* b = g.bias + c;
        bf16_t* vp = g.O2 + (row < NREAL ? ((size_t)(row >> 11) * 256 + cv) * SEQ + (row & (SEQ - 1)) : VT_META + (size_t)cv * 16 + (row - NREAL));
        const size_t st = row < NREAL ? SEQ : 16;
#pragma unroll
        for (int i = 0; i < 4; ++i) { const unsigned p = cvt_pk_bf16(v[2 * i] + b[2 * i], v[2 * i + 1] + b[2 * i + 1]); vp[(size_t)(2 * i) * st] = (bf16_t)(p & 0xffffu); vp[(size_t)(2 * i + 1) * st] = (bf16_t)(p >> 16); }
    } else {
        const int cq = c - 512; const float* b = g.bias2 + cq;
        u32x4 w; w.x = cvt_pk_bf16((v[0] + b[0]) * 0.125f, (v[1] + b[1]) * 0.125f); w.y = cvt_pk_bf16((v[2] + b[2]) * 0.125f, (v[3] + b[3]) * 0.125f);
        w.z = cvt_pk_bf16((v[4] + b[4]) * 0.125f, (v[5] + b[5]) * 0.125f); w.w = cvt_pk_bf16((v[6] + b[6]) * 0.125f, (v[7] + b[7]) * 0.125f);
        *(u32x4*)(g.O3 + (size_t)row * D + cq) = w;
    }
}
__device__ __forceinline__ void epi_kvq(const GemmDesc& g, const f32x4 (&acc)[2][2][4][2], const Unit& u, int wr, int wc, int fr, int fq) {
    { const int cbase = g.cbase;
#pragma unroll
        for (int ai = 0; ai < 2; ++ai)
#pragma unroll
            for (int m = 0; m < 4; ++m) {
                const int row = u.pm * BM + ai * HALF + wr * 64 + m * 16 + fr;
#pragma unroll
                for (int bj = 0; bj < 2; ++bj) {
                    const int c = cbase + u.pn * BM + bj * HALF + wc * 32 + 8 * fq;
                    const f32x4 v0 = acc[ai][bj][m][0], v1 = acc[ai][bj][m][1];
                    const float v[8] = {v0[0], v0[1], v0[2], v0[3], v1[0], v1[1], v1[2], v1[3]};
                    kvq_store8(g, row, c, v);
                    asm volatile("" ::: "memory");
                }
            }
    }
}
__device__ __forceinline__ void phase_kvq_q(CArgs& a, int jq, LAS unsigned char* lds, GemmDesc& g) {
    const bf16_t* Ub = (const bf16_t*)(a.ws + WS_U); const bf16_t* W = jq == 0 ? (const bf16_t*)(a.ws + WS_WKVQ) : (const bf16_t*)(a.ws + WS_WQ1);
    const int N = jq == 0 ? 1536 : 1024, cbase = jq == 0 ? 0 : 512;
    if (opaque_bid() < N / 32) {
        const int lane = opaque_tid() & 63, fr = lane & 15, fq = lane >> 4, task = opaque_bid();
        const bf16_t* const br[2] = {W + (size_t)(32 * task) * D, W + (size_t)(32 * task + 16) * D};
        f32x4 o[2];
        if (meta_block<2>(lds, Ub + (size_t)NREAL * D, br, D, o)) {
#pragma unroll
            for (int h = 0; h < 2; ++h) {
                const int c = cbase + 32 * task + 16 * h + 4 * fq; const f32x4 v = o[h]; const int row = NREAL + fr;
                if (c < 256) { const float* b = a.in[16] + c; u32x2 w; w.x = cvt_pk_bf16(v[0] + b[0], v[1] + b[1]); w.y = cvt_pk_bf16(v[2] + b[2], v[3] + b[3]); *(u32x2*)((bf16_t*)(a.ws + WS_K) + (size_t)row * 256 + c) = w; }
                else if (c < 512) { const int cv = c - 256; const float* b = a.in[16] + c; bf16_t* vp = (bf16_t*)(a.ws + WS_VT) + VT_META + (size_t)cv * 16 + fr;
                    const unsigned p0 = cvt_pk_bf16(v[0] + b[0], v[1] + b[1]), p1 = cvt_pk_bf16(v[2] + b[2], v[3] + b[3]);
                    vp[0] = (bf16_t)(p0 & 0xffffu); vp[16] = (bf16_t)(p0 >> 16); vp[32] = (bf16_t)(p1 & 0xffffu); vp[48] = (bf16_t)(p1 >> 16); }
                else { const int cq = c - 512; const float* b = a.in[18] + (size_t)jq * D + cq; u32x2 w; w.x = cvt_pk_bf16((v[0] + b[0]) * 0.125f, (v[1] + b[1]) * 0.125f); w.y = cvt_pk_bf16((v[2] + b[2]) * 0.125f, (v[3] + b[3]) * 0.125f);
                    *(u32x2*)((bf16_t*)(a.ws + WS_Q) + (size_t)row * D + cq) = w; }
            }
        }
    }
    g.kind = EPI_KVQ; g.K = D; g.perm = 1; g.gather = 0; g.moe = 0; g.nM = NREAL / BM; g.nN = N / BM; g.nwg = g.nM * g.nN; g.A = (const char*)Ub; g.Bt = (const char*)W;
    g.tstepA = g.tstepB = (size_t)BM * D * 2; g.wstride = 0; g.bias = a.in[16]; g.bias2 = a.in[18] + (size_t)jq * D; g.O1 = (bf16_t*)(a.ws + WS_K); g.O2 = (bf16_t*)(a.ws + WS_VT); g.O3 = (bf16_t*)(a.ws + WS_Q);
    g.jq = jq; g.cbase = cbase;
}

__device__ __forceinline__ void moe_scan(const int* cnt, LAS int* sh) {
    if (opaque_tid() == 0) { int acc = 0; for (int e = 0; e < 32; ++e) { sh[e] = acc; acc += (cnt[e] + 255) >> 8; } sh[32] = acc; }
    __syncthreads();
}
__device__ __forceinline__ void epi_moe1(const GemmDesc& g, LAS unsigned char* lds, const f32x4 (&acc)[2][2][4][2], const Unit& u, int wr, int wc, int fr, int fq) {
    { bf16_t* HB = g.O1;
        const LAS int* tabt = (const LAS int*)(lds + LDS_TABT) + u.slot * 256;
#pragma unroll
        for (int ai = 0; ai < 2; ++ai)
#pragma unroll
            for (int m = 0; m < 4; ++m) {
                const int rl = ai * HALF + wr * 64 + m * 16 + fr;
                if (tabt[rl] >= 0) {
                    const f32x4 g0 = acc[ai][0][m][0], g1 = acc[ai][0][m][1], u0 = acc[ai][1][m][0], u1 = acc[ai][1][m][1];
                    u32x4 w; w.x = cvt_pk_bf16(g0[0] * sigmoidf_(g0[0]) * u0[0], g0[1] * sigmoidf_(g0[1]) * u0[1]); w.y = cvt_pk_bf16(g0[2] * sigmoidf_(g0[2]) * u0[2], g0[3] * sigmoidf_(g0[3]) * u0[3]);
                    w.z = cvt_pk_bf16(g1[0] * sigmoidf_(g1[0]) * u1[0], g1[1] * sigmoidf_(g1[1]) * u1[1]); w.w = cvt_pk_bf16(g1[2] * sigmoidf_(g1[2]) * u1[2], g1[3] * sigmoidf_(g1[3]) * u1[3]);
                    *(u32x4*)(HB + ((size_t)u.pm * 256 + rl) * DEXP + u.pn * 128 + wc * 32 + 8 * fq) = w;
                }
                asm volatile("" ::: "memory");
            }
    }
}
__device__ __forceinline__ void phase_moe1(CArgs& a, int layer, LAS unsigned char* lds, GemmDesc& g) {
    LAS int* sh = (LAS int*)(lds + LDS_SH);
    const int* cnt = (const int*)(a.ws + WS_CTL) + CW_CNT + layer * 32;
    moe_scan(cnt, sh);
    g.kind = EPI_MOE1; g.K = D; g.perm = 1; g.gather = 1; g.moe = 1; g.npn = 4; g.nwg = sh[32] * 4; g.nM = 0; g.nN = 4;
    g.A = (const char*)(a.ws + WS_XN); g.Bt = (const char*)(a.ws + WS_W1) + (size_t)layer * 32 * 1024 * 1024 * 2; g.wstride = (size_t)1024 * 1024 * 2;
    g.tstepA = 0; g.tstepB = (size_t)256 * 1024 * 2; g.cnt = cnt; g.LTOK = (const int*)(a.ws + WS_LTOK); g.LGATE = (const float*)(a.ws + WS_LGATE); g.O1 = (bf16_t*)(a.ws + WS_HB);
}
__device__ __forceinline__ void epi_moe2(const GemmDesc& g, LAS unsigned char* lds, const f32x4 (&acc)[2][2][4][2], const Unit& u, int wr, int wc, int fr, int fq) {
    { bf16_t* YB = g.O1;
        const LAS int* tabt = (const LAS int*)(lds + LDS_TABT) + u.slot * 256; const LAS float* tabg = (const LAS float*)(lds + LDS_TABG) + u.slot * 256;
#pragma unroll
        for (int ai = 0; ai < 2; ++ai)
#pragma unroll
            for (int m = 0; m < 4; ++m) {
                const int rl = ai * HALF + wr * 64 + m * 16 + fr; const int rt = tabt[rl];
                if (rt >= 0) {
                    const float gs = tabg[rl];
                    bf16_t* yp = YB + ((size_t)(rt & 0x3fffffff) * 2 + (rt >> 30)) * D + u.pn * BM + wc * 32 + 8 * fq;
#pragma unroll
                    for (int bj = 0; bj < 2; ++bj) { const f32x4 v0 = acc[ai][bj][m][0] * gs, v1 = acc[ai][bj][m][1] * gs;
                        u32x4 w; w.x = cvt_pk_bf16(v0[0], v0[1]); w.y = cvt_pk_bf16(v0[2], v0[3]); w.z = cvt_pk_bf16(v1[0], v1[1]); w.w = cvt_pk_bf16(v1[2], v1[3]);
                        *(u32x4*)(yp + bj * HALF) = w; }
                }
                asm volatile("" ::: "memory");
            }
    }
}
__device__ __forceinline__ void phase_moe2(CArgs& a, int layer, LAS unsigned char* lds, GemmDesc& g) {
    LAS int* sh = (LAS int*)(lds + LDS_SH);
    const int* cnt = (const int*)(a.ws + WS_CTL) + CW_CNT + layer * 32;
    moe_scan(cnt, sh);
    g.kind = EPI_MOE2; g.K = DEXP; g.perm = 1; g.gather = 0; g.moe = 1; g.npn = 4; g.nwg = sh[32] * 4; g.nM = 0; g.nN = 4;
    g.A = (const char*)(a.ws + WS_HB); g.Bt = (const char*)(a.ws + WS_W2) + (size_t)layer * 32 * 1024 * 512 * 2; g.wstride = (size_t)1024 * 512 * 2;
    g.tstepA = (size_t)256 * DEXP * 2; g.tstepB = (size_t)256 * DEXP * 2; g.cnt = cnt; g.LTOK = (const int*)(a.ws + WS_LTOK); g.LGATE = (const float*)(a.ws + WS_LGATE); g.O1 = (bf16_t*)(a.ws + WS_YB);
}
__device__ __forceinline__ void gemm_epilogue(const GemmDesc& g, LAS unsigned char* lds, const f32x4 (&acc)[2][2][4][2], const Unit& u, int wr, int wc, int fr, int fq) {
    asm volatile("" : "+v"(fr), "+v"(fq));
    switch (g.kind) {
        case EPI_GLU: epi_glu(g, acc, u, wr, wc, fr, fq); break;
        case EPI_OPROJ: epi_oproj(g, acc, u, wr, wc, fr, fq); break;
        case EPI_KVQ: epi_kvq(g, acc, u, wr, wc, fr, fq); break;
        case EPI_MOE1: epi_moe1(g, lds, acc, u, wr, wc, fr, fq); break;
        default: epi_moe2(g, lds, acc, u, wr, wc, fr, fq); break;
    }
}

constexpr int AT_NSLOT = 272, AT_VROW = 552, AT_KBYTES = AT_NSLOT * 128, AT_VBYTES = 64 * AT_VROW;
__device__ __forceinline__ void attn_tile(LAS unsigned char* Ks, LAS unsigned char* Vs, const bf16_t* qp, bf16_t* op, float sink, int nblk  , int kb0  , int srel  , int smin  , int lmeta  , int tc, int q4) {
    const bf16x8 qf0 = as_bf16x8(*(const u32x4*)qp), qf1 = as_bf16x8(*(const u32x4*)(qp + 32));
    f32x4 s[10];
#pragma unroll
    for (int bi = 0; bi < 10; ++bi) {
        s[bi] = (f32x4){-1e30f, -1e30f, -1e30f, -1e30f};
        if (bi < nblk) {
            const int sl = (bi == 0 ? 0 : 16 + 16 * (kb0 + bi - 1)) + tc;
            const LAS unsigned char* kr = Ks + sl * 128;
            const bf16x8 kf0 = *(const LAS bf16x8*)(kr + ((q4 ^ (sl & 7)) << 4)), kf1 = *(const LAS bf16x8*)(kr + (((4 + q4) ^ (sl & 7)) << 4));
            f32x4 acc = {0.f, 0.f, 0.f, 0.f};
            acc = mfma16(kf0, qf0, acc); acc = mfma16(kf1, qf1, acc);
#pragma unroll
            for (int r = 0; r < 4; ++r) {
                const int kk = 16 * (kb0 + bi - 1) + 4 * q4 + r;
                const bool ok = bi == 0 ? (4 * q4 + r <= lmeta) : (kk >= smin && kk <= srel && kk >= srel - 127);
                s[bi][r] = ok ? acc[r] : -1e30f;
            }
        }
    }
    float m = sink;
#pragma unroll
    for (int bi = 0; bi < 10; ++bi) m = fmaxf(m, fmaxf(fmaxf(s[bi][0], s[bi][1]), fmaxf(s[bi][2], s[bi][3])));
    m = xor32_max(xor16_max(m));
    float den = 0.f;
    unsigned pk[10][2];
#pragma unroll
    for (int bi = 0; bi < 10; ++bi) {
        float p[4];
#pragma unroll
        for (int r = 0; r < 4; ++r) { p[r] = s[bi][r] > -1e29f ? fast_exp(s[bi][r] - m) : 0.f; den += p[r]; }
        pk[bi][0] = cvt_pk_bf16(p[0], p[1]); pk[bi][1] = cvt_pk_bf16(p[2], p[3]);
    }
    den = quad_sum(den);
    den += fast_exp(sink - m);
    const float inv = 1.0f / den;
    f32x4 o[4];
#pragma unroll
    for (int dt = 0; dt < 4; ++dt) o[dt] = (f32x4){0.f, 0.f, 0.f, 0.f};
#pragma unroll
    for (int pp = 0; pp < 5; ++pp) {
        if (2 * pp < nblk) {
            const int biA = 2 * pp, biB = 2 * pp + 1;
            const int slA = biA == 0 ? 0 : 16 + 16 * (kb0 + biA - 1), slB = biB < nblk ? 16 + 16 * (kb0 + biB - 1) : slA;
            u32x4 pw; pw.x = pk[biA][0]; pw.y = pk[biA][1]; pw.z = pk[biB][0]; pw.w = pk[biB][1];
            const bf16x8 pf = as_bf16x8(pw);
#pragma unroll
            for (int dt = 0; dt < 4; ++dt) {
                const LAS unsigned char* vr = Vs + (16 * dt + tc) * AT_VROW + 8 * q4;
                const u32x2 va = *(const LAS u32x2*)(vr + slA * 2), vb = *(const LAS u32x2*)(vr + slB * 2);
                u32x4 vw; vw.x = va.x; vw.y = va.y; vw.z = vb.x; vw.w = vb.y;
                o[dt] = mfma16(as_bf16x8(vw), pf, o[dt]);
            }
        }
    }
#pragma unroll
    for (int dt = 0; dt < 4; ++dt) { u32x2 w; w.x = cvt_pk_bf16(o[dt][0] * inv, o[dt][1] * inv); w.y = cvt_pk_bf16(o[dt][2] * inv, o[dt][3] * inv); *(u32x2*)(op + 16 * dt) = w; }
}
__device__ __forceinline__ void phase_attn(CArgs& a, int j, LAS unsigned char* lds) {
    const int tid = opaque_tid(), lane = tid & 63, wid = tid >> 6, tc = lane & 15, q4 = lane >> 4;
    const bf16_t* Q = (const bf16_t*)(a.ws + WS_Q); const bf16_t* K = (const bf16_t*)(a.ws + WS_K); const bf16_t* VT = (const bf16_t*)(a.ws + WS_VT);
    bf16_t* O = (bf16_t*)(a.ws + WS_Z);
    LAS unsigned char* Ks = lds; LAS unsigned char* Vs = lds + AT_KBYTES;
    constexpr int NU_REAL = NB * 4 * 16;
    for (int unit = opaque_bid(); unit < NU_REAL + 4; unit += GRID) {
        const bool meta = unit >= NU_REAL;
        const int qt = meta ? 0 : (unit & 15), kvh = meta ? unit - NU_REAL : ((unit >> 4) & 3), b = meta ? 0 : (unit >> 6), s0 = qt * 128;
        __syncthreads();
        for (int idx = tid; idx < AT_NSLOT * 8; idx += NTHREADS) {
            const int sl = idx >> 3, c = idx & 7, sw = s0 - 128 + (sl - 16);
            u32x4 v = {0u, 0u, 0u, 0u};
            if (sl < 16) v = *(const u32x4*)(K + (size_t)(NREAL + sl) * 256 + kvh * 64 + c * 8);
            else if (!meta && sw >= 0) v = *(const u32x4*)(K + (size_t)(b * SEQ + sw) * 256 + kvh * 64 + c * 8);
            *(LAS u32x4*)(Ks + sl * 128 + ((c ^ (sl & 7)) << 4)) = v;
        }
        for (int idx = tid; idx < 64 * 34; idx += NTHREADS) {
            const int d = idx / 34, ch = idx - d * 34, sw = s0 - 128 + 8 * (ch - 2);
            u32x4 v = {0u, 0u, 0u, 0u};
            if (ch < 2) v = *(const u32x4*)(VT + VT_META + (size_t)(kvh * 64 + d) * 16 + ch * 8);
            else if (!meta && sw >= 0) v = *(const u32x4*)(VT + ((size_t)(b * 4 + kvh) * 64 + d) * SEQ + sw);
            *(LAS u32x2*)(Vs + d * AT_VROW + ch * 16) = (u32x2){v.x, v.y}; *(LAS u32x2*)(Vs + d * AT_VROW + ch * 16 + 8) = (u32x2){v.z, v.w};
        }
        __syncthreads();
        const int g = wid & 3, hq = kvh * 4 + g;
        const float sink = a.in[19][j * 16 + hq];
        if (meta) {
            if (wid < 4) { const size_t row = (size_t)(NREAL + tc); attn_tile(Ks, Vs, Q + row * D + hq * 64 + 8 * q4, O + row * D + hq * 64 + 4 * q4, sink, 1, 0, 0, 0, tc, tc, q4); }
        } else {
#pragma unroll 1
            for (int jt = wid >> 2; jt < 8; jt += 2) {
                const int s = s0 + 16 * jt + tc; const size_t row = (size_t)(b * SEQ + s);
                attn_tile(Ks, Vs, Q + row * D + hq * 64 + 8 * q4, O + row * D + hq * 64 + 4 * q4, sink, 10, jt, 128 + 16 * jt + tc, 128 - s0, 64, tc, q4);
            }
        }
    }
}

__device__ __forceinline__ void phase_route(CArgs& a, int layer, bool dry, LAS unsigned char* lds) {
    LAS unsigned char* Wf = lds; LAS float* LG = (LAS float*)(lds + 98304); LAS int* hist = (LAS int*)(lds + 98304 + 24576); LAS int* hbase = hist + 32;
    const int tid = opaque_tid(), lane = tid & 63, wid = tid >> 6, tc = lane & 15, q4 = lane >> 4;
    for (int idx = tid; idx < 3 * 32 * 64; idx += NTHREADS) *(LAS u32x4*)(Wf + (size_t)idx * 16) = *(const u32x4*)(a.ws + WS_RW + (size_t)layer * 98304 + (size_t)idx * 16);
    if (tid < 32) hist[tid] = 0;
    __syncthreads();
    const float* H = (const float*)(a.ws + WS_H); const float* SSQ = (const float*)(a.ws + WS_SSQ); bf16_t* XN = (bf16_t*)(a.ws + WS_XN);
    int* cnt = (int*)(a.ws + WS_CTL) + (dry ? CW_DUMCNT : CW_CNT) + layer * 32; int* LTOK = (int*)(a.ws + (dry ? WS_DUMLT : WS_LTOK)); float* LGATE = (float*)(a.ws + (dry ? WS_DUMLG : WS_LGATE));
    const int tile = wid * GRID + opaque_bid();
    const bool active = tile < RT / 16;
    int e1, e2, r1, r2; float g1, g2;
    asm volatile("" : "=v"(e1), "=v"(e2), "=v"(r1), "=v"(r2), "=v"(g1), "=v"(g2));
    if (active) {
        const int row = tile * 16 + tc;
        float ss = 0.f;
        { const f32x4* sp = (const f32x4*)(SSQ + (size_t)row * 32 + 8 * q4); const f32x4 s0 = sp[0], s1 = sp[1]; ss = (s0[0] + s0[1]) + (s0[2] + s0[3]) + (s1[0] + s1[1]) + (s1[2] + s1[3]); }
        ss = quad_sum(ss);
        const float rstd = 1.0f / sqrtf(ss * (1.0f / D) + RMS_EPS);
        f32x4 acc[3];
#pragma unroll
        for (int rt = 0; rt < 3; ++rt) acc[rt] = (f32x4){0.f, 0.f, 0.f, 0.f};
        const float* hp = H + (size_t)row * D + 8 * q4; bf16_t* xp = XN + (size_t)row * D + 8 * q4;
#pragma unroll 1
        for (int kb = 0; kb < 4; ++kb) {
            f32x4 hv[8][2];
#pragma unroll
            for (int k8 = 0; k8 < 8; ++k8) { hv[k8][0] = *(const f32x4*)(hp + 32 * (kb * 8 + k8)); hv[k8][1] = *(const f32x4*)(hp + 32 * (kb * 8 + k8) + 4); }
#pragma unroll
            for (int k8 = 0; k8 < 8; ++k8) {
                const int ks = kb * 8 + k8; const f32x4 h0 = hv[k8][0], h1 = hv[k8][1];
                u32x4 xw; xw.x = cvt_pk_bf16(h0[0] * rstd, h0[1] * rstd); xw.y = cvt_pk_bf16(h0[2] * rstd, h0[3] * rstd);
                xw.z = cvt_pk_bf16(h1[0] * rstd, h1[1] * rstd); xw.w = cvt_pk_bf16(h1[2] * rstd, h1[3] * rstd);
                *(u32x4*)(xp + 32 * ks) = xw;
                const bf16x8 xf = as_bf16x8(xw);
#pragma unroll
                for (int rt = 0; rt < 3; ++rt) acc[rt] = mfma16(*(LAS bf16x8*)(Wf + ((size_t)(rt * 32 + ks) * 64 + lane) * 16), xf, acc[rt]);
            }
        }
        LAS float* lg = LG + wid * 16 * 48;
#pragma unroll
        for (int rt = 0; rt < 3; ++rt)
#pragma unroll
            for (int r = 0; r < 4; ++r) lg[tc * 48 + 16 * rt + 4 * q4 + r] = acc[rt][r];
        asm volatile("s_waitcnt lgkmcnt(0)" ::: "memory");
        if (lane < 16) {
            const LAS float* mylg = lg + lane * 48;
            float gl[4]; int gi = 0; float gm;
#pragma unroll
            for (int i = 0; i < 4; ++i) gl[i] = mylg[i] + a.in[23][layer * NGRP + i];
            gm = gl[0];
#pragma unroll
            for (int i = 1; i < 4; ++i) if (gl[i] > gm) { gm = gl[i]; gi = i; }
            float gz = 0.f;
#pragma unroll
            for (int i = 0; i < 4; ++i) gz += expf(gl[i] - gm);
            const float pg = 1.0f / gz;
            float el[8];
#pragma unroll
            for (int i = 0; i < 8; ++i) el[i] = mylg[4 + gi * 8 + i] + a.in[25][layer * NEXP + gi * 8 + i];
            int i1 = 0; float m1 = el[0];
#pragma unroll
            for (int i = 1; i < 8; ++i) if (el[i] > m1) { m1 = el[i]; i1 = i; }
            int i2 = -1; float m2 = -3.0e38f;
#pragma unroll
            for (int i = 0; i < 8; ++i) if (i != i1 && el[i] > m2) { m2 = el[i]; i2 = i; }
            float one = 1.0f; asm volatile("" : "+v"(one));
            const float x2 = expf(m2 - m1), q1 = one / (one + x2);
            g1 = pg * q1; g2 = pg * x2 * q1; e1 = gi * 8 + i1; e2 = gi * 8 + i2;
            r1 = __hip_atomic_fetch_add(&hist[e1], 1, __ATOMIC_RELAXED, __HIP_MEMORY_SCOPE_WORKGROUP); r2 = __hip_atomic_fetch_add(&hist[e2], 1, __ATOMIC_RELAXED, __HIP_MEMORY_SCOPE_WORKGROUP);
        }
    }
    __syncthreads();
    if (tid < 32) hbase[tid] = hist[tid] ? atomicAdd(&cnt[tid], hist[tid]) : 0;
    __syncthreads();
    if (active && lane < 16) {
        const int row = tile * 16 + lane;
        const int s1 = hbase[e1] + r1, s2 = hbase[e2] + r2;
        LTOK[(size_t)e1 * RT + s1] = row; LGATE[(size_t)e1 * RT + s1] = g1;
        LTOK[(size_t)e2 * RT + s2] = row | (1 << 30); LGATE[(size_t)e2 * RT + s2] = g2;
    }
}

__device__ __forceinline__ void phase_combine(CArgs& a, int layer, bool dry) {
    const int lane = opaque_tid() & 63, gw = opaque_bid() * 8 + (opaque_tid() >> 6);
    float* H = (float*)(a.ws + WS_H); const bf16_t* YB = (const bf16_t*)(a.ws + WS_YB);
    for (int row = gw; row < RT; row += GRID * 8) {
        f32x4 v[4]; float ssq = 0.f;
        float* hp = H + (size_t)row * D; const bf16_t* y0 = YB + (size_t)row * 2 * D; const bf16_t* y1 = y0 + D;
#pragma unroll
        for (int j = 0; j < 4; ++j) {
            const int c = 4 * lane + 256 * j;
            v[j] = *(const f32x4*)(hp + c);
            const u32x2 p0 = *(const u32x2*)(y0 + c), p1 = *(const u32x2*)(y1 + c);
            v[j][0] += bf16_lo(p0.x) + bf16_lo(p1.x); v[j][1] += bf16_hi(p0.x) + bf16_hi(p1.x); v[j][2] += bf16_lo(p0.y) + bf16_lo(p1.y); v[j][3] += bf16_hi(p0.y) + bf16_hi(p1.y);
            ssq += ssq4(v[j]);
        }
        ssq = wave_sum(ssq);
        if (layer < 3) {
            if (!dry) {
#pragma unroll
                for (int j = 0; j < 4; ++j) *(f32x4*)(hp + 4 * lane + 256 * j) = v[j];
                row_norm_store(v, ssq, lane, layer == 0 ? a.in[2] + D : nullptr, (bf16_t*)(a.ws + WS_U) + (size_t)row * D);
            } else {
                float* dp = (float*)(a.ws + WS_DUMH) + (size_t)row * D;
#pragma unroll
                for (int j = 0; j < 4; ++j) *(f32x4*)(dp + 4 * lane + 256 * j) = v[j];
                row_norm_store(v, ssq, lane, layer == 0 ? a.in[2] + D : nullptr, (bf16_t*)(a.ws + WS_DUMSSQ) + (size_t)(row & 1023) * D);
            }
        } else if (row < NREAL) {
            const float rstd = 1.0f / sqrtf(ssq * (1.0f / D) + RMS_EPS);
            float* op = a.out + (size_t)row * D;
#pragma unroll
            for (int j = 0; j < 4; ++j) { const int c = 4 * lane + 256 * j; const f32x4 g = *(const f32x4*)(a.in[5] + c);
                f32x4 o; o[0] = v[j][0] * rstd * g[0]; o[1] = v[j][1] * rstd * g[1]; o[2] = v[j][2] * rstd * g[2]; o[3] = v[j][3] * rstd * g[3];
                *(f32x4*)(op + c) = o; }
        }
    }
}

enum { PH_PREP = 0, PH_S5, PH_GLU, PH_ROUTE, PH_G1, PH_G2, PH_COMB, PH_KVQ, PH_ATT, PH_OPROJ, PH_QG };
constexpr int NPH = 27;
__constant__ int c_prog[NPH][2] = {
    {PH_PREP, 0},
    {PH_S5, 0}, {PH_GLU, 0}, {PH_ROUTE, 0}, {PH_G1, 0}, {PH_G2, 0}, {PH_COMB, 0},
    {PH_S5, 1}, {PH_GLU, 1}, {PH_ROUTE, 1}, {PH_G1, 1}, {PH_G2, 1}, {PH_COMB, 1},
    {PH_KVQ, 2}, {PH_ATT, 2}, {PH_OPROJ, 2}, {PH_ROUTE, 2}, {PH_G1, 2}, {PH_G2, 2}, {PH_COMB, 2},
    {PH_QG, 3}, {PH_ATT, 3}, {PH_OPROJ, 3}, {PH_ROUTE, 3}, {PH_G1, 3}, {PH_G2, 3}, {PH_COMB, 3},
};

__global__ void __launch_bounds__(NTHREADS) yoco_fwd(Args a) {
    extern __shared__ __attribute__((aligned(16))) unsigned char smem_raw[];
    LAS unsigned char* lds = (LAS unsigned char*)smem_raw;
    volatile LAS unsigned* const st = (volatile LAS unsigned*)(lds + LDS_BYTES - 64);
    if (threadIdx.x < 16) st[threadIdx.x] = 0u;
    __syncthreads();
    if (a.ph_hi - a.ph_lo > 1) xcd_barrier_post((unsigned*)(a.ws + WS_CTL) + CW_BAR);
    CArgs* const kp = (CArgs*)__builtin_amdgcn_kernarg_segment_ptr();
    for (int ph = a.ph_lo; ph < a.ph_hi; ++ph) {
        const int type = c_prog[ph][0], layer = c_prog[ph][1];
        const int reps = type == a.rep_type ? a.rep_n : 0;
        for (int r = 0; r <= reps; ++r) {
            const bool dry = r > 0;
            CArgs* lp = kp; asm volatile("" : "+s"(lp));
            CArgs& la = *lp;
            GemmDesc g; bool is_gemm = true;
            switch (type) {
                case PH_GLU: phase_glu(la, layer, dry, lds, g); break;
                case PH_G1: phase_moe1(la, layer, lds, g); break;
                case PH_G2: phase_moe2(la, layer, lds, g); break;
                case PH_KVQ: case PH_QG: phase_kvq_q(la, type == PH_QG ? 1 : 0, lds, g); break;
                case PH_OPROJ: phase_oproj(la, layer - 2, dry, lds, g); break;
                default: is_gemm = false; break;
            }
            g.skip_epi = 0;
#if defined(PROBE_SKIPEPI)
            if (dry) g.skip_epi = 1;
#endif
            if (is_gemm) gemm_run(lds, g);
            else switch (type) {
                case PH_PREP: phase_prep(la, lds); break;
                case PH_S5: phase_s5(la, layer, lds); break;
                case PH_ROUTE: phase_route(la, layer, dry, lds); break;
                case PH_COMB: phase_combine(la, layer, dry); break;
                default: phase_attn(la, layer - 2, lds); break;
            }
            BgConv bg{lp, st};
            if (type == PH_ROUTE && !dry) bg.flush((layer + 1) * 32 * NWT_E);
            if (r < reps || ph + 1 < a.ph_hi) { if (a.ph_hi - a.ph_lo > 1) xcd_barrier((unsigned*)(la.ws + WS_CTL) + CW_BAR, st, bg); else if (type == PH_ROUTE) bg.flush(NWT_MOE); }
        }
        if (a.rep_type == 100 && ph + 1 < a.ph_hi) for (int r = 0; r < a.rep_n; ++r) { BgConv bg{kp, st}; xcd_barrier((unsigned*)(a.ws + WS_CTL) + CW_BAR, st, bg); }
    }
}

extern "C" void kernel_launch(void* const* d_in, const int* in_sizes, int n_in, void* d_out, int out_size, void* d_ws, size_t ws_size, hipStream_t stream) {
    static int ready = 0;
    if (ready == 0) {
        if (n_in != 29 || ws_size < WS_END) { fprintf(stderr, "kernel_launch: expected 29 inputs and >= %zu bytes of workspace (got %d, %zu)\n", (size_t)WS_END, n_in, ws_size); ready = -1; return; }
        if (hipFuncSetAttribute((const void*)yoco_fwd, hipFuncAttributeMaxDynamicSharedMemorySize, LDS_BYTES) != hipSuccess) { fprintf(stderr, "kernel_launch: hipFuncSetAttribute failed\n"); ready = -1; return; }
        ready = 1;
    }
    if (ready < 0) return;
    (void)hipMemsetAsync((char*)d_ws + WS_CTL, 0, CTL_BYTES, stream);
    Args a{};
    for (int i = 0; i < 29; ++i) a.in[i] = (const float*)d_in[i];
    a.out = (float*)d_out; a.ws = (unsigned char*)d_ws;
#if defined(PROBE_TYPE)
    a.rep_type = PROBE_TYPE; a.rep_n = PROBE_N;
#else
    a.rep_type = -1; a.rep_n = 0;
#endif
#if MK_N_LAUNCHES == 1
    a.ph_lo = 0; a.ph_hi = NPH;
    hipLaunchKernelGGL(yoco_fwd, dim3(GRID), dim3(NTHREADS), LDS_BYTES, stream, a);
#else
    for (int ph = 0; ph < NPH; ++ph) { a.ph_lo = ph; a.ph_hi = ph + 1; hipLaunchKernelGGL(yoco_fwd, dim3(GRID), dim3(NTHREADS), LDS_BYTES, stream, a); }
#endif
}
```

```cpp
#include <hip/hip_runtime.h>
#include <cstdio>
#include <cstdint>

#ifndef MK_N_LAUNCHES
#define MK_N_LAUNCHES 1
#endif

#define LAS __attribute__((address_space(3)))
typedef unsigned short bf16_t;
typedef short bf16x8 __attribute__((ext_vector_type(8)));
typedef float f32x4 __attribute__((ext_vector_type(4)));
typedef float f32x2 __attribute__((ext_vector_type(2)));
typedef unsigned u32x4 __attribute__((ext_vector_type(4)));
typedef unsigned u32x2 __attribute__((ext_vector_type(2)));

constexpr int D = 1024, NB = 8, SEQ = 2048, NMETA = 16, LT = SEQ + NMETA  ;
constexpr int NREAL = NB * SEQ  , RT = NREAL + NMETA  , RPAD = 16640;
constexpr int NEXP = 32, DEXP = 512, NGRP = 4, EPG = 8;
constexpr int NTHREADS = 512, GRID = 256;
constexpr int LDS_BYTES = 155648;
constexpr float RMS_EPS = 1e-6f;
__device__ __forceinline__ int row_of(int b, int pos) { return pos < NMETA ? NREAL + pos : b * SEQ + (pos - NMETA); }

constexpr size_t al256(size_t x) { return (x + 255) & ~(size_t)255; }
constexpr size_t WS_CTL = 0;
constexpr size_t CTL_BYTES = 32768;
constexpr int CW_BAR = 0;
constexpr int CW_CNT = 4096;
constexpr int CW_DUMCNT = 4096 + 256;
constexpr int CW_BGC = 6144;
constexpr size_t WS_H = WS_CTL + CTL_BYTES;
constexpr size_t WS_U = WS_H + al256((size_t)RPAD * D * 2);
constexpr size_t WS_Z = WS_U + al256((size_t)RPAD * D * 2);
constexpr size_t WS_XN = WS_Z + al256((size_t)RPAD * D * 2);
constexpr size_t WS_Q = WS_XN + al256((size_t)RPAD * D * 2);
constexpr size_t WS_K = WS_Q + al256((size_t)RPAD * D * 2);
constexpr size_t WS_VT = WS_K + al256((size_t)RPAD * 256 * 2);
constexpr size_t VT_META = (size_t)NB * 256 * SEQ;
constexpr size_t WS_SSQ = WS_VT + al256((size_t)RPAD * 256 * 2);
constexpr size_t WS_LTOK = WS_SSQ + al256((size_t)RPAD * 32 * 4);
constexpr size_t WS_LGATE = WS_LTOK + al256((size_t)NEXP * RT * 4);
constexpr int HB_ROWS = 2 * RT + NEXP * 256;
constexpr size_t WS_HB = WS_LGATE + al256((size_t)NEXP * RT * 4);
constexpr size_t WS_YB = WS_HB + al256((size_t)HB_ROWS * DEXP * 2);
constexpr size_t TBL_K = 0, TBL_M = 16 * 1024, TBL_N = TBL_M + 64 * 1024, TBL_A16 = TBL_N + 64 * 1024, TBL_STRIDE = TBL_A16 + 512;
constexpr size_t WS_TBL = WS_YB + al256((size_t)RT * 2 * D * 2);
constexpr size_t WS_WGLU = WS_TBL + al256((size_t)2 * 64 * TBL_STRIDE);
constexpr size_t WS_WKVQ = WS_WGLU + (size_t)2 * 2048 * 1024 * 2;
constexpr size_t WS_WQ1 = WS_WKVQ + (size_t)1536 * 1024 * 2;
constexpr size_t WS_WO = WS_WQ1 + (size_t)1024 * 1024 * 2;
constexpr size_t WS_W1 = WS_WO + (size_t)2 * 1024 * 1024 * 2;
constexpr size_t WS_W2 = WS_W1 + (size_t)4 * 32 * 1024 * 1024 * 2;
constexpr size_t WS_RW = WS_W2 + (size_t)4 * 32 * 1024 * 512 * 2;
constexpr size_t WS_DUMH = WS_RW + (size_t)4 * 98304;
constexpr size_t WS_DUMSSQ = WS_DUMH + al256((size_t)RT * D * 4);
constexpr size_t WS_DUMLT = WS_DUMSSQ + al256((size_t)RT * 32 * 4);
constexpr size_t WS_DUMLG = WS_DUMLT + al256((size_t)NEXP * RT * 4);
#if defined(PROBE_TYPE)
constexpr size_t WS_END = WS_DUMLG + al256((size_t)NEXP * RT * 4);
#else
constexpr size_t WS_END = WS_DUMH;
#endif

struct Args {
    const float* in[29];
    float* out;
    unsigned char* ws;
    int ph_lo, ph_hi;
    int rep_type, rep_n;
};
typedef const __attribute__((address_space(4))) Args CArgs;

__device__ __forceinline__ unsigned cvt_pk_bf16(float lo, float hi) { unsigned r; asm volatile("v_cvt_pk_bf16_f32 %0, %1, %2" : "=v"(r) : "v"(lo), "v"(hi)); return r; }
__device__ __forceinline__ float bf16_lo(unsigned w) { return __uint_as_float(w << 16); }
__device__ __forceinline__ float bf16_hi(unsigned w) { return __uint_as_float(w & 0xffff0000u); }
__device__ __forceinline__ float fast_rcp(float x) { return __builtin_amdgcn_rcpf(x); }
__device__ __forceinline__ float fast_exp(float x) { return __builtin_amdgcn_exp2f(x * 1.4426950408889634f); }
__device__ __forceinline__ float sigmoidf_(float x) { return fast_rcp(1.0f + fast_exp(-x)); }
__device__ __forceinline__ float gelu_tanh(float x) { const float v = 0.7978845608028654f * (x + 0.044715f * x * x * x); return x * sigmoidf_(2.0f * v); }
__device__ __forceinline__ bf16x8 as_bf16x8(u32x4 v) { return __builtin_bit_cast(bf16x8, v); }
__device__ __forceinline__ f32x4 mfma16(bf16x8 a, bf16x8 b, f32x4 c) { return __builtin_amdgcn_mfma_f32_16x16x32_bf16(a, b, c, 0, 0, 0); }
__device__ __forceinline__ float xor32_sum(float v) { auto r = __builtin_amdgcn_permlane32_swap(__float_as_uint(v), __float_as_uint(v), false, false); return __uint_as_float(r[0]) + __uint_as_float(r[1]); }
__device__ __forceinline__ float xor16_sum(float v) { auto r = __builtin_amdgcn_permlane16_swap(__float_as_uint(v), __float_as_uint(v), false, false); return __uint_as_float(r[0]) + __uint_as_float(r[1]); }
__device__ __forceinline__ float xor32_max(float v) { auto r = __builtin_amdgcn_permlane32_swap(__float_as_uint(v), __float_as_uint(v), false, false); return fmaxf(__uint_as_float(r[0]), __uint_as_float(r[1])); }
__device__ __forceinline__ float xor16_max(float v) { auto r = __builtin_amdgcn_permlane16_swap(__float_as_uint(v), __float_as_uint(v), false, false); return fmaxf(__uint_as_float(r[0]), __uint_as_float(r[1])); }
__device__ __forceinline__ float quad_sum(float v) { return xor32_sum(xor16_sum(v)); }
template <int X> __device__ __forceinline__ float swz_xor(float v) { return __uint_as_float((unsigned)__builtin_amdgcn_ds_swizzle((int)__float_as_uint(v), (X << 10) | 0x1f)); }
__device__ __forceinline__ float wave_sum(float v) {
    v += swz_xor<1>(v); v += swz_xor<2>(v); v += swz_xor<4>(v); v += swz_xor<8>(v);
    return quad_sum(v);
}
__device__ __forceinline__ int opaque_bid() { int b = blockIdx.x; asm volatile("" : "+s"(b)); return b; }
__device__ __forceinline__ int opaque_tid() { int t = threadIdx.x; asm volatile("" : "+v"(t)); return t; }

#define XB_TMO      128
#define XB_XCNT(j)  (256  + 64 * (j))
#define XB_XSUB(j)  (1280 + 64 * (j))
#define XB_XGEN(j)  (2304 + 64 * (j))
#define XB_TOP      3328
#define XB_TOPGEN   3392
#define XCD_BAR_WORDS 3456
#define XB_SPIN_CAP (1u << 22)
__device__ __forceinline__ unsigned xb_ld(unsigned* p)              { return __hip_atomic_load(p, __ATOMIC_RELAXED, __HIP_MEMORY_SCOPE_AGENT); }
__device__ __forceinline__ unsigned xb_add(unsigned* p, unsigned v) { return __hip_atomic_fetch_add(p, v, __ATOMIC_RELAXED, __HIP_MEMORY_SCOPE_AGENT); }
__device__ __forceinline__ unsigned xb_xcc_id() { return (unsigned)__builtin_amdgcn_s_getreg((3 << 11) | 20) & 0xFu; }
#define XB_SPIN(cond, bar) do { unsigned _sp = 0; while (cond) { __builtin_amdgcn_s_sleep(1); \
    if ((++_sp & 255u) == 0u) { if (xb_ld(&(bar)[XB_TMO])) break; if (_sp > XB_SPIN_CAP) { atomicAdd(&(bar)[XB_TMO], 1u); break; } } } } while (0)
__device__ __forceinline__ void xcd_barrier_post(unsigned* bar) { if (threadIdx.x == 0) (void)xb_add(&bar[XB_XCNT(xb_xcc_id())], 1u); }
__device__ __forceinline__ void xcd_barrier_complete(unsigned* bar, unsigned x, unsigned& nloc, unsigned& nx) {
    const unsigned G = gridDim.x;
    unsigned sum, cnt, mine, sp = 0u;
    for (;;) {
        sum = 0u; cnt = 0u; mine = 0u;
#pragma unroll
        for (unsigned j = 0; j < 16; ++j) { const unsigned c = xb_ld(&bar[XB_XCNT(j)]); sum += c; cnt += (c > 0u) ? 1u : 0u; mine = (j == x) ? c : mine; }
        if (sum == G) break;
        __builtin_amdgcn_s_sleep(1);
        if ((++sp & 255u) == 0u) { if (xb_ld(&bar[XB_TMO])) break; if (sp > XB_SPIN_CAP) { atomicAdd(&bar[XB_TMO], 1u); break; } }
    }
    nloc = mine > 0u ? mine : 1u; nx = cnt > 0u ? cnt : 1u;
}
template <class BG>
__device__ __forceinline__ void xcd_barrier(unsigned* bar_, volatile LAS unsigned* st, BG& bg) {
    asm volatile("s_waitcnt vmcnt(0)" ::: "memory");
    __syncthreads();
    const unsigned flag0 = st[2];
    if (threadIdx.x >= 64) {
        while (st[2] == flag0) bg.step();
        bg.park();
    } else if (threadIdx.x == 0) {
        unsigned* bar = bar_; asm volatile("" : "+v"(bar));
        const unsigned bx = xb_xcc_id();
        __builtin_amdgcn_s_waitcnt(0);
        unsigned nloc = st[0], nx = st[1];
        if (nloc == 0u) { xcd_barrier_complete(bar, bx, nloc, nx); st[0] = nloc; st[1] = nx; }
        const unsigned old = xb_add(&bar[XB_XSUB(bx)], 1u);
        const unsigned gen = old / nloc;
        if (old + 1u == (gen + 1u) * nloc) {
            __builtin_amdgcn_fence(__ATOMIC_RELEASE, "agent");
            asm volatile("s_waitcnt vmcnt(0)" ::: "memory");
            const unsigned og = xb_add(&bar[XB_TOP], 1u);
            const unsigned tg = og / nx;
            if (og + 1u == (tg + 1u) * nx) xb_add(&bar[XB_TOPGEN], 1u);
            else XB_SPIN(xb_ld(&bar[XB_TOPGEN]) == tg, bar);
            __builtin_amdgcn_fence(__ATOMIC_ACQUIRE, "agent");
            xb_add(&bar[XB_XGEN(bx)], 1u);
            asm volatile("s_waitcnt vmcnt(0)" ::: "memory");
        } else {
            XB_SPIN(xb_ld(&bar[XB_XGEN(bx)]) == gen, bar);
            __builtin_amdgcn_fence(__ATOMIC_ACQUIRE, "agent");
            asm volatile("s_waitcnt vmcnt(0)" ::: "memory");
        }
        st[2] = flag0 + 1u;
    }
    __syncthreads();
}
constexpr int BM = 256, BK = 64, HALF = 128, HTB = HALF * BK * 2, STAGE_BYTES = 8 * HTB, NXCD = 8, WGM = 8;
constexpr int LDS_TABO = STAGE_BYTES;
constexpr int LDS_TABT = LDS_TABO + 3072;
constexpr int LDS_TABG = LDS_TABT + 3072;
constexpr int LDS_SH = LDS_TABG + 3072;
__host__ __device__ __forceinline__ int lds_byte(int r, int c) { const int st = (r >> 4) * 2 + (c >> 5), rr = r & 15, cc = c & 31, ob = rr * 64 + cc * 2; return st * 1024 + (ob ^ (((ob >> 9) & 1) << 5)); }
__host__ __device__ __forceinline__ void stage_rc(int b, int& R, int& C) { const int st = b / 1024, sb = b % 1024, swz = sb ^ (((sb >> 9) & 1) << 5); R = (st >> 1) * 16 + swz / 64; C = (st & 1) * 32 + (swz % 64) / 2; }
__host__ __device__ __forceinline__ int perm32(int rho) { const int n = rho >> 4, i = rho & 15; return 8 * (i >> 2) + 4 * n + (i & 3); }
struct Unit { int pm, pn, e, slot; };
__device__ __forceinline__ int xcd_chunk(int wgid, int nwg) { const int q = nwg / NXCD, r = nwg % NXCD, xcd = wgid % NXCD, off = wgid / NXCD; return (xcd < r ? xcd * (q + 1) : r * (q + 1) + (xcd - r) * q) + off; }

enum { EPI_GLU = 0, EPI_OPROJ, EPI_KVQ, EPI_MOE1, EPI_MOE2 };
struct GemmDesc {
    int kind, K, perm, gather, moe, skip_epi, stride, vb;
    int nM, nN, nwg, npn; const char* A; const char* Bt; size_t tstepA, tstepB, wstride; const int* cnt; const int* LTOK; const float* LGATE;
    const float* res32; const bf16_t* res16; bf16_t* Hout; float* SSQ; const float* bias; const float* bias2; bf16_t* O1; bf16_t* O2; bf16_t* O3; int jq, cbase;
};
__device__ __forceinline__ bool order_next(const GemmDesc& g, LAS unsigned char* lds, int i, Unit& u) {
    const int L = i * g.stride + g.vb; if (L >= g.nwg) return false;
    const int wgid = xcd_chunk(L, g.nwg);
    if (g.moe) {
        const LAS int* sh = (const LAS int*)(lds + LDS_SH);
        int e = 0;
        for (int q = 1; q < 32; ++q) if (wgid >= g.npn * sh[q]) e = q;
        const int nmt = sh[e + 1] - sh[e], local = wgid - g.npn * sh[e];
        u.pn = local / nmt; u.pm = sh[e] + (local - u.pn * nmt); u.e = e; u.slot = i % 3;
    } else {
        const int nig = WGM * g.nN, gid = wgid / nig, fm = gid * WGM, gsz = (g.nM - fm) < WGM ? (g.nM - fm) : WGM;
        u.pm = fm + ((wgid % nig) % gsz); u.pn = (wgid % nig) / gsz; u.e = 0; u.slot = 0;
    }
    return true;
}
__device__ __forceinline__ const char* order_a(const GemmDesc& g, const Unit& u) { return g.gather ? g.A : g.A + (size_t)u.pm * g.tstepA; }
__device__ __forceinline__ const char* order_b(const GemmDesc& g, const Unit& u) { return g.Bt + (size_t)u.e * g.wstride + (size_t)u.pn * g.tstepB; }
__device__ __forceinline__ void order_fill(const GemmDesc& g, LAS unsigned char* lds, const Unit& u) {
    const int t = opaque_tid();
    if (t < 256) {
        const LAS int* sh = (const LAS int*)(lds + LDS_SH);
        const int ne = g.cnt[u.e], idx = (u.pm - sh[u.e]) * 256 + t, ci = idx < ne ? idx : ne - 1;
        const int v = g.LTOK[(size_t)u.e * RT + ci];
        ((LAS unsigned*)(lds + LDS_TABO))[u.slot * 256 + t] = (unsigned)(v & 0x3fffffff) * (unsigned)(D * 2);
        ((LAS int*)(lds + LDS_TABT))[u.slot * 256 + t] = idx < ne ? v : -1;
        ((LAS float*)(lds + LDS_TABG))[u.slot * 256 + t] = g.LGATE[(size_t)u.e * RT + ci];
    }
}
__device__ __forceinline__ void gemm_epilogue(const GemmDesc& g, LAS unsigned char* lds, const f32x4 (&acc)[2][2][4][2], const Unit& u, int wr, int wc, int fr, int fq);

__device__ __forceinline__ void gemm_run(LAS unsigned char* lds, const GemmDesc& g) {
    const int tid = opaque_tid(), wid = __builtin_amdgcn_readfirstlane(tid >> 6), lane = tid & 63, wr = wid >> 2, wc = wid & 3, fr = lane & 15, fq = lane >> 4;
    const int K = g.K, nt = K / BK;
    unsigned voffA[2], voffB[2]; int Rr[2], Cc[2];
#pragma unroll
    for (int i = 0; i < 2; ++i) { int R, C; stage_rc(tid * 16 + i * 8192, R, C); const int Rb = g.perm ? ((R & ~31) + perm32(R & 31)) : R;
        voffA[i] = (unsigned)(R * K + C) * 2u; voffB[i] = (unsigned)(Rb * K + C) * 2u; Rr[i] = R * 4; Cc[i] = C * 2; }
    const size_t kstep = (size_t)(BK * 2);
    const size_t hstep = (size_t)HALF * K * 2;
    const unsigned ldsw = (unsigned)wid * 1024u;
    const int aoff = lds_byte(wr * 64 + fr, fq * 8), boff = lds_byte(wc * 32 + fr, fq * 8);
#define PG8_SA(b, h) (((b) * 2 + (h)) * HTB)
#define PG8_SB(b, h) ((4 + (b) * 2 + (h)) * HTB)
#define PG8_GLDS(src, dstoff) __builtin_amdgcn_global_load_lds((const unsigned*)(src), (LAS unsigned*)(lds + (dstoff)), 16, 0, 0)
#define PG8_STAGE_B(bufoff, gbase) do { _Pragma("unroll") for (int _i = 0; _i < 2; ++_i) PG8_GLDS((const char*)(gbase) + voffB[_i], (bufoff) + ldsw + _i * 8192); } while (0)
#define PG8_STAGE_A(bufoff, gbase, tsel, kt, h) do { if (g.gather) { \
            const unsigned _o0 = *(const LAS unsigned*)(lds + LDS_TABO + (tsel) * 1024 + (h) * 512 + Rr[0]), _o1 = *(const LAS unsigned*)(lds + LDS_TABO + (tsel) * 1024 + (h) * 512 + Rr[1]); \
            PG8_GLDS((const char*)(gbase) + (size_t)(kt) * kstep + _o0 + Cc[0], (bufoff) + ldsw); PG8_GLDS((const char*)(gbase) + (size_t)(kt) * kstep + _o1 + Cc[1], (bufoff) + ldsw + 8192); \
        } else { _Pragma("unroll") for (int _i = 0; _i < 2; ++_i) PG8_GLDS((const char*)(gbase) + (size_t)(kt) * kstep + (size_t)(h) * hstep + voffA[_i], (bufoff) + ldsw + _i * 8192); } } while (0)
#define PG8_LDA(dst, b, h) do { _Pragma("unroll") for (int m = 0; m < 4; ++m) _Pragma("unroll") for (int k = 0; k < 2; ++k) dst[m][k] = *(const LAS bf16x8*)(lds + PG8_SA(b, h) + aoff + m * 2048 + k * 1024); } while (0)
#define PG8_LDB(dst, b, h) do { _Pragma("unroll") for (int n = 0; n < 2; ++n) _Pragma("unroll") for (int k = 0; k < 2; ++k) dst[n][k] = *(const LAS bf16x8*)(lds + PG8_SB(b, h) + boff + n * 2048 + k * 1024); } while (0)
#define PG8_MMA(ai, bj, At, Bt) do { __builtin_amdgcn_s_setprio(1); _Pragma("unroll") for (int m = 0; m < 4; ++m) _Pragma("unroll") for (int n = 0; n < 2; ++n) _Pragma("unroll") for (int k = 0; k < 2; ++k) \
        acc[ai][bj][m][n] = __builtin_amdgcn_mfma_f32_16x16x32_bf16(Bt[n][k], At[m][k], acc[ai][bj][m][n], 0, 0, 0); __builtin_amdgcn_s_setprio(0); } while (0)
#define PG8_WAIT_V(n) asm volatile("s_waitcnt vmcnt(" #n ")" ::: "memory")
#define PG8_WAIT_L(n) asm volatile("s_waitcnt lgkmcnt(" #n ")" ::: "memory")
#define PG8_BAR __builtin_amdgcn_s_barrier()
#define PG8_SCHED __builtin_amdgcn_sched_barrier(0)
    Unit cur, nxt; int ui = 0;
    if (!order_next(g, lds, 0, cur)) return;
    f32x4 acc[2][2][4][2];
#pragma unroll
    for (int a = 0; a < 2; ++a)
#pragma unroll
        for (int b = 0; b < 2; ++b)
#pragma unroll
            for (int m = 0; m < 4; ++m)
#pragma unroll
                for (int n = 0; n < 2; ++n) acc[a][b][m][n] = (f32x4){0.f, 0.f, 0.f, 0.f};
    bf16x8 At[4][2], B0[2][2], B1[2][2];
    if (g.moe) { order_fill(g, lds, cur); __syncthreads(); }
    const char* cA = order_a(g, cur); const char* cB = order_b(g, cur); int cT = cur.slot;
    PG8_STAGE_B(PG8_SB(0, 0), cB); PG8_STAGE_B(PG8_SB(0, 1), cB + hstep); PG8_STAGE_A(PG8_SA(0, 0), cA, cT, 0, 0); PG8_STAGE_A(PG8_SA(0, 1), cA, cT, 0, 1);
    if (wr == 1) PG8_BAR;
    PG8_WAIT_V(2); PG8_BAR;
    PG8_STAGE_B(PG8_SB(1, 0), cB + kstep); PG8_STAGE_A(PG8_SA(1, 0), cA, cT, 1, 0); PG8_STAGE_B(PG8_SB(1, 1), cB + hstep + kstep);
    PG8_WAIT_V(6); PG8_BAR;
    for (;;) {
        const bool has_next = order_next(g, lds, ui + 1, nxt);
        if (g.moe && has_next) order_fill(g, lds, nxt);
        const char* nA = has_next ? order_a(g, nxt) : cA; const char* nB = has_next ? order_b(g, nxt) : cB; const int nT = has_next ? nxt.slot : cT;
        for (int t = 0; t < nt; t += 2) {
            const bool last = (t == nt - 2);
            const char* a2b = last ? nA : cA; const int a2T = last ? nT : cT, a2k = last ? 0 : t + 2, a3k = a2k + 1;
            const char* b2 = last ? nB : cB + (size_t)(t + 2) * kstep; const char* b3 = b2 + kstep;
            PG8_LDB(B0, 0, 0); PG8_LDB(B1, 0, 1); PG8_SCHED; PG8_LDA(At, 0, 0); PG8_STAGE_A(PG8_SA(1, 1), cA, cT, t + 1, 1);
            PG8_WAIT_V(8); PG8_WAIT_L(0); PG8_BAR; PG8_MMA(0, 0, At, B0); PG8_MMA(0, 1, At, B1); PG8_BAR; PG8_SCHED;
            PG8_LDA(At, 0, 1); PG8_STAGE_B(PG8_SB(0, 0), b2); PG8_STAGE_B(PG8_SB(0, 1), b2 + hstep); PG8_STAGE_A(PG8_SA(0, 0), a2b, a2T, a2k, 0);
            PG8_WAIT_V(8); PG8_WAIT_L(0); PG8_BAR; PG8_MMA(1, 0, At, B0); PG8_MMA(1, 1, At, B1); PG8_BAR; PG8_SCHED;
            PG8_LDB(B0, 1, 0); PG8_LDB(B1, 1, 1); PG8_SCHED; PG8_LDA(At, 1, 0); PG8_STAGE_A(PG8_SA(0, 1), a2b, a2T, a2k, 1);
            PG8_WAIT_V(8); PG8_WAIT_L(0); PG8_BAR; PG8_MMA(0, 0, At, B0); PG8_MMA(0, 1, At, B1); PG8_BAR; PG8_SCHED;
            PG8_LDA(At, 1, 1); PG8_STAGE_B(PG8_SB(1, 0), b3); PG8_STAGE_B(PG8_SB(1, 1), b3 + hstep); PG8_STAGE_A(PG8_SA(1, 0), a2b, a2T, a3k, 0);
            PG8_WAIT_V(8); PG8_WAIT_L(0); PG8_BAR; PG8_MMA(1, 0, At, B0); PG8_MMA(1, 1, At, B1); PG8_BAR; PG8_SCHED;
        }
        if (wr == 0) PG8_BAR;
        if (!g.skip_epi) gemm_epilogue(g, lds, acc, cur, wr, wc, fr, fq);
        if (!has_next) break;
#pragma unroll
        for (int a = 0; a < 2; ++a)
#pragma unroll
            for (int b = 0; b < 2; ++b)
#pragma unroll
                for (int m = 0; m < 4; ++m)
#pragma unroll
                    for (int n = 0; n < 2; ++n) acc[a][b][m][n] = (f32x4){0.f, 0.f, 0.f, 0.f};
        cur = nxt; cA = nA; cB = nB; cT = nT; ++ui;
        if (wr == 1) PG8_BAR;
    }
    PG8_WAIT_V(0);
    PG8_BAR;
#undef PG8_SA
#undef PG8_SB
#undef PG8_GLDS
#undef PG8_STAGE_A
#undef PG8_STAGE_B
#undef PG8_LDA
#undef PG8_LDB
#undef PG8_MMA
#undef PG8_WAIT_V
#undef PG8_WAIT_L
#undef PG8_BAR
#undef PG8_SCHED
}
__device__ __forceinline__ f32x4 meta_dot(const bf16_t* Am, const bf16_t* Brow0, int K, int fr, int fq) {
    f32x4 acc = {0.f, 0.f, 0.f, 0.f};
    const bf16_t* ap = Am + (size_t)fr * K + 8 * fq; const bf16_t* bp = Brow0 + (size_t)fr * K + 8 * fq;
#pragma unroll 4
    for (int ks = 0; ks < K / 32; ++ks) acc = mfma16(as_bf16x8(*(const u32x4*)(bp + 32 * ks)), as_bf16x8(*(const u32x4*)(ap + 32 * ks)), acc);
    return acc;
}

struct ConvDesc { const float* src; const float* gain; bf16_t* dst; int ld, K, mode, kblk, nblk; };
constexpr int NWT_E = 768;
constexpr int NWT_MOE = 4 * 32 * NWT_E, NWT_DENSE = 2 * 1024 + 256 + 2 * 512 + 2 * 512;
__device__ __forceinline__ ConvDesc conv_decode(CArgs& a, int ti) {
    ConvDesc d;
    if (ti < NWT_MOE) {
        const int le = ti / NWT_E, r = ti % NWT_E, which = r >> 8, tt = r & 255, layer = le >> 5;
        if (which < 2) { d.src = a.in[26 + which] + (size_t)le * D * DEXP; d.ld = DEXP; d.K = D; d.gain = a.in[3] + (size_t)layer * D; d.dst = (bf16_t*)(a.ws + WS_W1) + (size_t)le * 1024 * 1024; d.mode = 1 + which; d.nblk = tt & 15; d.kblk = tt >> 4; }
        else { d.src = a.in[28] + (size_t)le * DEXP * D; d.ld = D; d.K = DEXP; d.gain = nullptr; d.dst = (bf16_t*)(a.ws + WS_W2) + (size_t)le * 1024 * 512; d.mode = 0; d.nblk = tt & 31; d.kblk = tt >> 5; }
    } else {
        int r = ti - NWT_MOE;
        if (r < 2048) { const int layer = r >> 10, tt = r & 1023, nb = tt & 63, half = nb >> 5;
            d.src = a.in[14] + (size_t)layer * D * 2 * D + half * D; d.ld = 2 * D; d.K = D; d.gain = nullptr; d.dst = (bf16_t*)(a.ws + WS_WGLU) + (size_t)layer * 2048 * 1024; d.mode = 1 + half; d.nblk = nb & 31; d.kblk = tt >> 6; }
        else if ((r -= 2048) < 256) { d.src = a.in[15]; d.ld = 512; d.K = D; d.gain = a.in[4]; d.dst = (bf16_t*)(a.ws + WS_WKVQ); d.mode = 0; d.nblk = r & 15; d.kblk = r >> 4; }
        else if ((r -= 256) < 1024) { const int j = r >> 9, tt = r & 511;
            d.src = a.in[17] + (size_t)j * D * D; d.ld = D; d.K = D; d.gain = a.in[2] + (size_t)(2 + j) * D; d.dst = j == 0 ? (bf16_t*)(a.ws + WS_WKVQ) + (size_t)512 * 1024 : (bf16_t*)(a.ws + WS_WQ1); d.mode = 0; d.nblk = tt & 31; d.kblk = tt >> 5; }
        else { r -= 1024; const int j = r >> 9, tt = r & 511;
            d.src = a.in[20] + (size_t)j * D * D; d.ld = D; d.K = D; d.gain = nullptr; d.dst = (bf16_t*)(a.ws + WS_WO) + (size_t)j * 1024 * 1024; d.mode = 0; d.nblk = tt & 31; d.kblk = tt >> 5; }
    }
    return d;
}
__device__ __forceinline__ void conv_load(const ConvDesc& d, int lane, f32x4 (&v)[8]) {
    const float* p = d.src + (size_t)(d.kblk * 64 + 8 * (lane >> 3)) * d.ld + d.nblk * 32 + 4 * (lane & 7);
#pragma unroll
    for (int j = 0; j < 8; ++j) v[j] = __builtin_nontemporal_load((const f32x4*)(p + (size_t)j * d.ld));
}
__device__ __forceinline__ void conv_store(const ConvDesc& d, int lane, f32x4 (&v)[8]) {
    const int k0 = d.kblk * 64 + 8 * (lane >> 3);
    if (d.gain) { const f32x4 g0 = *(const f32x4*)(d.gain + k0), g1 = *(const f32x4*)(d.gain + k0 + 4);
        v[0] *= g0[0]; v[1] *= g0[1]; v[2] *= g0[2]; v[3] *= g0[3]; v[4] *= g1[0]; v[5] *= g1[1]; v[6] *= g1[2]; v[7] *= g1[3]; }
    const int n = d.nblk * 32 + 4 * (lane & 7), row = d.mode == 0 ? n : (256 * (n >> 7) + (n & 127) + (d.mode == 2 ? 128 : 0));
    bf16_t* q = d.dst + (size_t)row * d.K + k0;
#pragma unroll
    for (int c = 0; c < 4; ++c) {
        u32x4 w; w.x = cvt_pk_bf16(v[0][c], v[1][c]); w.y = cvt_pk_bf16(v[2][c], v[3][c]); w.z = cvt_pk_bf16(v[4][c], v[5][c]); w.w = cvt_pk_bf16(v[6][c], v[7][c]);
        asm volatile("global_store_dwordx4 %0, %1, off sc1\n\ts_nop 1" :: "v"(q + (size_t)c * d.K), "v"(w) : "memory");
    }
}
__device__ __forceinline__ void convert_weights(CArgs& a) {
    const int lane = opaque_tid() & 63, gw = (opaque_tid() >> 6) * GRID + opaque_bid();
    for (int ti = NWT_MOE + gw; ti < NWT_MOE + NWT_DENSE; ti += GRID * 8) {
        const ConvDesc d = conv_decode(a, ti); f32x4 v[8];
        conv_load(d, lane, v); conv_store(d, lane, v);
    }
}
struct BgConv {
    CArgs* a; volatile LAS unsigned* st;
    __device__ __forceinline__ int claim() const {
        int t = 0;
        if ((opaque_tid() & 63) == 0) { const unsigned x = xb_xcc_id() & 7u; t = (int)(xb_add((unsigned*)(a->ws + WS_CTL) + CW_BGC + 64 * x, 1u) * 16u + x); }
        return __builtin_amdgcn_readfirstlane(t);
    }
    __device__ __forceinline__ void run(int t) const { const int lane = opaque_tid() & 63; const ConvDesc d = conv_decode(*a, t); f32x4 v[8]; conv_load(d, lane, v); conv_store(d, lane, v); }
    __device__ __forceinline__ int claim_run() {
        const int t = claim();
        if (t < NWT_MOE) run(t);
        if (t + 8 < NWT_MOE) run(t + 8); else if ((opaque_tid() & 63) == 0) st[3] = 1u;
        return t + 8;
    }
    __device__ __forceinline__ void step() { if (st[3] == 0u) (void)claim_run(); else __builtin_amdgcn_s_sleep(32); }
    __device__ __forceinline__ void park() {}
    __device__ __forceinline__ void run_until(int limit, int budget) {
        for (int n = 0; n < budget; ++n) { if (st[3] != 0u) break; if (claim_run() >= limit) break; }
    }
};

struct cplx { float re, im; };
__device__ __forceinline__ cplx cmul(cplx a, cplx b) { return {a.re * b.re - a.im * b.im, a.re * b.im + a.im * b.re}; }

__device__ __forceinline__ void s5_tables(CArgs& a, int layer, int g, LAS unsigned char* lds) {
    LAS f32x2* pw = (LAS f32x2*)lds;
    LAS f32x2* bb = (LAS f32x2*)(lds + 64 * 17 * 8);
    LAS f32x2* cc = bb + 64 * 16;
    const int tid = opaque_tid();
    const float* a_re = a.in[6] + ((size_t)layer * 64 + g) * 64; const float* a_im = a.in[7] + ((size_t)layer * 64 + g) * 64;
    const float dt = expf(a.in[8][layer * 64 + g]);
    for (int idx = tid; idx < 64 * 17; idx += NTHREADS) {
        const int p = idx / 17, d = idx % 17;
        const float mag = expf(a_re[p] * dt * (float)d), ang = a_im[p] * dt * (float)d;
        float s, c; sincosf(ang, &s, &c);
        pw[idx] = (f32x2){mag * c, mag * s};
    }
    const float* b_re = a.in[9] + ((size_t)layer * 64 + g) * 1024; const float* b_im = a.in[10] + ((size_t)layer * 64 + g) * 1024;
    const float* c_re = a.in[11] + ((size_t)layer * 64 + g) * 1024; const float* c_im = a.in[12] + ((size_t)layer * 64 + g) * 1024;
    for (int idx = tid; idx < 1024; idx += NTHREADS) {
        const int p = idx >> 4;
        const float lr = a_re[p], li = a_im[p];
        const float mag = expf(lr * dt), ang = li * dt; float s, c; sincosf(ang, &s, &c);
        const float nr = mag * c - 1.0f, ni = mag * s;
        const float den = 1.0f / (lr * lr + li * li);
        const cplx f = {(nr * lr + ni * li) * den, (ni * lr - nr * li) * den};
        const cplx r = cmul(f, (cplx){b_re[idx], b_im[idx]});
        bb[idx] = (f32x2){r.re, r.im};
        cc[idx] = (f32x2){c_re[idx], c_im[idx]};
    }
    __syncthreads();
    unsigned char* tbl = a.ws + WS_TBL + ((size_t)layer * 64 + g) * TBL_STRIDE;
    for (int idx = tid; idx < 16 * 64; idx += NTHREADS) {
        const int delta = idx >> 6, l = idx & 63, c1 = l & 15, q4 = l >> 4, d = delta - (q4 >> 1);
        float v[8];
#pragma unroll
        for (int j = 0; j < 8; ++j) v[j] = 0.f;
        if (d >= 0) {
            for (int p = 0; p < 64; ++p) {
                const f32x2 cw = cc[c1 * 64 + p], pp = pw[p * 17 + d];
                const cplx t = cmul((cplx){cw.x, cw.y}, (cplx){pp.x, pp.y});
#pragma unroll
                for (int j = 0; j < 8; ++j) { const f32x2 bw = bb[p * 16 + 8 * (q4 & 1) + j]; v[j] += t.re * bw.x - t.im * bw.y; }
            }
        }
        u32x4 w; w.x = cvt_pk_bf16(v[0], v[1]); w.y = cvt_pk_bf16(v[2], v[3]); w.z = cvt_pk_bf16(v[4], v[5]); w.w = cvt_pk_bf16(v[6], v[7]);
        *(u32x4*)(tbl + TBL_K + (size_t)idx * 16) = w;
    }
    for (int idx = tid; idx < 64 * 64; idx += NTHREADS) {
        const int f = idx >> 6, l = idx & 63, rt = f >> 3, ks = f & 7, q4 = l >> 4, rho = 16 * rt + (l & 15), p = rho & 63, im = rho >> 6;
        const int k0 = 32 * ks + 8 * q4, jpos = k0 >> 4, c20 = k0 & 15;
        const f32x2 pp = pw[p * 17 + (15 - jpos)];
        float v[8];
#pragma unroll
        for (int j = 0; j < 8; ++j) { const f32x2 bw = bb[p * 16 + c20 + j]; const cplx t = cmul((cplx){pp.x, pp.y}, (cplx){bw.x, bw.y}); v[j] = im ? t.im : t.re; }
        u32x4 w; w.x = cvt_pk_bf16(v[0], v[1]); w.y = cvt_pk_bf16(v[2], v[3]); w.z = cvt_pk_bf16(v[4], v[5]); w.w = cvt_pk_bf16(v[6], v[7]);
        *(u32x4*)(tbl + TBL_M + (size_t)idx * 16) = w;
    }
    for (int idx = tid; idx < 64 * 64; idx += NTHREADS) {
        const int f = idx >> 6, l = idx & 63, i = f >> 2, ks = f & 3, q4 = l >> 4, c1 = l & 15;
        const int s0 = 32 * ks + 8 * q4;
        float v[8];
#pragma unroll
        for (int j = 0; j < 8; ++j) { const int sg = s0 + j, p = sg & 63; const f32x2 cw = cc[c1 * 64 + p], pp = pw[p * 17 + i + 1];
            const cplx t = cmul((cplx){cw.x, cw.y}, (cplx){pp.x, pp.y}); v[j] = (sg >> 6) ? -t.im : t.re; }
        u32x4 w; w.x = cvt_pk_bf16(v[0], v[1]); w.y = cvt_pk_bf16(v[2], v[3]); w.z = cvt_pk_bf16(v[4], v[5]); w.w = cvt_pk_bf16(v[6], v[7]);
        *(u32x4*)(tbl + TBL_N + (size_t)idx * 16) = w;
    }
    if (tid < 64) *(f32x2*)(tbl + TBL_A16 + tid * 8) = pw[tid * 17 + 16];
    __syncthreads();
}

__device__ __forceinline__ void row_norm_store(const f32x4 (&v)[4], float ssq, int lane, const float* g0, bf16_t* o0) {
    const float rstd = 1.0f / sqrtf(ssq * (1.0f / D) + RMS_EPS);
#pragma unroll
    for (int j = 0; j < 4; ++j) {
        const int c = 4 * lane + 256 * j;
        f32x4 g = {1.f, 1.f, 1.f, 1.f}; if (g0) g = *(const f32x4*)(g0 + c);
        u32x2 w; w.x = cvt_pk_bf16(v[j][0] * rstd * g[0], v[j][1] * rstd * g[1]); w.y = cvt_pk_bf16(v[j][2] * rstd * g[2], v[j][3] * rstd * g[3]);
        *(u32x2*)(o0 + c) = w;
    }
}
__device__ __forceinline__ void phase_prep(CArgs& a, LAS unsigned char* lds) {
    if (opaque_bid() < 128) s5_tables(a, opaque_bid() >> 6, opaque_bid() & 63, lds);
    else if (opaque_bid() < 128 + 48) {
        const int item = (opaque_bid() - 128) * NTHREADS + opaque_tid(), layer = item / 6144, idx = item % 6144;
        const float* wg = a.in[22] + (size_t)layer * D * NGRP; const float* we = a.in[24] + (size_t)layer * D * NEXP; const float* gain = a.in[3] + (size_t)layer * D;
        const int l = idx & 63, ks = (idx >> 6) & 31, rt = idx >> 11, o = 16 * rt + (l & 15), k0 = 32 * ks + 8 * (l >> 4);
        float v[8];
#pragma unroll
        for (int jq = 0; jq < 8; ++jq) v[jq] = (o < 4 ? wg[(size_t)(k0 + jq) * NGRP + o] : (o < 36 ? we[(size_t)(k0 + jq) * NEXP + (o - 4)] : 0.f)) * gain[k0 + jq];
        u32x4 w; w.x = cvt_pk_bf16(v[0], v[1]); w.y = cvt_pk_bf16(v[2], v[3]); w.z = cvt_pk_bf16(v[4], v[5]); w.w = cvt_pk_bf16(v[6], v[7]);
        *(u32x4*)(a.ws + WS_RW + (size_t)layer * 98304 + (size_t)idx * 16) = w;
    }
    convert_weights(a);
    const int lane = opaque_tid() & 63, gw = opaque_bid() * 8 + (opaque_tid() >> 6);
    bf16_t* U = (bf16_t*)(a.ws + WS_U);
    for (int row = gw; row < RT; row += GRID * 8) {
        const float* src = row < NREAL ? a.in[0] + (size_t)row * D : a.in[1] + (size_t)(row - NREAL) * D;
        f32x4 v[4]; float ssq = 0.f;
#pragma unroll
        for (int j = 0; j < 4; ++j) { v[j] = *(const f32x4*)(src + 4 * lane + 256 * j); ssq += v[j][0] * v[j][0] + v[j][1] * v[j][1] + v[j][2] * v[j][2] + v[j][3] * v[j][3]; }
        ssq = wave_sum(ssq);
        row_norm_store(v, ssq, lane, a.in[2], U + (size_t)row * D);
    }
}

constexpr int S5_CH = 528;
constexpr int S5_NCH = 129, S5_NCHP = 144;
__device__ __forceinline__ void phase_s5(CArgs& a, int layer, LAS unsigned char* lds) {
    LAS unsigned char* Ul = lds; LAS unsigned char* Sl = lds + S5_NCHP * S5_CH;
    const int tid = opaque_tid(), lane = tid & 63, w = __builtin_amdgcn_readfirstlane(tid >> 6), tc = lane & 15, q4 = lane >> 4;
    const bf16_t* U = (const bf16_t*)(a.ws + WS_U); bf16_t* Z = (bf16_t*)(a.ws + WS_Z);
    for (int ui = 0; ui < 2; ++ui) {
        const int unit = opaque_bid() * 2 + ui, b = unit >> 6, g = unit & 63;
        const unsigned char* tbl = a.ws + WS_TBL + ((size_t)layer * 64 + g) * TBL_STRIDE;
        for (int idx = tid; idx < LT * 2; idx += NTHREADS) {
            const int tok = idx >> 1, half = idx & 1;
            const u32x4 v = *(const u32x4*)(U + (size_t)row_of(b, tok) * D + 16 * g + 8 * half);
            *(LAS u32x4*)(Ul + (tok >> 4) * S5_CH + (tok & 15) * 32 + half * 16) = v;
        }
        __syncthreads();
        {
            bf16x8 mf[8];
#pragma unroll
            for (int ks = 0; ks < 8; ++ks) mf[ks] = as_bf16x8(*(const u32x4*)(tbl + TBL_M + ((size_t)(w * 8 + ks) * 64 + lane) * 16));
#pragma unroll 1
            for (int cg = 0; cg < 9; ++cg) {
                const int n = 16 * cg + tc;
                f32x4 acc = {0.f, 0.f, 0.f, 0.f};
#pragma unroll
                for (int ks = 0; ks < 8; ++ks) { const bf16x8 ub = *(LAS bf16x8*)(Ul + n * S5_CH + ks * 64 + q4 * 16); acc = mfma16(mf[ks], ub, acc); }
                *(LAS f32x4*)(Sl + n * S5_CH + (16 * w + 4 * q4) * 4) = acc;
            }
        }
        __syncthreads();
        if (w == 0) {
            const f32x2 a16 = *(const f32x2*)(tbl + TBL_A16 + lane * 8);
            float sr = 0.f, si = 0.f;
#pragma unroll 1
            for (int nb = 0; nb < 17; ++nb) {
                float xr[8], xi[8];
#pragma unroll
                for (int j = 0; j < 8; ++j) { xr[j] = *(LAS float*)(Sl + (nb * 8 + j) * S5_CH + lane * 4); xi[j] = *(LAS float*)(Sl + (nb * 8 + j) * S5_CH + 256 + lane * 4); }
                asm volatile("s_waitcnt lgkmcnt(0)" ::: "memory");
#pragma unroll
                for (int j = 0; j < 8; ++j) {
                    const unsigned pr = cvt_pk_bf16(sr, si);
                    *(LAS unsigned short*)(Sl + (nb * 8 + j) * S5_CH + lane * 2) = (unsigned short)(pr & 0xffffu);
                    *(LAS unsigned short*)(Sl + (nb * 8 + j) * S5_CH + 128 + lane * 2) = (unsigned short)(pr >> 16);
                    const float nr = a16.x * sr - a16.y * si + xr[j], ni = a16.x * si + a16.y * sr + xi[j];
                    sr = nr; si = ni;
                }
                asm volatile("" ::: "memory");
            }
        }
        __syncthreads();
        {
            const int i0 = w, i1 = 15 - w;
            bf16x8 kf0[8], kf1[8], nf0[4], nf1[4];
#pragma unroll
            for (int jj = 0; jj < 8; ++jj) {
                const int d0 = i0 - 2 * jj, d1 = i1 - 2 * jj;
                kf0[jj] = as_bf16x8(*(const u32x4*)(tbl + TBL_K + ((size_t)(d0 >= 0 ? d0 : 0) * 64 + lane) * 16));
                kf1[jj] = as_bf16x8(*(const u32x4*)(tbl + TBL_K + ((size_t)(d1 >= 0 ? d1 : 0) * 64 + lane) * 16));
            }
#pragma unroll
            for (int ks = 0; ks < 4; ++ks) {
                nf0[ks] = as_bf16x8(*(const u32x4*)(tbl + TBL_N + ((size_t)(i0 * 4 + ks) * 64 + lane) * 16));
                nf1[ks] = as_bf16x8(*(const u32x4*)(tbl + TBL_N + ((size_t)(i1 * 4 + ks) * 64 + lane) * 16));
            }
            const f32x4 dsk = *(const f32x4*)(a.in[13] + (size_t)layer * D + 16 * g + 4 * q4);
#pragma unroll 1
            for (int cg = 0; cg < 9; ++cg) {
                const int n = 16 * cg + tc;
                f32x4 acc0 = {0.f, 0.f, 0.f, 0.f}, acc1 = {0.f, 0.f, 0.f, 0.f};
#pragma unroll
                for (int jj = 0; jj < 8; ++jj) {
                    const bf16x8 ub = *(LAS bf16x8*)(Ul + n * S5_CH + jj * 64 + q4 * 16);
                    if (2 * jj <= i0) acc0 = mfma16(kf0[jj], ub, acc0);
                    if (2 * jj <= i1) acc1 = mfma16(kf1[jj], ub, acc1);
                }
#pragma unroll
                for (int ks = 0; ks < 4; ++ks) {
                    const bf16x8 sb = *(LAS bf16x8*)(Sl + n * S5_CH + ks * 64 + q4 * 16);
                    acc0 = mfma16(nf0[ks], sb, acc0); acc1 = mfma16(nf1[ks], sb, acc1);
                }
                if (n < S5_NCH && (n > 0 || b == 0)) {
#pragma unroll
                    for (int h = 0; h < 2; ++h) {
                        const int i = h ? i1 : i0; const f32x4 y = h ? acc1 : acc0;
                        const u32x2 uw = *(LAS u32x2*)(Ul + n * S5_CH + i * 32 + q4 * 8);
                        const float z0 = gelu_tanh(y[0] + dsk[0] * bf16_lo(uw.x)), z1 = gelu_tanh(y[1] + dsk[1] * bf16_hi(uw.x));
                        const float z2 = gelu_tanh(y[2] + dsk[2] * bf16_lo(uw.y)), z3 = gelu_tanh(y[3] + dsk[3] * bf16_hi(uw.y));
                        u32x2 o; o.x = cvt_pk_bf16(z0, z1); o.y = cvt_pk_bf16(z2, z3);
                        *(u32x2*)(Z + (size_t)row_of(b, 16 * n + i) * D + 16 * g + 4 * q4) = o;
                    }
                }
            }
        }
        __syncthreads();
    }
}

__device__ __forceinline__ float ssq4(f32x4 h) { return h[0] * h[0] + h[1] * h[1] + h[2] * h[2] + h[3] * h[3]; }
__device__ __forceinline__ int gwave() { return opaque_bid() * 8 + (opaque_tid() >> 6); }
template <int NACC> __device__ __forceinline__ bool meta_block(LAS unsigned char* lds, const bf16_t* Am, const bf16_t* const (&brow)[NACC], int K, f32x4 (&out)[NACC]) {
    const int tid = opaque_tid(), lane = tid & 63, wid = tid >> 6, fr = lane & 15, fq = lane >> 4, ksl = K / 8;
#pragma unroll
    for (int i = 0; i < NACC; ++i) {
        f32x4 acc = {0.f, 0.f, 0.f, 0.f};
        const bf16_t* ap = Am + (size_t)fr * K + wid * ksl + 8 * fq; const bf16_t* bp = brow[i] + (size_t)fr * K + wid * ksl + 8 * fq;
        for (int ks = 0; ks < ksl / 32; ++ks) acc = mfma16(as_bf16x8(*(const u32x4*)(bp + 32 * ks)), as_bf16x8(*(const u32x4*)(ap + 32 * ks)), acc);
        ((LAS f32x4*)lds)[(wid * NACC + i) * 64 + lane] = acc;
    }
    __syncthreads();
    if (wid == 0) {
#pragma unroll
        for (int i = 0; i < NACC; ++i) { f32x4 s = {0.f, 0.f, 0.f, 0.f};
#pragma unroll
            for (int w = 0; w < 8; ++w) s += ((LAS f32x4*)lds)[(w * NACC + i) * 64 + lane];
            out[i] = s; }
    }
    __syncthreads();
    return wid == 0;
}

__device__ __forceinline__ void load_res8(const GemmDesc& g, size_t off, float (&h)[8]) {
    if (g.res32) { const f32x4 a = *(const f32x4*)(g.res32 + off), b = *(const f32x4*)(g.res32 + off + 4); h[0] = a[0]; h[1] = a[1]; h[2] = a[2]; h[3] = a[3]; h[4] = b[0]; h[5] = b[1]; h[6] = b[2]; h[7] = b[3]; }
    else { const u32x4 w = *(const u32x4*)(g.res16 + off); h[0] = bf16_lo(w.x); h[1] = bf16_hi(w.x); h[2] = bf16_lo(w.y); h[3] = bf16_hi(w.y); h[4] = bf16_lo(w.z); h[5] = bf16_hi(w.z); h[6] = bf16_lo(w.w); h[7] = bf16_hi(w.w); }
}
__device__ __forceinline__ float store_h8(bf16_t* Hout, size_t off, const float (&h)[8]) {
    u32x4 w; w.x = cvt_pk_bf16(h[0], h[1]); w.y = cvt_pk_bf16(h[2], h[3]); w.z = cvt_pk_bf16(h[4], h[5]); w.w = cvt_pk_bf16(h[6], h[7]);
    *(u32x4*)(Hout + off) = w;
    return (h[0] * h[0] + h[1] * h[1]) + (h[2] * h[2] + h[3] * h[3]) + (h[4] * h[4] + h[5] * h[5]) + (h[6] * h[6] + h[7] * h[7]);
}
__device__ __forceinline__ void epi_glu(const GemmDesc& g, const f32x4 (&acc)[2][2][4][2], const Unit& u, int wr, int wc, int fr, int fq) {
#pragma unroll
    for (int ai = 0; ai < 2; ++ai) {
        const int row0 = u.pm * BM + ai * HALF + wr * 64 + fr; const size_t off0 = (size_t)row0 * D + u.pn * 128 + wc * 32 + 8 * fq;
        float h[4][8];
#pragma unroll
        for (int m = 0; m < 4; ++m) load_res8(g, off0 + (size_t)m * 16 * D, h[m]);
#pragma unroll
        for (int m = 0; m < 4; ++m) {
#pragma unroll
            for (int n = 0; n < 2; ++n) { const f32x4 v = acc[ai][0][m][n], gt = acc[ai][1][m][n];
                h[m][4 * n + 0] += v[0] * sigmoidf_(gt[0]); h[m][4 * n + 1] += v[1] * sigmoidf_(gt[1]); h[m][4 * n + 2] += v[2] * sigmoidf_(gt[2]); h[m][4 * n + 3] += v[3] * sigmoidf_(gt[3]); }
            float ss = store_h8(g.Hout, off0 + (size_t)m * 16 * D, h[m]);
            ss = quad_sum(ss);
            if (fq == 0) g.SSQ[(size_t)(row0 + 16 * m) * 32 + u.pn * 4 + wc] = ss;
        }
        asm volatile("" ::: "memory");
    }
}
__device__ __forceinline__ void phase_glu(CArgs& a, int layer, bool dry, LAS unsigned char* lds, GemmDesc& g) {
    const bf16_t* Zb = (const bf16_t*)(a.ws + WS_Z); const bf16_t* W = (const bf16_t*)(a.ws + WS_WGLU) + (size_t)layer * 2048 * 1024;
    g.res32 = layer == 0 ? a.in[0] : nullptr; g.res16 = (const bf16_t*)(a.ws + WS_H); g.Hout = (bf16_t*)(a.ws + (dry ? WS_DUMH : WS_H)); g.SSQ = (float*)(a.ws + (dry ? WS_DUMSSQ : WS_SSQ));
    if (opaque_bid() < 32) {
        const int lane = opaque_tid() & 63, fr = lane & 15, fq = lane >> 4, task = opaque_bid();
        const int c0 = 32 * task, rv = 256 * (c0 >> 7) + (c0 & 127);
        const bf16_t* const br[4] = {W + (size_t)rv * D, W + (size_t)(rv + 16) * D, W + (size_t)(rv + 128) * D, W + (size_t)(rv + 144) * D};
        f32x4 o[4];
        if (meta_block<4>(lds, Zb + (size_t)NREAL * D, br, D, o)) {
            float ss = 0.f;
#pragma unroll
            for (int n = 0; n < 2; ++n) {
                const f32x4 v = o[n], gt = o[2 + n]; const int c = c0 + 16 * n + 4 * fq;
                f32x4 h;
                if (layer == 0) h = *(const f32x4*)(a.in[1] + (size_t)fr * D + c);
                else { const u32x2 w = *(const u32x2*)(g.res16 + (size_t)(NREAL + fr) * D + c); h = (f32x4){bf16_lo(w.x), bf16_hi(w.x), bf16_lo(w.y), bf16_hi(w.y)}; }
                h[0] += v[0] * sigmoidf_(gt[0]); h[1] += v[1] * sigmoidf_(gt[1]); h[2] += v[2] * sigmoidf_(gt[2]); h[3] += v[3] * sigmoidf_(gt[3]);
                u32x2 w2; w2.x = cvt_pk_bf16(h[0], h[1]); w2.y = cvt_pk_bf16(h[2], h[3]); *(u32x2*)(g.Hout + (size_t)(NREAL + fr) * D + c) = w2; ss += ssq4(h);
            }
            ss = quad_sum(ss);
            if (fq == 0) g.SSQ[(size_t)(NREAL + fr) * 32 + task] = ss;
        }
    }
    g.stride = GRID; g.vb = opaque_bid(); g.kind = EPI_GLU; g.K = D; g.perm = 1; g.gather = 0; g.moe = 0; g.nM = NREAL / BM; g.nN = 2048 / BM; g.nwg = g.nM * g.nN; g.A = (const char*)Zb; g.Bt = (const char*)W;
    g.tstepA = g.tstepB = (size_t)BM * D * 2; g.wstride = 0;
}

__device__ __forceinline__ void epi_oproj(const GemmDesc& g, const f32x4 (&acc)[2][2][4][2], const Unit& u, int wr, int wc, int fr, int fq) {
#pragma unroll
    for (int ai = 0; ai < 2; ++ai)
#pragma unroll
        for (int bj = 0; bj < 2; ++bj) {
            const int row0 = u.pm * BM + ai * HALF + wr * 64 + fr, c0 = u.pn * BM + bj * HALF + wc * 32 + 8 * fq; const size_t off0 = (size_t)row0 * D + c0;
            const f32x4 b0 = *(const f32x4*)(g.bias + c0), b1 = *(const f32x4*)(g.bias + c0 + 4);
            float h[4][8];
#pragma unroll
            for (int m = 0; m < 4; ++m) load_res8(g, off0 + (size_t)m * 16 * D, h[m]);
#pragma unroll
            for (int m = 0; m < 4; ++m) {
#pragma unroll
                for (int n = 0; n < 2; ++n) { const f32x4 v = acc[ai][bj][m][n] + (n ? b1 : b0); h[m][4 * n + 0] += v[0]; h[m][4 * n + 1] += v[1]; h[m][4 * n + 2] += v[2]; h[m][4 * n + 3] += v[3]; }
                float ss = store_h8(g.Hout, off0 + (size_t)m * 16 * D, h[m]);
                ss = quad_sum(ss);
                if (fq == 0) g.SSQ[(size_t)(row0 + 16 * m) * 32 + u.pn * 8 + bj * 4 + wc] = ss;
            }
            asm volatile("" ::: "memory");
        }
}
__device__ __forceinline__ void phase_oproj(CArgs& a, int j, bool dry, LAS unsigned char* lds, GemmDesc& g) {
    const bf16_t* Ob = (const bf16_t*)(a.ws + WS_Z); const bf16_t* W = (const bf16_t*)(a.ws + WS_WO) + (size_t)j * 1024 * 1024;
    const float* bo = a.in[21] + (size_t)j * D;
    g.res32 = nullptr; g.res16 = (const bf16_t*)(a.ws + WS_H); g.Hout = (bf16_t*)(a.ws + (dry ? WS_DUMH : WS_H)); g.SSQ = (float*)(a.ws + (dry ? WS_DUMSSQ : WS_SSQ)); g.bias = bo;
    if (opaque_bid() < 32) {
        const int lane = opaque_tid() & 63, fr = lane & 15, fq = lane >> 4, task = opaque_bid(), c0 = 32 * task;
        const bf16_t* const br[2] = {W + (size_t)c0 * D, W + (size_t)(c0 + 16) * D};
        f32x4 o[2];
        if (meta_block<2>(lds, Ob + (size_t)NREAL * D, br, D, o)) {
            float ss = 0.f;
#pragma unroll
            for (int n = 0; n < 2; ++n) {
                const int c = c0 + 16 * n + 4 * fq; const size_t off = (size_t)(NREAL + fr) * D + c;
                const u32x2 w = *(const u32x2*)(g.res16 + off); f32x4 h = (f32x4){bf16_lo(w.x), bf16_hi(w.x), bf16_lo(w.y), bf16_hi(w.y)};
                h += o[n] + *(const f32x4*)(bo + c);
                u32x2 w2; w2.x = cvt_pk_bf16(h[0], h[1]); w2.y = cvt_pk_bf16(h[2], h[3]); *(u32x2*)(g.Hout + off) = w2; ss += ssq4(h);
            }
            ss = quad_sum(ss);
            if (fq == 0) g.SSQ[(size_t)(NREAL + fr) * 32 + task] = ss;
        }
    }
    g.stride = GRID; g.vb = opaque_bid(); g.kind = EPI_OPROJ; g.K = D; g.perm = 1; g.gather = 0; g.moe = 0; g.nM = NREAL / BM; g.nN = 1024 / BM; g.nwg = g.nM * g.nN; g.A = (const char*)Ob; g.Bt = (const char*)W;
    g.tstepA = g.tstepB = (size_t)BM * D * 2; g.wstride = 0;
}

__device__ __forceinline__ void kvq_store8(const GemmDesc& g, int row, int c, const float (&v)[8]) {
    if (c < 256) {
        const float* b = g.bias + c; u32x4 w; w.x = cvt_pk_bf16(v[0] + b[0], v[1] + b[1]); w.y = cvt_pk_bf16(v[2] + b[2], v[3] + b[3]); w.z = cvt_pk_bf16(v[4] + b[4], v[5] + b[5]); w.w = cvt_pk_bf16(v[6] + b[6], v[7] + b[7]);
        *(u32x4*)(g.O1 + (size_t)row * 256 + c) = w;
    } else if (c < 512) {
        const int cv = c - 256; const float* b = g.bias + c;
        bf16_t* vp = g.O2 + (row < NREAL ? ((size_t)(row >> 11) * 256 + cv) * SEQ + (row & (SEQ - 1)) : VT_META + (size_t)cv * 16 + (row - NREAL));
        const size_t st = row < NREAL ? SEQ : 16;
#pragma unroll
        for (int i = 0; i < 4; ++i) { const unsigned p = cvt_pk_bf16(v[2 * i] + b[2 * i], v[2 * i + 1] + b[2 * i + 1]); vp[(size_t)(2 * i) * st] = (bf16_t)(p & 0xffffu); vp[(size_t)(2 * i + 1) * st] = (bf16_t)(p >> 16); }
    } else {
        const int cq = c - 512; const float* b = g.bias2 + cq;
        u32x4 w; w.x = cvt_pk_bf16((v[0] + b[0]) * 0.125f, (v[1] + b[1]) * 0.125f); w.y = cvt_pk_bf16((v[2] + b[2]) * 0.125f, (v[3] + b[3]) * 0.125f);
        w.z = cvt_pk_bf16((v[4] + b[4]) * 0.125f, (v[5] + b[5]) * 0.125f); w.w = cvt_pk_bf16((v[6] + b[6]) * 0.125f, (v[7] + b[7]) * 0.125f);
        *(u32x4*)(g.O3 + (size_t)row * D + cq) = w;
    }
}
__device__ __forceinline__ void epi_kvq(const GemmDesc& g, const f32x4 (&acc)[2][2][4][2], const Unit& u, int wr, int wc, int fr, int fq) {
    { const int cbase = g.cbase;
#pragma unroll
        for (int ai = 0; ai < 2; ++ai)
#pragma unroll
            for (int m = 0; m < 4; ++m) {
                const int row = u.pm * BM + ai * HALF + wr * 64 + m * 16 + fr;
#pragma unroll
                for (int bj = 0; bj < 2; ++bj) {
                    const int c = cbase + u.pn * BM + bj * HALF + wc * 32 + 8 * fq;
                    const f32x4 v0 = acc[ai][bj][m][0], v1 = acc[ai][bj][m][1];
                    const float v[8] = {v0[0], v0[1], v0[2], v0[3], v1[0], v1[1], v1[2], v1[3]};
                    kvq_store8(g, row, c, v);
                    asm volatile("" ::: "memory");
                }
            }
    }
}
__device__ __forceinline__ void phase_kvq_q(CArgs& a, int jq, LAS unsigned char* lds, GemmDesc& g) {
    const bf16_t* Ub = (const bf16_t*)(a.ws + WS_U); const bf16_t* W = jq == 0 ? (const bf16_t*)(a.ws + WS_WKVQ) : (const bf16_t*)(a.ws + WS_WQ1);
    const int N = jq == 0 ? 1536 : 1024, cbase = jq == 0 ? 0 : 512;
    if (opaque_bid() < N / 32) {
        const int lane = opaque_tid() & 63, fr = lane & 15, fq = lane >> 4, task = opaque_bid();
        const bf16_t* const br[2] = {W + (size_t)(32 * task) * D, W + (size_t)(32 * task + 16) * D};
        f32x4 o[2];
        if (meta_block<2>(lds, Ub + (size_t)NREAL * D, br, D, o)) {
#pragma unroll
            for (int h = 0; h < 2; ++h) {
                const int c = cbase + 32 * task + 16 * h + 4 * fq; const f32x4 v = o[h]; const int row = NREAL + fr;
                if (c < 256) { const float* b = a.in[16] + c; u32x2 w; w.x = cvt_pk_bf16(v[0] + b[0], v[1] + b[1]); w.y = cvt_pk_bf16(v[2] + b[2], v[3] + b[3]); *(u32x2*)((bf16_t*)(a.ws + WS_K) + (size_t)row * 256 + c) = w; }
                else if (c < 512) { const int cv = c - 256; const float* b = a.in[16] + c; bf16_t* vp = (bf16_t*)(a.ws + WS_VT) + VT_META + (size_t)cv * 16 + fr;
                    const unsigned p0 = cvt_pk_bf16(v[0] + b[0], v[1] + b[1]), p1 = cvt_pk_bf16(v[2] + b[2], v[3] + b[3]);
                    vp[0] = (bf16_t)(p0 & 0xffffu); vp[16] = (bf16_t)(p0 >> 16); vp[32] = (bf16_t)(p1 & 0xffffu); vp[48] = (bf16_t)(p1 >> 16); }
                else { const int cq = c - 512; const float* b = a.in[18] + (size_t)jq * D + cq; u32x2 w; w.x = cvt_pk_bf16((v[0] + b[0]) * 0.125f, (v[1] + b[1]) * 0.125f); w.y = cvt_pk_bf16((v[2] + b[2]) * 0.125f, (v[3] + b[3]) * 0.125f);
                    *(u32x2*)((bf16_t*)(a.ws + WS_Q) + (size_t)row * D + cq) = w; }
            }
        }
    }
    g.stride = GRID; g.vb = opaque_bid(); g.kind = EPI_KVQ; g.K = D; g.perm = 1; g.gather = 0; g.moe = 0; g.nM = NREAL / BM; g.nN = N / BM; g.nwg = g.nM * g.nN; g.A = (const char*)Ub; g.Bt = (const char*)W;
    g.tstepA = g.tstepB = (size_t)BM * D * 2; g.wstride = 0; g.bias = a.in[16]; g.bias2 = a.in[18] + (size_t)jq * D; g.O1 = (bf16_t*)(a.ws + WS_K); g.O2 = (bf16_t*)(a.ws + WS_VT); g.O3 = (bf16_t*)(a.ws + WS_Q);
    g.jq = jq; g.cbase = cbase;
}

__device__ __forceinline__ void moe_scan(const int* cnt, LAS int* sh) {
    if (opaque_tid() == 0) { int acc = 0; for (int e = 0; e < 32; ++e) { sh[e] = acc; acc += (cnt[e] + 255) >> 8; } sh[32] = acc; }
    __syncthreads();
}
__device__ __forceinline__ void epi_moe1(const GemmDesc& g, LAS unsigned char* lds, const f32x4 (&acc)[2][2][4][2], const Unit& u, int wr, int wc, int fr, int fq) {
    { bf16_t* HB = g.O1;
        const LAS int* tabt = (const LAS int*)(lds + LDS_TABT) + u.slot * 256;
#pragma unroll
        for (int ai = 0; ai < 2; ++ai)
#pragma unroll
            for (int m = 0; m < 4; ++m) {
                const int rl = ai * HALF + wr * 64 + m * 16 + fr;
                if (tabt[rl] >= 0) {
                    const f32x4 g0 = acc[ai][0][m][0], g1 = acc[ai][0][m][1], u0 = acc[ai][1][m][0], u1 = acc[ai][1][m][1];
                    u32x4 w; w.x = cvt_pk_bf16(g0[0] * sigmoidf_(g0[0]) * u0[0], g0[1] * sigmoidf_(g0[1]) * u0[1]); w.y = cvt_pk_bf16(g0[2] * sigmoidf_(g0[2]) * u0[2], g0[3] * sigmoidf_(g0[3]) * u0[3]);
                    w.z = cvt_pk_bf16(g1[0] * sigmoidf_(g1[0]) * u1[0], g1[1] * sigmoidf_(g1[1]) * u1[1]); w.w = cvt_pk_bf16(g1[2] * sigmoidf_(g1[2]) * u1[2], g1[3] * sigmoidf_(g1[3]) * u1[3]);
                    *(u32x4*)(HB + ((size_t)u.pm * 256 + rl) * DEXP + u.pn * 128 + wc * 32 + 8 * fq) = w;
                }
                asm volatile("" ::: "memory");
            }
    }
}
__device__ __forceinline__ bool moe_roles(GemmDesc& g) {
    const int rounds = (g.nwg + GRID - 1) / GRID, per = rounds ? (g.nwg + rounds - 1) / rounds : GRID, ngw = ((per + 7) / 8) * 8 < GRID ? ((per + 7) / 8) * 8 : GRID;
    const int bid = opaque_bid(), rnk = bid >> 3;
    g.stride = ngw; g.vb = rnk * 8 + (bid & 7);
    if (rnk * 8 >= ngw) { g.nwg = 0; return true; }
    return false;
}
__device__ __forceinline__ bool phase_moe1(CArgs& a, int layer, LAS unsigned char* lds, GemmDesc& g) {
    LAS int* sh = (LAS int*)(lds + LDS_SH);
    const int* cnt = (const int*)(a.ws + WS_CTL) + CW_CNT + layer * 32;
    moe_scan(cnt, sh);
    g.kind = EPI_MOE1; g.K = D; g.perm = 1; g.gather = 1; g.moe = 1; g.npn = 4; g.nwg = sh[32] * 4; g.nM = 0; g.nN = 4;
    g.A = (const char*)(a.ws + WS_XN); g.Bt = (const char*)(a.ws + WS_W1) + (size_t)layer * 32 * 1024 * 1024 * 2; g.wstride = (size_t)1024 * 1024 * 2;
    g.tstepA = 0; g.tstepB = (size_t)256 * 1024 * 2; g.cnt = cnt; g.LTOK = (const int*)(a.ws + WS_LTOK); g.LGATE = (const float*)(a.ws + WS_LGATE); g.O1 = (bf16_t*)(a.ws + WS_HB);
    return moe_roles(g);
}
__device__ __forceinline__ void epi_moe2(const GemmDesc& g, LAS unsigned char* lds, const f32x4 (&acc)[2][2][4][2], const Unit& u, int wr, int wc, int fr, int fq) {
    { bf16_t* YB = g.O1;
        const LAS int* tabt = (const LAS int*)(lds + LDS_TABT) + u.slot * 256; const LAS float* tabg = (const LAS float*)(lds + LDS_TABG) + u.slot * 256;
#pragma unroll
        for (int ai = 0; ai < 2; ++ai)
#pragma unroll
            for (int m = 0; m < 4; ++m) {
                const int rl = ai * HALF + wr * 64 + m * 16 + fr; const int rt = tabt[rl];
                if (rt >= 0) {
                    const float gs = tabg[rl];
                    bf16_t* yp = YB + ((size_t)(rt & 0x3fffffff) * 2 + (rt >> 30)) * D + u.pn * BM + wc * 32 + 8 * fq;
#pragma unroll
                    for (int bj = 0; bj < 2; ++bj) { const f32x4 v0 = acc[ai][bj][m][0] * gs, v1 = acc[ai][bj][m][1] * gs;
                        u32x4 w; w.x = cvt_pk_bf16(v0[0], v0[1]); w.y = cvt_pk_bf16(v0[2], v0[3]); w.z = cvt_pk_bf16(v1[0], v1[1]); w.w = cvt_pk_bf16(v1[2], v1[3]);
                        *(u32x4*)(yp + bj * HALF) = w; }
                }
                asm volatile("" ::: "memory");
            }
    }
}
__device__ __forceinline__ bool phase_moe2(CArgs& a, int layer, LAS unsigned char* lds, GemmDesc& g) {
    LAS int* sh = (LAS int*)(lds + LDS_SH);
    const int* cnt = (const int*)(a.ws + WS_CTL) + CW_CNT + layer * 32;
    moe_scan(cnt, sh);
    g.kind = EPI_MOE2; g.K = DEXP; g.perm = 1; g.gather = 0; g.moe = 1; g.npn = 4; g.nwg = sh[32] * 4; g.nM = 0; g.nN = 4;
    g.A = (const char*)(a.ws + WS_HB); g.Bt = (const char*)(a.ws + WS_W2) + (size_t)layer * 32 * 1024 * 512 * 2; g.wstride = (size_t)1024 * 512 * 2;
    g.tstepA = (size_t)256 * DEXP * 2; g.tstepB = (size_t)256 * DEXP * 2; g.cnt = cnt; g.LTOK = (const int*)(a.ws + WS_LTOK); g.LGATE = (const float*)(a.ws + WS_LGATE); g.O1 = (bf16_t*)(a.ws + WS_YB);
    return moe_roles(g);
}
__device__ __forceinline__ void gemm_epilogue(const GemmDesc& g, LAS unsigned char* lds, const f32x4 (&acc)[2][2][4][2], const Unit& u, int wr, int wc, int fr, int fq) {
    asm volatile("" : "+v"(fr), "+v"(fq));
    switch (g.kind) {
        case EPI_GLU: epi_glu(g, acc, u, wr, wc, fr, fq); break;
        case EPI_OPROJ: epi_oproj(g, acc, u, wr, wc, fr, fq); break;
        case EPI_KVQ: epi_kvq(g, acc, u, wr, wc, fr, fq); break;
        case EPI_MOE1: epi_moe1(g, lds, acc, u, wr, wc, fr, fq); break;
        default: epi_moe2(g, lds, acc, u, wr, wc, fr, fq); break;
    }
}

constexpr int AT_NSLOT = 272, AT_VROW = 552, AT_KBYTES = AT_NSLOT * 128, AT_VBYTES = 64 * AT_VROW;
__device__ __forceinline__ void attn_tile(LAS unsigned char* Ks, LAS unsigned char* Vs, const bf16_t* qp, bf16_t* op, float sink, int nblk  , int kb0  , int srel  , int smin  , int lmeta  , int tc, int q4) {
    const bf16x8 qf0 = as_bf16x8(*(const u32x4*)qp), qf1 = as_bf16x8(*(const u32x4*)(qp + 32));
    f32x4 s[10];
#pragma unroll
    for (int bi = 0; bi < 10; ++bi) {
        s[bi] = (f32x4){-1e30f, -1e30f, -1e30f, -1e30f};
        if (bi < nblk) {
            const int sl = (bi == 0 ? 0 : 16 + 16 * (kb0 + bi - 1)) + tc;
            const LAS unsigned char* kr = Ks + sl * 128;
            const bf16x8 kf0 = *(const LAS bf16x8*)(kr + ((q4 ^ (sl & 7)) << 4)), kf1 = *(const LAS bf16x8*)(kr + (((4 + q4) ^ (sl & 7)) << 4));
            f32x4 acc = {0.f, 0.f, 0.f, 0.f};
            acc = mfma16(kf0, qf0, acc); acc = mfma16(kf1, qf1, acc);
#pragma unroll
            for (int r = 0; r < 4; ++r) {
                const int kk = 16 * (kb0 + bi - 1) + 4 * q4 + r;
                const bool ok = bi == 0 ? (4 * q4 + r <= lmeta) : (kk >= smin && kk <= srel && kk >= srel - 127);
                s[bi][r] = ok ? acc[r] : -1e30f;
            }
        }
    }
    float m = sink;
#pragma unroll
    for (int bi = 0; bi < 10; ++bi) m = fmaxf(m, fmaxf(fmaxf(s[bi][0], s[bi][1]), fmaxf(s[bi][2], s[bi][3])));
    m = xor32_max(xor16_max(m));
    float den = 0.f;
    unsigned pk[10][2];
#pragma unroll
    for (int bi = 0; bi < 10; ++bi) {
        float p[4];
#pragma unroll
        for (int r = 0; r < 4; ++r) { p[r] = s[bi][r] > -1e29f ? fast_exp(s[bi][r] - m) : 0.f; den += p[r]; }
        pk[bi][0] = cvt_pk_bf16(p[0], p[1]); pk[bi][1] = cvt_pk_bf16(p[2], p[3]);
    }
    den = quad_sum(den);
    den += fast_exp(sink - m);
    const float inv = 1.0f / den;
    f32x4 o[4];
#pragma unroll
    for (int dt = 0; dt < 4; ++dt) o[dt] = (f32x4){0.f, 0.f, 0.f, 0.f};
#pragma unroll
    for (int pp = 0; pp < 5; ++pp) {
        if (2 * pp < nblk) {
            const int biA = 2 * pp, biB = 2 * pp + 1;
            const int slA = biA == 0 ? 0 : 16 + 16 * (kb0 + biA - 1), slB = biB < nblk ? 16 + 16 * (kb0 + biB - 1) : slA;
            u32x4 pw; pw.x = pk[biA][0]; pw.y = pk[biA][1]; pw.z = pk[biB][0]; pw.w = pk[biB][1];
            const bf16x8 pf = as_bf16x8(pw);
#pragma unroll
            for (int dt = 0; dt < 4; ++dt) {
                const LAS unsigned char* vr = Vs + (16 * dt + tc) * AT_VROW + 8 * q4;
                const u32x2 va = *(const LAS u32x2*)(vr + slA * 2), vb = *(const LAS u32x2*)(vr + slB * 2);
                u32x4 vw; vw.x = va.x; vw.y = va.y; vw.z = vb.x; vw.w = vb.y;
                o[dt] = mfma16(as_bf16x8(vw), pf, o[dt]);
            }
        }
    }
#pragma unroll
    for (int dt = 0; dt < 4; ++dt) { u32x2 w; w.x = cvt_pk_bf16(o[dt][0] * inv, o[dt][1] * inv); w.y = cvt_pk_bf16(o[dt][2] * inv, o[dt][3] * inv); *(u32x2*)(op + 16 * dt) = w; }
}
__device__ __forceinline__ void phase_attn(CArgs& a, int j, LAS unsigned char* lds) {
    const int tid = opaque_tid(), lane = tid & 63, wid = tid >> 6, tc = lane & 15, q4 = lane >> 4;
    const bf16_t* Q = (const bf16_t*)(a.ws + WS_Q); const bf16_t* K = (const bf16_t*)(a.ws + WS_K); const bf16_t* VT = (const bf16_t*)(a.ws + WS_VT);
    bf16_t* O = (bf16_t*)(a.ws + WS_Z);
    LAS unsigned char* Ks = lds; LAS unsigned char* Vs = lds + AT_KBYTES;
    constexpr int NU_REAL = NB * 4 * 16;
    for (int unit = opaque_bid(); unit < NU_REAL + 4; unit += GRID) {
        const bool meta = unit >= NU_REAL;
        const int qt = meta ? 0 : (unit & 15), kvh = meta ? unit - NU_REAL : ((unit >> 4) & 3), b = meta ? 0 : (unit >> 6), s0 = qt * 128;
        __syncthreads();
        for (int idx = tid; idx < AT_NSLOT * 8; idx += NTHREADS) {
            const int sl = idx >> 3, c = idx & 7, sw = s0 - 128 + (sl - 16);
            u32x4 v = {0u, 0u, 0u, 0u};
            if (sl < 16) v = *(const u32x4*)(K + (size_t)(NREAL + sl) * 256 + kvh * 64 + c * 8);
            else if (!meta && sw >= 0) v = *(const u32x4*)(K + (size_t)(b * SEQ + sw) * 256 + kvh * 64 + c * 8);
            *(LAS u32x4*)(Ks + sl * 128 + ((c ^ (sl & 7)) << 4)) = v;
        }
        for (int idx = tid; idx < 64 * 34; idx += NTHREADS) {
            const int d = idx / 34, ch = idx - d * 34, sw = s0 - 128 + 8 * (ch - 2);
            u32x4 v = {0u, 0u, 0u, 0u};
            if (ch < 2) v = *(const u32x4*)(VT + VT_META + (size_t)(kvh * 64 + d) * 16 + ch * 8);
            else if (!meta && sw >= 0) v = *(const u32x4*)(VT + ((size_t)(b * 4 + kvh) * 64 + d) * SEQ + sw);
            *(LAS u32x2*)(Vs + d * AT_VROW + ch * 16) = (u32x2){v.x, v.y}; *(LAS u32x2*)(Vs + d * AT_VROW + ch * 16 + 8) = (u32x2){v.z, v.w};
        }
        __syncthreads();
        const int g = wid & 3, hq = kvh * 4 + g;
        const float sink = a.in[19][j * 16 + hq];
        if (meta) {
            if (wid < 4) { const size_t row = (size_t)(NREAL + tc); attn_tile(Ks, Vs, Q + row * D + hq * 64 + 8 * q4, O + row * D + hq * 64 + 4 * q4, sink, 1, 0, 0, 0, tc, tc, q4); }
        } else {
#pragma unroll 1
            for (int jt = wid >> 2; jt < 8; jt += 2) {
                const int s = s0 + 16 * jt + tc; const size_t row = (size_t)(b * SEQ + s);
                attn_tile(Ks, Vs, Q + row * D + hq * 64 + 8 * q4, O + row * D + hq * 64 + 4 * q4, sink, 10, jt, 128 + 16 * jt + tc, 128 - s0, 64, tc, q4);
            }
        }
    }
}

__device__ __forceinline__ void phase_route(CArgs& a, int layer, bool dry, LAS unsigned char* lds) {
    LAS unsigned char* Wf = lds; LAS float* LG = (LAS float*)(lds + 98304); LAS int* hist = (LAS int*)(lds + 98304 + 24576); LAS int* hbase = hist + 32;
    const int tid = opaque_tid(), lane = tid & 63, wid = tid >> 6, tc = lane & 15, q4 = lane >> 4;
    for (int idx = tid; idx < 3 * 32 * 64; idx += NTHREADS) *(LAS u32x4*)(Wf + (size_t)idx * 16) = *(const u32x4*)(a.ws + WS_RW + (size_t)layer * 98304 + (size_t)idx * 16);
    if (tid < 32) hist[tid] = 0;
    __syncthreads();
    const bf16_t* H = (const bf16_t*)(a.ws + WS_H); const float* SSQ = (const float*)(a.ws + WS_SSQ); bf16_t* XN = (bf16_t*)(a.ws + WS_XN);
    int* cnt = (int*)(a.ws + WS_CTL) + (dry ? CW_DUMCNT : CW_CNT) + layer * 32; int* LTOK = (int*)(a.ws + (dry ? WS_DUMLT : WS_LTOK)); float* LGATE = (float*)(a.ws + (dry ? WS_DUMLG : WS_LGATE));
    const int tile = wid * GRID + opaque_bid();
    const bool active = tile < RT / 16;
    int e1, e2, r1, r2; float g1, g2;
    asm volatile("" : "=v"(e1), "=v"(e2), "=v"(r1), "=v"(r2), "=v"(g1), "=v"(g2));
    if (active) {
        const int row = tile * 16 + tc;
        float ss = 0.f;
        { const f32x4* sp = (const f32x4*)(SSQ + (size_t)row * 32 + 8 * q4); const f32x4 s0 = sp[0], s1 = sp[1]; ss = (s0[0] + s0[1]) + (s0[2] + s0[3]) + (s1[0] + s1[1]) + (s1[2] + s1[3]); }
        ss = quad_sum(ss);
        const float rstd = 1.0f / sqrtf(ss * (1.0f / D) + RMS_EPS);
        f32x4 acc[3];
#pragma unroll
        for (int rt = 0; rt < 3; ++rt) acc[rt] = (f32x4){0.f, 0.f, 0.f, 0.f};
        const bf16_t* hp = H + (size_t)row * D + 8 * q4; bf16_t* xp = XN + (size_t)row * D + 8 * q4;
#pragma unroll 1
        for (int kb = 0; kb < 4; ++kb) {
            u32x4 hv[8];
#pragma unroll
            for (int k8 = 0; k8 < 8; ++k8) hv[k8] = *(const u32x4*)(hp + 32 * (kb * 8 + k8));
#pragma unroll
            for (int k8 = 0; k8 < 8; ++k8) {
                const int ks = kb * 8 + k8; const u32x4 hw = hv[k8];
                u32x4 xw; xw.x = cvt_pk_bf16(bf16_lo(hw.x) * rstd, bf16_hi(hw.x) * rstd); xw.y = cvt_pk_bf16(bf16_lo(hw.y) * rstd, bf16_hi(hw.y) * rstd);
                xw.z = cvt_pk_bf16(bf16_lo(hw.z) * rstd, bf16_hi(hw.z) * rstd); xw.w = cvt_pk_bf16(bf16_lo(hw.w) * rstd, bf16_hi(hw.w) * rstd);
                *(u32x4*)(xp + 32 * ks) = xw;
                const bf16x8 xf = as_bf16x8(xw);
#pragma unroll
                for (int rt = 0; rt < 3; ++rt) acc[rt] = mfma16(*(LAS bf16x8*)(Wf + ((size_t)(rt * 32 + ks) * 64 + lane) * 16), xf, acc[rt]);
            }
        }
        LAS float* lg = LG + wid * 16 * 48;
#pragma unroll
        for (int rt = 0; rt < 3; ++rt)
#pragma unroll
            for (int r = 0; r < 4; ++r) lg[tc * 48 + 16 * rt + 4 * q4 + r] = acc[rt][r];
        asm volatile("s_waitcnt lgkmcnt(0)" ::: "memory");
        if (lane < 16) {
            const LAS float* mylg = lg + lane * 48;
            float gl[4]; int gi = 0; float gm;
#pragma unroll
            for (int i = 0; i < 4; ++i) gl[i] = mylg[i] + a.in[23][layer * NGRP + i];
            gm = gl[0];
#pragma unroll
            for (int i = 1; i < 4; ++i) if (gl[i] > gm) { gm = gl[i]; gi = i; }
            float gz = 0.f;
#pragma unroll
            for (int i = 0; i < 4; ++i) gz += expf(gl[i] - gm);
            const float pg = 1.0f / gz;
            float el[8];
#pragma unroll
            for (int i = 0; i < 8; ++i) el[i] = mylg[4 + gi * 8 + i] + a.in[25][layer * NEXP + gi * 8 + i];
            int i1 = 0; float m1 = el[0];
#pragma unroll
            for (int i = 1; i < 8; ++i) if (el[i] > m1) { m1 = el[i]; i1 = i; }
            int i2 = -1; float m2 = -3.0e38f;
#pragma unroll
            for (int i = 0; i < 8; ++i) if (i != i1 && el[i] > m2) { m2 = el[i]; i2 = i; }
            float one = 1.0f; asm volatile("" : "+v"(one));
            const float x2 = expf(m2 - m1), q1 = one / (one + x2);
            g1 = pg * q1; g2 = pg * x2 * q1; e1 = gi * 8 + i1; e2 = gi * 8 + i2;
            r1 = __hip_atomic_fetch_add(&hist[e1], 1, __ATOMIC_RELAXED, __HIP_MEMORY_SCOPE_WORKGROUP); r2 = __hip_atomic_fetch_add(&hist[e2], 1, __ATOMIC_RELAXED, __HIP_MEMORY_SCOPE_WORKGROUP);
        }
    }
    __syncthreads();
    if (tid < 32) hbase[tid] = hist[tid] ? atomicAdd(&cnt[tid], hist[tid]) : 0;
    __syncthreads();
    if (active && lane < 16) {
        const int row = tile * 16 + lane;
        const int s1 = hbase[e1] + r1, s2 = hbase[e2] + r2;
        LTOK[(size_t)e1 * RT + s1] = row; LGATE[(size_t)e1 * RT + s1] = g1;
        LTOK[(size_t)e2 * RT + s2] = row | (1 << 30); LGATE[(size_t)e2 * RT + s2] = g2;
    }
}

__device__ __forceinline__ void phase_combine(CArgs& a, int layer, bool dry) {
    const int lane = opaque_tid() & 63, gw = opaque_bid() * 8 + (opaque_tid() >> 6);
    bf16_t* H = (bf16_t*)(a.ws + WS_H); const bf16_t* YB = (const bf16_t*)(a.ws + WS_YB);
    for (int row = gw; row < RT; row += GRID * 8) {
        float v[2][8]; float ssq = 0.f;
        bf16_t* hp = H + (size_t)row * D; const bf16_t* y0 = YB + (size_t)row * 2 * D; const bf16_t* y1 = y0 + D;
#pragma unroll
        for (int j = 0; j < 2; ++j) {
            const int c = 8 * lane + 512 * j;
            const u32x4 hw = *(const u32x4*)(hp + c), p0 = *(const u32x4*)(y0 + c), p1 = *(const u32x4*)(y1 + c);
            v[j][0] = bf16_lo(hw.x) + bf16_lo(p0.x) + bf16_lo(p1.x); v[j][1] = bf16_hi(hw.x) + bf16_hi(p0.x) + bf16_hi(p1.x);
            v[j][2] = bf16_lo(hw.y) + bf16_lo(p0.y) + bf16_lo(p1.y); v[j][3] = bf16_hi(hw.y) + bf16_hi(p0.y) + bf16_hi(p1.y);
            v[j][4] = bf16_lo(hw.z) + bf16_lo(p0.z) + bf16_lo(p1.z); v[j][5] = bf16_hi(hw.z) + bf16_hi(p0.z) + bf16_hi(p1.z);
            v[j][6] = bf16_lo(hw.w) + bf16_lo(p0.w) + bf16_lo(p1.w); v[j][7] = bf16_hi(hw.w) + bf16_hi(p0.w) + bf16_hi(p1.w);
#pragma unroll
            for (int e = 0; e < 8; ++e) ssq += v[j][e] * v[j][e];
        }
        ssq = wave_sum(ssq);
        const float rstd = 1.0f / sqrtf(ssq * (1.0f / D) + RMS_EPS);
        if (layer < 3) {
            bf16_t* ho = dry ? (bf16_t*)(a.ws + WS_DUMH) + (size_t)row * D : hp;
            bf16_t* uo = dry ? (bf16_t*)(a.ws + WS_DUMSSQ) + (size_t)(row & 1023) * D : (bf16_t*)(a.ws + WS_U) + (size_t)row * D;
            const float* gn = layer == 0 ? a.in[2] + D : nullptr;
#pragma unroll
            for (int j = 0; j < 2; ++j) {
                const int c = 8 * lane + 512 * j;
                u32x4 w; w.x = cvt_pk_bf16(v[j][0], v[j][1]); w.y = cvt_pk_bf16(v[j][2], v[j][3]); w.z = cvt_pk_bf16(v[j][4], v[j][5]); w.w = cvt_pk_bf16(v[j][6], v[j][7]);
                *(u32x4*)(ho + c) = w;
                f32x4 g0 = {1.f, 1.f, 1.f, 1.f}, g1 = g0; if (gn) { g0 = *(const f32x4*)(gn + c); g1 = *(const f32x4*)(gn + c + 4); }
                u32x4 x; x.x = cvt_pk_bf16(v[j][0] * rstd * g0[0], v[j][1] * rstd * g0[1]); x.y = cvt_pk_bf16(v[j][2] * rstd * g0[2], v[j][3] * rstd * g0[3]);
                x.z = cvt_pk_bf16(v[j][4] * rstd * g1[0], v[j][5] * rstd * g1[1]); x.w = cvt_pk_bf16(v[j][6] * rstd * g1[2], v[j][7] * rstd * g1[3]);
                *(u32x4*)(uo + c) = x;
            }
        } else if (row < NREAL) {
            float* op = a.out + (size_t)row * D;
#pragma unroll
            for (int j = 0; j < 2; ++j) { const int c = 8 * lane + 512 * j; const f32x4 g0 = *(const f32x4*)(a.in[5] + c), g1 = *(const f32x4*)(a.in[5] + c + 4);
                f32x4 o0, o1; o0[0] = v[j][0] * rstd * g0[0]; o0[1] = v[j][1] * rstd * g0[1]; o0[2] = v[j][2] * rstd * g0[2]; o0[3] = v[j][3] * rstd * g0[3];
                o1[0] = v[j][4] * rstd * g1[0]; o1[1] = v[j][5] * rstd * g1[1]; o1[2] = v[j][6] * rstd * g1[2]; o1[3] = v[j][7] * rstd * g1[3];
                *(f32x4*)(op + c) = o0; *(f32x4*)(op + c + 4) = o1; }
        }
    }
}

enum { PH_PREP = 0, PH_S5, PH_GLU, PH_ROUTE, PH_G1, PH_G2, PH_COMB, PH_KVQ, PH_ATT, PH_OPROJ, PH_QG };
constexpr int NPH = 27;
__constant__ int c_prog[NPH][2] = {
    {PH_PREP, 0},
    {PH_S5, 0}, {PH_GLU, 0}, {PH_ROUTE, 0}, {PH_G1, 0}, {PH_G2, 0}, {PH_COMB, 0},
    {PH_S5, 1}, {PH_GLU, 1}, {PH_ROUTE, 1}, {PH_G1, 1}, {PH_G2, 1}, {PH_COMB, 1},
    {PH_KVQ, 2}, {PH_ATT, 2}, {PH_OPROJ, 2}, {PH_ROUTE, 2}, {PH_G1, 2}, {PH_G2, 2}, {PH_COMB, 2},
    {PH_QG, 3}, {PH_ATT, 3}, {PH_OPROJ, 3}, {PH_ROUTE, 3}, {PH_G1, 3}, {PH_G2, 3}, {PH_COMB, 3},
};

__global__ void __launch_bounds__(NTHREADS) yoco_fwd(Args a) {
    extern __shared__ __attribute__((aligned(16))) unsigned char smem_raw[];
    LAS unsigned char* lds = (LAS unsigned char*)smem_raw;
    volatile LAS unsigned* const st = (volatile LAS unsigned*)(lds + LDS_BYTES - 64);
    if (threadIdx.x < 16) st[threadIdx.x] = 0u;
    __syncthreads();
    if (a.ph_hi - a.ph_lo > 1) xcd_barrier_post((unsigned*)(a.ws + WS_CTL) + CW_BAR);
    CArgs* const kp = (CArgs*)__builtin_amdgcn_kernarg_segment_ptr();
    for (int ph = a.ph_lo; ph < a.ph_hi; ++ph) {
        const int type = c_prog[ph][0], layer = c_prog[ph][1];
        const int reps = type == a.rep_type ? a.rep_n : 0;
        for (int r = 0; r <= reps; ++r) {
            const bool dry = r > 0;
            CArgs* lp = kp; asm volatile("" : "+s"(lp));
            CArgs& la = *lp;
            GemmDesc g; bool is_gemm = true; int conv_budget = 0, conv_limit = 0;
            BgConv bg{lp, st};
            switch (type) {
                case PH_GLU: phase_glu(la, layer, dry, lds, g); break;
                case PH_G1: if (phase_moe1(la, layer, lds, g)) { conv_budget = 18; conv_limit = (layer + 2) * 32 * NWT_E; } break;
                case PH_G2: if (phase_moe2(la, layer, lds, g)) { conv_budget = 12; conv_limit = (layer + 3) * 32 * NWT_E; } break;
                case PH_KVQ: case PH_QG: phase_kvq_q(la, type == PH_QG ? 1 : 0, lds, g); break;
                case PH_OPROJ: phase_oproj(la, layer - 2, dry, lds, g); break;
                default: is_gemm = false; break;
            }
            g.skip_epi = 0;
#if defined(PROBE_SKIPEPI)
            if (dry) g.skip_epi = 1;
#endif
            if (is_gemm) { gemm_run(lds, g); if (conv_budget) bg.run_until(conv_limit < NWT_MOE ? conv_limit : NWT_MOE, conv_budget); }
            else switch (type) {
                case PH_PREP: phase_prep(la, lds); break;
                case PH_S5: phase_s5(la, layer, lds); break;
                case PH_ROUTE: phase_route(la, layer, dry, lds); break;
                case PH_COMB: phase_combine(la, layer, dry); break;
                default: phase_attn(la, layer - 2, lds); break;
            }
            if (type == PH_ROUTE && !dry) bg.run_until((layer + 1) * 32 * NWT_E, 1 << 20);
            if (r < reps || ph + 1 < a.ph_hi) { if (a.ph_hi - a.ph_lo > 1) xcd_barrier((unsigned*)(la.ws + WS_CTL) + CW_BAR, st, bg); }
        }
        if (a.rep_type == 100 && ph + 1 < a.ph_hi) for (int r = 0; r < a.rep_n; ++r) { BgConv bg{kp, st}; xcd_barrier((unsigned*)(a.ws + WS_CTL) + CW_BAR, st, bg); }
    }
}

extern "C" void kernel_launch(void* const* d_in, const int* in_sizes, int n_in, void* d_out, int out_size, void* d_ws, size_t ws_size, hipStream_t stream) {
    static int ready = 0;
    if (ready == 0) {
        if (n_in != 29 || ws_size < WS_END) { fprintf(stderr, "kernel_launch: expected 29 inputs and >= %zu bytes of workspace (got %d, %zu)\n", (size_t)WS_END, n_in, ws_size); ready = -1; return; }
        if (hipFuncSetAttribute((const void*)yoco_fwd, hipFuncAttributeMaxDynamicSharedMemorySize, LDS_BYTES) != hipSuccess) { fprintf(stderr, "kernel_launch: hipFuncSetAttribute failed\n"); ready = -1; return; }
        ready = 1;
    }
    if (ready < 0) return;
    (void)hipMemsetAsync((char*)d_ws + WS_CTL, 0, CTL_BYTES, stream);
    Args a{};
    for (int i = 0; i < 29; ++i) a.in[i] = (const float*)d_in[i];
    a.out = (float*)d_out; a.ws = (unsigned char*)d_ws;
#if defined(PROBE_TYPE)
    a.rep_type = PROBE_TYPE; a.rep_n = PROBE_N;
#else
    a.rep_type = -1; a.rep_n = 0;
#endif
#if MK_N_LAUNCHES == 1
    a.ph_lo = 0; a.ph_hi = NPH;
    hipLaunchKernelGGL(yoco_fwd, dim3(GRID), dim3(NTHREADS), LDS_BYTES, stream, a);
#else
    for (int ph = 0; ph < NPH; ++ph) { a.ph_lo = ph; a.ph_hi = ph + 1; hipLaunchKernelGGL(yoco_fwd, dim3(GRID), dim3(NTHREADS), LDS_BYTES, stream, a); }
#endif
}
```

```cpp
#include <hip/hip_runtime.h>
#include <cstdio>
#include <cstdint>

#ifndef MK_N_LAUNCHES
#define MK_N_LAUNCHES 1
#endif

#define LAS __attribute__((address_space(3)))
typedef unsigned short bf16_t;
typedef short bf16x8 __attribute__((ext_vector_type(8)));
typedef float f32x4 __attribute__((ext_vector_type(4)));
typedef float f32x2 __attribute__((ext_vector_type(2)));
typedef unsigned u32x4 __attribute__((ext_vector_type(4)));
typedef unsigned u32x2 __attribute__((ext_vector_type(2)));

constexpr int D = 1024, NB = 8, SEQ = 2048, NMETA = 16, LT = SEQ + NMETA  ;
constexpr int NREAL = NB * SEQ  , RT = NREAL + NMETA  , RPAD = 16640;
constexpr int NEXP = 32, DEXP = 512, NGRP = 4, EPG = 8;
constexpr int NTHREADS = 512, GRID = 256;
constexpr int LDS_BYTES = 155648;
constexpr float RMS_EPS = 1e-6f;
__device__ __forceinline__ int row_of(int b, int pos) { return pos < NMETA ? NREAL + pos : b * SEQ + (pos - NMETA); }

constexpr size_t al256(size_t x) { return (x + 255) & ~(size_t)255; }
constexpr size_t WS_CTL = 0;
constexpr size_t CTL_BYTES = 32768;
constexpr int CW_BAR = 0;
constexpr int CW_CNT = 4096;
constexpr int CW_DUMCNT = 4096 + 256;
constexpr int CW_BGC = 6144;
constexpr size_t WS_H = WS_CTL + CTL_BYTES;
constexpr size_t WS_RSTD = WS_H + al256((size_t)RPAD * D * 2);
constexpr size_t WS_LRS = WS_RSTD + al256((size_t)RPAD * 4);
constexpr size_t WS_U = WS_LRS + al256((size_t)NEXP * RT * 4);
constexpr size_t WS_Z = WS_U + 256;
constexpr size_t WS_XN = WS_Z + al256((size_t)RPAD * D * 2);
constexpr size_t WS_Q = WS_XN + 256;
constexpr size_t WS_K = WS_Q + al256((size_t)RPAD * D * 2);
constexpr size_t WS_VT = WS_K + al256((size_t)RPAD * 256 * 2);
constexpr size_t VT_META = (size_t)NB * 256 * SEQ;
constexpr size_t WS_SSQ = WS_VT + al256((size_t)RPAD * 256 * 2);
constexpr size_t WS_LTOK = WS_SSQ + al256((size_t)RPAD * 32 * 4);
constexpr size_t WS_LGATE = WS_LTOK + al256((size_t)NEXP * RT * 4);
constexpr int HB_ROWS = 2 * RT + NEXP * 256;
constexpr size_t WS_HB = WS_LGATE + al256((size_t)NEXP * RT * 4);
constexpr size_t WS_YB = WS_HB + al256((size_t)HB_ROWS * DEXP * 2);
constexpr size_t TBL_K = 0, TBL_M = 16 * 1024, TBL_N = TBL_M + 64 * 1024, TBL_A16 = TBL_N + 64 * 1024, TBL_STRIDE = TBL_A16 + 512;
constexpr size_t WS_TBL = WS_YB + al256((size_t)RT * 2 * D * 2);
constexpr size_t WS_WGLU = WS_TBL + al256((size_t)2 * 64 * TBL_STRIDE);
constexpr size_t WS_WKVQ = WS_WGLU + (size_t)2 * 2048 * 1024 * 2;
constexpr size_t WS_WQ1 = WS_WKVQ + (size_t)1536 * 1024 * 2;
constexpr size_t WS_WO = WS_WQ1 + (size_t)1024 * 1024 * 2;
constexpr size_t WS_W1 = WS_WO + (size_t)2 * 1024 * 1024 * 2;
constexpr size_t WS_W2 = WS_W1 + (size_t)4 * 32 * 1024 * 1024 * 2;
constexpr size_t WS_RW = WS_W2 + (size_t)4 * 32 * 1024 * 512 * 2;
constexpr size_t WS_DUMH = WS_RW + (size_t)4 * 98304;
constexpr size_t WS_DUMSSQ = WS_DUMH + al256((size_t)RT * D * 4);
constexpr size_t WS_DUMLT = WS_DUMSSQ + al256((size_t)RT * 32 * 4);
constexpr size_t WS_DUMLG = WS_DUMLT + al256((size_t)NEXP * RT * 4);
#if defined(PROBE_TYPE)
constexpr size_t WS_END = WS_DUMLG + al256((size_t)NEXP * RT * 4);
#else
constexpr size_t WS_END = WS_DUMH;
#endif

struct Args {
    const float* in[29];
    float* out;
    unsigned char* ws;
    int ph_lo, ph_hi;
    int rep_type, rep_n;
};
typedef const __attribute__((address_space(4))) Args CArgs;

__device__ __forceinline__ unsigned cvt_pk_bf16(float lo, float hi) { unsigned r; asm volatile("v_cvt_pk_bf16_f32 %0, %1, %2" : "=v"(r) : "v"(lo), "v"(hi)); return r; }
__device__ __forceinline__ float bf16_lo(unsigned w) { return __uint_as_float(w << 16); }
__device__ __forceinline__ float bf16_hi(unsigned w) { return __uint_as_float(w & 0xffff0000u); }
__device__ __forceinline__ float fast_rcp(float x) { return __builtin_amdgcn_rcpf(x); }
__device__ __forceinline__ float fast_exp(float x) { return __builtin_amdgcn_exp2f(x * 1.4426950408889634f); }
__device__ __forceinline__ float sigmoidf_(float x) { return fast_rcp(1.0f + fast_exp(-x)); }
__device__ __forceinline__ float gelu_tanh(float x) { const float v = 0.7978845608028654f * (x + 0.044715f * x * x * x); return x * sigmoidf_(2.0f * v); }
__device__ __forceinline__ bf16x8 as_bf16x8(u32x4 v) { return __builtin_bit_cast(bf16x8, v); }
__device__ __forceinline__ f32x4 mfma16(bf16x8 a, bf16x8 b, f32x4 c) { return __builtin_amdgcn_mfma_f32_16x16x32_bf16(a, b, c, 0, 0, 0); }
__device__ __forceinline__ float xor32_sum(float v) { auto r = __builtin_amdgcn_permlane32_swap(__float_as_uint(v), __float_as_uint(v), false, false); return __uint_as_float(r[0]) + __uint_as_float(r[1]); }
__device__ __forceinline__ float xor16_sum(float v) { auto r = __builtin_amdgcn_permlane16_swap(__float_as_uint(v), __float_as_uint(v), false, false); return __uint_as_float(r[0]) + __uint_as_float(r[1]); }
__device__ __forceinline__ float xor32_max(float v) { auto r = __builtin_amdgcn_permlane32_swap(__float_as_uint(v), __float_as_uint(v), false, false); return fmaxf(__uint_as_float(r[0]), __uint_as_float(r[1])); }
__device__ __forceinline__ float xor16_max(float v) { auto r = __builtin_amdgcn_permlane16_swap(__float_as_uint(v), __float_as_uint(v), false, false); return fmaxf(__uint_as_float(r[0]), __uint_as_float(r[1])); }
__device__ __forceinline__ float quad_sum(float v) { return xor32_sum(xor16_sum(v)); }
template <int X> __device__ __forceinline__ float swz_xor(float v) { return __uint_as_float((unsigned)__builtin_amdgcn_ds_swizzle((int)__float_as_uint(v), (X << 10) | 0x1f)); }
__device__ __forceinline__ float wave_sum(float v) {
    v += swz_xor<1>(v); v += swz_xor<2>(v); v += swz_xor<4>(v); v += swz_xor<8>(v);
    return quad_sum(v);
}
__device__ __forceinline__ int opaque_bid() { int b = blockIdx.x; asm volatile("" : "+s"(b)); return b; }
__device__ __forceinline__ int opaque_tid() { int t = threadIdx.x; asm volatile("" : "+v"(t)); return t; }

#define XB_TMO      128
#define XB_XCNT(j)  (256  + 64 * (j))
#define XB_XSUB(j)  (1280 + 64 * (j))
#define XB_XGEN(j)  (2304 + 64 * (j))
#define XB_TOP      3328
#define XB_TOPGEN   3392
#define XCD_BAR_WORDS 3456
#define XB_SPIN_CAP (1u << 22)
__device__ __forceinline__ unsigned xb_ld(unsigned* p)              { return __hip_atomic_load(p, __ATOMIC_RELAXED, __HIP_MEMORY_SCOPE_AGENT); }
__device__ __forceinline__ unsigned xb_add(unsigned* p, unsigned v) { return __hip_atomic_fetch_add(p, v, __ATOMIC_RELAXED, __HIP_MEMORY_SCOPE_AGENT); }
__device__ __forceinline__ unsigned xb_xcc_id() { return (unsigned)__builtin_amdgcn_s_getreg((3 << 11) | 20) & 0xFu; }
#define XB_SPIN(cond, bar) do { unsigned _sp = 0; while (cond) { __builtin_amdgcn_s_sleep(1); \
    if ((++_sp & 255u) == 0u) { if (xb_ld(&(bar)[XB_TMO])) break; if (_sp > XB_SPIN_CAP) { atomicAdd(&(bar)[XB_TMO], 1u); break; } } } } while (0)
__device__ __forceinline__ void xcd_barrier_post(unsigned* bar) { if (threadIdx.x == 0) (void)xb_add(&bar[XB_XCNT(xb_xcc_id())], 1u); }
__device__ __forceinline__ void xcd_barrier_complete(unsigned* bar, unsigned x, unsigned& nloc, unsigned& nx) {
    const unsigned G = gridDim.x;
    unsigned sum, cnt, mine, sp = 0u;
    for (;;) {
        sum = 0u; cnt = 0u; mine = 0u;
#pragma unroll
        for (unsigned j = 0; j < 16; ++j) { const unsigned c = xb_ld(&bar[XB_XCNT(j)]); sum += c; cnt += (c > 0u) ? 1u : 0u; mine = (j == x) ? c : mine; }
        if (sum == G) break;
        __builtin_amdgcn_s_sleep(1);
        if ((++sp & 255u) == 0u) { if (xb_ld(&bar[XB_TMO])) break; if (sp > XB_SPIN_CAP) { atomicAdd(&bar[XB_TMO], 1u); break; } }
    }
    nloc = mine > 0u ? mine : 1u; nx = cnt > 0u ? cnt : 1u;
}
template <class BG>
__device__ __forceinline__ void xcd_barrier(unsigned* bar_, volatile LAS unsigned* st, BG& bg) {
    asm volatile("s_waitcnt vmcnt(0)" ::: "memory");
    __syncthreads();
    const unsigned flag0 = st[2];
    if (threadIdx.x >= 64) {
        while (st[2] == flag0) bg.step();
        bg.park();
    } else if (threadIdx.x == 0) {
        unsigned* bar = bar_; asm volatile("" : "+v"(bar));
        const unsigned bx = xb_xcc_id();
        __builtin_amdgcn_s_waitcnt(0);
        unsigned nloc = st[0], nx = st[1];
        if (nloc == 0u) { xcd_barrier_complete(bar, bx, nloc, nx); st[0] = nloc; st[1] = nx; }
        const unsigned old = xb_add(&bar[XB_XSUB(bx)], 1u);
        const unsigned gen = old / nloc;
        if (old + 1u == (gen + 1u) * nloc) {
            __builtin_amdgcn_fence(__ATOMIC_RELEASE, "agent");
            asm volatile("s_waitcnt vmcnt(0)" ::: "memory");
            const unsigned og = xb_add(&bar[XB_TOP], 1u);
            const unsigned tg = og / nx;
            if (og + 1u == (tg + 1u) * nx) xb_add(&bar[XB_TOPGEN], 1u);
            else XB_SPIN(xb_ld(&bar[XB_TOPGEN]) == tg, bar);
            __builtin_amdgcn_fence(__ATOMIC_ACQUIRE, "agent");
            xb_add(&bar[XB_XGEN(bx)], 1u);
            asm volatile("s_waitcnt vmcnt(0)" ::: "memory");
        } else {
            XB_SPIN(xb_ld(&bar[XB_XGEN(bx)]) == gen, bar);
            __builtin_amdgcn_fence(__ATOMIC_ACQUIRE, "agent");
            asm volatile("s_waitcnt vmcnt(0)" ::: "memory");
        }
        st[2] = flag0 + 1u;
    }
    __syncthreads();
}
constexpr int BM = 256, BK = 64, HALF = 128, HTB = HALF * BK * 2, STAGE_BYTES = 8 * HTB, NXCD = 8, WGM = 8;
constexpr int LDS_TABO = STAGE_BYTES;
constexpr int LDS_TABT = LDS_TABO + 3072;
constexpr int LDS_TABG = LDS_TABT + 3072;
constexpr int LDS_SH = LDS_TABG + 3072;
__host__ __device__ __forceinline__ int lds_byte(int r, int c) { const int st = (r >> 4) * 2 + (c >> 5), rr = r & 15, cc = c & 31, ob = rr * 64 + cc * 2; return st * 1024 + (ob ^ (((ob >> 9) & 1) << 5)); }
__host__ __device__ __forceinline__ void stage_rc(int b, int& R, int& C) { const int st = b / 1024, sb = b % 1024, swz = sb ^ (((sb >> 9) & 1) << 5); R = (st >> 1) * 16 + swz / 64; C = (st & 1) * 32 + (swz % 64) / 2; }
__host__ __device__ __forceinline__ int perm32(int rho) { const int n = rho >> 4, i = rho & 15; return 8 * (i >> 2) + 4 * n + (i & 3); }
struct Unit { int pm, pn, e, slot; };
__device__ __forceinline__ int xcd_chunk(int wgid, int nwg) { const int q = nwg / NXCD, r = nwg % NXCD, xcd = wgid % NXCD, off = wgid / NXCD; return (xcd < r ? xcd * (q + 1) : r * (q + 1) + (xcd - r) * q) + off; }

enum { EPI_GLU = 0, EPI_OPROJ, EPI_KVQ, EPI_MOE1, EPI_MOE2 };
struct GemmDesc {
    int kind, K, perm, gather, moe, skip_epi, stride, vb;
    int nM, nN, nwg, npn; const char* A; const char* Bt; size_t tstepA, tstepB, wstride; const int* cnt; const int* LTOK; const float* LGATE;
    const float* res32; const bf16_t* res16; bf16_t* Hout; float* SSQ; const float* bias; const float* bias2; const float* rstd; bf16_t* O1; bf16_t* O2; bf16_t* O3; int jq, cbase;
};
__device__ __forceinline__ bool order_next(const GemmDesc& g, LAS unsigned char* lds, int i, Unit& u) {
    const int L = i * g.stride + g.vb; if (L >= g.nwg) return false;
    const int wgid = xcd_chunk(L, g.nwg);
    if (g.moe) {
        const LAS int* sh = (const LAS int*)(lds + LDS_SH);
        int e = 0;
        for (int q = 1; q < 32; ++q) if (wgid >= g.npn * sh[q]) e = q;
        const int nmt = sh[e + 1] - sh[e], local = wgid - g.npn * sh[e];
        u.pn = local / nmt; u.pm = sh[e] + (local - u.pn * nmt); u.e = e; u.slot = i % 3;
    } else {
        const int nig = WGM * g.nN, gid = wgid / nig, fm = gid * WGM, gsz = (g.nM - fm) < WGM ? (g.nM - fm) : WGM;
        u.pm = fm + ((wgid % nig) % gsz); u.pn = (wgid % nig) / gsz; u.e = 0; u.slot = 0;
    }
    return true;
}
__device__ __forceinline__ const char* order_a(const GemmDesc& g, const Unit& u) { return g.gather ? g.A : g.A + (size_t)u.pm * g.tstepA; }
__device__ __forceinline__ const char* order_b(const GemmDesc& g, const Unit& u) { return g.Bt + (size_t)u.e * g.wstride + (size_t)u.pn * g.tstepB; }
__device__ __forceinline__ void order_fill(const GemmDesc& g, LAS unsigned char* lds, const Unit& u) {
    const int t = opaque_tid();
    if (t < 256) {
        const LAS int* sh = (const LAS int*)(lds + LDS_SH);
        const int ne = g.cnt[u.e], idx = (u.pm - sh[u.e]) * 256 + t, ci = idx < ne ? idx : ne - 1;
        const int v = g.LTOK[(size_t)u.e * RT + ci];
        ((LAS unsigned*)(lds + LDS_TABO))[u.slot * 256 + t] = (unsigned)(v & 0x3fffffff) * (unsigned)(D * 2);
        ((LAS int*)(lds + LDS_TABT))[u.slot * 256 + t] = idx < ne ? v : -1;
        ((LAS float*)(lds + LDS_TABG))[u.slot * 256 + t] = g.LGATE[(size_t)u.e * RT + ci];
    }
}
__device__ __forceinline__ void gemm_epilogue(const GemmDesc& g, LAS unsigned char* lds, const f32x4 (&acc)[2][2][4][2], const Unit& u, int wr, int wc, int fr, int fq);

__device__ __forceinline__ void gemm_run(LAS unsigned char* lds, const GemmDesc& g) {
    const int tid = opaque_tid(), wid = __builtin_amdgcn_readfirstlane(tid >> 6), lane = tid & 63, wr = wid >> 2, wc = wid & 3, fr = lane & 15, fq = lane >> 4;
    const int K = g.K, nt = K / BK;
    unsigned voffA[2], voffB[2]; int Rr[2], Cc[2];
#pragma unroll
    for (int i = 0; i < 2; ++i) { int R, C; stage_rc(tid * 16 + i * 8192, R, C); const int Rb = g.perm ? ((R & ~31) + perm32(R & 31)) : R;
        voffA[i] = (unsigned)(R * K + C) * 2u; voffB[i] = (unsigned)(Rb * K + C) * 2u; Rr[i] = R * 4; Cc[i] = C * 2; }
    const size_t kstep = (size_t)(BK * 2);
    const size_t hstep = (size_t)HALF * K * 2;
    const unsigned ldsw = (unsigned)wid * 1024u;
    const int aoff = lds_byte(wr * 64 + fr, fq * 8), boff = lds_byte(wc * 32 + fr, fq * 8);
#define PG8_SA(b, h) (((b) * 2 + (h)) * HTB)
#define PG8_SB(b, h) ((4 + (b) * 2 + (h)) * HTB)
#define PG8_GLDS(src, dstoff) __builtin_amdgcn_global_load_lds((const unsigned*)(src), (LAS unsigned*)(lds + (dstoff)), 16, 0, 0)
#define PG8_STAGE_B(bufoff, gbase) do { _Pragma("unroll") for (int _i = 0; _i < 2; ++_i) PG8_GLDS((const char*)(gbase) + voffB[_i], (bufoff) + ldsw + _i * 8192); } while (0)
#define PG8_STAGE_A(bufoff, gbase, tsel, kt, h) do { if (g.gather) { \
            const unsigned _o0 = *(const LAS unsigned*)(lds + LDS_TABO + (tsel) * 1024 + (h) * 512 + Rr[0]), _o1 = *(const LAS unsigned*)(lds + LDS_TABO + (tsel) * 1024 + (h) * 512 + Rr[1]); \
            PG8_GLDS((const char*)(gbase) + (size_t)(kt) * kstep + _o0 + Cc[0], (bufoff) + ldsw); PG8_GLDS((const char*)(gbase) + (size_t)(kt) * kstep + _o1 + Cc[1], (bufoff) + ldsw + 8192); \
        } else { _Pragma("unroll") for (int _i = 0; _i < 2; ++_i) PG8_GLDS((const char*)(gbase) + (size_t)(kt) * kstep + (size_t)(h) * hstep + voffA[_i], (bufoff) + ldsw + _i * 8192); } } while (0)
#define PG8_LDA(dst, b, h) do { _Pragma("unroll") for (int m = 0; m < 4; ++m) _Pragma("unroll") for (int k = 0; k < 2; ++k) dst[m][k] = *(const LAS bf16x8*)(lds + PG8_SA(b, h) + aoff + m * 2048 + k * 1024); } while (0)
#define PG8_LDB(dst, b, h) do { _Pragma("unroll") for (int n = 0; n < 2; ++n) _Pragma("unroll") for (int k = 0; k < 2; ++k) dst[n][k] = *(const LAS bf16x8*)(lds + PG8_SB(b, h) + boff + n * 2048 + k * 1024); } while (0)
#define PG8_MMA(ai, bj, At, Bt) do { __builtin_amdgcn_s_setprio(1); _Pragma("unroll") for (int m = 0; m < 4; ++m) _Pragma("unroll") for (int n = 0; n < 2; ++n) _Pragma("unroll") for (int k = 0; k < 2; ++k) \
        acc[ai][bj][m][n] = __builtin_amdgcn_mfma_f32_16x16x32_bf16(Bt[n][k], At[m][k], acc[ai][bj][m][n], 0, 0, 0); __builtin_amdgcn_s_setprio(0); } while (0)
#define PG8_WAIT_V(n) asm volatile("s_waitcnt vmcnt(" #n ")" ::: "memory")
#define PG8_WAIT_L(n) asm volatile("s_waitcnt lgkmcnt(" #n ")" ::: "memory")
#define PG8_BAR __builtin_amdgcn_s_barrier()
#define PG8_SCHED __builtin_amdgcn_sched_barrier(0)
    Unit cur, nxt; int ui = 0;
    if (!order_next(g, lds, 0, cur)) return;
    f32x4 acc[2][2][4][2];
#pragma unroll
    for (int a = 0; a < 2; ++a)
#pragma unroll
        for (int b = 0; b < 2; ++b)
#pragma unroll
            for (int m = 0; m < 4; ++m)
#pragma unroll
                for (int n = 0; n < 2; ++n) acc[a][b][m][n] = (f32x4){0.f, 0.f, 0.f, 0.f};
    bf16x8 At[4][2], B0[2][2], B1[2][2];
    if (g.moe) { order_fill(g, lds, cur); __syncthreads(); }
    const char* cA = order_a(g, cur); const char* cB = order_b(g, cur); int cT = cur.slot;
    PG8_STAGE_B(PG8_SB(0, 0), cB); PG8_STAGE_B(PG8_SB(0, 1), cB + hstep); PG8_STAGE_A(PG8_SA(0, 0), cA, cT, 0, 0); PG8_STAGE_A(PG8_SA(0, 1), cA, cT, 0, 1);
    if (wr == 1) PG8_BAR;
    PG8_WAIT_V(2); PG8_BAR;
    PG8_STAGE_B(PG8_SB(1, 0), cB + kstep); PG8_STAGE_A(PG8_SA(1, 0), cA, cT, 1, 0); PG8_STAGE_B(PG8_SB(1, 1), cB + hstep + kstep);
    PG8_WAIT_V(6); PG8_BAR;
    for (;;) {
        const bool has_next = order_next(g, lds, ui + 1, nxt);
        if (g.moe && has_next) order_fill(g, lds, nxt);
        const char* nA = has_next ? order_a(g, nxt) : cA; const char* nB = has_next ? order_b(g, nxt) : cB; const int nT = has_next ? nxt.slot : cT;
        for (int t = 0; t < nt; t += 2) {
            const bool last = (t == nt - 2);
            const char* a2b = last ? nA : cA; const int a2T = last ? nT : cT, a2k = last ? 0 : t + 2, a3k = a2k + 1;
            const char* b2 = last ? nB : cB + (size_t)(t + 2) * kstep; const char* b3 = b2 + kstep;
            PG8_LDB(B0, 0, 0); PG8_LDB(B1, 0, 1); PG8_SCHED; PG8_LDA(At, 0, 0); PG8_STAGE_A(PG8_SA(1, 1), cA, cT, t + 1, 1);
            PG8_WAIT_V(8); PG8_WAIT_L(0); PG8_BAR; PG8_MMA(0, 0, At, B0); PG8_MMA(0, 1, At, B1); PG8_BAR; PG8_SCHED;
            PG8_LDA(At, 0, 1); PG8_STAGE_B(PG8_SB(0, 0), b2); PG8_STAGE_B(PG8_SB(0, 1), b2 + hstep); PG8_STAGE_A(PG8_SA(0, 0), a2b, a2T, a2k, 0);
            PG8_WAIT_V(8); PG8_WAIT_L(0); PG8_BAR; PG8_MMA(1, 0, At, B0); PG8_MMA(1, 1, At, B1); PG8_BAR; PG8_SCHED;
            PG8_LDB(B0, 1, 0); PG8_LDB(B1, 1, 1); PG8_SCHED; PG8_LDA(At, 1, 0); PG8_STAGE_A(PG8_SA(0, 1), a2b, a2T, a2k, 1);
            PG8_WAIT_V(8); PG8_WAIT_L(0); PG8_BAR; PG8_MMA(0, 0, At, B0); PG8_MMA(0, 1, At, B1); PG8_BAR; PG8_SCHED;
            PG8_LDA(At, 1, 1); PG8_STAGE_B(PG8_SB(1, 0), b3); PG8_STAGE_B(PG8_SB(1, 1), b3 + hstep); PG8_STAGE_A(PG8_SA(1, 0), a2b, a2T, a3k, 0);
            PG8_WAIT_V(8); PG8_WAIT_L(0); PG8_BAR; PG8_MMA(1, 0, At, B0); PG8_MMA(1, 1, At, B1); PG8_BAR; PG8_SCHED;
        }
        if (wr == 0) PG8_BAR;
        if (!g.skip_epi) gemm_epilogue(g, lds, acc, cur, wr, wc, fr, fq);
        if (!has_next) break;
#pragma unroll
        for (int a = 0; a < 2; ++a)
#pragma unroll
            for (int b = 0; b < 2; ++b)
#pragma unroll
                for (int m = 0; m < 4; ++m)
#pragma unroll
                    for (int n = 0; n < 2; ++n) acc[a][b][m][n] = (f32x4){0.f, 0.f, 0.f, 0.f};
        cur = nxt; cA = nA; cB = nB; cT = nT; ++ui;
        if (wr == 1) PG8_BAR;
    }
    PG8_WAIT_V(0);
    PG8_BAR;
#undef PG8_SA
#undef PG8_SB
#undef PG8_GLDS
#undef PG8_STAGE_A
#undef PG8_STAGE_B
#undef PG8_LDA
#undef PG8_LDB
#undef PG8_MMA
#undef PG8_WAIT_V
#undef PG8_WAIT_L
#undef PG8_BAR
#undef PG8_SCHED
}
__device__ __forceinline__ f32x4 meta_dot(const bf16_t* Am, const bf16_t* Brow0, int K, int fr, int fq) {
    f32x4 acc = {0.f, 0.f, 0.f, 0.f};
    const bf16_t* ap = Am + (size_t)fr * K + 8 * fq; const bf16_t* bp = Brow0 + (size_t)fr * K + 8 * fq;
#pragma unroll 4
    for (int ks = 0; ks < K / 32; ++ks) acc = mfma16(as_bf16x8(*(const u32x4*)(bp + 32 * ks)), as_bf16x8(*(const u32x4*)(ap + 32 * ks)), acc);
    return acc;
}

struct ConvDesc { const float* src; const float* gain; bf16_t* dst; int ld, K, mode, kblk, nblk; };
constexpr int NWT_E = 768;
constexpr int NWT_MOE = 4 * 32 * NWT_E, NWT_DENSE = 2 * 1024 + 256 + 2 * 512 + 2 * 512;
__device__ __forceinline__ ConvDesc conv_decode(CArgs& a, int ti) {
    ConvDesc d;
    if (ti < NWT_MOE) {
        const int le = ti / NWT_E, r = ti % NWT_E, which = r >> 8, tt = r & 255, layer = le >> 5;
        if (which < 2) { d.src = a.in[26 + which] + (size_t)le * D * DEXP; d.ld = DEXP; d.K = D; d.gain = a.in[3] + (size_t)layer * D; d.dst = (bf16_t*)(a.ws + WS_W1) + (size_t)le * 1024 * 1024; d.mode = 1 + which; d.nblk = tt & 15; d.kblk = tt >> 4; }
        else { d.src = a.in[28] + (size_t)le * DEXP * D; d.ld = D; d.K = DEXP; d.gain = nullptr; d.dst = (bf16_t*)(a.ws + WS_W2) + (size_t)le * 1024 * 512; d.mode = 0; d.nblk = tt & 31; d.kblk = tt >> 5; }
    } else {
        int r = ti - NWT_MOE;
        if (r < 2048) { const int layer = r >> 10, tt = r & 1023, nb = tt & 63, half = nb >> 5;
            d.src = a.in[14] + (size_t)layer * D * 2 * D + half * D; d.ld = 2 * D; d.K = D; d.gain = nullptr; d.dst = (bf16_t*)(a.ws + WS_WGLU) + (size_t)layer * 2048 * 1024; d.mode = 1 + half; d.nblk = nb & 31; d.kblk = tt >> 6; }
        else if ((r -= 2048) < 256) { d.src = a.in[15]; d.ld = 512; d.K = D; d.gain = a.in[4]; d.dst = (bf16_t*)(a.ws + WS_WKVQ); d.mode = 0; d.nblk = r & 15; d.kblk = r >> 4; }
        else if ((r -= 256) < 1024) { const int j = r >> 9, tt = r & 511;
            d.src = a.in[17] + (size_t)j * D * D; d.ld = D; d.K = D; d.gain = a.in[2] + (size_t)(2 + j) * D; d.dst = j == 0 ? (bf16_t*)(a.ws + WS_WKVQ) + (size_t)512 * 1024 : (bf16_t*)(a.ws + WS_WQ1); d.mode = 0; d.nblk = tt & 31; d.kblk = tt >> 5; }
        else { r -= 1024; const int j = r >> 9, tt = r & 511;
            d.src = a.in[20] + (size_t)j * D * D; d.ld = D; d.K = D; d.gain = nullptr; d.dst = (bf16_t*)(a.ws + WS_WO) + (size_t)j * 1024 * 1024; d.mode = 0; d.nblk = tt & 31; d.kblk = tt >> 5; }
    }
    return d;
}
__device__ __forceinline__ void conv_load(const ConvDesc& d, int lane, f32x4 (&v)[8]) {
    const float* p = d.src + (size_t)(d.kblk * 64 + 8 * (lane >> 3)) * d.ld + d.nblk * 32 + 4 * (lane & 7);
#pragma unroll
    for (int j = 0; j < 8; ++j) v[j] = __builtin_nontemporal_load((const f32x4*)(p + (size_t)j * d.ld));
}
__device__ __forceinline__ void conv_store(const ConvDesc& d, int lane, f32x4 (&v)[8]) {
    const int k0 = d.kblk * 64 + 8 * (lane >> 3);
    if (d.gain) { const f32x4 g0 = *(const f32x4*)(d.gain + k0), g1 = *(const f32x4*)(d.gain + k0 + 4);
        v[0] *= g0[0]; v[1] *= g0[1]; v[2] *= g0[2]; v[3] *= g0[3]; v[4] *= g1[0]; v[5] *= g1[1]; v[6] *= g1[2]; v[7] *= g1[3]; }
    const int n = d.nblk * 32 + 4 * (lane & 7), row = d.mode == 0 ? n : (256 * (n >> 7) + (n & 127) + (d.mode == 2 ? 128 : 0));
    bf16_t* q = d.dst + (size_t)row * d.K + k0;
#pragma unroll
    for (int c = 0; c < 4; ++c) {
        u32x4 w; w.x = cvt_pk_bf16(v[0][c], v[1][c]); w.y = cvt_pk_bf16(v[2][c], v[3][c]); w.z = cvt_pk_bf16(v[4][c], v[5][c]); w.w = cvt_pk_bf16(v[6][c], v[7][c]);
        asm volatile("global_store_dwordx4 %0, %1, off sc1\n\ts_nop 1" :: "v"(q + (size_t)c * d.K), "v"(w) : "memory");
    }
}
__device__ __forceinline__ void convert_weights(CArgs& a) {
    const int lane = opaque_tid() & 63, gw = (opaque_tid() >> 6) * GRID + opaque_bid();
    for (int ti = NWT_MOE + gw; ti < NWT_MOE + NWT_DENSE; ti += GRID * 8) {
        const ConvDesc d = conv_decode(a, ti); f32x4 v[8];
        conv_load(d, lane, v); conv_store(d, lane, v);
    }
}
struct BgConv {
    CArgs* a; volatile LAS unsigned* st;
    __device__ __forceinline__ int claim() const {
        int t = 0;
        if ((opaque_tid() & 63) == 0) { const unsigned x = xb_xcc_id() & 7u; t = (int)(xb_add((unsigned*)(a->ws + WS_CTL) + CW_BGC + 64 * x, 1u) * 16u + x); }
        return __builtin_amdgcn_readfirstlane(t);
    }
    __device__ __forceinline__ void run(int t) const { const int lane = opaque_tid() & 63; const ConvDesc d = conv_decode(*a, t); f32x4 v[8]; conv_load(d, lane, v); conv_store(d, lane, v); }
    __device__ __forceinline__ int claim_run() {
        const int t = claim();
        if (t < NWT_MOE) run(t);
        if (t + 8 < NWT_MOE) run(t + 8); else if ((opaque_tid() & 63) == 0) st[3] = 1u;
        return t + 8;
    }
    __device__ __forceinline__ void step() { if (st[3] == 0u) (void)claim_run(); else __builtin_amdgcn_s_sleep(32); }
    __device__ __forceinline__ void park() {}
    __device__ __forceinline__ void run_until(int limit, int budget) {
        for (int n = 0; n < budget; ++n) { if (st[3] != 0u) break; if (claim_run() >= limit) break; }
    }
};

struct cplx { float re, im; };
__device__ __forceinline__ cplx cmul(cplx a, cplx b) { return {a.re * b.re - a.im * b.im, a.re * b.im + a.im * b.re}; }

__device__ __forceinline__ void s5_tables(CArgs& a, int layer, int g, LAS unsigned char* lds) {
    LAS f32x2* pw = (LAS f32x2*)lds;
    LAS f32x2* bb = (LAS f32x2*)(lds + 64 * 17 * 8);
    LAS f32x2* cc = bb + 64 * 16;
    const int tid = opaque_tid();
    const float* a_re = a.in[6] + ((size_t)layer * 64 + g) * 64; const float* a_im = a.in[7] + ((size_t)layer * 64 + g) * 64;
    const float dt = expf(a.in[8][layer * 64 + g]);
    for (int idx = tid; idx < 64 * 17; idx += NTHREADS) {
        const int p = idx / 17, d = idx % 17;
        const float mag = expf(a_re[p] * dt * (float)d), ang = a_im[p] * dt * (float)d;
        float s, c; sincosf(ang, &s, &c);
        pw[idx] = (f32x2){mag * c, mag * s};
    }
    const float* b_re = a.in[9] + ((size_t)layer * 64 + g) * 1024; const float* b_im = a.in[10] + ((size_t)layer * 64 + g) * 1024;
    const float* c_re = a.in[11] + ((size_t)layer * 64 + g) * 1024; const float* c_im = a.in[12] + ((size_t)layer * 64 + g) * 1024;
    for (int idx = tid; idx < 1024; idx += NTHREADS) {
        const int p = idx >> 4;
        const float lr = a_re[p], li = a_im[p];
        const float mag = expf(lr * dt), ang = li * dt; float s, c; sincosf(ang, &s, &c);
        const float nr = mag * c - 1.0f, ni = mag * s;
        const float den = 1.0f / (lr * lr + li * li);
        const cplx f = {(nr * lr + ni * li) * den, (ni * lr - nr * li) * den};
        const cplx r = cmul(f, (cplx){b_re[idx], b_im[idx]});
        bb[idx] = (f32x2){r.re, r.im};
        cc[idx] = (f32x2){c_re[idx], c_im[idx]};
    }
    __syncthreads();
    unsigned char* tbl = a.ws + WS_TBL + ((size_t)layer * 64 + g) * TBL_STRIDE;
    for (int idx = tid; idx < 16 * 64; idx += NTHREADS) {
        const int delta = idx >> 6, l = idx & 63, c1 = l & 15, q4 = l >> 4, d = delta - (q4 >> 1);
        float v[8];
#pragma unroll
        for (int j = 0; j < 8; ++j) v[j] = 0.f;
        if (d >= 0) {
            for (int p = 0; p < 64; ++p) {
                const f32x2 cw = cc[c1 * 64 + p], pp = pw[p * 17 + d];
                const cplx t = cmul((cplx){cw.x, cw.y}, (cplx){pp.x, pp.y});
#pragma unroll
                for (int j = 0; j < 8; ++j) { const f32x2 bw = bb[p * 16 + 8 * (q4 & 1) + j]; v[j] += t.re * bw.x - t.im * bw.y; }
            }
        }
        u32x4 w; w.x = cvt_pk_bf16(v[0], v[1]); w.y = cvt_pk_bf16(v[2], v[3]); w.z = cvt_pk_bf16(v[4], v[5]); w.w = cvt_pk_bf16(v[6], v[7]);
        *(u32x4*)(tbl + TBL_K + (size_t)idx * 16) = w;
    }
    for (int idx = tid; idx < 64 * 64; idx += NTHREADS) {
        const int f = idx >> 6, l = idx & 63, rt = f >> 3, ks = f & 7, q4 = l >> 4, rho = 16 * rt + (l & 15), p = rho & 63, im = rho >> 6;
        const int k0 = 32 * ks + 8 * q4, jpos = k0 >> 4, c20 = k0 & 15;
        const f32x2 pp = pw[p * 17 + (15 - jpos)];
        float v[8];
#pragma unroll
        for (int j = 0; j < 8; ++j) { const f32x2 bw = bb[p * 16 + c20 + j]; const cplx t = cmul((cplx){pp.x, pp.y}, (cplx){bw.x, bw.y}); v[j] = im ? t.im : t.re; }
        u32x4 w; w.x = cvt_pk_bf16(v[0], v[1]); w.y = cvt_pk_bf16(v[2], v[3]); w.z = cvt_pk_bf16(v[4], v[5]); w.w = cvt_pk_bf16(v[6], v[7]);
        *(u32x4*)(tbl + TBL_M + (size_t)idx * 16) = w;
    }
    for (int idx = tid; idx < 64 * 64; idx += NTHREADS) {
        const int f = idx >> 6, l = idx & 63, i = f >> 2, ks = f & 3, q4 = l >> 4, c1 = l & 15;
        const int s0 = 32 * ks + 8 * q4;
        float v[8];
#pragma unroll
        for (int j = 0; j < 8; ++j) { const int sg = s0 + j, p = sg & 63; const f32x2 cw = cc[c1 * 64 + p], pp = pw[p * 17 + i + 1];
            const cplx t = cmul((cplx){cw.x, cw.y}, (cplx){pp.x, pp.y}); v[j] = (sg >> 6) ? -t.im : t.re; }
        u32x4 w; w.x = cvt_pk_bf16(v[0], v[1]); w.y = cvt_pk_bf16(v[2], v[3]); w.z = cvt_pk_bf16(v[4], v[5]); w.w = cvt_pk_bf16(v[6], v[7]);
        *(u32x4*)(tbl + TBL_N + (size_t)idx * 16) = w;
    }
    if (tid < 64) *(f32x2*)(tbl + TBL_A16 + tid * 8) = pw[tid * 17 + 16];
    __syncthreads();
}

__device__ __forceinline__ void row_norm_store(const f32x4 (&v)[4], float ssq, int lane, const float* g0, bf16_t* o0) {
    const float rstd = 1.0f / sqrtf(ssq * (1.0f / D) + RMS_EPS);
#pragma unroll
    for (int j = 0; j < 4; ++j) {
        const int c = 4 * lane + 256 * j;
        f32x4 g = {1.f, 1.f, 1.f, 1.f}; if (g0) g = *(const f32x4*)(g0 + c);
        u32x2 w; w.x = cvt_pk_bf16(v[j][0] * rstd * g[0], v[j][1] * rstd * g[1]); w.y = cvt_pk_bf16(v[j][2] * rstd * g[2], v[j][3] * rstd * g[3]);
        *(u32x2*)(o0 + c) = w;
    }
}
__device__ __forceinline__ void phase_prep(CArgs& a, LAS unsigned char* lds) {
    if (opaque_bid() < 128) s5_tables(a, opaque_bid() >> 6, opaque_bid() & 63, lds);
    else if (opaque_bid() < 128 + 48) {
        const int item = (opaque_bid() - 128) * NTHREADS + opaque_tid(), layer = item / 6144, idx = item % 6144;
        const float* wg = a.in[22] + (size_t)layer * D * NGRP; const float* we = a.in[24] + (size_t)layer * D * NEXP; const float* gain = a.in[3] + (size_t)layer * D;
        const int l = idx & 63, ks = (idx >> 6) & 31, rt = idx >> 11, o = 16 * rt + (l & 15), k0 = 32 * ks + 8 * (l >> 4);
        float v[8];
#pragma unroll
        for (int jq = 0; jq < 8; ++jq) v[jq] = (o < 4 ? wg[(size_t)(k0 + jq) * NGRP + o] : (o < 36 ? we[(size_t)(k0 + jq) * NEXP + (o - 4)] : 0.f)) * gain[k0 + jq];
        u32x4 w; w.x = cvt_pk_bf16(v[0], v[1]); w.y = cvt_pk_bf16(v[2], v[3]); w.z = cvt_pk_bf16(v[4], v[5]); w.w = cvt_pk_bf16(v[6], v[7]);
        *(u32x4*)(a.ws + WS_RW + (size_t)layer * 98304 + (size_t)idx * 16) = w;
    }
    convert_weights(a);
    const int lane = opaque_tid() & 63, gw = opaque_bid() * 8 + (opaque_tid() >> 6);
    float* RSTD = (float*)(a.ws + WS_RSTD);
    for (int row = gw; row < RT; row += GRID * 8) {
        const float* src = row < NREAL ? a.in[0] + (size_t)row * D : a.in[1] + (size_t)(row - NREAL) * D;
        float ssq = 0.f;
#pragma unroll
        for (int j = 0; j < 4; ++j) { const f32x4 v = *(const f32x4*)(src + 4 * lane + 256 * j); ssq += v[0] * v[0] + v[1] * v[1] + v[2] * v[2] + v[3] * v[3]; }
        ssq = wave_sum(ssq);
        if (lane == 0) RSTD[row] = 1.0f / sqrtf(ssq * (1.0f / D) + RMS_EPS);
    }
}

constexpr int S5_CH = 528;
constexpr int S5_NCH = 129, S5_NCHP = 144;
__device__ __forceinline__ void phase_s5(CArgs& a, int layer, LAS unsigned char* lds) {
    LAS unsigned char* Ul = lds; LAS unsigned char* Sl = lds + S5_NCHP * S5_CH;
    const int tid = opaque_tid(), lane = tid & 63, w = __builtin_amdgcn_readfirstlane(tid >> 6), tc = lane & 15, q4 = lane >> 4;
    const bf16_t* H = (const bf16_t*)(a.ws + WS_H); const float* RSTD = (const float*)(a.ws + WS_RSTD); bf16_t* Z = (bf16_t*)(a.ws + WS_Z);
    for (int ui = 0; ui < 2; ++ui) {
        const int unit = opaque_bid() * 2 + ui, b = unit >> 6, g = unit & 63;
        const unsigned char* tbl = a.ws + WS_TBL + ((size_t)layer * 64 + g) * TBL_STRIDE;
        for (int idx = tid; idx < LT * 2; idx += NTHREADS) {
            const int tok = idx >> 1, half = idx & 1, row = row_of(b, tok), c = 16 * g + 8 * half;
            const float rs = RSTD[row]; const f32x4 g0 = *(const f32x4*)(a.in[2] + (size_t)layer * D + c), g1 = *(const f32x4*)(a.in[2] + (size_t)layer * D + c + 4);
            float hv[8];
            if (layer == 0) { const float* src = (row < NREAL ? a.in[0] + (size_t)row * D : a.in[1] + (size_t)(row - NREAL) * D) + c; const f32x4 x0 = *(const f32x4*)src, x1 = *(const f32x4*)(src + 4);
                hv[0] = x0[0]; hv[1] = x0[1]; hv[2] = x0[2]; hv[3] = x0[3]; hv[4] = x1[0]; hv[5] = x1[1]; hv[6] = x1[2]; hv[7] = x1[3]; }
            else { const u32x4 w = *(const u32x4*)(H + (size_t)row * D + c); hv[0] = bf16_lo(w.x); hv[1] = bf16_hi(w.x); hv[2] = bf16_lo(w.y); hv[3] = bf16_hi(w.y); hv[4] = bf16_lo(w.z); hv[5] = bf16_hi(w.z); hv[6] = bf16_lo(w.w); hv[7] = bf16_hi(w.w); }
            u32x4 v; v.x = cvt_pk_bf16(hv[0] * rs * g0[0], hv[1] * rs * g0[1]); v.y = cvt_pk_bf16(hv[2] * rs * g0[2], hv[3] * rs * g0[3]);
            v.z = cvt_pk_bf16(hv[4] * rs * g1[0], hv[5] * rs * g1[1]); v.w = cvt_pk_bf16(hv[6] * rs * g1[2], hv[7] * rs * g1[3]);
            *(LAS u32x4*)(Ul + (tok >> 4) * S5_CH + (tok & 15) * 32 + half * 16) = v;
        }
        __syncthreads();
        {
            bf16x8 mf[8];
#pragma unroll
            for (int ks = 0; ks < 8; ++ks) mf[ks] = as_bf16x8(*(const u32x4*)(tbl + TBL_M + ((size_t)(w * 8 + ks) * 64 + lane) * 16));
#pragma unroll 1
            for (int cg = 0; cg < 9; ++cg) {
                const int n = 16 * cg + tc;
                f32x4 acc = {0.f, 0.f, 0.f, 0.f};
#pragma unroll
                for (int ks = 0; ks < 8; ++ks) { const bf16x8 ub = *(LAS bf16x8*)(Ul + n * S5_CH + ks * 64 + q4 * 16); acc = mfma16(mf[ks], ub, acc); }
                *(LAS f32x4*)(Sl + n * S5_CH + (16 * w + 4 * q4) * 4) = acc;
            }
        }
        __syncthreads();
        if (w == 0) {
            const f32x2 a16 = *(const f32x2*)(tbl + TBL_A16 + lane * 8);
            float sr = 0.f, si = 0.f;
#pragma unroll 1
            for (int nb = 0; nb < 17; ++nb) {
                float xr[8], xi[8];
#pragma unroll
                for (int j = 0; j < 8; ++j) { xr[j] = *(LAS float*)(Sl + (nb * 8 + j) * S5_CH + lane * 4); xi[j] = *(LAS float*)(Sl + (nb * 8 + j) * S5_CH + 256 + lane * 4); }
                asm volatile("s_waitcnt lgkmcnt(0)" ::: "memory");
#pragma unroll
                for (int j = 0; j < 8; ++j) {
                    const unsigned pr = cvt_pk_bf16(sr, si);
                    *(LAS unsigned short*)(Sl + (nb * 8 + j) * S5_CH + lane * 2) = (unsigned short)(pr & 0xffffu);
                    *(LAS unsigned short*)(Sl + (nb * 8 + j) * S5_CH + 128 + lane * 2) = (unsigned short)(pr >> 16);
                    const float nr = a16.x * sr - a16.y * si + xr[j], ni = a16.x * si + a16.y * sr + xi[j];
                    sr = nr; si = ni;
                }
                asm volatile("" ::: "memory");
            }
        }
        __syncthreads();
        {
            const int i0 = w, i1 = 15 - w;
            bf16x8 kf0[8], kf1[8], nf0[4], nf1[4];
#pragma unroll
            for (int jj = 0; jj < 8; ++jj) {
                const int d0 = i0 - 2 * jj, d1 = i1 - 2 * jj;
                kf0[jj] = as_bf16x8(*(const u32x4*)(tbl + TBL_K + ((size_t)(d0 >= 0 ? d0 : 0) * 64 + lane) * 16));
                kf1[jj] = as_bf16x8(*(const u32x4*)(tbl + TBL_K + ((size_t)(d1 >= 0 ? d1 : 0) * 64 + lane) * 16));
            }
#pragma unroll
            for (int ks = 0; ks < 4; ++ks) {
                nf0[ks] = as_bf16x8(*(const u32x4*)(tbl + TBL_N + ((size_t)(i0 * 4 + ks) * 64 + lane) * 16));
                nf1[ks] = as_bf16x8(*(const u32x4*)(tbl + TBL_N + ((size_t)(i1 * 4 + ks) * 64 + lane) * 16));
            }
            const f32x4 dsk = *(const f32x4*)(a.in[13] + (size_t)layer * D + 16 * g + 4 * q4);
#pragma unroll 1
            for (int cg = 0; cg < 9; ++cg) {
                const int n = 16 * cg + tc;
                f32x4 acc0 = {0.f, 0.f, 0.f, 0.f}, acc1 = {0.f, 0.f, 0.f, 0.f};
#pragma unroll
                for (int jj = 0; jj < 8; ++jj) {
                    const bf16x8 ub = *(LAS bf16x8*)(Ul + n * S5_CH + jj * 64 + q4 * 16);
                    if (2 * jj <= i0) acc0 = mfma16(kf0[jj], ub, acc0);
                    if (2 * jj <= i1) acc1 = mfma16(kf1[jj], ub, acc1);
                }
#pragma unroll
                for (int ks = 0; ks < 4; ++ks) {
                    const bf16x8 sb = *(LAS bf16x8*)(Sl + n * S5_CH + ks * 64 + q4 * 16);
                    acc0 = mfma16(nf0[ks], sb, acc0); acc1 = mfma16(nf1[ks], sb, acc1);
                }
                if (n < S5_NCH && (n > 0 || b == 0)) {
#pragma unroll
                    for (int h = 0; h < 2; ++h) {
                        const int i = h ? i1 : i0; const f32x4 y = h ? acc1 : acc0;
                        const u32x2 uw = *(LAS u32x2*)(Ul + n * S5_CH + i * 32 + q4 * 8);
                        const float z0 = gelu_tanh(y[0] + dsk[0] * bf16_lo(uw.x)), z1 = gelu_tanh(y[1] + dsk[1] * bf16_hi(uw.x));
                        const float z2 = gelu_tanh(y[2] + dsk[2] * bf16_lo(uw.y)), z3 = gelu_tanh(y[3] + dsk[3] * bf16_hi(uw.y));
                        u32x2 o; o.x = cvt_pk_bf16(z0, z1); o.y = cvt_pk_bf16(z2, z3);
                        *(u32x2*)(Z + (size_t)row_of(b, 16 * n + i) * D + 16 * g + 4 * q4) = o;
                    }
                }
            }
        }
        __syncthreads();
    }
}

__device__ __forceinline__ float ssq4(f32x4 h) { return h[0] * h[0] + h[1] * h[1] + h[2] * h[2] + h[3] * h[3]; }
__device__ __forceinline__ int gwave() { return opaque_bid() * 8 + (opaque_tid() >> 6); }
template <int NACC> __device__ __forceinline__ bool meta_block(LAS unsigned char* lds, const bf16_t* Am, const bf16_t* const (&brow)[NACC], int K, f32x4 (&out)[NACC]) {
    const int tid = opaque_tid(), lane = tid & 63, wid = tid >> 6, fr = lane & 15, fq = lane >> 4, ksl = K / 8;
#pragma unroll
    for (int i = 0; i < NACC; ++i) {
        f32x4 acc = {0.f, 0.f, 0.f, 0.f};
        const bf16_t* ap = Am + (size_t)fr * K + wid * ksl + 8 * fq; const bf16_t* bp = brow[i] + (size_t)fr * K + wid * ksl + 8 * fq;
        for (int ks = 0; ks < ksl / 32; ++ks) acc = mfma16(as_bf16x8(*(const u32x4*)(bp + 32 * ks)), as_bf16x8(*(const u32x4*)(ap + 32 * ks)), acc);
        ((LAS f32x4*)lds)[(wid * NACC + i) * 64 + lane] = acc;
    }
    __syncthreads();
    if (wid == 0) {
#pragma unroll
        for (int i = 0; i < NACC; ++i) { f32x4 s = {0.f, 0.f, 0.f, 0.f};
#pragma unroll
            for (int w = 0; w < 8; ++w) s += ((LAS f32x4*)lds)[(w * NACC + i) * 64 + lane];
            out[i] = s; }
    }
    __syncthreads();
    return wid == 0;
}

__device__ __forceinline__ void load_res8(const GemmDesc& g, size_t off, float (&h)[8]) {
    if (g.res32) { const f32x4 a = *(const f32x4*)(g.res32 + off), b = *(const f32x4*)(g.res32 + off + 4); h[0] = a[0]; h[1] = a[1]; h[2] = a[2]; h[3] = a[3]; h[4] = b[0]; h[5] = b[1]; h[6] = b[2]; h[7] = b[3]; }
    else { const u32x4 w = *(const u32x4*)(g.res16 + off); h[0] = bf16_lo(w.x); h[1] = bf16_hi(w.x); h[2] = bf16_lo(w.y); h[3] = bf16_hi(w.y); h[4] = bf16_lo(w.z); h[5] = bf16_hi(w.z); h[6] = bf16_lo(w.w); h[7] = bf16_hi(w.w); }
}
__device__ __forceinline__ float store_h8(bf16_t* Hout, size_t off, const float (&h)[8]) {
    u32x4 w; w.x = cvt_pk_bf16(h[0], h[1]); w.y = cvt_pk_bf16(h[2], h[3]); w.z = cvt_pk_bf16(h[4], h[5]); w.w = cvt_pk_bf16(h[6], h[7]);
    *(u32x4*)(Hout + off) = w;
    return (h[0] * h[0] + h[1] * h[1]) + (h[2] * h[2] + h[3] * h[3]) + (h[4] * h[4] + h[5] * h[5]) + (h[6] * h[6] + h[7] * h[7]);
}
__device__ __forceinline__ void epi_glu(const GemmDesc& g, const f32x4 (&acc)[2][2][4][2], const Unit& u, int wr, int wc, int fr, int fq) {
#pragma unroll
    for (int ai = 0; ai < 2; ++ai) {
        const int row0 = u.pm * BM + ai * HALF + wr * 64 + fr; const size_t off0 = (size_t)row0 * D + u.pn * 128 + wc * 32 + 8 * fq;
        float h[4][8];
#pragma unroll
        for (int m = 0; m < 4; ++m) load_res8(g, off0 + (size_t)m * 16 * D, h[m]);
#pragma unroll
        for (int m = 0; m < 4; ++m) {
#pragma unroll
            for (int n = 0; n < 2; ++n) { const f32x4 v = acc[ai][0][m][n], gt = acc[ai][1][m][n];
                h[m][4 * n + 0] += v[0] * sigmoidf_(gt[0]); h[m][4 * n + 1] += v[1] * sigmoidf_(gt[1]); h[m][4 * n + 2] += v[2] * sigmoidf_(gt[2]); h[m][4 * n + 3] += v[3] * sigmoidf_(gt[3]); }
            float ss = store_h8(g.Hout, off0 + (size_t)m * 16 * D, h[m]);
            ss = quad_sum(ss);
            if (fq == 0) g.SSQ[(size_t)(row0 + 16 * m) * 32 + u.pn * 4 + wc] = ss;
        }
        asm volatile("" ::: "memory");
    }
}
__device__ __forceinline__ void phase_glu(CArgs& a, int layer, bool dry, LAS unsigned char* lds, GemmDesc& g) {
    const bf16_t* Zb = (const bf16_t*)(a.ws + WS_Z); const bf16_t* W = (const bf16_t*)(a.ws + WS_WGLU) + (size_t)layer * 2048 * 1024;
    g.res32 = layer == 0 ? a.in[0] : nullptr; g.res16 = (const bf16_t*)(a.ws + WS_H); g.Hout = (bf16_t*)(a.ws + (dry ? WS_DUMH : WS_H)); g.SSQ = (float*)(a.ws + (dry ? WS_DUMSSQ : WS_SSQ));
    if (opaque_bid() < 32) {
        const int lane = opaque_tid() & 63, fr = lane & 15, fq = lane >> 4, task = opaque_bid();
        const int c0 = 32 * task, rv = 256 * (c0 >> 7) + (c0 & 127);
        const bf16_t* const br[4] = {W + (size_t)rv * D, W + (size_t)(rv + 16) * D, W + (size_t)(rv + 128) * D, W + (size_t)(rv + 144) * D};
        f32x4 o[4];
        if (meta_block<4>(lds, Zb + (size_t)NREAL * D, br, D, o)) {
            float ss = 0.f;
#pragma unroll
            for (int n = 0; n < 2; ++n) {
                const f32x4 v = o[n], gt = o[2 + n]; const int c = c0 + 16 * n + 4 * fq;
                f32x4 h;
                if (layer == 0) h = *(const f32x4*)(a.in[1] + (size_t)fr * D + c);
                else { const u32x2 w = *(const u32x2*)(g.res16 + (size_t)(NREAL + fr) * D + c); h = (f32x4){bf16_lo(w.x), bf16_hi(w.x), bf16_lo(w.y), bf16_hi(w.y)}; }
                h[0] += v[0] * sigmoidf_(gt[0]); h[1] += v[1] * sigmoidf_(gt[1]); h[2] += v[2] * sigmoidf_(gt[2]); h[3] += v[3] * sigmoidf_(gt[3]);
                u32x2 w2; w2.x = cvt_pk_bf16(h[0], h[1]); w2.y = cvt_pk_bf16(h[2], h[3]); *(u32x2*)(g.Hout + (size_t)(NREAL + fr) * D + c) = w2; ss += ssq4(h);
            }
            ss = quad_sum(ss);
            if (fq == 0) g.SSQ[(size_t)(NREAL + fr) * 32 + task] = ss;
        }
    }
    g.stride = GRID; g.vb = opaque_bid(); g.kind = EPI_GLU; g.K = D; g.perm = 1; g.gather = 0; g.moe = 0; g.nM = NREAL / BM; g.nN = 2048 / BM; g.nwg = g.nM * g.nN; g.A = (const char*)Zb; g.Bt = (const char*)W;
    g.tstepA = g.tstepB = (size_t)BM * D * 2; g.wstride = 0;
}

__device__ __forceinline__ void epi_oproj(const GemmDesc& g, const f32x4 (&acc)[2][2][4][2], const Unit& u, int wr, int wc, int fr, int fq) {
#pragma unroll
    for (int ai = 0; ai < 2; ++ai)
#pragma unroll
        for (int bj = 0; bj < 2; ++bj) {
            const int row0 = u.pm * BM + ai * HALF + wr * 64 + fr, c0 = u.pn * BM + bj * HALF + wc * 32 + 8 * fq; const size_t off0 = (size_t)row0 * D + c0;
            const f32x4 b0 = *(const f32x4*)(g.bias + c0), b1 = *(const f32x4*)(g.bias + c0 + 4);
            float h[4][8];
#pragma unroll
            for (int m = 0; m < 4; ++m) load_res8(g, off0 + (size_t)m * 16 * D, h[m]);
#pragma unroll
            for (int m = 0; m < 4; ++m) {
#pragma unroll
                for (int n = 0; n < 2; ++n) { const f32x4 v = acc[ai][bj][m][n] + (n ? b1 : b0); h[m][4 * n + 0] += v[0]; h[m][4 * n + 1] += v[1]; h[m][4 * n + 2] += v[2]; h[m][4 * n + 3] += v[3]; }
                float ss = store_h8(g.Hout, off0 + (size_t)m * 16 * D, h[m]);
                ss = quad_sum(ss);
                if (fq == 0) g.SSQ[(size_t)(row0 + 16 * m) * 32 + u.pn * 8 + bj * 4 + wc] = ss;
            }
            asm volatile("" ::: "memory");
        }
}
__device__ __forceinline__ void phase_oproj(CArgs& a, int j, bool dry, LAS unsigned char* lds, GemmDesc& g) {
    const bf16_t* Ob = (const bf16_t*)(a.ws + WS_Z); const bf16_t* W = (const bf16_t*)(a.ws + WS_WO) + (size_t)j * 1024 * 1024;
    const float* bo = a.in[21] + (size_t)j * D;
    g.res32 = nullptr; g.res16 = (const bf16_t*)(a.ws + WS_H); g.Hout = (bf16_t*)(a.ws + (dry ? WS_DUMH : WS_H)); g.SSQ = (float*)(a.ws + (dry ? WS_DUMSSQ : WS_SSQ)); g.bias = bo;
    if (opaque_bid() < 32) {
        const int lane = opaque_tid() & 63, fr = lane & 15, fq = lane >> 4, task = opaque_bid(), c0 = 32 * task;
        const bf16_t* const br[2] = {W + (size_t)c0 * D, W + (size_t)(c0 + 16) * D};
        f32x4 o[2];
        if (meta_block<2>(lds, Ob + (size_t)NREAL * D, br, D, o)) {
            float ss = 0.f;
#pragma unroll
            for (int n = 0; n < 2; ++n) {
                const int c = c0 + 16 * n + 4 * fq; const size_t off = (size_t)(NREAL + fr) * D + c;
                const u32x2 w = *(const u32x2*)(g.res16 + off); f32x4 h = (f32x4){bf16_lo(w.x), bf16_hi(w.x), bf16_lo(w.y), bf16_hi(w.y)};
                h += o[n] + *(const f32x4*)(bo + c);
                u32x2 w2; w2.x = cvt_pk_bf16(h[0], h[1]); w2.y = cvt_pk_bf16(h[2], h[3]); *(u32x2*)(g.Hout + off) = w2; ss += ssq4(h);
            }
            ss = quad_sum(ss);
            if (fq == 0) g.SSQ[(size_t)(NREAL + fr) * 32 + task] = ss;
        }
    }
    g.stride = GRID; g.vb = opaque_bid(); g.kind = EPI_OPROJ; g.K = D; g.perm = 1; g.gather = 0; g.moe = 0; g.nM = NREAL / BM; g.nN = 1024 / BM; g.nwg = g.nM * g.nN; g.A = (const char*)Ob; g.Bt = (const char*)W;
    g.tstepA = g.tstepB = (size_t)BM * D * 2; g.wstride = 0;
}

__device__ __forceinline__ void kvq_store8(const GemmDesc& g, int row, int c, const float (&vin)[8]) {
    const float rs = g.rstd[row]; float v[8];
#pragma unroll
    for (int e = 0; e < 8; ++e) v[e] = vin[e] * rs;
    if (c < 256) {
        const float* b = g.bias + c; u32x4 w; w.x = cvt_pk_bf16(v[0] + b[0], v[1] + b[1]); w.y = cvt_pk_bf16(v[2] + b[2], v[3] + b[3]); w.z = cvt_pk_bf16(v[4] + b[4], v[5] + b[5]); w.w = cvt_pk_bf16(v[6] + b[6], v[7] + b[7]);
        *(u32x4*)(g.O1 + (size_t)row * 256 + c) = w;
    } else if (c < 512) {
        const int cv = c - 256; const float* b = g.bias + c;
        bf16_t* vp = g.O2 + (row < NREAL ? ((size_t)(row >> 11) * 256 + cv) * SEQ + (row & (SEQ - 1)) : VT_META + (size_t)cv * 16 + (row - NREAL));
        const size_t st = row < NREAL ? SEQ : 16;
#pragma unroll
        for (int i = 0; i < 4; ++i) { const unsigned p = cvt_pk_bf16(v[2 * i] + b[2 * i], v[2 * i + 1] + b[2 * i + 1]); vp[(size_t)(2 * i) * st] = (bf16_t)(p & 0xffffu); vp[(size_t)(2 * i + 1) * st] = (bf16_t)(p >> 16); }
    } else {
        const int cq = c - 512; const float* b = g.bias2 + cq;
        u32x4 w; w.x = cvt_pk_bf16((v[0] + b[0]) * 0.125f, (v[1] + b[1]) * 0.125f); w.y = cvt_pk_bf16((v[2] + b[2]) * 0.125f, (v[3] + b[3]) * 0.125f);
        w.z = cvt_pk_bf16((v[4] + b[4]) * 0.125f, (v[5] + b[5]) * 0.125f); w.w = cvt_pk_bf16((v[6] + b[6]) * 0.125f, (v[7] + b[7]) * 0.125f);
        *(u32x4*)(g.O3 + (size_t)row * D + cq) = w;
    }
}
__device__ __forceinline__ void epi_kvq(const GemmDesc& g, const f32x4 (&acc)[2][2][4][2], const Unit& u, int wr, int wc, int fr, int fq) {
    { const int cbase = g.cbase;
#pragma unroll
        for (int ai = 0; ai < 2; ++ai)
#pragma unroll
            for (int m = 0; m < 4; ++m) {
                const int row = u.pm * BM + ai * HALF + wr * 64 + m * 16 + fr;
#pragma unroll
                for (int bj = 0; bj < 2; ++bj) {
                    const int c = cbase + u.pn * BM + bj * HALF + wc * 32 + 8 * fq;
                    const f32x4 v0 = acc[ai][bj][m][0], v1 = acc[ai][bj][m][1];
                    const float v[8] = {v0[0], v0[1], v0[2], v0[3], v1[0], v1[1], v1[2], v1[3]};
                    kvq_store8(g, row, c, v);
                    asm volatile("" ::: "memory");
                }
            }
    }
}
__device__ __forceinline__ void phase_kvq_q(CArgs& a, int jq, LAS unsigned char* lds, GemmDesc& g) {
    const bf16_t* Ub = (const bf16_t*)(a.ws + WS_H); const bf16_t* W = jq == 0 ? (const bf16_t*)(a.ws + WS_WKVQ) : (const bf16_t*)(a.ws + WS_WQ1);
    const int N = jq == 0 ? 1536 : 1024, cbase = jq == 0 ? 0 : 512;
    if (opaque_bid() < N / 32) {
        const int lane = opaque_tid() & 63, fr = lane & 15, fq = lane >> 4, task = opaque_bid();
        const bf16_t* const br[2] = {W + (size_t)(32 * task) * D, W + (size_t)(32 * task + 16) * D};
        f32x4 o[2];
        if (meta_block<2>(lds, Ub + (size_t)NREAL * D, br, D, o)) {
#pragma unroll
            for (int h = 0; h < 2; ++h) {
                const int c = cbase + 32 * task + 16 * h + 4 * fq; const int row = NREAL + fr; const f32x4 v = o[h] * ((const float*)(a.ws + WS_RSTD))[row];
                if (c < 256) { const float* b = a.in[16] + c; u32x2 w; w.x = cvt_pk_bf16(v[0] + b[0], v[1] + b[1]); w.y = cvt_pk_bf16(v[2] + b[2], v[3] + b[3]); *(u32x2*)((bf16_t*)(a.ws + WS_K) + (size_t)row * 256 + c) = w; }
                else if (c < 512) { const int cv = c - 256; const float* b = a.in[16] + c; bf16_t* vp = (bf16_t*)(a.ws + WS_VT) + VT_META + (size_t)cv * 16 + fr;
                    const unsigned p0 = cvt_pk_bf16(v[0] + b[0], v[1] + b[1]), p1 = cvt_pk_bf16(v[2] + b[2], v[3] + b[3]);
                    vp[0] = (bf16_t)(p0 & 0xffffu); vp[16] = (bf16_t)(p0 >> 16); vp[32] = (bf16_t)(p1 & 0xffffu); vp[48] = (bf16_t)(p1 >> 16); }
                else { const int cq = c - 512; const float* b = a.in[18] + (size_t)jq * D + cq; u32x2 w; w.x = cvt_pk_bf16((v[0] + b[0]) * 0.125f, (v[1] + b[1]) * 0.125f); w.y = cvt_pk_bf16((v[2] + b[2]) * 0.125f, (v[3] + b[3]) * 0.125f);
                    *(u32x2*)((bf16_t*)(a.ws + WS_Q) + (size_t)row * D + cq) = w; }
            }
        }
    }
    g.stride = GRID; g.vb = opaque_bid(); g.kind = EPI_KVQ; g.K = D; g.perm = 1; g.gather = 0; g.moe = 0; g.nM = NREAL / BM; g.nN = N / BM; g.nwg = g.nM * g.nN; g.A = (const char*)Ub; g.Bt = (const char*)W;
    g.tstepA = g.tstepB = (size_t)BM * D * 2; g.wstride = 0; g.rstd = (const float*)(a.ws + WS_RSTD); g.bias = a.in[16]; g.bias2 = a.in[18] + (size_t)jq * D; g.O1 = (bf16_t*)(a.ws + WS_K); g.O2 = (bf16_t*)(a.ws + WS_VT); g.O3 = (bf16_t*)(a.ws + WS_Q);
    g.jq = jq; g.cbase = cbase;
}

__device__ __forceinline__ void moe_scan(const int* cnt, LAS int* sh) {
    if (opaque_tid() == 0) { int acc = 0; for (int e = 0; e < 32; ++e) { sh[e] = acc; acc += (cnt[e] + 255) >> 8; } sh[32] = acc; }
    __syncthreads();
}
__device__ __forceinline__ void epi_moe1(const GemmDesc& g, LAS unsigned char* lds, const f32x4 (&acc)[2][2][4][2], const Unit& u, int wr, int wc, int fr, int fq) {
    { bf16_t* HB = g.O1;
        const LAS int* tabt = (const LAS int*)(lds + LDS_TABT) + u.slot * 256;
#pragma unroll
        for (int ai = 0; ai < 2; ++ai)
#pragma unroll
            for (int m = 0; m < 4; ++m) {
                const int rl = ai * HALF + wr * 64 + m * 16 + fr;
                if (tabt[rl] >= 0) {
                    const float rs = ((const LAS float*)(lds + LDS_TABG))[u.slot * 256 + rl];
                    const f32x4 g0 = acc[ai][0][m][0] * rs, g1 = acc[ai][0][m][1] * rs, u0 = acc[ai][1][m][0] * rs, u1 = acc[ai][1][m][1] * rs;
                    u32x4 w; w.x = cvt_pk_bf16(g0[0] * sigmoidf_(g0[0]) * u0[0], g0[1] * sigmoidf_(g0[1]) * u0[1]); w.y = cvt_pk_bf16(g0[2] * sigmoidf_(g0[2]) * u0[2], g0[3] * sigmoidf_(g0[3]) * u0[3]);
                    w.z = cvt_pk_bf16(g1[0] * sigmoidf_(g1[0]) * u1[0], g1[1] * sigmoidf_(g1[1]) * u1[1]); w.w = cvt_pk_bf16(g1[2] * sigmoidf_(g1[2]) * u1[2], g1[3] * sigmoidf_(g1[3]) * u1[3]);
                    *(u32x4*)(HB + ((size_t)u.pm * 256 + rl) * DEXP + u.pn * 128 + wc * 32 + 8 * fq) = w;
                }
                asm volatile("" ::: "memory");
            }
    }
}
__device__ __forceinline__ bool moe_roles(GemmDesc& g) {
    const int rounds = (g.nwg + GRID - 1) / GRID, per = rounds ? (g.nwg + rounds - 1) / rounds : GRID, ngw = ((per + 7) / 8) * 8 < GRID ? ((per + 7) / 8) * 8 : GRID;
    const int bid = opaque_bid(), rnk = bid >> 3;
    g.stride = ngw; g.vb = rnk * 8 + (bid & 7);
    if (rnk * 8 >= ngw) { g.nwg = 0; return true; }
    return false;
}
__device__ __forceinline__ bool phase_moe1(CArgs& a, int layer, LAS unsigned char* lds, GemmDesc& g) {
    LAS int* sh = (LAS int*)(lds + LDS_SH);
    const int* cnt = (const int*)(a.ws + WS_CTL) + CW_CNT + layer * 32;
    moe_scan(cnt, sh);
    g.kind = EPI_MOE1; g.K = D; g.perm = 1; g.gather = 1; g.moe = 1; g.npn = 4; g.nwg = sh[32] * 4; g.nM = 0; g.nN = 4;
    g.A = (const char*)(a.ws + WS_H); g.Bt = (const char*)(a.ws + WS_W1) + (size_t)layer * 32 * 1024 * 1024 * 2; g.wstride = (size_t)1024 * 1024 * 2;
    g.tstepA = 0; g.tstepB = (size_t)256 * 1024 * 2; g.cnt = cnt; g.LTOK = (const int*)(a.ws + WS_LTOK); g.LGATE = (const float*)(a.ws + WS_LRS); g.O1 = (bf16_t*)(a.ws + WS_HB);
    return moe_roles(g);
}
__device__ __forceinline__ void epi_moe2(const GemmDesc& g, LAS unsigned char* lds, const f32x4 (&acc)[2][2][4][2], const Unit& u, int wr, int wc, int fr, int fq) {
    { bf16_t* YB = g.O1;
        const LAS int* tabt = (const LAS int*)(lds + LDS_TABT) + u.slot * 256; const LAS float* tabg = (const LAS float*)(lds + LDS_TABG) + u.slot * 256;
#pragma unroll
        for (int ai = 0; ai < 2; ++ai)
#pragma unroll
            for (int m = 0; m < 4; ++m) {
                const int rl = ai * HALF + wr * 64 + m * 16 + fr; const int rt = tabt[rl];
                if (rt >= 0) {
                    const float gs = tabg[rl];
                    bf16_t* yp = YB + ((size_t)(rt & 0x3fffffff) * 2 + (rt >> 30)) * D + u.pn * BM + wc * 32 + 8 * fq;
#pragma unroll
                    for (int bj = 0; bj < 2; ++bj) { const f32x4 v0 = acc[ai][bj][m][0] * gs, v1 = acc[ai][bj][m][1] * gs;
                        u32x4 w; w.x = cvt_pk_bf16(v0[0], v0[1]); w.y = cvt_pk_bf16(v0[2], v0[3]); w.z = cvt_pk_bf16(v1[0], v1[1]); w.w = cvt_pk_bf16(v1[2], v1[3]);
                        *(u32x4*)(yp + bj * HALF) = w; }
                }
                asm volatile("" ::: "memory");
            }
    }
}
__device__ __forceinline__ bool phase_moe2(CArgs& a, int layer, LAS unsigned char* lds, GemmDesc& g) {
    LAS int* sh = (LAS int*)(lds + LDS_SH);
    const int* cnt = (const int*)(a.ws + WS_CTL) + CW_CNT + layer * 32;
    moe_scan(cnt, sh);
    g.kind = EPI_MOE2; g.K = DEXP; g.perm = 1; g.gather = 0; g.moe = 1; g.npn = 4; g.nwg = sh[32] * 4; g.nM = 0; g.nN = 4;
    g.A = (const char*)(a.ws + WS_HB); g.Bt = (const char*)(a.ws + WS_W2) + (size_t)layer * 32 * 1024 * 512 * 2; g.wstride = (size_t)1024 * 512 * 2;
    g.tstepA = (size_t)256 * DEXP * 2; g.tstepB = (size_t)256 * DEXP * 2; g.cnt = cnt; g.LTOK = (const int*)(a.ws + WS_LTOK); g.LGATE = (const float*)(a.ws + WS_LGATE); g.O1 = (bf16_t*)(a.ws + WS_YB);
    return moe_roles(g);
}
__device__ __forceinline__ void gemm_epilogue(const GemmDesc& g, LAS unsigned char* lds, const f32x4 (&acc)[2][2][4][2], const Unit& u, int wr, int wc, int fr, int fq) {
    asm volatile("" : "+v"(fr), "+v"(fq));
    switch (g.kind) {
        case EPI_GLU: epi_glu(g, acc, u, wr, wc, fr, fq); break;
        case EPI_OPROJ: epi_oproj(g, acc, u, wr, wc, fr, fq); break;
        case EPI_KVQ: epi_kvq(g, acc, u, wr, wc, fr, fq); break;
        case EPI_MOE1: epi_moe1(g, lds, acc, u, wr, wc, fr, fq); break;
        default: epi_moe2(g, lds, acc, u, wr, wc, fr, fq); break;
    }
}

constexpr int AT_NSLOT = 272, AT_VROW = 552, AT_KBYTES = AT_NSLOT * 128, AT_VBYTES = 64 * AT_VROW;
__device__ __forceinline__ void attn_tile(LAS unsigned char* Ks, LAS unsigned char* Vs, const bf16_t* qp, bf16_t* op, float sink, int nblk  , int kb0  , int srel  , int smin  , int lmeta  , int tc, int q4) {
    const bf16x8 qf0 = as_bf16x8(*(const u32x4*)qp), qf1 = as_bf16x8(*(const u32x4*)(qp + 32));
    f32x4 s[10];
#pragma unroll
    for (int bi = 0; bi < 10; ++bi) {
        s[bi] = (f32x4){-1e30f, -1e30f, -1e30f, -1e30f};
        if (bi < nblk) {
            const int sl = (bi == 0 ? 0 : 16 + 16 * (kb0 + bi - 1)) + tc;
            const LAS unsigned char* kr = Ks + sl * 128;
            const bf16x8 kf0 = *(const LAS bf16x8*)(kr + ((q4 ^ (sl & 7)) << 4)), kf1 = *(const LAS bf16x8*)(kr + (((4 + q4) ^ (sl & 7)) << 4));
            f32x4 acc = {0.f, 0.f, 0.f, 0.f};
            acc = mfma16(kf0, qf0, acc); acc = mfma16(kf1, qf1, acc);
#pragma unroll
            for (int r = 0; r < 4; ++r) {
                const int kk = 16 * (kb0 + bi - 1) + 4 * q4 + r;
                const bool ok = bi == 0 ? (4 * q4 + r <= lmeta) : (kk >= smin && kk <= srel && kk >= srel - 127);
                s[bi][r] = ok ? acc[r] : -1e30f;
            }
        }
    }
    float m = sink;
#pragma unroll
    for (int bi = 0; bi < 10; ++bi) m = fmaxf(m, fmaxf(fmaxf(s[bi][0], s[bi][1]), fmaxf(s[bi][2], s[bi][3])));
    m = xor32_max(xor16_max(m));
    float den = 0.f;
    unsigned pk[10][2];
#pragma unroll
    for (int bi = 0; bi < 10; ++bi) {
        float p[4];
#pragma unroll
        for (int r = 0; r < 4; ++r) { p[r] = s[bi][r] > -1e29f ? fast_exp(s[bi][r] - m) : 0.f; den += p[r]; }
        pk[bi][0] = cvt_pk_bf16(p[0], p[1]); pk[bi][1] = cvt_pk_bf16(p[2], p[3]);
    }
    den = quad_sum(den);
    den += fast_exp(sink - m);
    const float inv = 1.0f / den;
    f32x4 o[4];
#pragma unroll
    for (int dt = 0; dt < 4; ++dt) o[dt] = (f32x4){0.f, 0.f, 0.f, 0.f};
#pragma unroll
    for (int pp = 0; pp < 5; ++pp) {
        if (2 * pp < nblk) {
            const int biA = 2 * pp, biB = 2 * pp + 1;
            const int slA = biA == 0 ? 0 : 16 + 16 * (kb0 + biA - 1), slB = biB < nblk ? 16 + 16 * (kb0 + biB - 1) : slA;
            u32x4 pw; pw.x = pk[biA][0]; pw.y = pk[biA][1]; pw.z = pk[biB][0]; pw.w = pk[biB][1];
            const bf16x8 pf = as_bf16x8(pw);
#pragma unroll
            for (int dt = 0; dt < 4; ++dt) {
                const LAS unsigned char* vr = Vs + (16 * dt + tc) * AT_VROW + 8 * q4;
                const u32x2 va = *(const LAS u32x2*)(vr + slA * 2), vb = *(const LAS u32x2*)(vr + slB * 2);
                u32x4 vw; vw.x = va.x; vw.y = va.y; vw.z = vb.x; vw.w = vb.y;
                o[dt] = mfma16(as_bf16x8(vw), pf, o[dt]);
            }
        }
    }
#pragma unroll
    for (int dt = 0; dt < 4; ++dt) { u32x2 w; w.x = cvt_pk_bf16(o[dt][0] * inv, o[dt][1] * inv); w.y = cvt_pk_bf16(o[dt][2] * inv, o[dt][3] * inv); *(u32x2*)(op + 16 * dt) = w; }
}
__device__ __forceinline__ void phase_attn(CArgs& a, int j, LAS unsigned char* lds) {
    const int tid = opaque_tid(), lane = tid & 63, wid = tid >> 6, tc = lane & 15, q4 = lane >> 4;
    const bf16_t* Q = (const bf16_t*)(a.ws + WS_Q); const bf16_t* K = (const bf16_t*)(a.ws + WS_K); const bf16_t* VT = (const bf16_t*)(a.ws + WS_VT);
    bf16_t* O = (bf16_t*)(a.ws + WS_Z);
    LAS unsigned char* Ks = lds; LAS unsigned char* Vs = lds + AT_KBYTES;
    constexpr int NU_REAL = NB * 4 * 16;
    for (int unit = opaque_bid(); unit < NU_REAL + 4; unit += GRID) {
        const bool meta = unit >= NU_REAL;
        const int qt = meta ? 0 : (unit & 15), kvh = meta ? unit - NU_REAL : ((unit >> 4) & 3), b = meta ? 0 : (unit >> 6), s0 = qt * 128;
        __syncthreads();
        for (int idx = tid; idx < AT_NSLOT * 8; idx += NTHREADS) {
            const int sl = idx >> 3, c = idx & 7, sw = s0 - 128 + (sl - 16);
            u32x4 v = {0u, 0u, 0u, 0u};
            if (sl < 16) v = *(const u32x4*)(K + (size_t)(NREAL + sl) * 256 + kvh * 64 + c * 8);
            else if (!meta && sw >= 0) v = *(const u32x4*)(K + (size_t)(b * SEQ + sw) * 256 + kvh * 64 + c * 8);
            *(LAS u32x4*)(Ks + sl * 128 + ((c ^ (sl & 7)) << 4)) = v;
        }
        for (int idx = tid; idx < 64 * 34; idx += NTHREADS) {
            const int d = idx / 34, ch = idx - d * 34, sw = s0 - 128 + 8 * (ch - 2);
            u32x4 v = {0u, 0u, 0u, 0u};
            if (ch < 2) v = *(const u32x4*)(VT + VT_META + (size_t)(kvh * 64 + d) * 16 + ch * 8);
            else if (!meta && sw >= 0) v = *(const u32x4*)(VT + ((size_t)(b * 4 + kvh) * 64 + d) * SEQ + sw);
            *(LAS u32x2*)(Vs + d * AT_VROW + ch * 16) = (u32x2){v.x, v.y}; *(LAS u32x2*)(Vs + d * AT_VROW + ch * 16 + 8) = (u32x2){v.z, v.w};
        }
        __syncthreads();
        const int g = wid & 3, hq = kvh * 4 + g;
        const float sink = a.in[19][j * 16 + hq];
        if (meta) {
            if (wid < 4) { const size_t row = (size_t)(NREAL + tc); attn_tile(Ks, Vs, Q + row * D + hq * 64 + 8 * q4, O + row * D + hq * 64 + 4 * q4, sink, 1, 0, 0, 0, tc, tc, q4); }
        } else {
#pragma unroll 1
            for (int jt = wid >> 2; jt < 8; jt += 2) {
                const int s = s0 + 16 * jt + tc; const size_t row = (size_t)(b * SEQ + s);
                attn_tile(Ks, Vs, Q + row * D + hq * 64 + 8 * q4, O + row * D + hq * 64 + 4 * q4, sink, 10, jt, 128 + 16 * jt + tc, 128 - s0, 64, tc, q4);
            }
        }
    }
}

__device__ __forceinline__ void phase_route(CArgs& a, int layer, bool dry, LAS unsigned char* lds) {
    LAS unsigned char* Wf = lds; LAS float* LG = (LAS float*)(lds + 98304); LAS int* hist = (LAS int*)(lds + 98304 + 24576); LAS int* hbase = hist + 32;
    const int tid = opaque_tid(), lane = tid & 63, wid = tid >> 6, tc = lane & 15, q4 = lane >> 4;
    for (int idx = tid; idx < 3 * 32 * 64; idx += NTHREADS) *(LAS u32x4*)(Wf + (size_t)idx * 16) = *(const u32x4*)(a.ws + WS_RW + (size_t)layer * 98304 + (size_t)idx * 16);
    if (tid < 32) hist[tid] = 0;
    __syncthreads();
    const bf16_t* H = (const bf16_t*)(a.ws + WS_H); const float* SSQ = (const float*)(a.ws + WS_SSQ); float* LRS = (float*)(a.ws + (dry ? WS_DUMLG : WS_LRS));
    int* cnt = (int*)(a.ws + WS_CTL) + (dry ? CW_DUMCNT : CW_CNT) + layer * 32; int* LTOK = (int*)(a.ws + (dry ? WS_DUMLT : WS_LTOK)); float* LGATE = (float*)(a.ws + (dry ? WS_DUMLG : WS_LGATE));
    const int tile = wid * GRID + opaque_bid();
    const bool active = tile < RT / 16;
    int e1, e2, r1, r2; float g1, g2, rstd_keep;
    asm volatile("" : "=v"(e1), "=v"(e2), "=v"(r1), "=v"(r2), "=v"(g1), "=v"(g2), "=v"(rstd_keep));
    if (active) {
        const int row = tile * 16 + tc;
        float ss = 0.f;
        { const f32x4* sp = (const f32x4*)(SSQ + (size_t)row * 32 + 8 * q4); const f32x4 s0 = sp[0], s1 = sp[1]; ss = (s0[0] + s0[1]) + (s0[2] + s0[3]) + (s1[0] + s1[1]) + (s1[2] + s1[3]); }
        ss = quad_sum(ss);
        const float rstd = 1.0f / sqrtf(ss * (1.0f / D) + RMS_EPS); rstd_keep = rstd;
        f32x4 acc[3];
#pragma unroll
        for (int rt = 0; rt < 3; ++rt) acc[rt] = (f32x4){0.f, 0.f, 0.f, 0.f};
        const bf16_t* hp = H + (size_t)row * D + 8 * q4;
#pragma unroll 1
        for (int kb = 0; kb < 4; ++kb) {
            u32x4 hv[8];
#pragma unroll
            for (int k8 = 0; k8 < 8; ++k8) hv[k8] = *(const u32x4*)(hp + 32 * (kb * 8 + k8));
#pragma unroll
            for (int k8 = 0; k8 < 8; ++k8) {
                const int ks = kb * 8 + k8; const bf16x8 xf = as_bf16x8(hv[k8]);
#pragma unroll
                for (int rt = 0; rt < 3; ++rt) acc[rt] = mfma16(*(LAS bf16x8*)(Wf + ((size_t)(rt * 32 + ks) * 64 + lane) * 16), xf, acc[rt]);
            }
        }
        LAS float* lg = LG + wid * 16 * 48;
#pragma unroll
        for (int rt = 0; rt < 3; ++rt)
#pragma unroll
            for (int r = 0; r < 4; ++r) lg[tc * 48 + 16 * rt + 4 * q4 + r] = acc[rt][r] * rstd;
        asm volatile("s_waitcnt lgkmcnt(0)" ::: "memory");
        if (lane < 16) {
            const LAS float* mylg = lg + lane * 48;
            float gl[4]; int gi = 0; float gm;
#pragma unroll
            for (int i = 0; i < 4; ++i) gl[i] = mylg[i] + a.in[23][layer * NGRP + i];
            gm = gl[0];
#pragma unroll
            for (int i = 1; i < 4; ++i) if (gl[i] > gm) { gm = gl[i]; gi = i; }
            float gz = 0.f;
#pragma unroll
            for (int i = 0; i < 4; ++i) gz += expf(gl[i] - gm);
            const float pg = 1.0f / gz;
            float el[8];
#pragma unroll
            for (int i = 0; i < 8; ++i) el[i] = mylg[4 + gi * 8 + i] + a.in[25][layer * NEXP + gi * 8 + i];
            int i1 = 0; float m1 = el[0];
#pragma unroll
            for (int i = 1; i < 8; ++i) if (el[i] > m1) { m1 = el[i]; i1 = i; }
            int i2 = -1; float m2 = -3.0e38f;
#pragma unroll
            for (int i = 0; i < 8; ++i) if (i != i1 && el[i] > m2) { m2 = el[i]; i2 = i; }
            float one = 1.0f; asm volatile("" : "+v"(one));
            const float x2 = expf(m2 - m1), q1 = one / (one + x2);
            g1 = pg * q1; g2 = pg * x2 * q1; e1 = gi * 8 + i1; e2 = gi * 8 + i2;
            r1 = __hip_atomic_fetch_add(&hist[e1], 1, __ATOMIC_RELAXED, __HIP_MEMORY_SCOPE_WORKGROUP); r2 = __hip_atomic_fetch_add(&hist[e2], 1, __ATOMIC_RELAXED, __HIP_MEMORY_SCOPE_WORKGROUP);
        }
    }
    __syncthreads();
    if (tid < 32) hbase[tid] = hist[tid] ? atomicAdd(&cnt[tid], hist[tid]) : 0;
    __syncthreads();
    if (active && lane < 16) {
        const int row = tile * 16 + lane;
        const int s1 = hbase[e1] + r1, s2 = hbase[e2] + r2;
        LTOK[(size_t)e1 * RT + s1] = row; LGATE[(size_t)e1 * RT + s1] = g1; LRS[(size_t)e1 * RT + s1] = rstd_keep;
        LTOK[(size_t)e2 * RT + s2] = row | (1 << 30); LGATE[(size_t)e2 * RT + s2] = g2; LRS[(size_t)e2 * RT + s2] = rstd_keep;
    }
}

__device__ __forceinline__ void phase_combine(CArgs& a, int layer, bool dry) {
    const int lane = opaque_tid() & 63, gw = opaque_bid() * 8 + (opaque_tid() >> 6);
    bf16_t* H = (bf16_t*)(a.ws + WS_H); const bf16_t* YB = (const bf16_t*)(a.ws + WS_YB);
    for (int row = gw; row < RT; row += GRID * 8) {
        float v[2][8]; float ssq = 0.f;
        bf16_t* hp = H + (size_t)row * D; const bf16_t* y0 = YB + (size_t)row * 2 * D; const bf16_t* y1 = y0 + D;
#pragma unroll
        for (int j = 0; j < 2; ++j) {
            const int c = 8 * lane + 512 * j;
            const u32x4 hw = *(const u32x4*)(hp + c), p0 = *(const u32x4*)(y0 + c), p1 = *(const u32x4*)(y1 + c);
            v[j][0] = bf16_lo(hw.x) + bf16_lo(p0.x) + bf16_lo(p1.x); v[j][1] = bf16_hi(hw.x) + bf16_hi(p0.x) + bf16_hi(p1.x);
            v[j][2] = bf16_lo(hw.y) + bf16_lo(p0.y) + bf16_lo(p1.y); v[j][3] = bf16_hi(hw.y) + bf16_hi(p0.y) + bf16_hi(p1.y);
            v[j][4] = bf16_lo(hw.z) + bf16_lo(p0.z) + bf16_lo(p1.z); v[j][5] = bf16_hi(hw.z) + bf16_hi(p0.z) + bf16_hi(p1.z);
            v[j][6] = bf16_lo(hw.w) + bf16_lo(p0.w) + bf16_lo(p1.w); v[j][7] = bf16_hi(hw.w) + bf16_hi(p0.w) + bf16_hi(p1.w);
#pragma unroll
            for (int e = 0; e < 8; ++e) ssq += v[j][e] * v[j][e];
        }
        ssq = wave_sum(ssq);
        const float rstd = 1.0f / sqrtf(ssq * (1.0f / D) + RMS_EPS);
        if (layer < 3) {
            bf16_t* ho = dry ? (bf16_t*)(a.ws + WS_DUMH) + (size_t)row * D : hp;
#pragma unroll
            for (int j = 0; j < 2; ++j) {
                const int c = 8 * lane + 512 * j;
                u32x4 w; w.x = cvt_pk_bf16(v[j][0], v[j][1]); w.y = cvt_pk_bf16(v[j][2], v[j][3]); w.z = cvt_pk_bf16(v[j][4], v[j][5]); w.w = cvt_pk_bf16(v[j][6], v[j][7]);
                *(u32x4*)(ho + c) = w;
            }
            if (lane == 0) ((float*)(a.ws + (dry ? WS_DUMSSQ : WS_RSTD)))[row] = rstd;
        } else if (row < NREAL) {
            float* op = a.out + (size_t)row * D;
#pragma unroll
            for (int j = 0; j < 2; ++j) { const int c = 8 * lane + 512 * j; const f32x4 g0 = *(const f32x4*)(a.in[5] + c), g1 = *(const f32x4*)(a.in[5] + c + 4);
                f32x4 o0, o1; o0[0] = v[j][0] * rstd * g0[0]; o0[1] = v[j][1] * rstd * g0[1]; o0[2] = v[j][2] * rstd * g0[2]; o0[3] = v[j][3] * rstd * g0[3];
                o1[0] = v[j][4] * rstd * g1[0]; o1[1] = v[j][5] * rstd * g1[1]; o1[2] = v[j][6] * rstd * g1[2]; o1[3] = v[j][7] * rstd * g1[3];
                *(f32x4*)(op + c) = o0; *(f32x4*)(op + c + 4) = o1; }
        }
    }
}

enum { PH_PREP = 0, PH_S5, PH_GLU, PH_ROUTE, PH_G1, PH_G2, PH_COMB, PH_KVQ, PH_ATT, PH_OPROJ, PH_QG };
constexpr int NPH = 27;
__constant__ int c_prog[NPH][2] = {
    {PH_PREP, 0},
    {PH_S5, 0}, {PH_GLU, 0}, {PH_ROUTE, 0}, {PH_G1, 0}, {PH_G2, 0}, {PH_COMB, 0},
    {PH_S5, 1}, {PH_GLU, 1}, {PH_ROUTE, 1}, {PH_G1, 1}, {PH_G2, 1}, {PH_COMB, 1},
    {PH_KVQ, 2}, {PH_ATT, 2}, {PH_OPROJ, 2}, {PH_ROUTE, 2}, {PH_G1, 2}, {PH_G2, 2}, {PH_COMB, 2},
    {PH_QG, 3}, {PH_ATT, 3}, {PH_OPROJ, 3}, {PH_ROUTE, 3}, {PH_G1, 3}, {PH_G2, 3}, {PH_COMB, 3},
};

__global__ void __launch_bounds__(NTHREADS) yoco_fwd(Args a) {
    extern __shared__ __attribute__((aligned(16))) unsigned char smem_raw[];
    LAS unsigned char* lds = (LAS unsigned char*)smem_raw;
    volatile LAS unsigned* const st = (volatile LAS unsigned*)(lds + LDS_BYTES - 64);
    if (threadIdx.x < 16) st[threadIdx.x] = 0u;
    __syncthreads();
    if (a.ph_hi - a.ph_lo > 1) xcd_barrier_post((unsigned*)(a.ws + WS_CTL) + CW_BAR);
    CArgs* const kp = (CArgs*)__builtin_amdgcn_kernarg_segment_ptr();
    for (int ph = a.ph_lo; ph < a.ph_hi; ++ph) {
        const int type = c_prog[ph][0], layer = c_prog[ph][1];
        const int reps = type == a.rep_type ? a.rep_n : 0;
        for (int r = 0; r <= reps; ++r) {
            const bool dry = r > 0;
            CArgs* lp = kp; asm volatile("" : "+s"(lp));
            CArgs& la = *lp;
            GemmDesc g; bool is_gemm = true; int conv_budget = 0, conv_limit = 0;
            BgConv bg{lp, st};
            switch (type) {
                case PH_GLU: phase_glu(la, layer, dry, lds, g); break;
                case PH_G1: if (phase_moe1(la, layer, lds, g)) { conv_budget = 18; conv_limit = (layer + 2) * 32 * NWT_E; } break;
                case PH_G2: if (phase_moe2(la, layer, lds, g)) { conv_budget = 12; conv_limit = (layer + 3) * 32 * NWT_E; } break;
                case PH_KVQ: case PH_QG: phase_kvq_q(la, type == PH_QG ? 1 : 0, lds, g); break;
                case PH_OPROJ: phase_oproj(la, layer - 2, dry, lds, g); break;
                default: is_gemm = false; break;
            }
            g.skip_epi = 0;
#if defined(PROBE_SKIPEPI)
            if (dry) g.skip_epi = 1;
#endif
            if (is_gemm) { gemm_run(lds, g); if (conv_budget) bg.run_until(conv_limit < NWT_MOE ? conv_limit : NWT_MOE, conv_budget); }
            else switch (type) {
                case PH_PREP: phase_prep(la, lds); break;
                case PH_S5: phase_s5(la, layer, lds); break;
                case PH_ROUTE: phase_route(la, layer, dry, lds); break;
                case PH_COMB: phase_combine(la, layer, dry); break;
                default: phase_attn(la, layer - 2, lds); break;
            }
            if (type == PH_ROUTE && !dry) bg.run_until((layer + 1) * 32 * NWT_E, 1 << 20);
            if (r < reps || ph + 1 < a.ph_hi) { if (a.ph_hi - a.ph_lo > 1) xcd_barrier((unsigned*)(la.ws + WS_CTL) + CW_BAR, st, bg); }
        }
        if (a.rep_type == 100 && ph + 1 < a.ph_hi) for (int r = 0; r < a.rep_n; ++r) { BgConv bg{kp, st}; xcd_barrier((unsigned*)(a.ws + WS_CTL) + CW_BAR, st, bg); }
    }
}

extern "C" void kernel_launch(void* const* d_in, const int* in_sizes, int n_in, void* d_out, int out_size, void* d_ws, size_t ws_size, hipStream_t stream) {
    static int ready = 0;
    if (ready == 0) {
        if (n_in != 29 || ws_size < WS_END) { fprintf(stderr, "kernel_launch: expected 29 inputs and >= %zu bytes of workspace (got %d, %zu)\n", (size_t)WS_END, n_in, ws_size); ready = -1; return; }
        if (hipFuncSetAttribute((const void*)yoco_fwd, hipFuncAttributeMaxDynamicSharedMemorySize, LDS_BYTES) != hipSuccess) { fprintf(stderr, "kernel_launch: hipFuncSetAttribute failed\n"); ready = -1; return; }
        ready = 1;
    }
    if (ready < 0) return;
    (void)hipMemsetAsync((char*)d_ws + WS_CTL, 0, CTL_BYTES, stream);
    Args a{};
    for (int i = 0; i < 29; ++i) a.in[i] = (const float*)d_in[i];
    a.out = (float*)d_out; a.ws = (unsigned char*)d_ws;
#if defined(PROBE_TYPE)
    a.rep_type = PROBE_TYPE; a.rep_n = PROBE_N;
#else
    a.rep_type = -1; a.rep_n = 0;
#endif
#if MK_N_LAUNCHES == 1
    a.ph_lo = 0; a.ph_hi = NPH;
    hipLaunchKernelGGL(yoco_fwd, dim3(GRID), dim3(NTHREADS), LDS_BYTES, stream, a);
#else
    for (int ph = 0; ph < NPH; ++ph) { a.ph_lo = ph; a.ph_hi = ph + 1; hipLaunchKernelGGL(yoco_fwd, dim3(GRID), dim3(NTHREADS), LDS_BYTES, stream, a); }
#endif
}
```

```cpp
#include <hip/hip_runtime.h>
#include <cstdio>
#include <cstdint>

#ifndef MK_N_LAUNCHES
#define MK_N_LAUNCHES 1
#endif

#define LAS __attribute__((address_space(3)))
typedef unsigned short bf16_t;
typedef short bf16x8 __attribute__((ext_vector_type(8)));
typedef float f32x4 __attribute__((ext_vector_type(4)));
typedef float f32x2 __attribute__((ext_vector_type(2)));
typedef unsigned u32x4 __attribute__((ext_vector_type(4)));
typedef unsigned u32x2 __attribute__((ext_vector_type(2)));

constexpr int D = 1024, NB = 8, SEQ = 2048, NMETA = 16, LT = SEQ + NMETA  ;
constexpr int NREAL = NB * SEQ  , RT = NREAL + NMETA  , RPAD = 16640;
constexpr int NEXP = 32, DEXP = 512, NGRP = 4, EPG = 8;
constexpr int NTHREADS = 512, GRID = 256;
constexpr int LDS_BYTES = 155648;
constexpr float RMS_EPS = 1e-6f;
__device__ __forceinline__ int row_of(int b, int pos) { return pos < NMETA ? NREAL + pos : b * SEQ + (pos - NMETA); }

constexpr size_t al256(size_t x) { return (x + 255) & ~(size_t)255; }
constexpr size_t WS_CTL = 0;
constexpr size_t CTL_BYTES = 32768;
constexpr int CW_BAR = 0;
constexpr int CW_CNT = 4096;
constexpr int CW_DUMCNT = 4096 + 256;
constexpr int CW_BGC = 6144;
constexpr size_t WS_H = WS_CTL + CTL_BYTES;
constexpr size_t WS_RSTD = WS_H + al256((size_t)RPAD * D * 2);
constexpr size_t WS_LRS = WS_RSTD + al256((size_t)RPAD * 4);
constexpr size_t WS_U = WS_LRS + al256((size_t)NEXP * RT * 4);
constexpr size_t WS_Z = WS_U + 256;
constexpr size_t WS_XN = WS_Z + al256((size_t)RPAD * D * 2);
constexpr size_t WS_Q = WS_XN + 256;
constexpr size_t WS_K = WS_Q + al256((size_t)RPAD * D * 2);
constexpr size_t WS_VT = WS_K + al256((size_t)RPAD * 256 * 2);
constexpr size_t VT_META = (size_t)NB * 256 * SEQ;
constexpr size_t WS_LTOK = WS_VT + al256((size_t)RPAD * 256 * 2);
constexpr size_t WS_LGATE = WS_LTOK + al256((size_t)NEXP * RT * 4);
constexpr int HB_ROWS = 2 * RT + NEXP * 256;
constexpr size_t WS_HB = WS_LGATE + al256((size_t)NEXP * RT * 4);
constexpr size_t WS_YB = WS_HB + al256((size_t)HB_ROWS * DEXP * 2);
constexpr size_t TBL_K = 0, TBL_M = 16 * 1024, TBL_N = TBL_M + 64 * 1024, TBL_A16 = TBL_N + 64 * 1024, TBL_STRIDE = TBL_A16 + 512;
constexpr size_t WS_TBL = WS_YB + al256((size_t)RT * 2 * D * 2);
constexpr size_t WS_WGLU = WS_TBL + al256((size_t)2 * 64 * TBL_STRIDE);
constexpr size_t WS_WKVQ = WS_WGLU + (size_t)2 * 2048 * 1024 * 2;
constexpr size_t WS_WQ1 = WS_WKVQ + (size_t)1536 * 1024 * 2;
constexpr size_t WS_WO = WS_WQ1 + (size_t)1024 * 1024 * 2;
constexpr size_t WS_W1 = WS_WO + (size_t)2 * 1024 * 1024 * 2;
constexpr size_t WS_W2 = WS_W1 + (size_t)4 * 32 * 1024 * 1024 * 2;
constexpr size_t WS_RW = WS_W2 + (size_t)4 * 32 * 1024 * 512 * 2;
constexpr size_t WS_DUMH = WS_RW + (size_t)4 * 98304;
constexpr size_t WS_DUMSSQ = WS_DUMH + al256((size_t)RT * D * 4);
constexpr size_t WS_DUMLT = WS_DUMSSQ + al256((size_t)RT * 32 * 4);
constexpr size_t WS_DUMLG = WS_DUMLT + al256((size_t)NEXP * RT * 4);
#if defined(PROBE_TYPE)
constexpr size_t WS_END = WS_DUMLG + al256((size_t)NEXP * RT * 4);
#else
constexpr size_t WS_END = WS_DUMH;
#endif

struct Args {
    const float* in[29];
    float* out;
    unsigned char* ws;
    int ph_lo, ph_hi;
    int rep_type, rep_n;
};
typedef const __attribute__((address_space(4))) Args CArgs;

__device__ __forceinline__ unsigned cvt_pk_bf16(float lo, float hi) { unsigned r; asm volatile("v_cvt_pk_bf16_f32 %0, %1, %2" : "=v"(r) : "v"(lo), "v"(hi)); return r; }
__device__ __forceinline__ float bf16_lo(unsigned w) { return __uint_as_float(w << 16); }
__device__ __forceinline__ float bf16_hi(unsigned w) { return __uint_as_float(w & 0xffff0000u); }
__device__ __forceinline__ float fast_rcp(float x) { return __builtin_amdgcn_rcpf(x); }
__device__ __forceinline__ float fast_exp(float x) { return __builtin_amdgcn_exp2f(x * 1.4426950408889634f); }
__device__ __forceinline__ float sigmoidf_(float x) { return fast_rcp(1.0f + fast_exp(-x)); }
__device__ __forceinline__ float gelu_tanh(float x) { const float v = 0.7978845608028654f * (x + 0.044715f * x * x * x); return x * sigmoidf_(2.0f * v); }
__device__ __forceinline__ bf16x8 as_bf16x8(u32x4 v) { return __builtin_bit_cast(bf16x8, v); }
__device__ __forceinline__ f32x4 mfma16(bf16x8 a, bf16x8 b, f32x4 c) { return __builtin_amdgcn_mfma_f32_16x16x32_bf16(a, b, c, 0, 0, 0); }
__device__ __forceinline__ float xor32_sum(float v) { auto r = __builtin_amdgcn_permlane32_swap(__float_as_uint(v), __float_as_uint(v), false, false); return __uint_as_float(r[0]) + __uint_as_float(r[1]); }
__device__ __forceinline__ float xor16_sum(float v) { auto r = __builtin_amdgcn_permlane16_swap(__float_as_uint(v), __float_as_uint(v), false, false); return __uint_as_float(r[0]) + __uint_as_float(r[1]); }
__device__ __forceinline__ float xor32_max(float v) { auto r = __builtin_amdgcn_permlane32_swap(__float_as_uint(v), __float_as_uint(v), false, false); return fmaxf(__uint_as_float(r[0]), __uint_as_float(r[1])); }
__device__ __forceinline__ float xor16_max(float v) { auto r = __builtin_amdgcn_permlane16_swap(__float_as_uint(v), __float_as_uint(v), false, false); return fmaxf(__uint_as_float(r[0]), __uint_as_float(r[1])); }
__device__ __forceinline__ float quad_sum(float v) { return xor32_sum(xor16_sum(v)); }
template <int X> __device__ __forceinline__ float swz_xor(float v) { return __uint_as_float((unsigned)__builtin_amdgcn_ds_swizzle((int)__float_as_uint(v), (X << 10) | 0x1f)); }
__device__ __forceinline__ float wave_sum(float v) {
    v += swz_xor<1>(v); v += swz_xor<2>(v); v += swz_xor<4>(v); v += swz_xor<8>(v);
    return quad_sum(v);
}
__device__ __forceinline__ int opaque_bid() { int b = blockIdx.x; asm volatile("" : "+s"(b)); return b; }
__device__ __forceinline__ int opaque_tid() { int t = threadIdx.x; asm volatile("" : "+v"(t)); return t; }

#define XB_TMO      128
#define XB_XCNT(j)  (256  + 64 * (j))
#define XB_XSUB(j)  (1280 + 64 * (j))
#define XB_XGEN(j)  (2304 + 64 * (j))
#define XB_TOP      3328
#define XB_TOPGEN   3392
#define XCD_BAR_WORDS 3456
#define XB_SPIN_CAP (1u << 22)
__device__ __forceinline__ unsigned xb_ld(unsigned* p)              { return __hip_atomic_load(p, __ATOMIC_RELAXED, __HIP_MEMORY_SCOPE_AGENT); }
__device__ __forceinline__ unsigned xb_add(unsigned* p, unsigned v) { return __hip_atomic_fetch_add(p, v, __ATOMIC_RELAXED, __HIP_MEMORY_SCOPE_AGENT); }
__device__ __forceinline__ unsigned xb_xcc_id() { return (unsigned)__builtin_amdgcn_s_getreg((3 << 11) | 20) & 0xFu; }
#define XB_SPIN(cond, bar) do { unsigned _sp = 0; while (cond) { __builtin_amdgcn_s_sleep(1); \
    if ((++_sp & 255u) == 0u) { if (xb_ld(&(bar)[XB_TMO])) break; if (_sp > XB_SPIN_CAP) { atomicAdd(&(bar)[XB_TMO], 1u); break; } } } } while (0)
__device__ __forceinline__ void xcd_barrier_post(unsigned* bar) { if (threadIdx.x == 0) (void)xb_add(&bar[XB_XCNT(xb_xcc_id())], 1u); }
__device__ __forceinline__ void xcd_barrier_complete(unsigned* bar, unsigned x, unsigned& nloc, unsigned& nx) {
    const unsigned G = gridDim.x;
    unsigned sum, cnt, mine, sp = 0u;
    for (;;) {
        sum = 0u; cnt = 0u; mine = 0u;
#pragma unroll
        for (unsigned j = 0; j < 16; ++j) { const unsigned c = xb_ld(&bar[XB_XCNT(j)]); sum += c; cnt += (c > 0u) ? 1u : 0u; mine = (j == x) ? c : mine; }
        if (sum == G) break;
        __builtin_amdgcn_s_sleep(1);
        if ((++sp & 255u) == 0u) { if (xb_ld(&bar[XB_TMO])) break; if (sp > XB_SPIN_CAP) { atomicAdd(&bar[XB_TMO], 1u); break; } }
    }
    nloc = mine > 0u ? mine : 1u; nx = cnt > 0u ? cnt : 1u;
}
template <class BG>
__device__ __forceinline__ void xcd_barrier(unsigned* bar_, volatile LAS unsigned* st, BG& bg) {
    asm volatile("s_waitcnt vmcnt(0)" ::: "memory");
    __syncthreads();
    const unsigned flag0 = st[2];
    if (threadIdx.x >= 64) {
        while (st[2] == flag0) bg.step();
        bg.park();
    } else if (threadIdx.x == 0) {
        unsigned* bar = bar_; asm volatile("" : "+v"(bar));
        const unsigned bx = xb_xcc_id();
        __builtin_amdgcn_s_waitcnt(0);
        unsigned nloc = st[0], nx = st[1];
        if (nloc == 0u) { xcd_barrier_complete(bar, bx, nloc, nx); st[0] = nloc; st[1] = nx; }
        const unsigned old = xb_add(&bar[XB_XSUB(bx)], 1u);
        const unsigned gen = old / nloc;
        if (old + 1u == (gen + 1u) * nloc) {
            __builtin_amdgcn_fence(__ATOMIC_RELEASE, "agent");
            asm volatile("s_waitcnt vmcnt(0)" ::: "memory");
            const unsigned og = xb_add(&bar[XB_TOP], 1u);
            const unsigned tg = og / nx;
            if (og + 1u == (tg + 1u) * nx) xb_add(&bar[XB_TOPGEN], 1u);
            else XB_SPIN(xb_ld(&bar[XB_TOPGEN]) == tg, bar);
            __builtin_amdgcn_fence(__ATOMIC_ACQUIRE, "agent");
            xb_add(&bar[XB_XGEN(bx)], 1u);
            asm volatile("s_waitcnt vmcnt(0)" ::: "memory");
        } else {
            XB_SPIN(xb_ld(&bar[XB_XGEN(bx)]) == gen, bar);
            __builtin_amdgcn_fence(__ATOMIC_ACQUIRE, "agent");
            asm volatile("s_waitcnt vmcnt(0)" ::: "memory");
        }
        st[2] = flag0 + 1u;
    }
    __syncthreads();
}
constexpr int BM = 256, BK = 64, HALF = 128, HTB = HALF * BK * 2, STAGE_BYTES = 8 * HTB, NXCD = 8, WGM = 8;
constexpr int LDS_TABO = STAGE_BYTES;
constexpr int LDS_TABT = LDS_TABO + 3072;
constexpr int LDS_TABG = LDS_TABT + 3072;
constexpr int LDS_SH = LDS_TABG + 3072;
__host__ __device__ __forceinline__ int lds_byte(int r, int c) { const int st = (r >> 4) * 2 + (c >> 5), rr = r & 15, cc = c & 31, ob = rr * 64 + cc * 2; return st * 1024 + (ob ^ (((ob >> 9) & 1) << 5)); }
__host__ __device__ __forceinline__ void stage_rc(int b, int& R, int& C) { const int st = b / 1024, sb = b % 1024, swz = sb ^ (((sb >> 9) & 1) << 5); R = (st >> 1) * 16 + swz / 64; C = (st & 1) * 32 + (swz % 64) / 2; }
__host__ __device__ __forceinline__ int perm32(int rho) { const int n = rho >> 4, i = rho & 15; return 8 * (i >> 2) + 4 * n + (i & 3); }
struct Unit { int pm, pn, e, slot; };
__device__ __forceinline__ int xcd_chunk(int wgid, int nwg) { const int q = nwg / NXCD, r = nwg % NXCD, xcd = wgid % NXCD, off = wgid / NXCD; return (xcd < r ? xcd * (q + 1) : r * (q + 1) + (xcd - r) * q) + off; }

enum { EPI_GLU = 0, EPI_OPROJ, EPI_KVQ, EPI_MOE1, EPI_MOE2 };
struct GemmDesc {
    int kind, K, perm, gather, moe, skip_epi, stride, vb;
    int nM, nN, nwg, npn; const char* A; const char* Bt; size_t tstepA, tstepB, wstride; const int* cnt; const int* LTOK; const float* LGATE;
    const float* res32; const bf16_t* res16; bf16_t* Hout; const float* bias; const float* bias2; const float* rstd; bf16_t* O1; bf16_t* O2; bf16_t* O3; int jq, cbase;
};
__device__ __forceinline__ bool order_next(const GemmDesc& g, LAS unsigned char* lds, int i, Unit& u) {
    const int L = i * g.stride + g.vb; if (L >= g.nwg) return false;
    const int wgid = xcd_chunk(L, g.nwg);
    if (g.moe) {
        const LAS int* sh = (const LAS int*)(lds + LDS_SH);
        int e = 0;
        for (int q = 1; q < 32; ++q) if (wgid >= g.npn * sh[q]) e = q;
        const int nmt = sh[e + 1] - sh[e], local = wgid - g.npn * sh[e];
        u.pn = local / nmt; u.pm = sh[e] + (local - u.pn * nmt); u.e = e; u.slot = i % 3;
    } else {
        const int nig = WGM * g.nN, gid = wgid / nig, fm = gid * WGM, gsz = (g.nM - fm) < WGM ? (g.nM - fm) : WGM;
        u.pm = fm + ((wgid % nig) % gsz); u.pn = (wgid % nig) / gsz; u.e = 0; u.slot = 0;
    }
    return true;
}
__device__ __forceinline__ const char* order_a(const GemmDesc& g, const Unit& u) { return g.gather ? g.A : g.A + (size_t)u.pm * g.tstepA; }
__device__ __forceinline__ const char* order_b(const GemmDesc& g, const Unit& u) { return g.Bt + (size_t)u.e * g.wstride + (size_t)u.pn * g.tstepB; }
__device__ __forceinline__ void order_fill(const GemmDesc& g, LAS unsigned char* lds, const Unit& u) {
    const int t = opaque_tid();
    if (t < 256) {
        const LAS int* sh = (const LAS int*)(lds + LDS_SH);
        const int ne = g.cnt[u.e], idx = (u.pm - sh[u.e]) * 256 + t, ci = idx < ne ? idx : ne - 1;
        const int v = g.LTOK[(size_t)u.e * RT + ci];
        ((LAS unsigned*)(lds + LDS_TABO))[u.slot * 256 + t] = (unsigned)(v & 0x3fffffff) * (unsigned)(D * 2);
        ((LAS int*)(lds + LDS_TABT))[u.slot * 256 + t] = idx < ne ? v : -1;
        ((LAS float*)(lds + LDS_TABG))[u.slot * 256 + t] = g.LGATE[(size_t)u.e * RT + ci];
    }
}
__device__ __forceinline__ void gemm_epilogue(const GemmDesc& g, LAS unsigned char* lds, const f32x4 (&acc)[2][2][4][2], const Unit& u, int wr, int wc, int fr, int fq);

__device__ __forceinline__ void gemm_run(LAS unsigned char* lds, const GemmDesc& g) {
    const int tid = opaque_tid(), wid = __builtin_amdgcn_readfirstlane(tid >> 6), lane = tid & 63, wr = wid >> 2, wc = wid & 3, fr = lane & 15, fq = lane >> 4;
    const int K = g.K, nt = K / BK;
    unsigned voffB[2], go[2][2];
    const size_t kstep = (size_t)(BK * 2);
    const size_t hstep = (size_t)HALF * K * 2;
#pragma unroll
    for (int i = 0; i < 2; ++i) { int R, C; stage_rc(tid * 16 + i * 8192, R, C); const int Rb = g.perm ? ((R & ~31) + perm32(R & 31)) : R;
        voffB[i] = (unsigned)(Rb * K + C) * 2u; go[0][i] = (unsigned)(R * K + C) * 2u; go[1][i] = go[0][i] + (unsigned)hstep; }
    const unsigned ldsw = (unsigned)wid * 1024u;
    const int aoff = lds_byte(wr * 64 + fr, fq * 8), boff = lds_byte(wc * 32 + fr, fq * 8);
#define PG8_SA(b, h) (((b) * 2 + (h)) * HTB)
#define PG8_SB(b, h) ((4 + (b) * 2 + (h)) * HTB)
#define PG8_GLDS(src, dstoff) __builtin_amdgcn_global_load_lds((const unsigned*)(src), (LAS unsigned*)(lds + (dstoff)), 16, 0, 0)
#define PG8_STAGE_B(bufoff, gbase) do { _Pragma("unroll") for (int _i = 0; _i < 2; ++_i) PG8_GLDS((const char*)(gbase) + voffB[_i], (bufoff) + ldsw + _i * 8192); } while (0)
#define PG8_GO_LOAD(tsel) do { if (g.gather) { _Pragma("unroll") for (int _i = 0; _i < 2; ++_i) { int _R, _C; stage_rc(tid * 16 + _i * 8192, _R, _C); _Pragma("unroll") for (int _h = 0; _h < 2; ++_h) \
            go[_h][_i] = *(const LAS unsigned*)(lds + LDS_TABO + (tsel) * 1024 + _h * 512 + _R * 4) + (unsigned)(_C * 2); } } } while (0)
#define PG8_STAGE_A(bufoff, gbase, kt, h) do { _Pragma("unroll") for (int _i = 0; _i < 2; ++_i) PG8_GLDS((const char*)(gbase) + (size_t)(kt) * kstep + go[h][_i], (bufoff) + ldsw + _i * 8192); } while (0)
#define PG8_STAGE_AN(bufoff, gbase, tsel, kt, h) do { if (last && g.gather) { _Pragma("unroll") for (int _i = 0; _i < 2; ++_i) { int _R, _C; stage_rc(tid * 16 + _i * 8192, _R, _C); \
            const unsigned _o = *(const LAS unsigned*)(lds + LDS_TABO + (tsel) * 1024 + (h) * 512 + _R * 4) + (unsigned)(_C * 2); PG8_GLDS((const char*)(gbase) + (size_t)(kt) * kstep + _o, (bufoff) + ldsw + _i * 8192); } \
        } else PG8_STAGE_A(bufoff, gbase, kt, h); } while (0)
#define PG8_LDA(dst, b, h) do { _Pragma("unroll") for (int m = 0; m < 4; ++m) _Pragma("unroll") for (int k = 0; k < 2; ++k) dst[m][k] = *(const LAS bf16x8*)(lds + PG8_SA(b, h) + aoff + m * 2048 + k * 1024); } while (0)
#define PG8_LDB(dst, b, h) do { _Pragma("unroll") for (int n = 0; n < 2; ++n) _Pragma("unroll") for (int k = 0; k < 2; ++k) dst[n][k] = *(const LAS bf16x8*)(lds + PG8_SB(b, h) + boff + n * 2048 + k * 1024); } while (0)
#define PG8_MMA(ai, bj, At, Bt) do { __builtin_amdgcn_s_setprio(1); _Pragma("unroll") for (int m = 0; m < 4; ++m) _Pragma("unroll") for (int n = 0; n < 2; ++n) _Pragma("unroll") for (int k = 0; k < 2; ++k) \
        acc[ai][bj][m][n] = __builtin_amdgcn_mfma_f32_16x16x32_bf16(Bt[n][k], At[m][k], acc[ai][bj][m][n], 0, 0, 0); __builtin_amdgcn_s_setprio(0); } while (0)
#define PG8_WAIT_V(n) asm volatile("s_waitcnt vmcnt(" #n ")" ::: "memory")
#define PG8_WAIT_L(n) asm volatile("s_waitcnt lgkmcnt(" #n ")" ::: "memory")
#define PG8_BAR __builtin_amdgcn_s_barrier()
#define PG8_SCHED __builtin_amdgcn_sched_barrier(0)
    Unit cur, nxt; int ui = 0;
    if (!order_next(g, lds, 0, cur)) return;
    f32x4 acc[2][2][4][2];
#pragma unroll
    for (int a = 0; a < 2; ++a)
#pragma unroll
        for (int b = 0; b < 2; ++b)
#pragma unroll
            for (int m = 0; m < 4; ++m)
#pragma unroll
                for (int n = 0; n < 2; ++n) acc[a][b][m][n] = (f32x4){0.f, 0.f, 0.f, 0.f};
    bf16x8 At[4][2], B0[2][2], B1[2][2];
    if (g.moe) { order_fill(g, lds, cur); __syncthreads(); PG8_GO_LOAD(cur.slot); }
    const char* cA = order_a(g, cur); const char* cB = order_b(g, cur); int cT = cur.slot;
    PG8_STAGE_B(PG8_SB(0, 0), cB); PG8_STAGE_B(PG8_SB(0, 1), cB + hstep); PG8_STAGE_A(PG8_SA(0, 0), cA, 0, 0); PG8_STAGE_A(PG8_SA(0, 1), cA, 0, 1);
    if (wr == 1) PG8_BAR;
    PG8_WAIT_V(2); PG8_BAR;
    PG8_STAGE_B(PG8_SB(1, 0), cB + kstep); PG8_STAGE_A(PG8_SA(1, 0), cA, 1, 0); PG8_STAGE_B(PG8_SB(1, 1), cB + hstep + kstep);
    PG8_WAIT_V(6); PG8_BAR;
    for (;;) {
        const bool has_next = order_next(g, lds, ui + 1, nxt);
        if (g.moe && has_next) order_fill(g, lds, nxt);
        const char* nA = has_next ? order_a(g, nxt) : cA; const char* nB = has_next ? order_b(g, nxt) : cB; const int nT = has_next ? nxt.slot : cT;
        for (int t = 0; t < nt; t += 2) {
            const bool last = (t == nt - 2);
            const char* a2b = last ? nA : cA; const int a2k = last ? 0 : t + 2, a3k = a2k + 1;
            const char* b2 = last ? nB : cB + (size_t)(t + 2) * kstep; const char* b3 = b2 + kstep;
            PG8_LDB(B0, 0, 0); PG8_LDB(B1, 0, 1); PG8_SCHED; PG8_LDA(At, 0, 0); PG8_STAGE_A(PG8_SA(1, 1), cA, t + 1, 1);
            PG8_WAIT_V(8); PG8_WAIT_L(0); PG8_BAR; PG8_MMA(0, 0, At, B0); PG8_MMA(0, 1, At, B1); PG8_BAR; PG8_SCHED;
            PG8_LDA(At, 0, 1); PG8_STAGE_B(PG8_SB(0, 0), b2); PG8_STAGE_B(PG8_SB(0, 1), b2 + hstep); PG8_STAGE_AN(PG8_SA(0, 0), a2b, nT, a2k, 0);
            PG8_WAIT_V(8); PG8_WAIT_L(0); PG8_BAR; PG8_MMA(1, 0, At, B0); PG8_MMA(1, 1, At, B1); PG8_BAR; PG8_SCHED;
            PG8_LDB(B0, 1, 0); PG8_LDB(B1, 1, 1); PG8_SCHED; PG8_LDA(At, 1, 0); PG8_STAGE_AN(PG8_SA(0, 1), a2b, nT, a2k, 1);
            PG8_WAIT_V(8); PG8_WAIT_L(0); PG8_BAR; PG8_MMA(0, 0, At, B0); PG8_MMA(0, 1, At, B1); PG8_BAR; PG8_SCHED;
            PG8_LDA(At, 1, 1); PG8_STAGE_B(PG8_SB(1, 0), b3); PG8_STAGE_B(PG8_SB(1, 1), b3 + hstep); PG8_STAGE_AN(PG8_SA(1, 0), a2b, nT, a3k, 0);
            PG8_WAIT_V(8); PG8_WAIT_L(0); PG8_BAR; PG8_MMA(1, 0, At, B0); PG8_MMA(1, 1, At, B1); PG8_BAR; PG8_SCHED;
        }
        if (wr == 0) PG8_BAR;
        if (!g.skip_epi) gemm_epilogue(g, lds, acc, cur, wr, wc, fr, fq);
        if (!has_next) break;
#pragma unroll
        for (int a = 0; a < 2; ++a)
#pragma unroll
            for (int b = 0; b < 2; ++b)
#pragma unroll
                for (int m = 0; m < 4; ++m)
#pragma unroll
                    for (int n = 0; n < 2; ++n) acc[a][b][m][n] = (f32x4){0.f, 0.f, 0.f, 0.f};
        cur = nxt; cA = nA; cB = nB; cT = nT; ++ui;
        PG8_GO_LOAD(cT);
        if (wr == 1) PG8_BAR;
    }
    PG8_WAIT_V(0);
    PG8_BAR;
#undef PG8_SA
#undef PG8_SB
#undef PG8_GLDS
#undef PG8_STAGE_A
#undef PG8_STAGE_AN
#undef PG8_GO_LOAD
#undef PG8_STAGE_B
#undef PG8_LDA
#undef PG8_LDB
#undef PG8_MMA
#undef PG8_WAIT_V
#undef PG8_WAIT_L
#undef PG8_BAR
#undef PG8_SCHED
}
__device__ __forceinline__ f32x4 meta_dot(const bf16_t* Am, const bf16_t* Brow0, int K, int fr, int fq) {
    f32x4 acc = {0.f, 0.f, 0.f, 0.f};
    const bf16_t* ap = Am + (size_t)fr * K + 8 * fq; const bf16_t* bp = Brow0 + (size_t)fr * K + 8 * fq;
#pragma unroll 4
    for (int ks = 0; ks < K / 32; ++ks) acc = mfma16(as_bf16x8(*(const u32x4*)(bp + 32 * ks)), as_bf16x8(*(const u32x4*)(ap + 32 * ks)), acc);
    return acc;
}

struct ConvDesc { const float* src; const float* gain; bf16_t* dst; int ld, K, mode, kblk, nblk; };
constexpr int NWT_E = 768;
constexpr int NWT_MOE = 4 * 32 * NWT_E, NWT_DENSE = 2 * 1024 + 256 + 2 * 512 + 2 * 512;
__device__ __forceinline__ ConvDesc conv_decode(CArgs& a, int ti) {
    ConvDesc d;
    if (ti < NWT_MOE) {
        const int le = ti / NWT_E, r = ti % NWT_E, which = r >> 8, tt = r & 255, layer = le >> 5;
        if (which < 2) { d.src = a.in[26 + which] + (size_t)le * D * DEXP; d.ld = DEXP; d.K = D; d.gain = a.in[3] + (size_t)layer * D; d.dst = (bf16_t*)(a.ws + WS_W1) + (size_t)le * 1024 * 1024; d.mode = 1 + which; d.nblk = tt & 15; d.kblk = tt >> 4; }
        else { d.src = a.in[28] + (size_t)le * DEXP * D; d.ld = D; d.K = DEXP; d.gain = nullptr; d.dst = (bf16_t*)(a.ws + WS_W2) + (size_t)le * 1024 * 512; d.mode = 0; d.nblk = tt & 31; d.kblk = tt >> 5; }
    } else {
        int r = ti - NWT_MOE;
        if (r < 2048) { const int layer = r >> 10, tt = r & 1023, nb = tt & 63, half = nb >> 5;
            d.src = a.in[14] + (size_t)layer * D * 2 * D + half * D; d.ld = 2 * D; d.K = D; d.gain = nullptr; d.dst = (bf16_t*)(a.ws + WS_WGLU) + (size_t)layer * 2048 * 1024; d.mode = 1 + half; d.nblk = nb & 31; d.kblk = tt >> 6; }
        else if ((r -= 2048) < 256) { d.src = a.in[15]; d.ld = 512; d.K = D; d.gain = a.in[4]; d.dst = (bf16_t*)(a.ws + WS_WKVQ); d.mode = 0; d.nblk = r & 15; d.kblk = r >> 4; }
        else if ((r -= 256) < 1024) { const int j = r >> 9, tt = r & 511;
            d.src = a.in[17] + (size_t)j * D * D; d.ld = D; d.K = D; d.gain = a.in[2] + (size_t)(2 + j) * D; d.dst = j == 0 ? (bf16_t*)(a.ws + WS_WKVQ) + (size_t)512 * 1024 : (bf16_t*)(a.ws + WS_WQ1); d.mode = 0; d.nblk = tt & 31; d.kblk = tt >> 5; }
        else { r -= 1024; const int j = r >> 9, tt = r & 511;
            d.src = a.in[20] + (size_t)j * D * D; d.ld = D; d.K = D; d.gain = nullptr; d.dst = (bf16_t*)(a.ws + WS_WO) + (size_t)j * 1024 * 1024; d.mode = 0; d.nblk = tt & 31; d.kblk = tt >> 5; }
    }
    return d;
}
__device__ __forceinline__ void conv_load(const ConvDesc& d, int lane, f32x4 (&v)[8]) {
    const float* p = d.src + (size_t)(d.kblk * 64 + 8 * (lane >> 3)) * d.ld + d.nblk * 32 + 4 * (lane & 7);
#pragma unroll
    for (int j = 0; j < 8; ++j) v[j] = __builtin_nontemporal_load((const f32x4*)(p + (size_t)j * d.ld));
}
__device__ __forceinline__ void conv_store(const ConvDesc& d, int lane, f32x4 (&v)[8]) {
    const int k0 = d.kblk * 64 + 8 * (lane >> 3);
    if (d.gain) { const f32x4 g0 = *(const f32x4*)(d.gain + k0), g1 = *(const f32x4*)(d.gain + k0 + 4);
        v[0] *= g0[0]; v[1] *= g0[1]; v[2] *= g0[2]; v[3] *= g0[3]; v[4] *= g1[0]; v[5] *= g1[1]; v[6] *= g1[2]; v[7] *= g1[3]; }
    const int n = d.nblk * 32 + 4 * (lane & 7), row = d.mode == 0 ? n : (256 * (n >> 7) + (n & 127) + (d.mode == 2 ? 128 : 0));
    bf16_t* q = d.dst + (size_t)row * d.K + k0;
#pragma unroll
    for (int c = 0; c < 4; ++c) {
        u32x4 w; w.x = cvt_pk_bf16(v[0][c], v[1][c]); w.y = cvt_pk_bf16(v[2][c], v[3][c]); w.z = cvt_pk_bf16(v[4][c], v[5][c]); w.w = cvt_pk_bf16(v[6][c], v[7][c]);
        asm volatile("global_store_dwordx4 %0, %1, off sc1\n\ts_nop 1" :: "v"(q + (size_t)c * d.K), "v"(w) : "memory");
    }
}
__device__ __forceinline__ void convert_weights(CArgs& a) {
    const int lane = opaque_tid() & 63, gw = (opaque_tid() >> 6) * GRID + opaque_bid();
    for (int ti = NWT_MOE + gw; ti < NWT_MOE + NWT_DENSE; ti += GRID * 16) {
        const int t1 = ti + GRID * 8; const bool two = t1 < NWT_MOE + NWT_DENSE;
        const ConvDesc d0 = conv_decode(a, ti); ConvDesc d1 = d0; f32x4 va[8], vb[8];
        conv_load(d0, lane, va);
        if (two) { d1 = conv_decode(a, t1); conv_load(d1, lane, vb); }
        conv_store(d0, lane, va);
        if (two) conv_store(d1, lane, vb);
    }
}
struct BgConv {
    CArgs* a; volatile LAS unsigned* st;
    __device__ __forceinline__ int claim() const {
        int t = 0;
        if ((opaque_tid() & 63) == 0) { const unsigned x = xb_xcc_id() & 7u; t = (int)(xb_add((unsigned*)(a->ws + WS_CTL) + CW_BGC + 64 * x, 1u) * 16u + x); }
        return __builtin_amdgcn_readfirstlane(t);
    }
    __device__ __forceinline__ int claim_run() {
        const int t = claim(); const int lane = opaque_tid() & 63;
        const bool v0 = t < NWT_MOE, v1 = t + 8 < NWT_MOE;
        ConvDesc d0, d1; f32x4 va[8], vb[8];
        if (v0) { d0 = conv_decode(*a, t); conv_load(d0, lane, va); }
        if (v1) { d1 = conv_decode(*a, t + 8); conv_load(d1, lane, vb); }
        if (v0) conv_store(d0, lane, va);
        if (v1) conv_store(d1, lane, vb); else if (lane == 0) st[3] = 1u;
        return t + 8;
    }
    __device__ __forceinline__ void step() { if (st[3] == 0u) (void)claim_run(); else __builtin_amdgcn_s_sleep(32); }
    __device__ __forceinline__ void park() {}
    __device__ __forceinline__ void drain_others(int limit) {
        if (opaque_tid() < 64) {
            for (unsigned x = 0; x < 8u; ++x) {
                unsigned* ctr = (unsigned*)(a->ws + WS_CTL) + CW_BGC + 64 * x;
                while ((int)((unsigned)__builtin_amdgcn_readfirstlane(xb_ld(ctr)) * 16u + x) < limit) {
                    int t = 0; if ((opaque_tid() & 63) == 0) t = (int)(xb_add(ctr, 1u) * 16u + x);
                    t = __builtin_amdgcn_readfirstlane(t);
                    const int lane = opaque_tid() & 63;
                    if (t < NWT_MOE) { const ConvDesc d = conv_decode(*a, t); f32x4 v[8]; conv_load(d, lane, v); conv_store(d, lane, v); }
                    if (t + 8 < NWT_MOE) { const ConvDesc d = conv_decode(*a, t + 8); f32x4 v[8]; conv_load(d, lane, v); conv_store(d, lane, v); }
                }
            }
        }
    }
    __device__ __forceinline__ void run_until(int limit, int budget) {
        for (int n = 0; n < budget; ++n) { if (st[3] != 0u) break; if (claim_run() >= limit) break; }
    }
};

struct cplx { float re, im; };
__device__ __forceinline__ cplx cmul(cplx a, cplx b) { return {a.re * b.re - a.im * b.im, a.re * b.im + a.im * b.re}; }

__device__ __forceinline__ void hw_sincos(float x, float& sn, float& cs) { float r = x * 0.15915494309189535f; r -= floorf(r); sn = __builtin_amdgcn_sinf(r); cs = __builtin_amdgcn_cosf(r); }
__device__ __forceinline__ void s5_tables(CArgs& a, int layer, int g, int part, LAS unsigned char* lds) {
    LAS f32x2* pw = (LAS f32x2*)lds;
    LAS f32x2* bb = (LAS f32x2*)(lds + 64 * 17 * 8);
    LAS f32x2* cc = bb + 64 * 16;
    const int tid = opaque_tid();
    const float* a_re = a.in[6] + ((size_t)layer * 64 + g) * 64; const float* a_im = a.in[7] + ((size_t)layer * 64 + g) * 64;
    const float dt = expf(a.in[8][layer * 64 + g]);
    for (int idx = tid; idx < 64 * 17; idx += NTHREADS) {
        const int p = idx / 17, d = idx % 17;
        const float mag = expf(a_re[p] * dt * (float)d), ang = a_im[p] * dt * (float)d;
        float s, c; hw_sincos(ang, s, c);
        pw[idx] = (f32x2){mag * c, mag * s};
    }
    const float* b_re = a.in[9] + ((size_t)layer * 64 + g) * 1024; const float* b_im = a.in[10] + ((size_t)layer * 64 + g) * 1024;
    const float* c_re = a.in[11] + ((size_t)layer * 64 + g) * 1024; const float* c_im = a.in[12] + ((size_t)layer * 64 + g) * 1024;
    for (int idx = tid; idx < 1024; idx += NTHREADS) {
        const int p = idx >> 4;
        const float lr = a_re[p], li = a_im[p];
        const float mag = expf(lr * dt), ang = li * dt; float s, c; hw_sincos(ang, s, c);
        const float nr = mag * c - 1.0f, ni = mag * s;
        const float den = 1.0f / (lr * lr + li * li);
        const cplx f = {(nr * lr + ni * li) * den, (ni * lr - nr * li) * den};
        const cplx r = cmul(f, (cplx){b_re[idx], b_im[idx]});
        bb[idx] = (f32x2){r.re, r.im};
        cc[idx] = (f32x2){c_re[idx], c_im[idx]};
    }
    __syncthreads();
    unsigned char* tbl = a.ws + WS_TBL + ((size_t)layer * 64 + g) * TBL_STRIDE;
    for (int idx = part * 512 + tid; idx < part * 512 + 512; idx += NTHREADS) {
        const int delta = idx >> 6, l = idx & 63, c1 = l & 15, q4 = l >> 4, d = delta - (q4 >> 1);
        float v[8];
#pragma unroll
        for (int j = 0; j < 8; ++j) v[j] = 0.f;
        if (d >= 0) {
            for (int p = 0; p < 64; ++p) {
                const f32x2 cw = cc[c1 * 64 + p], pp = pw[p * 17 + d];
                const cplx t = cmul((cplx){cw.x, cw.y}, (cplx){pp.x, pp.y});
#pragma unroll
                for (int j = 0; j < 8; ++j) { const f32x2 bw = bb[p * 16 + 8 * (q4 & 1) + j]; v[j] += t.re * bw.x - t.im * bw.y; }
            }
        }
        u32x4 w; w.x = cvt_pk_bf16(v[0], v[1]); w.y = cvt_pk_bf16(v[2], v[3]); w.z = cvt_pk_bf16(v[4], v[5]); w.w = cvt_pk_bf16(v[6], v[7]);
        *(u32x4*)(tbl + TBL_K + (size_t)idx * 16) = w;
    }
    if (part == 0)
    for (int idx = tid; idx < 64 * 64; idx += NTHREADS) {
        const int f = idx >> 6, l = idx & 63, rt = f >> 3, ks = f & 7, q4 = l >> 4, rho = 16 * rt + (l & 15), p = rho & 63, im = rho >> 6;
        const int k0 = 32 * ks + 8 * q4, jpos = k0 >> 4, c20 = k0 & 15;
        const f32x2 pp = pw[p * 17 + (15 - jpos)];
        float v[8];
#pragma unroll
        for (int j = 0; j < 8; ++j) { const f32x2 bw = bb[p * 16 + c20 + j]; const cplx t = cmul((cplx){pp.x, pp.y}, (cplx){bw.x, bw.y}); v[j] = im ? t.im : t.re; }
        u32x4 w; w.x = cvt_pk_bf16(v[0], v[1]); w.y = cvt_pk_bf16(v[2], v[3]); w.z = cvt_pk_bf16(v[4], v[5]); w.w = cvt_pk_bf16(v[6], v[7]);
        *(u32x4*)(tbl + TBL_M + (size_t)idx * 16) = w;
    }
    if (part == 1)
    for (int idx = tid; idx < 64 * 64; idx += NTHREADS) {
        const int f = idx >> 6, l = idx & 63, i = f >> 2, ks = f & 3, q4 = l >> 4, c1 = l & 15;
        const int s0 = 32 * ks + 8 * q4;
        float v[8];
#pragma unroll
        for (int j = 0; j < 8; ++j) { const int sg = s0 + j, p = sg & 63; const f32x2 cw = cc[c1 * 64 + p], pp = pw[p * 17 + i + 1];
            const cplx t = cmul((cplx){cw.x, cw.y}, (cplx){pp.x, pp.y}); v[j] = (sg >> 6) ? -t.im : t.re; }
        u32x4 w; w.x = cvt_pk_bf16(v[0], v[1]); w.y = cvt_pk_bf16(v[2], v[3]); w.z = cvt_pk_bf16(v[4], v[5]); w.w = cvt_pk_bf16(v[6], v[7]);
        *(u32x4*)(tbl + TBL_N + (size_t)idx * 16) = w;
    }
    if (part == 1 && tid < 64) *(f32x2*)(tbl + TBL_A16 + tid * 8) = pw[tid * 17 + 16];
    __syncthreads();
}

__device__ __forceinline__ void row_norm_store(const f32x4 (&v)[4], float ssq, int lane, const float* g0, bf16_t* o0) {
    const float rstd = 1.0f / sqrtf(ssq * (1.0f / D) + RMS_EPS);
#pragma unroll
    for (int j = 0; j < 4; ++j) {
        const int c = 4 * lane + 256 * j;
        f32x4 g = {1.f, 1.f, 1.f, 1.f}; if (g0) g = *(const f32x4*)(g0 + c);
        u32x2 w; w.x = cvt_pk_bf16(v[j][0] * rstd * g[0], v[j][1] * rstd * g[1]); w.y = cvt_pk_bf16(v[j][2] * rstd * g[2], v[j][3] * rstd * g[3]);
        *(u32x2*)(o0 + c) = w;
    }
}
__device__ __forceinline__ void phase_prep(CArgs& a, LAS unsigned char* lds) {
    if (opaque_bid() < 128) { s5_tables(a, opaque_bid() >> 6, opaque_bid() & 63, 0, lds); s5_tables(a, opaque_bid() >> 6, opaque_bid() & 63, 1, lds); }
    if (opaque_tid() < 96) {
        const int item = opaque_bid() * 96 + opaque_tid(), layer = item / 6144, idx = item % 6144;
        const float* wg = a.in[22] + (size_t)layer * D * NGRP; const float* we = a.in[24] + (size_t)layer * D * NEXP; const float* gain = a.in[3] + (size_t)layer * D;
        const int l = idx & 63, ks = (idx >> 6) & 31, rt = idx >> 11, o = 16 * rt + (l & 15), k0 = 32 * ks + 8 * (l >> 4);
        float v[8];
#pragma unroll
        for (int jq = 0; jq < 8; ++jq) v[jq] = (o < 4 ? wg[(size_t)(k0 + jq) * NGRP + o] : (o < 36 ? we[(size_t)(k0 + jq) * NEXP + (o - 4)] : 0.f)) * gain[k0 + jq];
        u32x4 w; w.x = cvt_pk_bf16(v[0], v[1]); w.y = cvt_pk_bf16(v[2], v[3]); w.z = cvt_pk_bf16(v[4], v[5]); w.w = cvt_pk_bf16(v[6], v[7]);
        *(u32x4*)(a.ws + WS_RW + (size_t)layer * 98304 + (size_t)idx * 16) = w;
    }
    convert_weights(a);
    const int lane = opaque_tid() & 63, gw = opaque_bid() * 8 + (opaque_tid() >> 6);
    float* RSTD = (float*)(a.ws + WS_RSTD);
    for (int row0 = gw; row0 < RT; row0 += GRID * 8 * 4) {
        f32x4 v[4][4];
#pragma unroll
        for (int q = 0; q < 4; ++q) { const int row = row0 + q * GRID * 8, rr = row < RT ? row : RT - 1;
            const float* src = rr < NREAL ? a.in[0] + (size_t)rr * D : a.in[1] + (size_t)(rr - NREAL) * D;
#pragma unroll
            for (int j = 0; j < 4; ++j) v[q][j] = *(const f32x4*)(src + 4 * lane + 256 * j); }
#pragma unroll
        for (int q = 0; q < 4; ++q) { const int row = row0 + q * GRID * 8; float ssq = 0.f;
#pragma unroll
            for (int j = 0; j < 4; ++j) ssq += v[q][j][0] * v[q][j][0] + v[q][j][1] * v[q][j][1] + v[q][j][2] * v[q][j][2] + v[q][j][3] * v[q][j][3];
            ssq = wave_sum(ssq);
            if (lane == 0 && row < RT) RSTD[row] = 1.0f / sqrtf(ssq * (1.0f / D) + RMS_EPS); }
    }
}

constexpr int S5_CH = 528;
constexpr int S5_NCH = 129, S5_NCHP = 144;
__device__ __forceinline__ cplx cmulc(cplx x, cplx y) { return {x.re * y.re - x.im * y.im, x.re * y.im + x.im * y.re}; }
__device__ __forceinline__ void phase_s5(CArgs& a, int layer, LAS unsigned char* lds) {
    LAS unsigned char* Ul = lds; LAS unsigned char* Sl = lds + S5_NCHP * S5_CH;
    const int tid = opaque_tid(), lane = tid & 63, w = __builtin_amdgcn_readfirstlane(tid >> 6), tc = lane & 15, q4 = lane >> 4;
    const bf16_t* H = (const bf16_t*)(a.ws + WS_H); const float* RSTD = (const float*)(a.ws + WS_RSTD); bf16_t* Z = (bf16_t*)(a.ws + WS_Z);
    const int b = opaque_bid() >> 5, gp = 2 * (opaque_bid() & 31);
    u32x4 keep[9];
    {
        const int half = tid & 1, c = 16 * gp + 8 * half;
        const float* gn = a.in[2] + (size_t)layer * D + c;
        const f32x4 ga0 = *(const f32x4*)gn, ga1 = *(const f32x4*)(gn + 4), gb0 = *(const f32x4*)(gn + 16), gb1 = *(const f32x4*)(gn + 20);
#pragma unroll
        for (int k0 = 0; k0 < 9; k0 += 3) {
            float rs[3]; u32x4 ha[3], hb[3]; f32x4 xa0[3], xa1[3], xb0[3], xb1[3];
#pragma unroll
            for (int q = 0; q < 3; ++q) {
                const int idx = tid + (k0 + q) * NTHREADS, tok = (idx < LT * 2 ? idx : LT * 2 - 1) >> 1, row = row_of(b, tok);
                rs[q] = RSTD[row];
                if (layer == 0) { const float* src = (row < NREAL ? a.in[0] + (size_t)row * D : a.in[1] + (size_t)(row - NREAL) * D) + c;
                    xa0[q] = *(const f32x4*)src; xa1[q] = *(const f32x4*)(src + 4); xb0[q] = *(const f32x4*)(src + 16); xb1[q] = *(const f32x4*)(src + 20); }
                else { ha[q] = *(const u32x4*)(H + (size_t)row * D + c); hb[q] = *(const u32x4*)(H + (size_t)row * D + c + 16); }
            }
#pragma unroll
            for (int q = 0; q < 3; ++q) {
                const int idx = tid + (k0 + q) * NTHREADS, tok = idx >> 1; const float r_ = rs[q];
                float va[8], vb[8];
                if (layer == 0) {
#pragma unroll
                    for (int e = 0; e < 4; ++e) { va[e] = xa0[q][e]; va[4 + e] = xa1[q][e]; vb[e] = xb0[q][e]; vb[4 + e] = xb1[q][e]; }
                } else {
                    const u32x4 p = ha[q], r2 = hb[q];
                    va[0] = bf16_lo(p.x); va[1] = bf16_hi(p.x); va[2] = bf16_lo(p.y); va[3] = bf16_hi(p.y); va[4] = bf16_lo(p.z); va[5] = bf16_hi(p.z); va[6] = bf16_lo(p.w); va[7] = bf16_hi(p.w);
                    vb[0] = bf16_lo(r2.x); vb[1] = bf16_hi(r2.x); vb[2] = bf16_lo(r2.y); vb[3] = bf16_hi(r2.y); vb[4] = bf16_lo(r2.z); vb[5] = bf16_hi(r2.z); vb[6] = bf16_lo(r2.w); vb[7] = bf16_hi(r2.w);
                }
                u32x4 v; v.x = cvt_pk_bf16(va[0] * r_ * ga0[0], va[1] * r_ * ga0[1]); v.y = cvt_pk_bf16(va[2] * r_ * ga0[2], va[3] * r_ * ga0[3]);
                v.z = cvt_pk_bf16(va[4] * r_ * ga1[0], va[5] * r_ * ga1[1]); v.w = cvt_pk_bf16(va[6] * r_ * ga1[2], va[7] * r_ * ga1[3]);
                if (idx < LT * 2) *(LAS u32x4*)(Ul + (tok >> 4) * S5_CH + (tok & 15) * 32 + half * 16) = v;
                u32x4 k; k.x = cvt_pk_bf16(vb[0] * r_ * gb0[0], vb[1] * r_ * gb0[1]); k.y = cvt_pk_bf16(vb[2] * r_ * gb0[2], vb[3] * r_ * gb0[3]);
                k.z = cvt_pk_bf16(vb[4] * r_ * gb1[0], vb[5] * r_ * gb1[1]); k.w = cvt_pk_bf16(vb[6] * r_ * gb1[2], vb[7] * r_ * gb1[3]);
                keep[k0 + q] = k;
            }
        }
    }
#pragma unroll 1
    for (int ui = 0; ui < 2; ++ui) {
        const int g = gp + ui;
        const unsigned char* tbl = a.ws + WS_TBL + ((size_t)layer * 64 + g) * TBL_STRIDE;
        if (ui == 1) {
            const int half = tid & 1;
#pragma unroll
            for (int k = 0; k < 9; ++k) { const int idx = tid + k * NTHREADS, tok = idx >> 1; if (idx < LT * 2) *(LAS u32x4*)(Ul + (tok >> 4) * S5_CH + (tok & 15) * 32 + half * 16) = keep[k]; }
        }
        bf16x8 mf[8];
#pragma unroll
        for (int ks = 0; ks < 8; ++ks) mf[ks] = as_bf16x8(*(const u32x4*)(tbl + TBL_M + ((size_t)(w * 8 + ks) * 64 + lane) * 16));
        const int i0 = w, i1 = 15 - w;
        bf16x8 kf0[8], kf1[8], nf0[4], nf1[4];
#pragma unroll
        for (int jj = 0; jj < 8; ++jj) {
            const int d0 = i0 - 2 * jj, d1 = i1 - 2 * jj;
            kf0[jj] = as_bf16x8(*(const u32x4*)(tbl + TBL_K + ((size_t)(d0 >= 0 ? d0 : 0) * 64 + lane) * 16));
            kf1[jj] = as_bf16x8(*(const u32x4*)(tbl + TBL_K + ((size_t)(d1 >= 0 ? d1 : 0) * 64 + lane) * 16));
        }
#pragma unroll
        for (int ks = 0; ks < 4; ++ks) {
            nf0[ks] = as_bf16x8(*(const u32x4*)(tbl + TBL_N + ((size_t)(i0 * 4 + ks) * 64 + lane) * 16));
            nf1[ks] = as_bf16x8(*(const u32x4*)(tbl + TBL_N + ((size_t)(i1 * 4 + ks) * 64 + lane) * 16));
        }
        const f32x2 a16v = *(const f32x2*)(tbl + TBL_A16 + lane * 8);
        __syncthreads();
        {
#pragma unroll 1
            for (int cg = 0; cg < 9; ++cg) {
                const int n = 16 * cg + tc;
                f32x4 acc = {0.f, 0.f, 0.f, 0.f};
#pragma unroll
                for (int ks = 0; ks < 8; ++ks) { const bf16x8 ub = *(LAS bf16x8*)(Ul + n * S5_CH + ks * 64 + q4 * 16); acc = mfma16(mf[ks], ub, acc); }
                *(LAS f32x4*)(Sl + n * S5_CH + (16 * w + 4 * q4) * 4) = acc;
            }
        }
        __syncthreads();
        {
            const cplx a1 = {a16v.x, a16v.y};
            const int nb0 = 16 * w, ncnt = w == 7 ? 17 : 16;
            cplx s = {0.f, 0.f};
#pragma unroll 4
            for (int j = 0; j < 16; ++j) { const float xr = *(LAS float*)(Sl + (nb0 + j) * S5_CH + lane * 4), xi = *(LAS float*)(Sl + (nb0 + j) * S5_CH + 256 + lane * 4); const cplx t = cmulc(a1, s); s = {t.re + xr, t.im + xi}; }
            if (w < 7) { *(LAS float*)(Sl + (130 + w) * S5_CH + lane * 4) = s.re; *(LAS float*)(Sl + (130 + w) * S5_CH + 256 + lane * 4) = s.im; }
            cplx A = a1;
#pragma unroll
            for (int q = 0; q < 4; ++q) A = cmulc(A, A);
            __syncthreads();
            cplx c = {0.f, 0.f};
            for (int v = 0; v < w; ++v) { const float er = *(LAS float*)(Sl + (130 + v) * S5_CH + lane * 4), ei = *(LAS float*)(Sl + (130 + v) * S5_CH + 256 + lane * 4); const cplx t = cmulc(A, c); c = {t.re + er, t.im + ei}; }
            float sr = c.re, si = c.im;
#pragma unroll 1
            for (int nb = 0; nb < 3; ++nb) {
                const int cntb = nb < 2 ? 8 : ncnt - 16;
                float xr[8], xi[8];
#pragma unroll
                for (int j = 0; j < 8; ++j) { const int n = nb0 + nb * 8 + (j < cntb ? j : 0); xr[j] = *(LAS float*)(Sl + n * S5_CH + lane * 4); xi[j] = *(LAS float*)(Sl + n * S5_CH + 256 + lane * 4); }
                asm volatile("s_waitcnt lgkmcnt(0)" ::: "memory");
#pragma unroll
                for (int j = 0; j < 8; ++j) {
                    if (j < cntb) {
                        const int n = nb0 + nb * 8 + j;
                        const unsigned pr = cvt_pk_bf16(sr, si);
                        *(LAS unsigned short*)(Sl + n * S5_CH + lane * 2) = (unsigned short)(pr & 0xffffu);
                        *(LAS unsigned short*)(Sl + n * S5_CH + 128 + lane * 2) = (unsigned short)(pr >> 16);
                        const float nr = a1.re * sr - a1.im * si + xr[j], ni = a1.re * si + a1.im * sr + xi[j];
                        sr = nr; si = ni;
                    }
                }
                asm volatile("" ::: "memory");
            }
        }
        __syncthreads();
        {
            const f32x4 dsk = *(const f32x4*)(a.in[13] + (size_t)layer * D + 16 * g + 4 * q4);
#pragma unroll 1
            for (int cg = 0; cg < 9; ++cg) {
                const int n = 16 * cg + tc;
                f32x4 acc0 = {0.f, 0.f, 0.f, 0.f}, acc1 = {0.f, 0.f, 0.f, 0.f};
#pragma unroll
                for (int jj = 0; jj < 8; ++jj) {
                    const bf16x8 ub = *(LAS bf16x8*)(Ul + n * S5_CH + jj * 64 + q4 * 16);
                    if (2 * jj <= i0) acc0 = mfma16(kf0[jj], ub, acc0);
                    if (2 * jj <= i1) acc1 = mfma16(kf1[jj], ub, acc1);
                }
#pragma unroll
                for (int ks = 0; ks < 4; ++ks) {
                    const bf16x8 sb = *(LAS bf16x8*)(Sl + n * S5_CH + ks * 64 + q4 * 16);
                    acc0 = mfma16(nf0[ks], sb, acc0); acc1 = mfma16(nf1[ks], sb, acc1);
                }
                if (n < S5_NCH && (n > 0 || b == 0)) {
#pragma unroll
                    for (int h = 0; h < 2; ++h) {
                        const int i = h ? i1 : i0; const f32x4 y = h ? acc1 : acc0;
                        const u32x2 uw = *(LAS u32x2*)(Ul + n * S5_CH + i * 32 + q4 * 8);
                        const float z0 = gelu_tanh(y[0] + dsk[0] * bf16_lo(uw.x)), z1 = gelu_tanh(y[1] + dsk[1] * bf16_hi(uw.x));
                        const float z2 = gelu_tanh(y[2] + dsk[2] * bf16_lo(uw.y)), z3 = gelu_tanh(y[3] + dsk[3] * bf16_hi(uw.y));
                        u32x2 o; o.x = cvt_pk_bf16(z0, z1); o.y = cvt_pk_bf16(z2, z3);
                        *(u32x2*)(Z + (size_t)row_of(b, 16 * n + i) * D + 16 * g + 4 * q4) = o;
                    }
                }
            }
        }
        __syncthreads();
    }
}

__device__ __forceinline__ float ssq4(f32x4 h) { return h[0] * h[0] + h[1] * h[1] + h[2] * h[2] + h[3] * h[3]; }
__device__ __forceinline__ int gwave() { return opaque_bid() * 8 + (opaque_tid() >> 6); }
template <int NACC> __device__ __forceinline__ bool meta_block(LAS unsigned char* lds, const bf16_t* Am, const bf16_t* const (&brow)[NACC], int K, f32x4 (&out)[NACC]) {
    const int tid = opaque_tid(), lane = tid & 63, wid = tid >> 6, fr = lane & 15, fq = lane >> 4, ksl = K / 8;
#pragma unroll
    for (int i = 0; i < NACC; ++i) {
        f32x4 acc = {0.f, 0.f, 0.f, 0.f};
        const bf16_t* ap = Am + (size_t)fr * K + wid * ksl + 8 * fq; const bf16_t* bp = brow[i] + (size_t)fr * K + wid * ksl + 8 * fq;
        for (int ks = 0; ks < ksl / 32; ++ks) acc = mfma16(as_bf16x8(*(const u32x4*)(bp + 32 * ks)), as_bf16x8(*(const u32x4*)(ap + 32 * ks)), acc);
        ((LAS f32x4*)lds)[(wid * NACC + i) * 64 + lane] = acc;
    }
    __syncthreads();
    if (wid == 0) {
#pragma unroll
        for (int i = 0; i < NACC; ++i) { f32x4 s = {0.f, 0.f, 0.f, 0.f};
#pragma unroll
            for (int w = 0; w < 8; ++w) s += ((LAS f32x4*)lds)[(w * NACC + i) * 64 + lane];
            out[i] = s; }
    }
    __syncthreads();
    return wid == 0;
}

__device__ __forceinline__ void load_res8(const GemmDesc& g, size_t off, float (&h)[8]) {
    if (g.res32) { const f32x4 a = *(const f32x4*)(g.res32 + off), b = *(const f32x4*)(g.res32 + off + 4); h[0] = a[0]; h[1] = a[1]; h[2] = a[2]; h[3] = a[3]; h[4] = b[0]; h[5] = b[1]; h[6] = b[2]; h[7] = b[3]; }
    else { const u32x4 w = *(const u32x4*)(g.res16 + off); h[0] = bf16_lo(w.x); h[1] = bf16_hi(w.x); h[2] = bf16_lo(w.y); h[3] = bf16_hi(w.y); h[4] = bf16_lo(w.z); h[5] = bf16_hi(w.z); h[6] = bf16_lo(w.w); h[7] = bf16_hi(w.w); }
}
__device__ __forceinline__ void store_h8(bf16_t* Hout, size_t off, const float (&h)[8]) {
    u32x4 w; w.x = cvt_pk_bf16(h[0], h[1]); w.y = cvt_pk_bf16(h[2], h[3]); w.z = cvt_pk_bf16(h[4], h[5]); w.w = cvt_pk_bf16(h[6], h[7]);
    *(u32x4*)(Hout + off) = w;
}
__device__ __forceinline__ void epi_glu(const GemmDesc& g, const f32x4 (&acc)[2][2][4][2], const Unit& u, int wr, int wc, int fr, int fq) {
#pragma unroll
    for (int ai = 0; ai < 2; ++ai) {
        const int row0 = u.pm * BM + ai * HALF + wr * 64 + fr; const size_t off0 = (size_t)row0 * D + u.pn * 128 + wc * 32 + 8 * fq;
        float h[4][8];
#pragma unroll
        for (int m = 0; m < 4; ++m) load_res8(g, off0 + (size_t)m * 16 * D, h[m]);
#pragma unroll
        for (int m = 0; m < 4; ++m) {
#pragma unroll
            for (int n = 0; n < 2; ++n) { const f32x4 v = acc[ai][0][m][n], gt = acc[ai][1][m][n];
                h[m][4 * n + 0] += v[0] * sigmoidf_(gt[0]); h[m][4 * n + 1] += v[1] * sigmoidf_(gt[1]); h[m][4 * n + 2] += v[2] * sigmoidf_(gt[2]); h[m][4 * n + 3] += v[3] * sigmoidf_(gt[3]); }
            store_h8(g.Hout, off0 + (size_t)m * 16 * D, h[m]);
        }
        asm volatile("" ::: "memory");
    }
}
__device__ __forceinline__ void phase_glu(CArgs& a, int layer, bool dry, LAS unsigned char* lds, GemmDesc& g) {
    const bf16_t* Zb = (const bf16_t*)(a.ws + WS_Z); const bf16_t* W = (const bf16_t*)(a.ws + WS_WGLU) + (size_t)layer * 2048 * 1024;
    g.res32 = layer == 0 ? a.in[0] : nullptr; g.res16 = (const bf16_t*)(a.ws + WS_H); g.Hout = (bf16_t*)(a.ws + (dry ? WS_DUMH : WS_H));
    if (opaque_bid() < 32) {
        const int lane = opaque_tid() & 63, fr = lane & 15, fq = lane >> 4, task = opaque_bid();
        const int c0 = 32 * task, rv = 256 * (c0 >> 7) + (c0 & 127);
        const bf16_t* const br[4] = {W + (size_t)rv * D, W + (size_t)(rv + 16) * D, W + (size_t)(rv + 128) * D, W + (size_t)(rv + 144) * D};
        f32x4 o[4];
        if (meta_block<4>(lds, Zb + (size_t)NREAL * D, br, D, o)) {
#pragma unroll
            for (int n = 0; n < 2; ++n) {
                const f32x4 v = o[n], gt = o[2 + n]; const int c = c0 + 16 * n + 4 * fq;
                f32x4 h;
                if (layer == 0) h = *(const f32x4*)(a.in[1] + (size_t)fr * D + c);
                else { const u32x2 w = *(const u32x2*)(g.res16 + (size_t)(NREAL + fr) * D + c); h = (f32x4){bf16_lo(w.x), bf16_hi(w.x), bf16_lo(w.y), bf16_hi(w.y)}; }
                h[0] += v[0] * sigmoidf_(gt[0]); h[1] += v[1] * sigmoidf_(gt[1]); h[2] += v[2] * sigmoidf_(gt[2]); h[3] += v[3] * sigmoidf_(gt[3]);
                u32x2 w2; w2.x = cvt_pk_bf16(h[0], h[1]); w2.y = cvt_pk_bf16(h[2], h[3]); *(u32x2*)(g.Hout + (size_t)(NREAL + fr) * D + c) = w2;
            }
        }
    }
    g.stride = GRID; g.vb = opaque_bid(); g.kind = EPI_GLU; g.K = D; g.perm = 1; g.gather = 0; g.moe = 0; g.nM = NREAL / BM; g.nN = 2048 / BM; g.nwg = g.nM * g.nN; g.A = (const char*)Zb; g.Bt = (const char*)W;
    g.tstepA = g.tstepB = (size_t)BM * D * 2; g.wstride = 0;
}

__device__ __forceinline__ void epi_oproj(const GemmDesc& g, const f32x4 (&acc)[2][2][4][2], const Unit& u, int wr, int wc, int fr, int fq) {
#pragma unroll
    for (int ai = 0; ai < 2; ++ai)
#pragma unroll
        for (int bj = 0; bj < 2; ++bj) {
            const int row0 = u.pm * BM + ai * HALF + wr * 64 + fr, c0 = u.pn * BM + bj * HALF + wc * 32 + 8 * fq; const size_t off0 = (size_t)row0 * D + c0;
            const f32x4 b0 = *(const f32x4*)(g.bias + c0), b1 = *(const f32x4*)(g.bias + c0 + 4);
            float h[4][8];
#pragma unroll
            for (int m = 0; m < 4; ++m) load_res8(g, off0 + (size_t)m * 16 * D, h[m]);
#pragma unroll
            for (int m = 0; m < 4; ++m) {
#pragma unroll
                for (int n = 0; n < 2; ++n) { const f32x4 v = acc[ai][bj][m][n] + (n ? b1 : b0); h[m][4 * n + 0] += v[0]; h[m][4 * n + 1] += v[1]; h[m][4 * n + 2] += v[2]; h[m][4 * n + 3] += v[3]; }
                store_h8(g.Hout, off0 + (size_t)m * 16 * D, h[m]);
            }
            asm volatile("" ::: "memory");
        }
}
__device__ __forceinline__ void phase_oproj(CArgs& a, int j, bool dry, LAS unsigned char* lds, GemmDesc& g) {
    const bf16_t* Ob = (const bf16_t*)(a.ws + WS_Z); const bf16_t* W = (const bf16_t*)(a.ws + WS_WO) + (size_t)j * 1024 * 1024;
    const float* bo = a.in[21] + (size_t)j * D;
    g.res32 = nullptr; g.res16 = (const bf16_t*)(a.ws + WS_H); g.Hout = (bf16_t*)(a.ws + (dry ? WS_DUMH : WS_H)); g.bias = bo;
    if (opaque_bid() < 32) {
        const int lane = opaque_tid() & 63, fr = lane & 15, fq = lane >> 4, task = opaque_bid(), c0 = 32 * task;
        const bf16_t* const br[2] = {W + (size_t)c0 * D, W + (size_t)(c0 + 16) * D};
        f32x4 o[2];
        if (meta_block<2>(lds, Ob + (size_t)NREAL * D, br, D, o)) {
#pragma unroll
            for (int n = 0; n < 2; ++n) {
                const int c = c0 + 16 * n + 4 * fq; const size_t off = (size_t)(NREAL + fr) * D + c;
                const u32x2 w = *(const u32x2*)(g.res16 + off); f32x4 h = (f32x4){bf16_lo(w.x), bf16_hi(w.x), bf16_lo(w.y), bf16_hi(w.y)};
                h += o[n] + *(const f32x4*)(bo + c);
                u32x2 w2; w2.x = cvt_pk_bf16(h[0], h[1]); w2.y = cvt_pk_bf16(h[2], h[3]); *(u32x2*)(g.Hout + off) = w2;
            }
        }
    }
    g.stride = GRID; g.vb = opaque_bid(); g.kind = EPI_OPROJ; g.K = D; g.perm = 1; g.gather = 0; g.moe = 0; g.nM = NREAL / BM; g.nN = 1024 / BM; g.nwg = g.nM * g.nN; g.A = (const char*)Ob; g.Bt = (const char*)W;
    g.tstepA = g.tstepB = (size_t)BM * D * 2; g.wstride = 0;
}

__device__ __forceinline__ void kvq_store8(const GemmDesc& g, int row, int c, const float (&vin)[8]) {
    const float rs = g.rstd[row]; float v[8];
#pragma unroll
    for (int e = 0; e < 8; ++e) v[e] = vin[e] * rs;
    if (c < 256) {
        const float* b = g.bias + c; u32x4 w; w.x = cvt_pk_bf16(v[0] + b[0], v[1] + b[1]); w.y = cvt_pk_bf16(v[2] + b[2], v[3] + b[3]); w.z = cvt_pk_bf16(v[4] + b[4], v[5] + b[5]); w.w = cvt_pk_bf16(v[6] + b[6], v[7] + b[7]);
        *(u32x4*)(g.O1 + (size_t)row * 256 + c) = w;
    } else if (c < 512) {
        const int cv = c - 256; const float* b = g.bias + c;
        bf16_t* vp = g.O2 + (row < NREAL ? ((size_t)(row >> 11) * 256 + cv) * SEQ + (row & (SEQ - 1)) : VT_META + (size_t)cv * 16 + (row - NREAL));
        const size_t st = row < NREAL ? SEQ : 16;
#pragma unroll
        for (int i = 0; i < 4; ++i) { const unsigned p = cvt_pk_bf16(v[2 * i] + b[2 * i], v[2 * i + 1] + b[2 * i + 1]); vp[(size_t)(2 * i) * st] = (bf16_t)(p & 0xffffu); vp[(size_t)(2 * i + 1) * st] = (bf16_t)(p >> 16); }
    } else {
        const int cq = c - 512; const float* b = g.bias2 + cq;
        u32x4 w; w.x = cvt_pk_bf16((v[0] + b[0]) * 0.125f, (v[1] + b[1]) * 0.125f); w.y = cvt_pk_bf16((v[2] + b[2]) * 0.125f, (v[3] + b[3]) * 0.125f);
        w.z = cvt_pk_bf16((v[4] + b[4]) * 0.125f, (v[5] + b[5]) * 0.125f); w.w = cvt_pk_bf16((v[6] + b[6]) * 0.125f, (v[7] + b[7]) * 0.125f);
        *(u32x4*)(g.O3 + (size_t)row * D + cq) = w;
    }
}
__device__ __forceinline__ void epi_kvq(const GemmDesc& g, const f32x4 (&acc)[2][2][4][2], const Unit& u, int wr, int wc, int fr, int fq) {
    { const int cbase = g.cbase;
#pragma unroll
        for (int ai = 0; ai < 2; ++ai)
#pragma unroll
            for (int m = 0; m < 4; ++m) {
                const int row = u.pm * BM + ai * HALF + wr * 64 + m * 16 + fr;
#pragma unroll
                for (int bj = 0; bj < 2; ++bj) {
                    const int c = cbase + u.pn * BM + bj * HALF + wc * 32 + 8 * fq;
                    const f32x4 v0 = acc[ai][bj][m][0], v1 = acc[ai][bj][m][1];
                    const float v[8] = {v0[0], v0[1], v0[2], v0[3], v1[0], v1[1], v1[2], v1[3]};
                    kvq_store8(g, row, c, v);
                    asm volatile("" ::: "memory");
                }
            }
    }
}
__device__ __forceinline__ void phase_kvq_q(CArgs& a, int jq, LAS unsigned char* lds, GemmDesc& g) {
    const bf16_t* Ub = (const bf16_t*)(a.ws + WS_H); const bf16_t* W = jq == 0 ? (const bf16_t*)(a.ws + WS_WKVQ) : (const bf16_t*)(a.ws + WS_WQ1);
    const int N = jq == 0 ? 1536 : 1024, cbase = jq == 0 ? 0 : 512;
    const int mb0 = jq == 0 ? 160 : 0;
    if (opaque_bid() >= mb0 && opaque_bid() < mb0 + N / 32) {
        const int lane = opaque_tid() & 63, fr = lane & 15, fq = lane >> 4, task = opaque_bid() - mb0;
        const bf16_t* const br[2] = {W + (size_t)(32 * task) * D, W + (size_t)(32 * task + 16) * D};
        f32x4 o[2];
        if (meta_block<2>(lds, Ub + (size_t)NREAL * D, br, D, o)) {
#pragma unroll
            for (int h = 0; h < 2; ++h) {
                const int c = cbase + 32 * task + 16 * h + 4 * fq; const int row = NREAL + fr; const f32x4 v = o[h] * ((const float*)(a.ws + WS_RSTD))[row];
                if (c < 256) { const float* b = a.in[16] + c; u32x2 w; w.x = cvt_pk_bf16(v[0] + b[0], v[1] + b[1]); w.y = cvt_pk_bf16(v[2] + b[2], v[3] + b[3]); *(u32x2*)((bf16_t*)(a.ws + WS_K) + (size_t)row * 256 + c) = w; }
                else if (c < 512) { const int cv = c - 256; const float* b = a.in[16] + c; bf16_t* vp = (bf16_t*)(a.ws + WS_VT) + VT_META + (size_t)cv * 16 + fr;
                    const unsigned p0 = cvt_pk_bf16(v[0] + b[0], v[1] + b[1]), p1 = cvt_pk_bf16(v[2] + b[2], v[3] + b[3]);
                    vp[0] = (bf16_t)(p0 & 0xffffu); vp[16] = (bf16_t)(p0 >> 16); vp[32] = (bf16_t)(p1 & 0xffffu); vp[48] = (bf16_t)(p1 >> 16); }
                else { const int cq = c - 512; const float* b = a.in[18] + (size_t)jq * D + cq; u32x2 w; w.x = cvt_pk_bf16((v[0] + b[0]) * 0.125f, (v[1] + b[1]) * 0.125f); w.y = cvt_pk_bf16((v[2] + b[2]) * 0.125f, (v[3] + b[3]) * 0.125f);
                    *(u32x2*)((bf16_t*)(a.ws + WS_Q) + (size_t)row * D + cq) = w; }
            }
        }
    }
    g.stride = GRID; g.vb = opaque_bid(); g.kind = EPI_KVQ; g.K = D; g.perm = 1; g.gather = 0; g.moe = 0; g.nM = NREAL / BM; g.nN = N / BM; g.nwg = g.nM * g.nN; g.A = (const char*)Ub; g.Bt = (const char*)W;
    g.tstepA = g.tstepB = (size_t)BM * D * 2; g.wstride = 0; g.rstd = (const float*)(a.ws + WS_RSTD); g.bias = a.in[16]; g.bias2 = a.in[18] + (size_t)jq * D; g.O1 = (bf16_t*)(a.ws + WS_K); g.O2 = (bf16_t*)(a.ws + WS_VT); g.O3 = (bf16_t*)(a.ws + WS_Q);
    g.jq = jq; g.cbase = cbase;
}

__device__ __forceinline__ void moe_scan(const int* cnt, LAS int* sh) {
    if (opaque_tid() == 0) { int acc = 0; for (int e = 0; e < 32; ++e) { sh[e] = acc; acc += (cnt[e] + 255) >> 8; } sh[32] = acc; }
    __syncthreads();
}
__device__ __forceinline__ void epi_moe1(const GemmDesc& g, LAS unsigned char* lds, const f32x4 (&acc)[2][2][4][2], const Unit& u, int wr, int wc, int fr, int fq) {
    { bf16_t* HB = g.O1;
        const LAS int* tabt = (const LAS int*)(lds + LDS_TABT) + u.slot * 256;
#pragma unroll
        for (int ai = 0; ai < 2; ++ai)
#pragma unroll
            for (int m = 0; m < 4; ++m) {
                const int rl = ai * HALF + wr * 64 + m * 16 + fr;
                if (tabt[rl] >= 0) {
                    const float rs = ((const LAS float*)(lds + LDS_TABG))[u.slot * 256 + rl];
                    const f32x4 g0 = acc[ai][0][m][0] * rs, g1 = acc[ai][0][m][1] * rs, u0 = acc[ai][1][m][0] * rs, u1 = acc[ai][1][m][1] * rs;
                    u32x4 w; w.x = cvt_pk_bf16(g0[0] * sigmoidf_(g0[0]) * u0[0], g0[1] * sigmoidf_(g0[1]) * u0[1]); w.y = cvt_pk_bf16(g0[2] * sigmoidf_(g0[2]) * u0[2], g0[3] * sigmoidf_(g0[3]) * u0[3]);
                    w.z = cvt_pk_bf16(g1[0] * sigmoidf_(g1[0]) * u1[0], g1[1] * sigmoidf_(g1[1]) * u1[1]); w.w = cvt_pk_bf16(g1[2] * sigmoidf_(g1[2]) * u1[2], g1[3] * sigmoidf_(g1[3]) * u1[3]);
                    *(u32x4*)(HB + ((size_t)u.pm * 256 + rl) * DEXP + u.pn * 128 + wc * 32 + 8 * fq) = w;
                }
                asm volatile("" ::: "memory");
            }
    }
}
__device__ __forceinline__ bool moe_roles(GemmDesc& g) {
    const int rounds = (g.nwg + GRID - 1) / GRID, per = rounds ? (g.nwg + rounds - 1) / rounds : GRID, ngw = ((per + 7) / 8) * 8 < GRID ? ((per + 7) / 8) * 8 : GRID;
    const int bid = opaque_bid(), rnk = bid >> 3;
    g.stride = ngw; g.vb = rnk * 8 + (bid & 7);
    if (rnk * 8 >= ngw) { g.nwg = 0; return true; }
    return false;
}
__device__ __forceinline__ bool phase_moe1(CArgs& a, int layer, LAS unsigned char* lds, GemmDesc& g) {
    LAS int* sh = (LAS int*)(lds + LDS_SH);
    const int* cnt = (const int*)(a.ws + WS_CTL) + CW_CNT + layer * 32;
    moe_scan(cnt, sh);
    g.kind = EPI_MOE1; g.K = D; g.perm = 1; g.gather = 1; g.moe = 1; g.npn = 4; g.nwg = sh[32] * 4; g.nM = 0; g.nN = 4;
    g.A = (const char*)(a.ws + WS_H); g.Bt = (const char*)(a.ws + WS_W1) + (size_t)layer * 32 * 1024 * 1024 * 2; g.wstride = (size_t)1024 * 1024 * 2;
    g.tstepA = 0; g.tstepB = (size_t)256 * 1024 * 2; g.cnt = cnt; g.LTOK = (const int*)(a.ws + WS_LTOK); g.LGATE = (const float*)(a.ws + WS_LRS); g.O1 = (bf16_t*)(a.ws + WS_HB);
    return moe_roles(g);
}
__device__ __forceinline__ void epi_moe2(const GemmDesc& g, LAS unsigned char* lds, const f32x4 (&acc)[2][2][4][2], const Unit& u, int wr, int wc, int fr, int fq) {
    { bf16_t* YB = g.O1;
        const LAS int* tabt = (const LAS int*)(lds + LDS_TABT) + u.slot * 256; const LAS float* tabg = (const LAS float*)(lds + LDS_TABG) + u.slot * 256;
#pragma unroll
        for (int ai = 0; ai < 2; ++ai)
#pragma unroll
            for (int m = 0; m < 4; ++m) {
                const int rl = ai * HALF + wr * 64 + m * 16 + fr; const int rt = tabt[rl];
                if (rt >= 0) {
                    const float gs = tabg[rl];
                    bf16_t* yp = YB + ((size_t)(rt & 0x3fffffff) * 2 + (rt >> 30)) * D + u.pn * BM + wc * 32 + 8 * fq;
#pragma unroll
                    for (int bj = 0; bj < 2; ++bj) { const f32x4 v0 = acc[ai][bj][m][0] * gs, v1 = acc[ai][bj][m][1] * gs;
                        u32x4 w; w.x = cvt_pk_bf16(v0[0], v0[1]); w.y = cvt_pk_bf16(v0[2], v0[3]); w.z = cvt_pk_bf16(v1[0], v1[1]); w.w = cvt_pk_bf16(v1[2], v1[3]);
                        *(u32x4*)(yp + bj * HALF) = w; }
                }
                asm volatile("" ::: "memory");
            }
    }
}
__device__ __forceinline__ bool phase_moe2(CArgs& a, int layer, LAS unsigned char* lds, GemmDesc& g) {
    LAS int* sh = (LAS int*)(lds + LDS_SH);
    const int* cnt = (const int*)(a.ws + WS_CTL) + CW_CNT + layer * 32;
    moe_scan(cnt, sh);
    g.kind = EPI_MOE2; g.K = DEXP; g.perm = 1; g.gather = 0; g.moe = 1; g.npn = 4; g.nwg = sh[32] * 4; g.nM = 0; g.nN = 4;
    g.A = (const char*)(a.ws + WS_HB); g.Bt = (const char*)(a.ws + WS_W2) + (size_t)layer * 32 * 1024 * 512 * 2; g.wstride = (size_t)1024 * 512 * 2;
    g.tstepA = (size_t)256 * DEXP * 2; g.tstepB = (size_t)256 * DEXP * 2; g.cnt = cnt; g.LTOK = (const int*)(a.ws + WS_LTOK); g.LGATE = (const float*)(a.ws + WS_LGATE); g.O1 = (bf16_t*)(a.ws + WS_YB);
    return moe_roles(g);
}
__device__ __forceinline__ void gemm_epilogue(const GemmDesc& g, LAS unsigned char* lds, const f32x4 (&acc)[2][2][4][2], const Unit& u, int wr, int wc, int fr, int fq) {
    asm volatile("" : "+v"(fr), "+v"(fq));
    switch (g.kind) {
        case EPI_GLU: epi_glu(g, acc, u, wr, wc, fr, fq); break;
        case EPI_OPROJ: epi_oproj(g, acc, u, wr, wc, fr, fq); break;
        case EPI_KVQ: epi_kvq(g, acc, u, wr, wc, fr, fq); break;
        case EPI_MOE1: epi_moe1(g, lds, acc, u, wr, wc, fr, fq); break;
        default: epi_moe2(g, lds, acc, u, wr, wc, fr, fq); break;
    }
}

constexpr int AT_NSLOT = 272, AT_VROW = 552, AT_KBYTES = AT_NSLOT * 128, AT_VBYTES = 64 * AT_VROW;
__device__ __forceinline__ void attn_tile(LAS unsigned char* Ks, LAS unsigned char* Vs, const bf16x8 qf0, const bf16x8 qf1, bf16_t* op, float sink, int nblk  , int kb0  , int srel  , int smin  , int lmeta  , int tc, int q4) {
    f32x4 s[10];
    const int dq = srel - 128 - 16 * kb0;
#pragma unroll
    for (int bi = 0; bi < 10; ++bi) {
        s[bi] = (f32x4){-1e30f, -1e30f, -1e30f, -1e30f};
        if (bi < nblk) {
            const int sl = (bi == 0 ? 0 : 16 + 16 * (kb0 + bi - 1)) + tc;
            const LAS unsigned char* kr = Ks + sl * 128;
            const bf16x8 kf0 = *(const LAS bf16x8*)(kr + ((q4 ^ (sl & 7)) << 4)), kf1 = *(const LAS bf16x8*)(kr + (((4 + q4) ^ (sl & 7)) << 4));
            f32x4 acc = {0.f, 0.f, 0.f, 0.f};
            acc = mfma16(kf0, qf0, acc); acc = mfma16(kf1, qf1, acc);
            const bool blk_ok = bi == 0 || (kb0 + bi - 1) >= (smin >> 4);
#pragma unroll
            for (int r = 0; r < 4; ++r) {
                const bool ok = bi == 0 ? (4 * q4 + r <= lmeta) : bi == 1 ? (blk_ok && 4 * q4 + r > dq) : bi == 9 ? (blk_ok && 4 * q4 + r <= dq) : blk_ok;
                s[bi][r] = ok ? acc[r] : -1e30f;
            }
        }
    }
    float m = sink;
#pragma unroll
    for (int bi = 0; bi < 10; ++bi) m = fmaxf(m, fmaxf(fmaxf(s[bi][0], s[bi][1]), fmaxf(s[bi][2], s[bi][3])));
    m = xor32_max(xor16_max(m));
    float den = 0.f;
    unsigned pk[10][2];
#pragma unroll
    for (int bi = 0; bi < 10; ++bi) {
        float p[4];
#pragma unroll
        for (int r = 0; r < 4; ++r) { p[r] = s[bi][r] > -1e29f ? fast_exp(s[bi][r] - m) : 0.f; den += p[r]; }
        pk[bi][0] = cvt_pk_bf16(p[0], p[1]); pk[bi][1] = cvt_pk_bf16(p[2], p[3]);
    }
    den = quad_sum(den);
    den += fast_exp(sink - m);
    const float inv = 1.0f / den;
    f32x4 o[4];
#pragma unroll
    for (int dt = 0; dt < 4; ++dt) o[dt] = (f32x4){0.f, 0.f, 0.f, 0.f};
#pragma unroll
    for (int pp = 0; pp < 5; ++pp) {
        if (2 * pp < nblk) {
            const int biA = 2 * pp, biB = 2 * pp + 1;
            const int slA = biA == 0 ? 0 : 16 + 16 * (kb0 + biA - 1), slB = biB < nblk ? 16 + 16 * (kb0 + biB - 1) : slA;
            u32x4 pw; pw.x = pk[biA][0]; pw.y = pk[biA][1]; pw.z = pk[biB][0]; pw.w = pk[biB][1];
            const bf16x8 pf = as_bf16x8(pw);
#pragma unroll
            for (int dt = 0; dt < 4; ++dt) {
                const LAS unsigned char* vr = Vs + (16 * dt + tc) * AT_VROW + 8 * q4;
                const u32x2 va = *(const LAS u32x2*)(vr + slA * 2), vb = *(const LAS u32x2*)(vr + slB * 2);
                u32x4 vw; vw.x = va.x; vw.y = va.y; vw.z = vb.x; vw.w = vb.y;
                o[dt] = mfma16(as_bf16x8(vw), pf, o[dt]);
            }
        }
    }
#pragma unroll
    for (int dt = 0; dt < 4; ++dt) { u32x2 w; w.x = cvt_pk_bf16(o[dt][0] * inv, o[dt][1] * inv); w.y = cvt_pk_bf16(o[dt][2] * inv, o[dt][3] * inv); *(u32x2*)(op + 16 * dt) = w; }
}
constexpr int AT_BUF = 70656;
struct AtUnit { int meta, kvh, b, s0; };
__device__ __forceinline__ AtUnit at_decode(int unit) { AtUnit u; u.meta = unit >= NB * 4 * 16; const int qt = u.meta ? 0 : (unit & 15); u.kvh = u.meta ? unit - NB * 4 * 16 : ((unit >> 4) & 3); u.b = u.meta ? 0 : (unit >> 6); u.s0 = qt * 128; return u; }
__device__ __forceinline__ void at_fill_load(const bf16_t* K, const bf16_t* VT, const AtUnit& u, int tid, u32x4 (&kr)[5], u32x4 (&vr)[5]) {
#pragma unroll
    for (int i = 0; i < 5; ++i) {
        const int idx = tid + i * NTHREADS;
        { const int sl = idx >> 3, c = idx & 7, sw = u.s0 - 128 + (sl - 16);
          u32x4 v = {0u, 0u, 0u, 0u};
          if (idx < AT_NSLOT * 8) { if (sl < 16) v = *(const u32x4*)(K + (size_t)(NREAL + sl) * 256 + u.kvh * 64 + c * 8); else if (!u.meta && sw >= 0) v = *(const u32x4*)(K + (size_t)(u.b * SEQ + sw) * 256 + u.kvh * 64 + c * 8); }
          kr[i] = v; }
        { const int d = idx / 34, ch = idx - d * 34, sw = u.s0 - 128 + 8 * (ch - 2);
          u32x4 v = {0u, 0u, 0u, 0u};
          if (idx < 64 * 34) { if (ch < 2) v = *(const u32x4*)(VT + VT_META + (size_t)(u.kvh * 64 + d) * 16 + ch * 8); else if (!u.meta && sw >= 0) v = *(const u32x4*)(VT + ((size_t)(u.b * 4 + u.kvh) * 64 + d) * SEQ + sw); }
          vr[i] = v; }
    }
}
__device__ __forceinline__ void at_fill_store(LAS unsigned char* Ks, LAS unsigned char* Vs, int tid, const u32x4 (&kr)[5], const u32x4 (&vr)[5]) {
#pragma unroll
    for (int i = 0; i < 5; ++i) {
        const int idx = tid + i * NTHREADS;
        if (idx < AT_NSLOT * 8) { const int sl = idx >> 3, c = idx & 7; *(LAS u32x4*)(Ks + sl * 128 + ((c ^ (sl & 7)) << 4)) = kr[i]; }
        if (idx < 64 * 34) { const int d = idx / 34, ch = idx - d * 34; *(LAS u32x2*)(Vs + d * AT_VROW + ch * 16) = (u32x2){vr[i].x, vr[i].y}; *(LAS u32x2*)(Vs + d * AT_VROW + ch * 16 + 8) = (u32x2){vr[i].z, vr[i].w}; }
    }
}
__device__ __forceinline__ void phase_attn(CArgs& a, int j, LAS unsigned char* lds) {
    const int tid = opaque_tid(), lane = tid & 63, wid = tid >> 6, tc = lane & 15, q4 = lane >> 4;
    const bf16_t* Q = (const bf16_t*)(a.ws + WS_Q); const bf16_t* K = (const bf16_t*)(a.ws + WS_K); const bf16_t* VT = (const bf16_t*)(a.ws + WS_VT);
    bf16_t* O = (bf16_t*)(a.ws + WS_Z);
    constexpr int NU = NB * 4 * 16 + 4;
    int unit = opaque_bid(), cur = 0;
    if (unit >= NU) return;
    u32x4 kr[5], vr[5];
    { const AtUnit u0 = at_decode(unit); at_fill_load(K, VT, u0, tid, kr, vr); at_fill_store(lds, lds + AT_KBYTES, tid, kr, vr); }
    __syncthreads();
#pragma unroll 1
    for (;;) {
        const AtUnit u = at_decode(unit);
        const int nextu = unit + GRID; const bool more = nextu < NU;
        LAS unsigned char* Ks = lds + cur * AT_BUF; LAS unsigned char* Vs = Ks + AT_KBYTES;
        const int g = wid & 3, hq = u.kvh * 4 + g, jt0 = wid >> 2;
        const float sink = a.in[19][j * 16 + hq];
        if (more) { const AtUnit un = at_decode(nextu); at_fill_load(K, VT, un, tid, kr, vr); }
        if (u.meta) {
            if (wid < 4) { const size_t row = (size_t)(NREAL + tc); const bf16_t* qp = Q + row * D + hq * 64 + 8 * q4;
                attn_tile(Ks, Vs, as_bf16x8(*(const u32x4*)qp), as_bf16x8(*(const u32x4*)(qp + 32)), O + row * D + hq * 64 + 4 * q4, sink, 1, 0, 0, 0, tc, tc, q4); }
        } else {
            const bf16_t* qbase = Q + ((size_t)(u.b * SEQ + u.s0 + tc)) * D + hq * 64 + 8 * q4;
            u32x4 qn0 = *(const u32x4*)(qbase + (size_t)(16 * jt0) * D), qn1 = *(const u32x4*)(qbase + (size_t)(16 * jt0) * D + 32);
#pragma unroll 1
            for (int t = 0; t < 4; ++t) {
                const int jt = jt0 + 2 * t; const size_t row = (size_t)(u.b * SEQ + u.s0 + 16 * jt + tc);
                const bf16x8 q0 = as_bf16x8(qn0), q1 = as_bf16x8(qn1);
                if (t < 3) { qn0 = *(const u32x4*)(qbase + (size_t)(16 * (jt + 2)) * D); qn1 = *(const u32x4*)(qbase + (size_t)(16 * (jt + 2)) * D + 32); }
                attn_tile(Ks, Vs, q0, q1, O + row * D + hq * 64 + 4 * q4, sink, 10, jt, 128 + 16 * jt + tc, 128 - u.s0, 64, tc, q4);
            }
        }
        if (!more) break;
        at_fill_store(lds + (cur ^ 1) * AT_BUF, lds + (cur ^ 1) * AT_BUF + AT_KBYTES, tid, kr, vr);
        __syncthreads();
        cur ^= 1; unit = nextu;
    }
}

__device__ __forceinline__ void phase_route(CArgs& a, int layer, bool dry, LAS unsigned char* lds) {
    LAS unsigned char* Wf = lds; LAS float* LG = (LAS float*)(lds + 98304); LAS int* hist = (LAS int*)(lds + 98304 + 24576); LAS int* hbase = hist + 32;
    const int tid = opaque_tid(), lane = tid & 63, wid = tid >> 6, tc = lane & 15, q4 = lane >> 4;
    for (int idx = tid; idx < 3 * 32 * 64; idx += NTHREADS) *(LAS u32x4*)(Wf + (size_t)idx * 16) = *(const u32x4*)(a.ws + WS_RW + (size_t)layer * 98304 + (size_t)idx * 16);
    if (tid < 32) hist[tid] = 0;
    __syncthreads();
    const bf16_t* H = (const bf16_t*)(a.ws + WS_H); float* LRS = (float*)(a.ws + (dry ? WS_DUMLG : WS_LRS));
    int* cnt = (int*)(a.ws + WS_CTL) + (dry ? CW_DUMCNT : CW_CNT) + layer * 32; int* LTOK = (int*)(a.ws + (dry ? WS_DUMLT : WS_LTOK)); float* LGATE = (float*)(a.ws + (dry ? WS_DUMLG : WS_LGATE));
    const int tile = wid * GRID + opaque_bid();
    const bool active = tile < RT / 16;
    int e1, e2, r1, r2; float g1, g2, rstd_keep;
    asm volatile("" : "=v"(e1), "=v"(e2), "=v"(r1), "=v"(r2), "=v"(g1), "=v"(g2), "=v"(rstd_keep));
    if (active) {
        const int row = tile * 16 + tc;
        float ss = 0.f;
        f32x4 acc[3];
#pragma unroll
        for (int rt = 0; rt < 3; ++rt) acc[rt] = (f32x4){0.f, 0.f, 0.f, 0.f};
        const bf16_t* hp = H + (size_t)row * D + 8 * q4;
#pragma unroll 1
        for (int kb = 0; kb < 4; ++kb) {
            u32x4 hv[8];
#pragma unroll
            for (int k8 = 0; k8 < 8; ++k8) hv[k8] = *(const u32x4*)(hp + 32 * (kb * 8 + k8));
#pragma unroll
            for (int k8 = 0; k8 < 8; ++k8) {
                const int ks = kb * 8 + k8; const bf16x8 xf = as_bf16x8(hv[k8]);
                { const u32x4 hw = hv[k8]; const float e0 = bf16_lo(hw.x), e1 = bf16_hi(hw.x), e2 = bf16_lo(hw.y), e3 = bf16_hi(hw.y), e4 = bf16_lo(hw.z), e5 = bf16_hi(hw.z), e6 = bf16_lo(hw.w), e7 = bf16_hi(hw.w);
                  ss += (e0 * e0 + e1 * e1) + (e2 * e2 + e3 * e3) + (e4 * e4 + e5 * e5) + (e6 * e6 + e7 * e7); }
#pragma unroll
                for (int rt = 0; rt < 3; ++rt) acc[rt] = mfma16(*(LAS bf16x8*)(Wf + ((size_t)(rt * 32 + ks) * 64 + lane) * 16), xf, acc[rt]);
            }
        }
        ss = quad_sum(ss);
        const float rstd = 1.0f / sqrtf(ss * (1.0f / D) + RMS_EPS); rstd_keep = rstd;
        LAS float* lg = LG + wid * 16 * 48;
#pragma unroll
        for (int rt = 0; rt < 3; ++rt)
#pragma unroll
            for (int r = 0; r < 4; ++r) lg[tc * 48 + 16 * rt + 4 * q4 + r] = acc[rt][r] * rstd;
        asm volatile("s_waitcnt lgkmcnt(0)" ::: "memory");
        if (lane < 16) {
            const LAS float* mylg = lg + lane * 48;
            float gl[4]; int gi = 0; float gm;
#pragma unroll
            for (int i = 0; i < 4; ++i) gl[i] = mylg[i] + a.in[23][layer * NGRP + i];
            gm = gl[0];
#pragma unroll
            for (int i = 1; i < 4; ++i) if (gl[i] > gm) { gm = gl[i]; gi = i; }
            float gz = 0.f;
#pragma unroll
            for (int i = 0; i < 4; ++i) gz += expf(gl[i] - gm);
            const float pg = 1.0f / gz;
            float el[8];
#pragma unroll
            for (int i = 0; i < 8; ++i) el[i] = mylg[4 + gi * 8 + i] + a.in[25][layer * NEXP + gi * 8 + i];
            int i1 = 0; float m1 = el[0];
#pragma unroll
            for (int i = 1; i < 8; ++i) if (el[i] > m1) { m1 = el[i]; i1 = i; }
            int i2 = -1; float m2 = -3.0e38f;
#pragma unroll
            for (int i = 0; i < 8; ++i) if (i != i1 && el[i] > m2) { m2 = el[i]; i2 = i; }
            float one = 1.0f; asm volatile("" : "+v"(one));
            const float x2 = expf(m2 - m1), q1 = one / (one + x2);
            g1 = pg * q1; g2 = pg * x2 * q1; e1 = gi * 8 + i1; e2 = gi * 8 + i2;
            r1 = __hip_atomic_fetch_add(&hist[e1], 1, __ATOMIC_RELAXED, __HIP_MEMORY_SCOPE_WORKGROUP); r2 = __hip_atomic_fetch_add(&hist[e2], 1, __ATOMIC_RELAXED, __HIP_MEMORY_SCOPE_WORKGROUP);
        }
    }
    __syncthreads();
    if (tid < 32) hbase[tid] = hist[tid] ? atomicAdd(&cnt[tid], hist[tid]) : 0;
    __syncthreads();
    if (active && lane < 16) {
        const int row = tile * 16 + lane;
        const int s1 = hbase[e1] + r1, s2 = hbase[e2] + r2;
        LTOK[(size_t)e1 * RT + s1] = row; LGATE[(size_t)e1 * RT + s1] = g1; LRS[(size_t)e1 * RT + s1] = rstd_keep;
        LTOK[(size_t)e2 * RT + s2] = row | (1 << 30); LGATE[(size_t)e2 * RT + s2] = g2; LRS[(size_t)e2 * RT + s2] = rstd_keep;
    }
}

__device__ __forceinline__ void comb_load(const bf16_t* H, const bf16_t* YB, int row, int lane, u32x4 (&w)[2][3]) {
    const bf16_t* hp = H + (size_t)row * D; const bf16_t* y0 = YB + (size_t)row * 2 * D;
#pragma unroll
    for (int j = 0; j < 2; ++j) { const int c = 8 * lane + 512 * j; w[j][0] = *(const u32x4*)(hp + c); w[j][1] = *(const u32x4*)(y0 + c); w[j][2] = *(const u32x4*)(y0 + D + c); }
}
__device__ __forceinline__ void comb_finish(CArgs& a, int layer, bool dry, int row, int lane, const u32x4 (&w)[2][3]) {
    float v[2][8]; float ssq = 0.f;
#pragma unroll
    for (int j = 0; j < 2; ++j) {
        const u32x4 hw = w[j][0], p0 = w[j][1], p1 = w[j][2];
        v[j][0] = bf16_lo(hw.x) + bf16_lo(p0.x) + bf16_lo(p1.x); v[j][1] = bf16_hi(hw.x) + bf16_hi(p0.x) + bf16_hi(p1.x);
        v[j][2] = bf16_lo(hw.y) + bf16_lo(p0.y) + bf16_lo(p1.y); v[j][3] = bf16_hi(hw.y) + bf16_hi(p0.y) + bf16_hi(p1.y);
        v[j][4] = bf16_lo(hw.z) + bf16_lo(p0.z) + bf16_lo(p1.z); v[j][5] = bf16_hi(hw.z) + bf16_hi(p0.z) + bf16_hi(p1.z);
        v[j][6] = bf16_lo(hw.w) + bf16_lo(p0.w) + bf16_lo(p1.w); v[j][7] = bf16_hi(hw.w) + bf16_hi(p0.w) + bf16_hi(p1.w);
#pragma unroll
        for (int e = 0; e < 8; ++e) ssq += v[j][e] * v[j][e];
    }
    ssq = wave_sum(ssq);
    const float rstd = 1.0f / sqrtf(ssq * (1.0f / D) + RMS_EPS);
    if (layer < 3) {
        bf16_t* ho = (bf16_t*)(a.ws + (dry ? WS_DUMH : WS_H)) + (size_t)row * D;
#pragma unroll
        for (int j = 0; j < 2; ++j) {
            const int c = 8 * lane + 512 * j;
            u32x4 o; o.x = cvt_pk_bf16(v[j][0], v[j][1]); o.y = cvt_pk_bf16(v[j][2], v[j][3]); o.z = cvt_pk_bf16(v[j][4], v[j][5]); o.w = cvt_pk_bf16(v[j][6], v[j][7]);
            *(u32x4*)(ho + c) = o;
        }
        if (lane == 0) ((float*)(a.ws + (dry ? WS_DUMSSQ : WS_RSTD)))[row] = rstd;
    } else if (row < NREAL) {
        float* op = a.out + (size_t)row * D;
#pragma unroll
        for (int j = 0; j < 2; ++j) { const int c = 8 * lane + 512 * j; const f32x4 g0 = *(const f32x4*)(a.in[5] + c), g1 = *(const f32x4*)(a.in[5] + c + 4);
            f32x4 o0, o1; o0[0] = v[j][0] * rstd * g0[0]; o0[1] = v[j][1] * rstd * g0[1]; o0[2] = v[j][2] * rstd * g0[2]; o0[3] = v[j][3] * rstd * g0[3];
            o1[0] = v[j][4] * rstd * g1[0]; o1[1] = v[j][5] * rstd * g1[1]; o1[2] = v[j][6] * rstd * g1[2]; o1[3] = v[j][7] * rstd * g1[3];
            *(f32x4*)(op + c) = o0; *(f32x4*)(op + c + 4) = o1; }
    }
}
__device__ __forceinline__ void phase_combine(CArgs& a, int layer, bool dry) {
    const int lane = opaque_tid() & 63, gw = opaque_bid() * 8 + (opaque_tid() >> 6);
    const bf16_t* H = (const bf16_t*)(a.ws + WS_H); const bf16_t* YB = (const bf16_t*)(a.ws + WS_YB);
    for (int row = gw; row < RT; row += GRID * 16) {
        const int row1 = row + GRID * 8; const bool two = row1 < RT;
        u32x4 wa[2][3], wb[2][3];
        comb_load(H, YB, row, lane, wa);
        if (two) comb_load(H, YB, row1, lane, wb);
        comb_finish(a, layer, dry, row, lane, wa);
        if (two) comb_finish(a, layer, dry, row1, lane, wb);
    }
}

enum { PH_PREP = 0, PH_S5, PH_GLU, PH_ROUTE, PH_G1, PH_G2, PH_COMB, PH_KVQ, PH_ATT, PH_OPROJ, PH_QG };
constexpr int NPH = 27;
__constant__ int c_prog[NPH][2] = {
    {PH_PREP, 0},
    {PH_S5, 0}, {PH_GLU, 0}, {PH_ROUTE, 0}, {PH_G1, 0}, {PH_G2, 0}, {PH_COMB, 0},
    {PH_S5, 1}, {PH_GLU, 1}, {PH_ROUTE, 1}, {PH_G1, 1}, {PH_G2, 1}, {PH_COMB, 1},
    {PH_KVQ, 2}, {PH_ATT, 2}, {PH_OPROJ, 2}, {PH_ROUTE, 2}, {PH_G1, 2}, {PH_G2, 2}, {PH_COMB, 2},
    {PH_QG, 3}, {PH_ATT, 3}, {PH_OPROJ, 3}, {PH_ROUTE, 3}, {PH_G1, 3}, {PH_G2, 3}, {PH_COMB, 3},
};

__global__ void __launch_bounds__(NTHREADS) yoco_fwd(Args a) {
    extern __shared__ __attribute__((aligned(16))) unsigned char smem_raw[];
    LAS unsigned char* lds = (LAS unsigned char*)smem_raw;
    volatile LAS unsigned* const st = (volatile LAS unsigned*)(lds + LDS_BYTES - 64);
    if (threadIdx.x < 16) st[threadIdx.x] = 0u;
    __syncthreads();
    if (a.ph_hi - a.ph_lo > 1) xcd_barrier_post((unsigned*)(a.ws + WS_CTL) + CW_BAR);
    CArgs* const kp = (CArgs*)__builtin_amdgcn_kernarg_segment_ptr();
#if defined(PROBE_TMASK)
    unsigned long long t_acc = 0ull;
#endif
    for (int ph = a.ph_lo; ph < a.ph_hi; ++ph) {
        const int type = c_prog[ph][0], layer = c_prog[ph][1];
#if defined(PROBE_TMASK)
        const unsigned long long t_ph0 = __builtin_amdgcn_s_memrealtime();
#endif
        const int reps = type == a.rep_type ? a.rep_n : 0;
        for (int r = 0; r <= reps; ++r) {
            const bool dry = r > 0;
            CArgs* lp = kp; asm volatile("" : "+s"(lp));
            CArgs& la = *lp;
            GemmDesc g; bool is_gemm = true; int conv_budget = 0, conv_limit = 0;
            BgConv bg{lp, st};
            switch (type) {
                case PH_GLU: phase_glu(la, layer, dry, lds, g); break;
                case PH_G1: if (phase_moe1(la, layer, lds, g)) { conv_budget = 18; conv_limit = (layer + 2) * 32 * NWT_E; } break;
                case PH_G2: if (phase_moe2(la, layer, lds, g)) { conv_budget = 12; conv_limit = (layer + 3) * 32 * NWT_E; } break;
                case PH_KVQ: case PH_QG: phase_kvq_q(la, type == PH_QG ? 1 : 0, lds, g); break;
                case PH_OPROJ: phase_oproj(la, layer - 2, dry, lds, g); break;
                default: is_gemm = false; break;
            }
            g.skip_epi = 0;
#if defined(PROBE_SKIPEPI)
            if (dry) g.skip_epi = 1;
#endif
            if (is_gemm) { gemm_run(lds, g); if (conv_budget) bg.run_until(conv_limit < NWT_MOE ? conv_limit : NWT_MOE, conv_budget); }
            else switch (type) {
                case PH_PREP: phase_prep(la, lds); break;
                case PH_S5: phase_s5(la, layer, lds); break;
                case PH_ROUTE: phase_route(la, layer, dry, lds); break;
                case PH_COMB: phase_combine(la, layer, dry); break;
                default: phase_attn(la, layer - 2, lds); break;
            }
            if (type == PH_ROUTE && !dry) { bg.run_until((layer + 1) * 32 * NWT_E, 1 << 20); bg.drain_others((layer + 1) * 32 * NWT_E); }
            if (r < reps || ph + 1 < a.ph_hi) { if (a.ph_hi - a.ph_lo > 1) xcd_barrier((unsigned*)(la.ws + WS_CTL) + CW_BAR, st, bg); }
        }
#if defined(PROBE_TMASK)
        if ((PROBE_TMASK >> type) & 1) t_acc += __builtin_amdgcn_s_memrealtime() - t_ph0;
#endif
        if (a.rep_type == 100 && ph + 1 < a.ph_hi) for (int r = 0; r < a.rep_n; ++r) { BgConv bg{kp, st}; xcd_barrier((unsigned*)(a.ws + WS_CTL) + CW_BAR, st, bg); }
    }
#if defined(PROBE_TMASK)
    if (blockIdx.x == 0) { const unsigned long long t0 = __builtin_amdgcn_s_memrealtime(); while (__builtin_amdgcn_s_memrealtime() - t0 < 8ull * t_acc) __builtin_amdgcn_s_sleep(32); }
#endif
}

extern "C" void kernel_launch(void* const* d_in, const int* in_sizes, int n_in, void* d_out, int out_size, void* d_ws, size_t ws_size, hipStream_t stream) {
    static int ready = 0;
    if (ready == 0) {
        if (n_in != 29 || ws_size < WS_END) { fprintf(stderr, "kernel_launch: expected 29 inputs and >= %zu bytes of workspace (got %d, %zu)\n", (size_t)WS_END, n_in, ws_size); ready = -1; return; }
        if (hipFuncSetAttribute((const void*)yoco_fwd, hipFuncAttributeMaxDynamicSharedMemorySize, LDS_BYTES) != hipSuccess) { fprintf(stderr, "kernel_launch: hipFuncSetAttribute failed\n"); ready = -1; return; }
        ready = 1;
    }
    if (ready < 0) return;
    (void)hipMemsetAsync((char*)d_ws + WS_CTL, 0, CTL_BYTES, stream);
    Args a{};
    for (int i = 0; i < 29; ++i) a.in[i] = (const float*)d_in[i];
    a.out = (float*)d_out; a.ws = (unsigned char*)d_ws;
#if defined(PROBE_TYPE)
    a.rep_type = PROBE_TYPE; a.rep_n = PROBE_N;
#else
    a.rep_type = -1; a.rep_n = 0;
#endif
#if MK_N_LAUNCHES == 1
    a.ph_lo = 0; a.ph_hi = NPH;
    hipLaunchKernelGGL(yoco_fwd, dim3(GRID), dim3(NTHREADS), LDS_BYTES, stream, a);
#else
    for (int ph = 0; ph < NPH; ++ph) { a.ph_lo = ph; a.ph_hi = ph + 1; hipLaunchKernelGGL(yoco_fwd, dim3(GRID), dim3(NTHREADS), LDS_BYTES, stream, a); }
#endif
}
```

```cpp
#include <hip/hip_runtime.h>
#include <cstdio>
#include <cstdint>

#ifndef MK_N_LAUNCHES
#define MK_N_LAUNCHES 1
#endif

#define LAS __attribute__((address_space(3)))
typedef unsigned short bf16_t;
typedef short bf16x8 __attribute__((ext_vector_type(8)));
typedef float f32x4 __attribute__((ext_vector_type(4)));
typedef float f32x2 __attribute__((ext_vector_type(2)));
typedef unsigned u32x4 __attribute__((ext_vector_type(4)));
typedef unsigned u32x2 __attribute__((ext_vector_type(2)));

constexpr int D = 1024, NB = 8, SEQ = 2048, NMETA = 16, LT = SEQ + NMETA  ;
constexpr int NREAL = NB * SEQ  , RT = NREAL + NMETA  , RPAD = 16640;
constexpr int NEXP = 32, DEXP = 512, NGRP = 4, EPG = 8;
constexpr int NTHREADS = 512, GRID = 256;
constexpr int LDS_BYTES = 155648;
constexpr float RMS_EPS = 1e-6f;
__device__ __forceinline__ int row_of(int b, int pos) { return pos < NMETA ? NREAL + pos : b * SEQ + (pos - NMETA); }

constexpr size_t al256(size_t x) { return (x + 255) & ~(size_t)255; }
constexpr size_t WS_CTL = 0;
constexpr size_t CTL_BYTES = 32768;
constexpr int CW_BAR = 0;
constexpr int CW_CNT = 4096;
constexpr int CW_DUMCNT = 4096 + 256;
constexpr int CW_BGC = 6144;
constexpr size_t WS_H = WS_CTL + CTL_BYTES;
constexpr size_t WS_RSTD = WS_H + al256((size_t)RPAD * D * 2);
constexpr size_t WS_LRS = WS_RSTD + al256((size_t)RPAD * 4);
constexpr size_t WS_U = WS_LRS + al256((size_t)NEXP * RT * 4);
constexpr size_t WS_Z = WS_U + 256;
constexpr size_t WS_XN = WS_Z + al256((size_t)RPAD * D * 2);
constexpr size_t WS_Q = WS_XN + 256;
constexpr size_t WS_K = WS_Q + al256((size_t)RPAD * D * 2);
constexpr size_t WS_VT = WS_K + al256((size_t)RPAD * 256 * 2);
constexpr size_t VT_META = (size_t)NB * 256 * SEQ;
constexpr size_t WS_LTOK = WS_VT + al256((size_t)RPAD * 256 * 2);
constexpr size_t WS_LGATE = WS_LTOK + al256((size_t)NEXP * RT * 4);
constexpr int HB_ROWS = 2 * RT + NEXP * 256;
constexpr size_t WS_HB = WS_LGATE + al256((size_t)NEXP * RT * 4);
constexpr size_t WS_YB = WS_HB + al256((size_t)HB_ROWS * DEXP * 2);
constexpr size_t TBL_K = 0, TBL_M = 16 * 1024, TBL_N = TBL_M + 64 * 1024, TBL_A16 = TBL_N + 64 * 1024, TBL_STRIDE = TBL_A16 + 512;
constexpr size_t WS_TBL = WS_YB + al256((size_t)RT * 2 * D * 2);
constexpr size_t WS_WGLU = WS_TBL + al256((size_t)2 * 64 * TBL_STRIDE);
constexpr size_t WS_WKVQ = WS_WGLU + (size_t)2 * 2048 * 1024 * 2;
constexpr size_t WS_WQ1 = WS_WKVQ + (size_t)1536 * 1024 * 2;
constexpr size_t WS_WO = WS_WQ1 + (size_t)1024 * 1024 * 2;
constexpr size_t WS_W1 = WS_WO + (size_t)2 * 1024 * 1024 * 2;
constexpr size_t WS_W2 = WS_W1 + (size_t)4 * 32 * 1024 * 1024 * 2;
constexpr size_t WS_RW = WS_W2 + (size_t)4 * 32 * 1024 * 512 * 2;
constexpr size_t WS_DUMH = WS_RW + (size_t)4 * 98304;
constexpr size_t WS_DUMSSQ = WS_DUMH + al256((size_t)RT * D * 4);
constexpr size_t WS_DUMLT = WS_DUMSSQ + al256((size_t)RT * 32 * 4);
constexpr size_t WS_DUMLG = WS_DUMLT + al256((size_t)NEXP * RT * 4);
#if defined(PROBE_TYPE)
constexpr size_t WS_END = WS_DUMLG + al256((size_t)NEXP * RT * 4);
#else
constexpr size_t WS_END = WS_DUMH;
#endif

struct Args {
    const float* in[29];
    float* out;
    unsigned char* ws;
    int ph_lo, ph_hi;
    int rep_type, rep_n;
};
typedef const __attribute__((address_space(4))) Args CArgs;

__device__ __forceinline__ unsigned cvt_pk_bf16(float lo, float hi) { unsigned r; asm volatile("v_cvt_pk_bf16_f32 %0, %1, %2" : "=v"(r) : "v"(lo), "v"(hi)); return r; }
__device__ __forceinline__ float bf16_lo(unsigned w) { return __uint_as_float(w << 16); }
__device__ __forceinline__ float bf16_hi(unsigned w) { return __uint_as_float(w & 0xffff0000u); }
__device__ __forceinline__ float fast_rcp(float x) { return __builtin_amdgcn_rcpf(x); }
__device__ __forceinline__ float fast_exp(float x) { return __builtin_amdgcn_exp2f(x * 1.4426950408889634f); }
__device__ __forceinline__ float sigmoidf_(float x) { return fast_rcp(1.0f + fast_exp(-x)); }
__device__ __forceinline__ float gelu_tanh(float x) { const float v = 0.7978845608028654f * (x + 0.044715f * x * x * x); return x * sigmoidf_(2.0f * v); }
__device__ __forceinline__ bf16x8 as_bf16x8(u32x4 v) { return __builtin_bit_cast(bf16x8, v); }
__device__ __forceinline__ f32x4 mfma16(bf16x8 a, bf16x8 b, f32x4 c) { return __builtin_amdgcn_mfma_f32_16x16x32_bf16(a, b, c, 0, 0, 0); }
constexpr int F8_LAYER = 3;
constexpr float F8_WSCALE = 64.f, F8_HSCALE = 8.f;
typedef int i32x8 __attribute__((ext_vector_type(8)));
typedef int i32x4 __attribute__((ext_vector_type(4)));
__device__ __forceinline__ unsigned pk4_fp8(float a, float b, float c, float d) {
    int w = 0;
    w = __builtin_amdgcn_cvt_pk_fp8_f32(__builtin_amdgcn_fmed3f(a, -448.f, 448.f), __builtin_amdgcn_fmed3f(b, -448.f, 448.f), w, false);
    w = __builtin_amdgcn_cvt_pk_fp8_f32(__builtin_amdgcn_fmed3f(c, -448.f, 448.f), __builtin_amdgcn_fmed3f(d, -448.f, 448.f), w, true);
    return (unsigned)w;
}
__device__ __forceinline__ f32x4 mfma8(bf16x8 a0, bf16x8 a1, bf16x8 b0, bf16x8 b1, f32x4 c) {
    const i32x8 a = __builtin_shufflevector(__builtin_bit_cast(i32x4, a0), __builtin_bit_cast(i32x4, a1), 0, 1, 2, 3, 4, 5, 6, 7);
    const i32x8 b = __builtin_shufflevector(__builtin_bit_cast(i32x4, b0), __builtin_bit_cast(i32x4, b1), 0, 1, 2, 3, 4, 5, 6, 7);
    return __builtin_amdgcn_mfma_scale_f32_16x16x128_f8f6f4(a, b, c, 0, 0, 0, 0, 0, 0);
}
__device__ __forceinline__ float xor32_sum(float v) { auto r = __builtin_amdgcn_permlane32_swap(__float_as_uint(v), __float_as_uint(v), false, false); return __uint_as_float(r[0]) + __uint_as_float(r[1]); }
__device__ __forceinline__ float xor16_sum(float v) { auto r = __builtin_amdgcn_permlane16_swap(__float_as_uint(v), __float_as_uint(v), false, false); return __uint_as_float(r[0]) + __uint_as_float(r[1]); }
__device__ __forceinline__ float xor32_max(float v) { auto r = __builtin_amdgcn_permlane32_swap(__float_as_uint(v), __float_as_uint(v), false, false); return fmaxf(__uint_as_float(r[0]), __uint_as_float(r[1])); }
__device__ __forceinline__ float xor16_max(float v) { auto r = __builtin_amdgcn_permlane16_swap(__float_as_uint(v), __float_as_uint(v), false, false); return fmaxf(__uint_as_float(r[0]), __uint_as_float(r[1])); }
__device__ __forceinline__ float quad_sum(float v) { return xor32_sum(xor16_sum(v)); }
template <int X> __device__ __forceinline__ float swz_xor(float v) { return __uint_as_float((unsigned)__builtin_amdgcn_ds_swizzle((int)__float_as_uint(v), (X << 10) | 0x1f)); }
__device__ __forceinline__ float wave_sum(float v) {
    v += swz_xor<1>(v); v += swz_xor<2>(v); v += swz_xor<4>(v); v += swz_xor<8>(v);
    return quad_sum(v);
}
__device__ __forceinline__ int opaque_bid() { int b = blockIdx.x; asm volatile("" : "+s"(b)); return b; }
__device__ __forceinline__ int opaque_tid() { int t = threadIdx.x; asm volatile("" : "+v"(t)); return t; }

#define XB_TMO      128
#define XB_XCNT(j)  (256  + 64 * (j))
#define XB_XSUB(j)  (1280 + 64 * (j))
#define XB_XGEN(j)  (2304 + 64 * (j))
#define XB_TOP      3328
#define XB_TOPGEN   3392
#define XCD_BAR_WORDS 3456
#define XB_SPIN_CAP (1u << 22)
__device__ __forceinline__ unsigned xb_ld(unsigned* p)              { return __hip_atomic_load(p, __ATOMIC_RELAXED, __HIP_MEMORY_SCOPE_AGENT); }
__device__ __forceinline__ unsigned xb_add(unsigned* p, unsigned v) { return __hip_atomic_fetch_add(p, v, __ATOMIC_RELAXED, __HIP_MEMORY_SCOPE_AGENT); }
__device__ __forceinline__ unsigned xb_xcc_id() { return (unsigned)__builtin_amdgcn_s_getreg((3 << 11) | 20) & 0xFu; }
#define XB_SPIN(cond, bar) do { unsigned _sp = 0; while (cond) { __builtin_amdgcn_s_sleep(1); \
    if ((++_sp & 255u) == 0u) { if (xb_ld(&(bar)[XB_TMO])) break; if (_sp > XB_SPIN_CAP) { atomicAdd(&(bar)[XB_TMO], 1u); break; } } } } while (0)
__device__ __forceinline__ void xcd_barrier_post(unsigned* bar) { if (threadIdx.x == 0) (void)xb_add(&bar[XB_XCNT(xb_xcc_id())], 1u); }
__device__ __forceinline__ void xcd_barrier_complete(unsigned* bar, unsigned x, unsigned& nloc, unsigned& nx) {
    const unsigned G = gridDim.x;
    unsigned sum, cnt, mine, sp = 0u;
    for (;;) {
        sum = 0u; cnt = 0u; mine = 0u;
#pragma unroll
        for (unsigned j = 0; j < 16; ++j) { const unsigned c = xb_ld(&bar[XB_XCNT(j)]); sum += c; cnt += (c > 0u) ? 1u : 0u; mine = (j == x) ? c : mine; }
        if (sum == G) break;
        __builtin_amdgcn_s_sleep(1);
        if ((++sp & 255u) == 0u) { if (xb_ld(&bar[XB_TMO])) break; if (sp > XB_SPIN_CAP) { atomicAdd(&bar[XB_TMO], 1u); break; } }
    }
    nloc = mine > 0u ? mine : 1u; nx = cnt > 0u ? cnt : 1u;
}
template <class BG>
__device__ __forceinline__ void xcd_barrier(unsigned* bar_, volatile LAS unsigned* st, BG& bg) {
    asm volatile("s_waitcnt vmcnt(0)" ::: "memory");
    __syncthreads();
    const unsigned flag0 = st[2];
    if (threadIdx.x >= 64) {
        while (st[2] == flag0) bg.step();
        bg.park();
    } else if (threadIdx.x == 0) {
        unsigned* bar = bar_; asm volatile("" : "+v"(bar));
        const unsigned bx = xb_xcc_id();
        __builtin_amdgcn_s_waitcnt(0);
        unsigned nloc = st[0], nx = st[1];
        if (nloc == 0u) { xcd_barrier_complete(bar, bx, nloc, nx); st[0] = nloc; st[1] = nx; }
        const unsigned old = xb_add(&bar[XB_XSUB(bx)], 1u);
        const unsigned gen = old / nloc;
        if (old + 1u == (gen + 1u) * nloc) {
            __builtin_amdgcn_fence(__ATOMIC_RELEASE, "agent");
            asm volatile("s_waitcnt vmcnt(0)" ::: "memory");
            const unsigned og = xb_add(&bar[XB_TOP], 1u);
            const unsigned tg = og / nx;
            if (og + 1u == (tg + 1u) * nx) xb_add(&bar[XB_TOPGEN], 1u);
            else XB_SPIN(xb_ld(&bar[XB_TOPGEN]) == tg, bar);
            __builtin_amdgcn_fence(__ATOMIC_ACQUIRE, "agent");
            xb_add(&bar[XB_XGEN(bx)], 1u);
            asm volatile("s_waitcnt vmcnt(0)" ::: "memory");
        } else {
            XB_SPIN(xb_ld(&bar[XB_XGEN(bx)]) == gen, bar);
            __builtin_amdgcn_fence(__ATOMIC_ACQUIRE, "agent");
            asm volatile("s_waitcnt vmcnt(0)" ::: "memory");
        }
        st[2] = flag0 + 1u;
    }
    __syncthreads();
}
constexpr int BM = 256, BK = 64, HALF = 128, HTB = HALF * BK * 2, STAGE_BYTES = 8 * HTB, NXCD = 8, WGM = 8;
constexpr int LDS_TABO = STAGE_BYTES;
constexpr int LDS_TABT = LDS_TABO + 3072;
constexpr int LDS_TABG = LDS_TABT + 3072;
constexpr int LDS_SH = LDS_TABG + 3072;
__host__ __device__ __forceinline__ int lds_byte(int r, int c) { const int st = (r >> 4) * 2 + (c >> 5), rr = r & 15, cc = c & 31, ob = rr * 64 + cc * 2; return st * 1024 + (ob ^ (((ob >> 9) & 1) << 5)); }
__host__ __device__ __forceinline__ void stage_rc(int b, int& R, int& C) { const int st = b / 1024, sb = b % 1024, swz = sb ^ (((sb >> 9) & 1) << 5); R = (st >> 1) * 16 + swz / 64; C = (st & 1) * 32 + (swz % 64) / 2; }
__host__ __device__ __forceinline__ int perm32(int rho) { const int n = rho >> 4, i = rho & 15; return 8 * (i >> 2) + 4 * n + (i & 3); }
struct Unit { int pm, pn, e, slot; };
__device__ __forceinline__ int xcd_chunk(int wgid, int nwg) { const int q = nwg / NXCD, r = nwg % NXCD, xcd = wgid % NXCD, off = wgid / NXCD; return (xcd < r ? xcd * (q + 1) : r * (q + 1) + (xcd - r) * q) + off; }

enum { EPI_GLU = 0, EPI_OPROJ, EPI_KVQ, EPI_MOE1, EPI_MOE2 };
struct GemmDesc {
    int kind, K, perm, gather, moe, skip_epi, stride, vb;
    int f8, arow;
    int nM, nN, nwg, npn; const char* A; const char* Bt; size_t tstepA, tstepB, wstride; const int* cnt; const int* LTOK; const float* LGATE;
    const float* res32; const bf16_t* res16; bf16_t* Hout; const float* bias; const float* bias2; const float* rstd; bf16_t* O1; bf16_t* O2; bf16_t* O3; int jq, cbase;
};
__device__ __forceinline__ bool order_next(const GemmDesc& g, LAS unsigned char* lds, int i, Unit& u) {
    const int L = i * g.stride + g.vb; if (L >= g.nwg) return false;
    const int wgid = xcd_chunk(L, g.nwg);
    if (g.moe) {
        const LAS int* sh = (const LAS int*)(lds + LDS_SH);
        int e = 0;
        for (int q = 1; q < 32; ++q) if (wgid >= g.npn * sh[q]) e = q;
        const int nmt = sh[e + 1] - sh[e], local = wgid - g.npn * sh[e];
        u.pn = local / nmt; u.pm = sh[e] + (local - u.pn * nmt); u.e = e; u.slot = i % 3;
    } else {
        const int nig = WGM * g.nN, gid = wgid / nig, fm = gid * WGM, gsz = (g.nM - fm) < WGM ? (g.nM - fm) : WGM;
        u.pm = fm + ((wgid % nig) % gsz); u.pn = (wgid % nig) / gsz; u.e = 0; u.slot = 0;
    }
    return true;
}
__device__ __forceinline__ const char* order_a(const GemmDesc& g, const Unit& u) { return g.gather ? g.A : g.A + (size_t)u.pm * g.tstepA; }
__device__ __forceinline__ const char* order_b(const GemmDesc& g, const Unit& u) { return g.Bt + (size_t)u.e * g.wstride + (size_t)u.pn * g.tstepB; }
__device__ __forceinline__ void order_fill(const GemmDesc& g, LAS unsigned char* lds, const Unit& u) {
    const int t = opaque_tid();
    if (t < 256) {
        const LAS int* sh = (const LAS int*)(lds + LDS_SH);
        const int ne = g.cnt[u.e], idx = (u.pm - sh[u.e]) * 256 + t, ci = idx < ne ? idx : ne - 1;
        const int v = g.LTOK[(size_t)u.e * RT + ci];
        ((LAS unsigned*)(lds + LDS_TABO))[u.slot * 256 + t] = (unsigned)(v & 0x3fffffff) * (unsigned)g.arow;
        ((LAS int*)(lds + LDS_TABT))[u.slot * 256 + t] = idx < ne ? v : -1;
        ((LAS float*)(lds + LDS_TABG))[u.slot * 256 + t] = g.LGATE[(size_t)u.e * RT + ci];
    }
}
__device__ __forceinline__ void gemm_epilogue(const GemmDesc& g, LAS unsigned char* lds, const f32x4 (&acc)[2][2][4][2], const Unit& u, int wr, int wc, int fr, int fq);

template <bool F8>
__device__ __forceinline__ void gemm_run(LAS unsigned char* lds, const GemmDesc& g) {
    const int tid = opaque_tid(), wid = __builtin_amdgcn_readfirstlane(tid >> 6), lane = tid & 63, wr = wid >> 2, wc = wid & 3, fr = lane & 15, fq = lane >> 4;
    const int K = g.K, nt = K / BK;
    unsigned voffB[2], go[2][2];
    const size_t kstep = (size_t)(BK * 2);
    const size_t hstep = (size_t)HALF * K * 2;
#pragma unroll
    for (int i = 0; i < 2; ++i) { int R, C; stage_rc(tid * 16 + i * 8192, R, C); const int Rb = g.perm ? ((R & ~31) + perm32(R & 31)) : R;
        voffB[i] = (unsigned)(Rb * K + C) * 2u; go[0][i] = (unsigned)(R * K + C) * 2u; go[1][i] = go[0][i] + (unsigned)hstep; }
    const unsigned ldsw = (unsigned)wid * 1024u;
    const int aoff = lds_byte(wr * 64 + fr, fq * 8), boff = lds_byte(wc * 32 + fr, fq * 8);
#define PG8_SA(b, h) (((b) * 2 + (h)) * HTB)
#define PG8_SB(b, h) ((4 + (b) * 2 + (h)) * HTB)
#define PG8_GLDS(src, dstoff) __builtin_amdgcn_global_load_lds((const unsigned*)(src), (LAS unsigned*)(lds + (dstoff)), 16, 0, 0)
#define PG8_STAGE_B(bufoff, gbase) do { _Pragma("unroll") for (int _i = 0; _i < 2; ++_i) PG8_GLDS((const char*)(gbase) + voffB[_i], (bufoff) + ldsw + _i * 8192); } while (0)
#define PG8_GO_LOAD(tsel) do { if (g.gather) { _Pragma("unroll") for (int _i = 0; _i < 2; ++_i) { int _R, _C; stage_rc(tid * 16 + _i * 8192, _R, _C); _Pragma("unroll") for (int _h = 0; _h < 2; ++_h) \
            go[_h][_i] = *(const LAS unsigned*)(lds + LDS_TABO + (tsel) * 1024 + _h * 512 + _R * 4) + (unsigned)(_C * 2); } } } while (0)
#define PG8_STAGE_A(bufoff, gbase, kt, h) do { _Pragma("unroll") for (int _i = 0; _i < 2; ++_i) PG8_GLDS((const char*)(gbase) + (size_t)(kt) * kstep + go[h][_i], (bufoff) + ldsw + _i * 8192); } while (0)
#define PG8_STAGE_AN(bufoff, gbase, tsel, kt, h) do { if (last && g.gather) { _Pragma("unroll") for (int _i = 0; _i < 2; ++_i) { int _R, _C; stage_rc(tid * 16 + _i * 8192, _R, _C); \
            const unsigned _o = *(const LAS unsigned*)(lds + LDS_TABO + (tsel) * 1024 + (h) * 512 + _R * 4) + (unsigned)(_C * 2); PG8_GLDS((const char*)(gbase) + (size_t)(kt) * kstep + _o, (bufoff) + ldsw + _i * 8192); } \
        } else PG8_STAGE_A(bufoff, gbase, kt, h); } while (0)
#define PG8_LDA(dst, b, h) do { _Pragma("unroll") for (int m = 0; m < 4; ++m) _Pragma("unroll") for (int k = 0; k < 2; ++k) dst[m][k] = *(const LAS bf16x8*)(lds + PG8_SA(b, h) + aoff + m * 2048 + k * 1024); } while (0)
#define PG8_LDB(dst, b, h) do { _Pragma("unroll") for (int n = 0; n < 2; ++n) _Pragma("unroll") for (int k = 0; k < 2; ++k) dst[n][k] = *(const LAS bf16x8*)(lds + PG8_SB(b, h) + boff + n * 2048 + k * 1024); } while (0)
#define PG8_MMA(ai, bj, At, Bt) do { __builtin_amdgcn_s_setprio(1); if constexpr (F8) { _Pragma("unroll") for (int m = 0; m < 4; ++m) _Pragma("unroll") for (int n = 0; n < 2; ++n) \
        acc[ai][bj][m][n] = mfma8(Bt[n][0], Bt[n][1], At[m][0], At[m][1], acc[ai][bj][m][n]); } else { _Pragma("unroll") for (int m = 0; m < 4; ++m) _Pragma("unroll") for (int n = 0; n < 2; ++n) _Pragma("unroll") for (int k = 0; k < 2; ++k) \
        acc[ai][bj][m][n] = __builtin_amdgcn_mfma_f32_16x16x32_bf16(Bt[n][k], At[m][k], acc[ai][bj][m][n], 0, 0, 0); } __builtin_amdgcn_s_setprio(0); } while (0)
#define PG8_WAIT_V(n) asm volatile("s_waitcnt vmcnt(" #n ")" ::: "memory")
#define PG8_WAIT_L(n) asm volatile("s_waitcnt lgkmcnt(" #n ")" ::: "memory")
#define PG8_BAR __builtin_amdgcn_s_barrier()
#define PG8_SCHED __builtin_amdgcn_sched_barrier(0)
    Unit cur, nxt; int ui = 0;
    if (!order_next(g, lds, 0, cur)) return;
    f32x4 acc[2][2][4][2];
#pragma unroll
    for (int a = 0; a < 2; ++a)
#pragma unroll
        for (int b = 0; b < 2; ++b)
#pragma unroll
            for (int m = 0; m < 4; ++m)
#pragma unroll
                for (int n = 0; n < 2; ++n) acc[a][b][m][n] = (f32x4){0.f, 0.f, 0.f, 0.f};
    bf16x8 At[4][2], B0[2][2], B1[2][2];
    if (g.moe) { order_fill(g, lds, cur); __syncthreads(); PG8_GO_LOAD(cur.slot); }
    const char* cA = order_a(g, cur); const char* cB = order_b(g, cur); int cT = cur.slot;
    PG8_STAGE_B(PG8_SB(0, 0), cB); PG8_STAGE_B(PG8_SB(0, 1), cB + hstep); PG8_STAGE_A(PG8_SA(0, 0), cA, 0, 0); PG8_STAGE_A(PG8_SA(0, 1), cA, 0, 1);
    if (wr == 1) PG8_BAR;
    PG8_WAIT_V(2); PG8_BAR;
    PG8_STAGE_B(PG8_SB(1, 0), cB + kstep); PG8_STAGE_A(PG8_SA(1, 0), cA, 1, 0); PG8_STAGE_B(PG8_SB(1, 1), cB + hstep + kstep);
    PG8_WAIT_V(6); PG8_BAR;
    for (;;) {
        const bool has_next = order_next(g, lds, ui + 1, nxt);
        if (g.moe && has_next) order_fill(g, lds, nxt);
        const char* nA = has_next ? order_a(g, nxt) : cA; const char* nB = has_next ? order_b(g, nxt) : cB; const int nT = has_next ? nxt.slot : cT;
        for (int t = 0; t < nt; t += 2) {
            const bool last = (t == nt - 2);
            const char* a2b = last ? nA : cA; const int a2k = last ? 0 : t + 2, a3k = a2k + 1;
            const char* b2 = last ? nB : cB + (size_t)(t + 2) * kstep; const char* b3 = b2 + kstep;
            PG8_LDB(B0, 0, 0); PG8_LDB(B1, 0, 1); PG8_SCHED; PG8_LDA(At, 0, 0); PG8_STAGE_A(PG8_SA(1, 1), cA, t + 1, 1);
            PG8_WAIT_V(8); PG8_WAIT_L(0); PG8_BAR; PG8_MMA(0, 0, At, B0); PG8_MMA(0, 1, At, B1); PG8_BAR; PG8_SCHED;
            PG8_LDA(At, 0, 1); PG8_STAGE_B(PG8_SB(0, 0), b2); PG8_STAGE_B(PG8_SB(0, 1), b2 + hstep); PG8_STAGE_AN(PG8_SA(0, 0), a2b, nT, a2k, 0);
            PG8_WAIT_V(8); PG8_WAIT_L(0); PG8_BAR; PG8_MMA(1, 0, At, B0); PG8_MMA(1, 1, At, B1); PG8_BAR; PG8_SCHED;
            PG8_LDB(B0, 1, 0); PG8_LDB(B1, 1, 1); PG8_SCHED; PG8_LDA(At, 1, 0); PG8_STAGE_AN(PG8_SA(0, 1), a2b, nT, a2k, 1);
            PG8_WAIT_V(8); PG8_WAIT_L(0); PG8_BAR; PG8_MMA(0, 0, At, B0); PG8_MMA(0, 1, At, B1); PG8_BAR; PG8_SCHED;
            PG8_LDA(At, 1, 1); PG8_STAGE_B(PG8_SB(1, 0), b3); PG8_STAGE_B(PG8_SB(1, 1), b3 + hstep); PG8_STAGE_AN(PG8_SA(1, 0), a2b, nT, a3k, 0);
            PG8_WAIT_V(8); PG8_WAIT_L(0); PG8_BAR; PG8_MMA(1, 0, At, B0); PG8_MMA(1, 1, At, B1); PG8_BAR; PG8_SCHED;
        }
        if (wr == 0) PG8_BAR;
        if (!g.skip_epi) gemm_epilogue(g, lds, acc, cur, wr, wc, fr, fq);
        if (!has_next) break;
#pragma unroll
        for (int a = 0; a < 2; ++a)
#pragma unroll
            for (int b = 0; b < 2; ++b)
#pragma unroll
                for (int m = 0; m < 4; ++m)
#pragma unroll
                    for (int n = 0; n < 2; ++n) acc[a][b][m][n] = (f32x4){0.f, 0.f, 0.f, 0.f};
        cur = nxt; cA = nA; cB = nB; cT = nT; ++ui;
        PG8_GO_LOAD(cT);
        if (wr == 1) PG8_BAR;
    }
    PG8_WAIT_V(0);
    PG8_BAR;
#undef PG8_SA
#undef PG8_SB
#undef PG8_GLDS
#undef PG8_STAGE_A
#undef PG8_STAGE_AN
#undef PG8_GO_LOAD
#undef PG8_STAGE_B
#undef PG8_LDA
#undef PG8_LDB
#undef PG8_MMA
#undef PG8_WAIT_V
#undef PG8_WAIT_L
#undef PG8_BAR
#undef PG8_SCHED
}
__device__ __forceinline__ f32x4 meta_dot(const bf16_t* Am, const bf16_t* Brow0, int K, int fr, int fq) {
    f32x4 acc = {0.f, 0.f, 0.f, 0.f};
    const bf16_t* ap = Am + (size_t)fr * K + 8 * fq; const bf16_t* bp = Brow0 + (size_t)fr * K + 8 * fq;
#pragma unroll 4
    for (int ks = 0; ks < K / 32; ++ks) acc = mfma16(as_bf16x8(*(const u32x4*)(bp + 32 * ks)), as_bf16x8(*(const u32x4*)(ap + 32 * ks)), acc);
    return acc;
}

struct ConvDesc { const float* src; const float* gain; bf16_t* dst; int ld, K, mode, kblk, nblk; };
constexpr int NWT_E = 768;
constexpr int NWT_MOE = 4 * 32 * NWT_E, NWT_DENSE = 2 * 1024 + 256 + 2 * 512 + 2 * 512;
__device__ __forceinline__ ConvDesc conv_decode(CArgs& a, int ti) {
    ConvDesc d;
    if (ti < NWT_MOE) {
        const int le = ti / NWT_E, r = ti % NWT_E, which = r >> 8, tt = r & 255, layer = le >> 5;
        if (which < 2) { d.src = a.in[26 + which] + (size_t)le * D * DEXP; d.ld = DEXP; d.K = D; d.gain = a.in[3] + (size_t)layer * D; d.dst = (bf16_t*)(a.ws + WS_W1) + (size_t)le * 1024 * 1024; d.mode = 1 + which; d.nblk = tt & 15; d.kblk = tt >> 4; }
        else { d.src = a.in[28] + (size_t)le * DEXP * D; d.ld = D; d.K = DEXP; d.gain = nullptr; d.dst = (bf16_t*)(a.ws + WS_W2) + (size_t)le * 1024 * 512; d.mode = 0; d.nblk = tt & 31; d.kblk = tt >> 5; }
    } else {
        int r = ti - NWT_MOE;
        if (r < 2048) { const int layer = r >> 10, tt = r & 1023, nb = tt & 63, half = nb >> 5;
            d.src = a.in[14] + (size_t)layer * D * 2 * D + half * D; d.ld = 2 * D; d.K = D; d.gain = nullptr; d.dst = (bf16_t*)(a.ws + WS_WGLU) + (size_t)layer * 2048 * 1024; d.mode = 1 + half; d.nblk = nb & 31; d.kblk = tt >> 6; }
        else if ((r -= 2048) < 256) { d.src = a.in[15]; d.ld = 512; d.K = D; d.gain = a.in[4]; d.dst = (bf16_t*)(a.ws + WS_WKVQ); d.mode = 0; d.nblk = r & 15; d.kblk = r >> 4; }
        else if ((r -= 256) < 1024) { const int j = r >> 9, tt = r & 511;
            d.src = a.in[17] + (size_t)j * D * D; d.ld = D; d.K = D; d.gain = a.in[2] + (size_t)(2 + j) * D; d.dst = j == 0 ? (bf16_t*)(a.ws + WS_WKVQ) + (size_t)512 * 1024 : (bf16_t*)(a.ws + WS_WQ1); d.mode = 0; d.nblk = tt & 31; d.kblk = tt >> 5; }
        else { r -= 1024; const int j = r >> 9, tt = r & 511;
            d.src = a.in[20] + (size_t)j * D * D; d.ld = D; d.K = D; d.gain = nullptr; d.dst = (bf16_t*)(a.ws + WS_WO) + (size_t)j * 1024 * 1024; d.mode = 0; d.nblk = tt & 31; d.kblk = tt >> 5; }
    }
    return d;
}
__device__ __forceinline__ void conv_load(const ConvDesc& d, int lane, f32x4 (&v)[8]) {
    const float* p = d.src + (size_t)(d.kblk * 64 + 8 * (lane >> 3)) * d.ld + d.nblk * 32 + 4 * (lane & 7);
#pragma unroll
    for (int j = 0; j < 8; ++j) v[j] = __builtin_nontemporal_load((const f32x4*)(p + (size_t)j * d.ld));
}
__device__ __forceinline__ void conv_store(const ConvDesc& d, int lane, f32x4 (&v)[8]) {
    const int k0 = d.kblk * 64 + 8 * (lane >> 3);
    if (d.gain) { const f32x4 g0 = *(const f32x4*)(d.gain + k0), g1 = *(const f32x4*)(d.gain + k0 + 4);
        v[0] *= g0[0]; v[1] *= g0[1]; v[2] *= g0[2]; v[3] *= g0[3]; v[4] *= g1[0]; v[5] *= g1[1]; v[6] *= g1[2]; v[7] *= g1[3]; }
    const int n = d.nblk * 32 + 4 * (lane & 7), row = d.mode == 0 ? n : (256 * (n >> 7) + (n & 127) + (d.mode == 2 ? 128 : 0));
    bf16_t* q = d.dst + (size_t)row * d.K + k0;
#pragma unroll
    for (int c = 0; c < 4; ++c) {
        u32x4 w; w.x = cvt_pk_bf16(v[0][c], v[1][c]); w.y = cvt_pk_bf16(v[2][c], v[3][c]); w.z = cvt_pk_bf16(v[4][c], v[5][c]); w.w = cvt_pk_bf16(v[6][c], v[7][c]);
        asm volatile("global_store_dwordx4 %0, %1, off sc1\n\ts_nop 1" :: "v"(q + (size_t)c * d.K), "v"(w) : "memory");
    }
}
constexpr int F8_T0 = F8_LAYER < 4 ? F8_LAYER * 32 * NWT_E : NWT_MOE;
__device__ __forceinline__ void conv_pair8(CArgs& a, int ti, int lane) {
    const int le = ti / NWT_E, r = ti % NWT_E, which = r >> 8, tt = r & 255, layer = le >> 5, t7 = (tt & 7) | ((tt >> 4) << 3);
    const float* src; const float* gain; unsigned char* dst; int ld, K, mode, nblk, kpair;
    if (which < 2) { src = a.in[26 + which] + (size_t)le * D * DEXP; ld = DEXP; K = D; gain = a.in[3] + (size_t)layer * D; dst = a.ws + WS_W1 + (size_t)layer * 32 * 1024 * 1024 * 2 + (size_t)(le & 31) * 1024 * 1024; mode = 1 + which; nblk = t7 & 15; kpair = t7 >> 4; }
    else { src = a.in[28] + (size_t)le * DEXP * D; ld = D; K = DEXP; gain = nullptr; dst = a.ws + WS_W2 + (size_t)layer * 32 * 1024 * 512 * 2 + (size_t)(le & 31) * 1024 * 512; mode = 0; nblk = t7 & 31; kpair = t7 >> 5; }
    const int k0 = kpair * 128 + 16 * (lane >> 3);
    const float* p = src + (size_t)k0 * ld + nblk * 32 + 4 * (lane & 7);
    f32x4 va[8], vb[8];
#pragma unroll
    for (int j = 0; j < 8; ++j) va[j] = __builtin_nontemporal_load((const f32x4*)(p + (size_t)j * ld));
#pragma unroll
    for (int j = 0; j < 8; ++j) vb[j] = __builtin_nontemporal_load((const f32x4*)(p + (size_t)(8 + j) * ld));
    if (gain) { const f32x4 g0 = *(const f32x4*)(gain + k0), g1 = *(const f32x4*)(gain + k0 + 4), g2 = *(const f32x4*)(gain + k0 + 8), g3 = *(const f32x4*)(gain + k0 + 12);
#pragma unroll
        for (int j = 0; j < 4; ++j) { va[j] *= g0[j] * F8_WSCALE; va[4 + j] *= g1[j] * F8_WSCALE; vb[j] *= g2[j] * F8_WSCALE; vb[4 + j] *= g3[j] * F8_WSCALE; } }
    else {
#pragma unroll
        for (int j = 0; j < 8; ++j) { va[j] *= F8_WSCALE; vb[j] *= F8_WSCALE; } }
    const int n = nblk * 32 + 4 * (lane & 7), row = mode == 0 ? n : (256 * (n >> 7) + (n & 127) + (mode == 2 ? 128 : 0));
    unsigned char* q = dst + (size_t)row * K + k0;
#pragma unroll
    for (int c = 0; c < 4; ++c) {
        u32x4 w; w.x = pk4_fp8(va[0][c], va[1][c], va[2][c], va[3][c]); w.y = pk4_fp8(va[4][c], va[5][c], va[6][c], va[7][c]); w.z = pk4_fp8(vb[0][c], vb[1][c], vb[2][c], vb[3][c]); w.w = pk4_fp8(vb[4][c], vb[5][c], vb[6][c], vb[7][c]);
        asm volatile("global_store_dwordx4 %0, %1, off sc1\n\ts_nop 1" :: "v"(q + (size_t)c * K), "v"(w) : "memory");
    }
}
__device__ __forceinline__ void convert_weights(CArgs& a) {
    const int lane = opaque_tid() & 63, gw = (opaque_tid() >> 6) * GRID + opaque_bid();
    for (int ti = NWT_MOE + gw; ti < NWT_MOE + NWT_DENSE; ti += GRID * 16) {
        const int t1 = ti + GRID * 8; const bool two = t1 < NWT_MOE + NWT_DENSE;
        const ConvDesc d0 = conv_decode(a, ti); ConvDesc d1 = d0; f32x4 va[8], vb[8];
        conv_load(d0, lane, va);
        if (two) { d1 = conv_decode(a, t1); conv_load(d1, lane, vb); }
        conv_store(d0, lane, va);
        if (two) conv_store(d1, lane, vb);
    }
}
struct BgConv {
    CArgs* a; volatile LAS unsigned* st;
    __device__ __forceinline__ int claim() const {
        int t = 0;
        if ((opaque_tid() & 63) == 0) { const unsigned x = xb_xcc_id() & 7u; t = (int)(xb_add((unsigned*)(a->ws + WS_CTL) + CW_BGC + 64 * x, 1u) * 16u + x); }
        return __builtin_amdgcn_readfirstlane(t);
    }
    __device__ __forceinline__ int claim_run() {
        const int t = claim(); const int lane = opaque_tid() & 63;
        if (t >= F8_T0) { if (t < NWT_MOE) conv_pair8(*a, t, lane); else if (lane == 0) st[3] = 1u; return t + 8; }
        const bool v0 = t < NWT_MOE, v1 = t + 8 < NWT_MOE;
        ConvDesc d0, d1; f32x4 va[8], vb[8];
        if (v0) { d0 = conv_decode(*a, t); conv_load(d0, lane, va); }
        if (v1) { d1 = conv_decode(*a, t + 8); conv_load(d1, lane, vb); }
        if (v0) conv_store(d0, lane, va);
        if (v1) conv_store(d1, lane, vb); else if (lane == 0) st[3] = 1u;
        return t + 8;
    }
    __device__ __forceinline__ void step() { if (st[3] == 0u) (void)claim_run(); else __builtin_amdgcn_s_sleep(32); }
    __device__ __forceinline__ void park() {}
    __device__ __forceinline__ void drain_others(int limit) {
        if (opaque_tid() < 64) {
            for (unsigned x = 0; x < 8u; ++x) {
                unsigned* ctr = (unsigned*)(a->ws + WS_CTL) + CW_BGC + 64 * x;
                while ((int)((unsigned)__builtin_amdgcn_readfirstlane(xb_ld(ctr)) * 16u + x) < limit) {
                    int t = 0; if ((opaque_tid() & 63) == 0) t = (int)(xb_add(ctr, 1u) * 16u + x);
                    t = __builtin_amdgcn_readfirstlane(t);
                    const int lane = opaque_tid() & 63;
                    if (t >= F8_T0) { if (t < NWT_MOE) conv_pair8(*a, t, lane); }
                    else { { const ConvDesc d = conv_decode(*a, t); f32x4 v[8]; conv_load(d, lane, v); conv_store(d, lane, v); }
                           { const ConvDesc d = conv_decode(*a, t + 8); f32x4 v[8]; conv_load(d, lane, v); conv_store(d, lane, v); } }
                }
            }
        }
    }
    __device__ __forceinline__ void run_until(int limit, int budget) {
        for (int n = 0; n < budget; ++n) { if (st[3] != 0u) break; if (claim_run() >= limit) break; }
    }
};

struct cplx { float re, im; };
__device__ __forceinline__ cplx cmul(cplx a, cplx b) { return {a.re * b.re - a.im * b.im, a.re * b.im + a.im * b.re}; }

__device__ __forceinline__ void hw_sincos(float x, float& sn, float& cs) { float r = x * 0.15915494309189535f; r -= floorf(r); sn = __builtin_amdgcn_sinf(r); cs = __builtin_amdgcn_cosf(r); }
__device__ __forceinline__ void s5_tables(CArgs& a, int layer, int g, int part, LAS unsigned char* lds) {
    LAS f32x2* pw = (LAS f32x2*)lds;
    LAS f32x2* bb = (LAS f32x2*)(lds + 64 * 17 * 8);
    LAS f32x2* cc = bb + 64 * 16;
    const int tid = opaque_tid();
    const float* a_re = a.in[6] + ((size_t)layer * 64 + g) * 64; const float* a_im = a.in[7] + ((size_t)layer * 64 + g) * 64;
    const float dt = expf(a.in[8][layer * 64 + g]);
    for (int idx = tid; idx < 64 * 17; idx += NTHREADS) {
        const int p = idx / 17, d = idx % 17;
        const float mag = expf(a_re[p] * dt * (float)d), ang = a_im[p] * dt * (float)d;
        float s, c; hw_sincos(ang, s, c);
        pw[idx] = (f32x2){mag * c, mag * s};
    }
    const float* b_re = a.in[9] + ((size_t)layer * 64 + g) * 1024; const float* b_im = a.in[10] + ((size_t)layer * 64 + g) * 1024;
    const float* c_re = a.in[11] + ((size_t)layer * 64 + g) * 1024; const float* c_im = a.in[12] + ((size_t)layer * 64 + g) * 1024;
    for (int idx = tid; idx < 1024; idx += NTHREADS) {
        const int p = idx >> 4;
        const float lr = a_re[p], li = a_im[p];
        const float mag = expf(lr * dt), ang = li * dt; float s, c; hw_sincos(ang, s, c);
        const float nr = mag * c - 1.0f, ni = mag * s;
        const float den = 1.0f / (lr * lr + li * li);
        const cplx f = {(nr * lr + ni * li) * den, (ni * lr - nr * li) * den};
        const cplx r = cmul(f, (cplx){b_re[idx], b_im[idx]});
        bb[idx] = (f32x2){r.re, r.im};
        cc[idx] = (f32x2){c_re[idx], c_im[idx]};
    }
    __syncthreads();
    unsigned char* tbl = a.ws + WS_TBL + ((size_t)layer * 64 + g) * TBL_STRIDE;
    for (int idx = part * 512 + tid; idx < part * 512 + 512; idx += NTHREADS) {
        const int delta = idx >> 6, l = idx & 63, c1 = l & 15, q4 = l >> 4, d = delta - (q4 >> 1);
        float v[8];
#pragma unroll
        for (int j = 0; j < 8; ++j) v[j] = 0.f;
        if (d >= 0) {
            for (int p = 0; p < 64; ++p) {
                const f32x2 cw = cc[c1 * 64 + p], pp = pw[p * 17 + d];
                const cplx t = cmul((cplx){cw.x, cw.y}, (cplx){pp.x, pp.y});
#pragma unroll
                for (int j = 0; j < 8; ++j) { const f32x2 bw = bb[p * 16 + 8 * (q4 & 1) + j]; v[j] += t.re * bw.x - t.im * bw.y; }
            }
        }
        u32x4 w; w.x = cvt_pk_bf16(v[0], v[1]); w.y = cvt_pk_bf16(v[2], v[3]); w.z = cvt_pk_bf16(v[4], v[5]); w.w = cvt_pk_bf16(v[6], v[7]);
        *(u32x4*)(tbl + TBL_K + (size_t)idx * 16) = w;
    }
    if (part == 0)
    for (int idx = tid; idx < 64 * 64; idx += NTHREADS) {
        const int f = idx >> 6, l = idx & 63, rt = f >> 3, ks = f & 7, q4 = l >> 4, rho = 16 * rt + (l & 15), p = rho & 63, im = rho >> 6;
        const int k0 = 32 * ks + 8 * q4, jpos = k0 >> 4, c20 = k0 & 15;
        const f32x2 pp = pw[p * 17 + (15 - jpos)];
        float v[8];
#pragma unroll
        for (int j = 0; j < 8; ++j) { const f32x2 bw = bb[p * 16 + c20 + j]; const cplx t = cmul((cplx){pp.x, pp.y}, (cplx){bw.x, bw.y}); v[j] = im ? t.im : t.re; }
        u32x4 w; w.x = cvt_pk_bf16(v[0], v[1]); w.y = cvt_pk_bf16(v[2], v[3]); w.z = cvt_pk_bf16(v[4], v[5]); w.w = cvt_pk_bf16(v[6], v[7]);
        *(u32x4*)(tbl + TBL_M + (size_t)idx * 16) = w;
    }
    if (part == 1)
    for (int idx = tid; idx < 64 * 64; idx += NTHREADS) {
        const int f = idx >> 6, l = idx & 63, i = f >> 2, ks = f & 3, q4 = l >> 4, c1 = l & 15;
        const int s0 = 32 * ks + 8 * q4;
        float v[8];
#pragma unroll
        for (int j = 0; j < 8; ++j) { const int sg = s0 + j, p = sg & 63; const f32x2 cw = cc[c1 * 64 + p], pp = pw[p * 17 + i + 1];
            const cplx t = cmul((cplx){cw.x, cw.y}, (cplx){pp.x, pp.y}); v[j] = (sg >> 6) ? -t.im : t.re; }
        u32x4 w; w.x = cvt_pk_bf16(v[0], v[1]); w.y = cvt_pk_bf16(v[2], v[3]); w.z = cvt_pk_bf16(v[4], v[5]); w.w = cvt_pk_bf16(v[6], v[7]);
        *(u32x4*)(tbl + TBL_N + (size_t)idx * 16) = w;
    }
    if (part == 1 && tid < 64) *(f32x2*)(tbl + TBL_A16 + tid * 8) = pw[tid * 17 + 16];
    __syncthreads();
}

__device__ __forceinline__ void row_norm_store(const f32x4 (&v)[4], float ssq, int lane, const float* g0, bf16_t* o0) {
    const float rstd = 1.0f / sqrtf(ssq * (1.0f / D) + RMS_EPS);
#pragma unroll
    for (int j = 0; j < 4; ++j) {
        const int c = 4 * lane + 256 * j;
        f32x4 g = {1.f, 1.f, 1.f, 1.f}; if (g0) g = *(const f32x4*)(g0 + c);
        u32x2 w; w.x = cvt_pk_bf16(v[j][0] * rstd * g[0], v[j][1] * rstd * g[1]); w.y = cvt_pk_bf16(v[j][2] * rstd * g[2], v[j][3] * rstd * g[3]);
        *(u32x2*)(o0 + c) = w;
    }
}
__device__ __forceinline__ void phase_prep(CArgs& a, LAS unsigned char* lds) {
    if (opaque_bid() < 128) { s5_tables(a, opaque_bid() >> 6, opaque_bid() & 63, 0, lds); s5_tables(a, opaque_bid() >> 6, opaque_bid() & 63, 1, lds); }
    if (opaque_tid() < 96) {
        const int item = opaque_bid() * 96 + opaque_tid(), layer = item / 6144, idx = item % 6144;
        const float* wg = a.in[22] + (size_t)layer * D * NGRP; const float* we = a.in[24] + (size_t)layer * D * NEXP; const float* gain = a.in[3] + (size_t)layer * D;
        const int l = idx & 63, ks = (idx >> 6) & 31, rt = idx >> 11, o = 16 * rt + (l & 15), k0 = 32 * ks + 8 * (l >> 4);
        float v[8];
#pragma unroll
        for (int jq = 0; jq < 8; ++jq) v[jq] = (o < 4 ? wg[(size_t)(k0 + jq) * NGRP + o] : (o < 36 ? we[(size_t)(k0 + jq) * NEXP + (o - 4)] : 0.f)) * gain[k0 + jq];
        u32x4 w; w.x = cvt_pk_bf16(v[0], v[1]); w.y = cvt_pk_bf16(v[2], v[3]); w.z = cvt_pk_bf16(v[4], v[5]); w.w = cvt_pk_bf16(v[6], v[7]);
        *(u32x4*)(a.ws + WS_RW + (size_t)layer * 98304 + (size_t)idx * 16) = w;
    }
    convert_weights(a);
    const int lane = opaque_tid() & 63, gw = opaque_bid() * 8 + (opaque_tid() >> 6);
    float* RSTD = (float*)(a.ws + WS_RSTD);
    for (int row0 = gw; row0 < RT; row0 += GRID * 8 * 4) {
        f32x4 v[4][4];
#pragma unroll
        for (int q = 0; q < 4; ++q) { const int row = row0 + q * GRID * 8, rr = row < RT ? row : RT - 1;
            const float* src = rr < NREAL ? a.in[0] + (size_t)rr * D : a.in[1] + (size_t)(rr - NREAL) * D;
#pragma unroll
            for (int j = 0; j < 4; ++j) v[q][j] = *(const f32x4*)(src + 4 * lane + 256 * j); }
#pragma unroll
        for (int q = 0; q < 4; ++q) { const int row = row0 + q * GRID * 8; float ssq = 0.f;
#pragma unroll
            for (int j = 0; j < 4; ++j) ssq += v[q][j][0] * v[q][j][0] + v[q][j][1] * v[q][j][1] + v[q][j][2] * v[q][j][2] + v[q][j][3] * v[q][j][3];
            ssq = wave_sum(ssq);
            if (lane == 0 && row < RT) RSTD[row] = 1.0f / sqrtf(ssq * (1.0f / D) + RMS_EPS); }
    }
}

constexpr int S5_CH = 528;
constexpr int S5_NCH = 129, S5_NCHP = 144;
__device__ __forceinline__ cplx cmulc(cplx x, cplx y) { return {x.re * y.re - x.im * y.im, x.re * y.im + x.im * y.re}; }
__device__ __forceinline__ void phase_s5(CArgs& a, int layer, LAS unsigned char* lds) {
    LAS unsigned char* Ul = lds; LAS unsigned char* Sl = lds + S5_NCHP * S5_CH;
    const int tid = opaque_tid(), lane = tid & 63, w = __builtin_amdgcn_readfirstlane(tid >> 6), tc = lane & 15, q4 = lane >> 4;
    const bf16_t* H = (const bf16_t*)(a.ws + WS_H); const float* RSTD = (const float*)(a.ws + WS_RSTD); bf16_t* Z = (bf16_t*)(a.ws + WS_Z);
    const int b = opaque_bid() >> 5, gp = 2 * (opaque_bid() & 31);
    u32x4 keep[9];
    {
        const int half = tid & 1, c = 16 * gp + 8 * half;
        const float* gn = a.in[2] + (size_t)layer * D + c;
        const f32x4 ga0 = *(const f32x4*)gn, ga1 = *(const f32x4*)(gn + 4), gb0 = *(const f32x4*)(gn + 16), gb1 = *(const f32x4*)(gn + 20);
#pragma unroll
        for (int k0 = 0; k0 < 9; k0 += 3) {
            float rs[3]; u32x4 ha[3], hb[3]; f32x4 xa0[3], xa1[3], xb0[3], xb1[3];
#pragma unroll
            for (int q = 0; q < 3; ++q) {
                const int idx = tid + (k0 + q) * NTHREADS, tok = (idx < LT * 2 ? idx : LT * 2 - 1) >> 1, row = row_of(b, tok);
                rs[q] = RSTD[row];
                if (layer == 0) { const float* src = (row < NREAL ? a.in[0] + (size_t)row * D : a.in[1] + (size_t)(row - NREAL) * D) + c;
                    xa0[q] = *(const f32x4*)src; xa1[q] = *(const f32x4*)(src + 4); xb0[q] = *(const f32x4*)(src + 16); xb1[q] = *(const f32x4*)(src + 20); }
                else { ha[q] = *(const u32x4*)(H + (size_t)row * D + c); hb[q] = *(const u32x4*)(H + (size_t)row * D + c + 16); }
            }
#pragma unroll
            for (int q = 0; q < 3; ++q) {
                const int idx = tid + (k0 + q) * NTHREADS, tok = idx >> 1; const float r_ = rs[q];
                float va[8], vb[8];
                if (layer == 0) {
#pragma unroll
                    for (int e = 0; e < 4; ++e) { va[e] = xa0[q][e]; va[4 + e] = xa1[q][e]; vb[e] = xb0[q][e]; vb[4 + e] = xb1[q][e]; }
                } else {
                    const u32x4 p = ha[q], r2 = hb[q];
                    va[0] = bf16_lo(p.x); va[1] = bf16_hi(p.x); va[2] = bf16_lo(p.y); va[3] = bf16_hi(p.y); va[4] = bf16_lo(p.z); va[5] = bf16_hi(p.z); va[6] = bf16_lo(p.w); va[7] = bf16_hi(p.w);
                    vb[0] = bf16_lo(r2.x); vb[1] = bf16_hi(r2.x); vb[2] = bf16_lo(r2.y); vb[3] = bf16_hi(r2.y); vb[4] = bf16_lo(r2.z); vb[5] = bf16_hi(r2.z); vb[6] = bf16_lo(r2.w); vb[7] = bf16_hi(r2.w);
                }
                u32x4 v; v.x = cvt_pk_bf16(va[0] * r_ * ga0[0], va[1] * r_ * ga0[1]); v.y = cvt_pk_bf16(va[2] * r_ * ga0[2], va[3] * r_ * ga0[3]);
                v.z = cvt_pk_bf16(va[4] * r_ * ga1[0], va[5] * r_ * ga1[1]); v.w = cvt_pk_bf16(va[6] * r_ * ga1[2], va[7] * r_ * ga1[3]);
                if (idx < LT * 2) *(LAS u32x4*)(Ul + (tok >> 4) * S5_CH + (tok & 15) * 32 + half * 16) = v;
                u32x4 k; k.x = cvt_pk_bf16(vb[0] * r_ * gb0[0], vb[1] * r_ * gb0[1]); k.y = cvt_pk_bf16(vb[2] * r_ * gb0[2], vb[3] * r_ * gb0[3]);
                k.z = cvt_pk_bf16(vb[4] * r_ * gb1[0], vb[5] * r_ * gb1[1]); k.w = cvt_pk_bf16(vb[6] * r_ * gb1[2], vb[7] * r_ * gb1[3]);
                keep[k0 + q] = k;
            }
        }
    }
#pragma unroll 1
    for (int ui = 0; ui < 2; ++ui) {
        const int g = gp + ui;
        const unsigned char* tbl = a.ws + WS_TBL + ((size_t)layer * 64 + g) * TBL_STRIDE;
        if (ui == 1) {
            const int half = tid & 1;
#pragma unroll
            for (int k = 0; k < 9; ++k) { const int idx = tid + k * NTHREADS, tok = idx >> 1; if (idx < LT * 2) *(LAS u32x4*)(Ul + (tok >> 4) * S5_CH + (tok & 15) * 32 + half * 16) = keep[k]; }
        }
        bf16x8 mf[8];
#pragma unroll
        for (int ks = 0; ks < 8; ++ks) mf[ks] = as_bf16x8(*(const u32x4*)(tbl + TBL_M + ((size_t)(w * 8 + ks) * 64 + lane) * 16));
        const int i0 = w, i1 = 15 - w;
        bf16x8 kf0[8], kf1[8], nf0[4], nf1[4];
#pragma unroll
        for (int jj = 0; jj < 8; ++jj) {
            const int d0 = i0 - 2 * jj, d1 = i1 - 2 * jj;
            kf0[jj] = as_bf16x8(*(const u32x4*)(tbl + TBL_K + ((size_t)(d0 >= 0 ? d0 : 0) * 64 + lane) * 16));
            kf1[jj] = as_bf16x8(*(const u32x4*)(tbl + TBL_K + ((size_t)(d1 >= 0 ? d1 : 0) * 64 + lane) * 16));
        }
#pragma unroll
        for (int ks = 0; ks < 4; ++ks) {
            nf0[ks] = as_bf16x8(*(const u32x4*)(tbl + TBL_N + ((size_t)(i0 * 4 + ks) * 64 + lane) * 16));
            nf1[ks] = as_bf16x8(*(const u32x4*)(tbl + TBL_N + ((size_t)(i1 * 4 + ks) * 64 + lane) * 16));
        }
        const f32x2 a16v = *(const f32x2*)(tbl + TBL_A16 + lane * 8);
        __syncthreads();
        {
#pragma unroll 1
            for (int cg = 0; cg < 9; ++cg) {
                const int n = 16 * cg + tc;
                f32x4 acc = {0.f, 0.f, 0.f, 0.f};
#pragma unroll
                for (int ks = 0; ks < 8; ++ks) { const bf16x8 ub = *(LAS bf16x8*)(Ul + n * S5_CH + ks * 64 + q4 * 16); acc = mfma16(mf[ks], ub, acc); }
                *(LAS f32x4*)(Sl + n * S5_CH + (16 * w + 4 * q4) * 4) = acc;
            }
        }
        __syncthreads();
        {
            const cplx a1 = {a16v.x, a16v.y};
            const int nb0 = 16 * w, ncnt = w == 7 ? 17 : 16;
            cplx s = {0.f, 0.f};
#pragma unroll 4
            for (int j = 0; j < 16; ++j) { const float xr = *(LAS float*)(Sl + (nb0 + j) * S5_CH + lane * 4), xi = *(LAS float*)(Sl + (nb0 + j) * S5_CH + 256 + lane * 4); const cplx t = cmulc(a1, s); s = {t.re + xr, t.im + xi}; }
            if (w < 7) { *(LAS float*)(Sl + (130 + w) * S5_CH + lane * 4) = s.re; *(LAS float*)(Sl + (130 + w) * S5_CH + 256 + lane * 4) = s.im; }
            cplx A = a1;
#pragma unroll
            for (int q = 0; q < 4; ++q) A = cmulc(A, A);
            __syncthreads();
            cplx c = {0.f, 0.f};
            for (int v = 0; v < w; ++v) { const float er = *(LAS float*)(Sl + (130 + v) * S5_CH + lane * 4), ei = *(LAS float*)(Sl + (130 + v) * S5_CH + 256 + lane * 4); const cplx t = cmulc(A, c); c = {t.re + er, t.im + ei}; }
            float sr = c.re, si = c.im;
#pragma unroll 1
            for (int nb = 0; nb < 3; ++nb) {
                const int cntb = nb < 2 ? 8 : ncnt - 16;
                float xr[8], xi[8];
#pragma unroll
                for (int j = 0; j < 8; ++j) { const int n = nb0 + nb * 8 + (j < cntb ? j : 0); xr[j] = *(LAS float*)(Sl + n * S5_CH + lane * 4); xi[j] = *(LAS float*)(Sl + n * S5_CH + 256 + lane * 4); }
                asm volatile("s_waitcnt lgkmcnt(0)" ::: "memory");
#pragma unroll
                for (int j = 0; j < 8; ++j) {
                    if (j < cntb) {
                        const int n = nb0 + nb * 8 + j;
                        const unsigned pr = cvt_pk_bf16(sr, si);
                        *(LAS unsigned short*)(Sl + n * S5_CH + lane * 2) = (unsigned short)(pr & 0xffffu);
                        *(LAS unsigned short*)(Sl + n * S5_CH + 128 + lane * 2) = (unsigned short)(pr >> 16);
                        const float nr = a1.re * sr - a1.im * si + xr[j], ni = a1.re * si + a1.im * sr + xi[j];
                        sr = nr; si = ni;
                    }
                }
                asm volatile("" ::: "memory");
            }
        }
        __syncthreads();
        {
            const f32x4 dsk = *(const f32x4*)(a.in[13] + (size_t)layer * D + 16 * g + 4 * q4);
#pragma unroll 1
            for (int cg = 0; cg < 9; ++cg) {
                const int n = 16 * cg + tc;
                f32x4 acc0 = {0.f, 0.f, 0.f, 0.f}, acc1 = {0.f, 0.f, 0.f, 0.f};
#pragma unroll
                for (int jj = 0; jj < 8; ++jj) {
                    const bf16x8 ub = *(LAS bf16x8*)(Ul + n * S5_CH + jj * 64 + q4 * 16);
                    if (2 * jj <= i0) acc0 = mfma16(kf0[jj], ub, acc0);
                    if (2 * jj <= i1) acc1 = mfma16(kf1[jj], ub, acc1);
                }
#pragma unroll
                for (int ks = 0; ks < 4; ++ks) {
                    const bf16x8 sb = *(LAS bf16x8*)(Sl + n * S5_CH + ks * 64 + q4 * 16);
                    acc0 = mfma16(nf0[ks], sb, acc0); acc1 = mfma16(nf1[ks], sb, acc1);
                }
                if (n < S5_NCH && (n > 0 || b == 0)) {
#pragma unroll
                    for (int h = 0; h < 2; ++h) {
                        const int i = h ? i1 : i0; const f32x4 y = h ? acc1 : acc0;
                        const u32x2 uw = *(LAS u32x2*)(Ul + n * S5_CH + i * 32 + q4 * 8);
                        const float z0 = gelu_tanh(y[0] + dsk[0] * bf16_lo(uw.x)), z1 = gelu_tanh(y[1] + dsk[1] * bf16_hi(uw.x));
                        const float z2 = gelu_tanh(y[2] + dsk[2] * bf16_lo(uw.y)), z3 = gelu_tanh(y[3] + dsk[3] * bf16_hi(uw.y));
                        u32x2 o; o.x = cvt_pk_bf16(z0, z1); o.y = cvt_pk_bf16(z2, z3);
                        *(u32x2*)(Z + (size_t)row_of(b, 16 * n + i) * D + 16 * g + 4 * q4) = o;
                    }
                }
            }
        }
        __syncthreads();
    }
}

__device__ __forceinline__ float ssq4(f32x4 h) { return h[0] * h[0] + h[1] * h[1] + h[2] * h[2] + h[3] * h[3]; }
__device__ __forceinline__ int gwave() { return opaque_bid() * 8 + (opaque_tid() >> 6); }
template <int NACC> __device__ __forceinline__ bool meta_block(LAS unsigned char* lds, const bf16_t* Am, const bf16_t* const (&brow)[NACC], int K, f32x4 (&out)[NACC]) {
    const int tid = opaque_tid(), lane = tid & 63, wid = tid >> 6, fr = lane & 15, fq = lane >> 4, ksl = K / 8;
#pragma unroll
    for (int i = 0; i < NACC; ++i) {
        f32x4 acc = {0.f, 0.f, 0.f, 0.f};
        const bf16_t* ap = Am + (size_t)fr * K + wid * ksl + 8 * fq; const bf16_t* bp = brow[i] + (size_t)fr * K + wid * ksl + 8 * fq;
        for (int ks = 0; ks < ksl / 32; ++ks) acc = mfma16(as_bf16x8(*(const u32x4*)(bp + 32 * ks)), as_bf16x8(*(const u32x4*)(ap + 32 * ks)), acc);
        ((LAS f32x4*)lds)[(wid * NACC + i) * 64 + lane] = acc;
    }
    __syncthreads();
    if (wid == 0) {
#pragma unroll
        for (int i = 0; i < NACC; ++i) { f32x4 s = {0.f, 0.f, 0.f, 0.f};
#pragma unroll
            for (int w = 0; w < 8; ++w) s += ((LAS f32x4*)lds)[(w * NACC + i) * 64 + lane];
            out[i] = s; }
    }
    __syncthreads();
    return wid == 0;
}

__device__ __forceinline__ void load_res8(const GemmDesc& g, size_t off, float (&h)[8]) {
    if (g.res32) { const f32x4 a = *(const f32x4*)(g.res32 + off), b = *(const f32x4*)(g.res32 + off + 4); h[0] = a[0]; h[1] = a[1]; h[2] = a[2]; h[3] = a[3]; h[4] = b[0]; h[5] = b[1]; h[6] = b[2]; h[7] = b[3]; }
    else { const u32x4 w = *(const u32x4*)(g.res16 + off); h[0] = bf16_lo(w.x); h[1] = bf16_hi(w.x); h[2] = bf16_lo(w.y); h[3] = bf16_hi(w.y); h[4] = bf16_lo(w.z); h[5] = bf16_hi(w.z); h[6] = bf16_lo(w.w); h[7] = bf16_hi(w.w); }
}
__device__ __forceinline__ void store_h8(bf16_t* Hout, size_t off, const float (&h)[8]) {
    u32x4 w; w.x = cvt_pk_bf16(h[0], h[1]); w.y = cvt_pk_bf16(h[2], h[3]); w.z = cvt_pk_bf16(h[4], h[5]); w.w = cvt_pk_bf16(h[6], h[7]);
    *(u32x4*)(Hout + off) = w;
}
__device__ __forceinline__ void epi_glu(const GemmDesc& g, const f32x4 (&acc)[2][2][4][2], const Unit& u, int wr, int wc, int fr, int fq) {
#pragma unroll
    for (int ai = 0; ai < 2; ++ai) {
        const int row0 = u.pm * BM + ai * HALF + wr * 64 + fr; const size_t off0 = (size_t)row0 * D + u.pn * 128 + wc * 32 + 8 * fq;
        float h[4][8];
#pragma unroll
        for (int m = 0; m < 4; ++m) load_res8(g, off0 + (size_t)m * 16 * D, h[m]);
#pragma unroll
        for (int m = 0; m < 4; ++m) {
#pragma unroll
            for (int n = 0; n < 2; ++n) { const f32x4 v = acc[ai][0][m][n], gt = acc[ai][1][m][n];
                h[m][4 * n + 0] += v[0] * sigmoidf_(gt[0]); h[m][4 * n + 1] += v[1] * sigmoidf_(gt[1]); h[m][4 * n + 2] += v[2] * sigmoidf_(gt[2]); h[m][4 * n + 3] += v[3] * sigmoidf_(gt[3]); }
            store_h8(g.Hout, off0 + (size_t)m * 16 * D, h[m]);
        }
        asm volatile("" ::: "memory");
    }
}
__device__ __forceinline__ void phase_glu(CArgs& a, int layer, bool dry, LAS unsigned char* lds, GemmDesc& g) {
    const bf16_t* Zb = (const bf16_t*)(a.ws + WS_Z); const bf16_t* W = (const bf16_t*)(a.ws + WS_WGLU) + (size_t)layer * 2048 * 1024;
    g.res32 = layer == 0 ? a.in[0] : nullptr; g.res16 = (const bf16_t*)(a.ws + WS_H); g.Hout = (bf16_t*)(a.ws + (dry ? WS_DUMH : WS_H));
    if (opaque_bid() < 32) {
        const int lane = opaque_tid() & 63, fr = lane & 15, fq = lane >> 4, task = opaque_bid();
        const int c0 = 32 * task, rv = 256 * (c0 >> 7) + (c0 & 127);
        const bf16_t* const br[4] = {W + (size_t)rv * D, W + (size_t)(rv + 16) * D, W + (size_t)(rv + 128) * D, W + (size_t)(rv + 144) * D};
        f32x4 o[4];
        if (meta_block<4>(lds, Zb + (size_t)NREAL * D, br, D, o)) {
#pragma unroll
            for (int n = 0; n < 2; ++n) {
                const f32x4 v = o[n], gt = o[2 + n]; const int c = c0 + 16 * n + 4 * fq;
                f32x4 h;
                if (layer == 0) h = *(const f32x4*)(a.in[1] + (size_t)fr * D + c);
                else { const u32x2 w = *(const u32x2*)(g.res16 + (size_t)(NREAL + fr) * D + c); h = (f32x4){bf16_lo(w.x), bf16_hi(w.x), bf16_lo(w.y), bf16_hi(w.y)}; }
                h[0] += v[0] * sigmoidf_(gt[0]); h[1] += v[1] * sigmoidf_(gt[1]); h[2] += v[2] * sigmoidf_(gt[2]); h[3] += v[3] * sigmoidf_(gt[3]);
                u32x2 w2; w2.x = cvt_pk_bf16(h[0], h[1]); w2.y = cvt_pk_bf16(h[2], h[3]); *(u32x2*)(g.Hout + (size_t)(NREAL + fr) * D + c) = w2;
            }
        }
    }
    g.stride = GRID; g.vb = opaque_bid(); g.kind = EPI_GLU; g.K = D; g.perm = 1; g.gather = 0; g.moe = 0; g.nM = NREAL / BM; g.nN = 2048 / BM; g.nwg = g.nM * g.nN; g.A = (const char*)Zb; g.Bt = (const char*)W;
    g.tstepA = g.tstepB = (size_t)BM * D * 2; g.wstride = 0;
}

__device__ __forceinline__ void epi_oproj(const GemmDesc& g, const f32x4 (&acc)[2][2][4][2], const Unit& u, int wr, int wc, int fr, int fq) {
#pragma unroll
    for (int ai = 0; ai < 2; ++ai)
#pragma unroll
        for (int bj = 0; bj < 2; ++bj) {
            const int row0 = u.pm * BM + ai * HALF + wr * 64 + fr, c0 = u.pn * BM + bj * HALF + wc * 32 + 8 * fq; const size_t off0 = (size_t)row0 * D + c0;
            const f32x4 b0 = *(const f32x4*)(g.bias + c0), b1 = *(const f32x4*)(g.bias + c0 + 4);
            float h[4][8];
#pragma unroll
            for (int m = 0; m < 4; ++m) load_res8(g, off0 + (size_t)m * 16 * D, h[m]);
#pragma unroll
            for (int m = 0; m < 4; ++m) {
#pragma unroll
                for (int n = 0; n < 2; ++n) { const f32x4 v = acc[ai][bj][m][n] + (n ? b1 : b0); h[m][4 * n + 0] += v[0]; h[m][4 * n + 1] += v[1]; h[m][4 * n + 2] += v[2]; h[m][4 * n + 3] += v[3]; }
                store_h8(g.Hout, off0 + (size_t)m * 16 * D, h[m]);
            }
            asm volatile("" ::: "memory");
        }
}
__device__ __forceinline__ void phase_oproj(CArgs& a, int j, bool dry, LAS unsigned char* lds, GemmDesc& g) {
    const bf16_t* Ob = (const bf16_t*)(a.ws + WS_Z); const bf16_t* W = (const bf16_t*)(a.ws + WS_WO) + (size_t)j * 1024 * 1024;
    const float* bo = a.in[21] + (size_t)j * D;
    g.res32 = nullptr; g.res16 = (const bf16_t*)(a.ws + WS_H); g.Hout = (bf16_t*)(a.ws + (dry ? WS_DUMH : WS_H)); g.bias = bo;
    if (opaque_bid() < 32) {
        const int lane = opaque_tid() & 63, fr = lane & 15, fq = lane >> 4, task = opaque_bid(), c0 = 32 * task;
        const bf16_t* const br[2] = {W + (size_t)c0 * D, W + (size_t)(c0 + 16) * D};
        f32x4 o[2];
        if (meta_block<2>(lds, Ob + (size_t)NREAL * D, br, D, o)) {
#pragma unroll
            for (int n = 0; n < 2; ++n) {
                const int c = c0 + 16 * n + 4 * fq; const size_t off = (size_t)(NREAL + fr) * D + c;
                const u32x2 w = *(const u32x2*)(g.res16 + off); f32x4 h = (f32x4){bf16_lo(w.x), bf16_hi(w.x), bf16_lo(w.y), bf16_hi(w.y)};
                h += o[n] + *(const f32x4*)(bo + c);
                u32x2 w2; w2.x = cvt_pk_bf16(h[0], h[1]); w2.y = cvt_pk_bf16(h[2], h[3]); *(u32x2*)(g.Hout + off) = w2;
            }
        }
    }
    g.stride = GRID; g.vb = opaque_bid(); g.kind = EPI_OPROJ; g.K = D; g.perm = 1; g.gather = 0; g.moe = 0; g.nM = NREAL / BM; g.nN = 1024 / BM; g.nwg = g.nM * g.nN; g.A = (const char*)Ob; g.Bt = (const char*)W;
    g.tstepA = g.tstepB = (size_t)BM * D * 2; g.wstride = 0;
}

__device__ __forceinline__ void kvq_store8(const GemmDesc& g, int row, int c, const float (&vin)[8]) {
    const float rs = g.rstd[row]; float v[8];
#pragma unroll
    for (int e = 0; e < 8; ++e) v[e] = vin[e] * rs;
    if (c < 256) {
        const float* b = g.bias + c; u32x4 w; w.x = cvt_pk_bf16(v[0] + b[0], v[1] + b[1]); w.y = cvt_pk_bf16(v[2] + b[2], v[3] + b[3]); w.z = cvt_pk_bf16(v[4] + b[4], v[5] + b[5]); w.w = cvt_pk_bf16(v[6] + b[6], v[7] + b[7]);
        *(u32x4*)(g.O1 + (size_t)row * 256 + c) = w;
    } else if (c < 512) {
        const int cv = c - 256; const float* b = g.bias + c;
        bf16_t* vp = g.O2 + (row < NREAL ? ((size_t)(row >> 11) * 256 + cv) * SEQ + (row & (SEQ - 1)) : VT_META + (size_t)cv * 16 + (row - NREAL));
        const size_t st = row < NREAL ? SEQ : 16;
#pragma unroll
        for (int i = 0; i < 4; ++i) { const unsigned p = cvt_pk_bf16(v[2 * i] + b[2 * i], v[2 * i + 1] + b[2 * i + 1]); vp[(size_t)(2 * i) * st] = (bf16_t)(p & 0xffffu); vp[(size_t)(2 * i + 1) * st] = (bf16_t)(p >> 16); }
    } else {
        const int cq = c - 512; const float* b = g.bias2 + cq;
        u32x4 w; w.x = cvt_pk_bf16((v[0] + b[0]) * 0.125f, (v[1] + b[1]) * 0.125f); w.y = cvt_pk_bf16((v[2] + b[2]) * 0.125f, (v[3] + b[3]) * 0.125f);
        w.z = cvt_pk_bf16((v[4] + b[4]) * 0.125f, (v[5] + b[5]) * 0.125f); w.w = cvt_pk_bf16((v[6] + b[6]) * 0.125f, (v[7] + b[7]) * 0.125f);
        *(u32x4*)(g.O3 + (size_t)row * D + cq) = w;
    }
}
__device__ __forceinline__ void epi_kvq(const GemmDesc& g, const f32x4 (&acc)[2][2][4][2], const Unit& u, int wr, int wc, int fr, int fq) {
    { const int cbase = g.cbase;
#pragma unroll
        for (int ai = 0; ai < 2; ++ai)
#pragma unroll
            for (int m = 0; m < 4; ++m) {
                const int row = u.pm * BM + ai * HALF + wr * 64 + m * 16 + fr;
#pragma unroll
                for (int bj = 0; bj < 2; ++bj) {
                    const int c = cbase + u.pn * BM + bj * HALF + wc * 32 + 8 * fq;
                    const f32x4 v0 = acc[ai][bj][m][0], v1 = acc[ai][bj][m][1];
                    const float v[8] = {v0[0], v0[1], v0[2], v0[3], v1[0], v1[1], v1[2], v1[3]};
                    kvq_store8(g, row, c, v);
                    asm volatile("" ::: "memory");
                }
            }
    }
}
__device__ __forceinline__ void phase_kvq_q(CArgs& a, int jq, LAS unsigned char* lds, GemmDesc& g) {
    const bf16_t* Ub = (const bf16_t*)(a.ws + WS_H); const bf16_t* W = jq == 0 ? (const bf16_t*)(a.ws + WS_WKVQ) : (const bf16_t*)(a.ws + WS_WQ1);
    const int N = jq == 0 ? 1536 : 1024, cbase = jq == 0 ? 0 : 512;
    const int mb0 = jq == 0 ? 160 : 0;
    if (opaque_bid() >= mb0 && opaque_bid() < mb0 + N / 32) {
        const int lane = opaque_tid() & 63, fr = lane & 15, fq = lane >> 4, task = opaque_bid() - mb0;
        const bf16_t* const br[2] = {W + (size_t)(32 * task) * D, W + (size_t)(32 * task + 16) * D};
        f32x4 o[2];
        if (meta_block<2>(lds, Ub + (size_t)NREAL * D, br, D, o)) {
#pragma unroll
            for (int h = 0; h < 2; ++h) {
                const int c = cbase + 32 * task + 16 * h + 4 * fq; const int row = NREAL + fr; const f32x4 v = o[h] * ((const float*)(a.ws + WS_RSTD))[row];
                if (c < 256) { const float* b = a.in[16] + c; u32x2 w; w.x = cvt_pk_bf16(v[0] + b[0], v[1] + b[1]); w.y = cvt_pk_bf16(v[2] + b[2], v[3] + b[3]); *(u32x2*)((bf16_t*)(a.ws + WS_K) + (size_t)row * 256 + c) = w; }
                else if (c < 512) { const int cv = c - 256; const float* b = a.in[16] + c; bf16_t* vp = (bf16_t*)(a.ws + WS_VT) + VT_META + (size_t)cv * 16 + fr;
                    const unsigned p0 = cvt_pk_bf16(v[0] + b[0], v[1] + b[1]), p1 = cvt_pk_bf16(v[2] + b[2], v[3] + b[3]);
                    vp[0] = (bf16_t)(p0 & 0xffffu); vp[16] = (bf16_t)(p0 >> 16); vp[32] = (bf16_t)(p1 & 0xffffu); vp[48] = (bf16_t)(p1 >> 16); }
                else { const int cq = c - 512; const float* b = a.in[18] + (size_t)jq * D + cq; u32x2 w; w.x = cvt_pk_bf16((v[0] + b[0]) * 0.125f, (v[1] + b[1]) * 0.125f); w.y = cvt_pk_bf16((v[2] + b[2]) * 0.125f, (v[3] + b[3]) * 0.125f);
                    *(u32x2*)((bf16_t*)(a.ws + WS_Q) + (size_t)row * D + cq) = w; }
            }
        }
    }
    g.stride = GRID; g.vb = opaque_bid(); g.kind = EPI_KVQ; g.K = D; g.perm = 1; g.gather = 0; g.moe = 0; g.nM = NREAL / BM; g.nN = N / BM; g.nwg = g.nM * g.nN; g.A = (const char*)Ub; g.Bt = (const char*)W;
    g.tstepA = g.tstepB = (size_t)BM * D * 2; g.wstride = 0; g.rstd = (const float*)(a.ws + WS_RSTD); g.bias = a.in[16]; g.bias2 = a.in[18] + (size_t)jq * D; g.O1 = (bf16_t*)(a.ws + WS_K); g.O2 = (bf16_t*)(a.ws + WS_VT); g.O3 = (bf16_t*)(a.ws + WS_Q);
    g.jq = jq; g.cbase = cbase;
}

__device__ __forceinline__ void moe_scan(const int* cnt, LAS int* sh) {
    if (opaque_tid() == 0) { int acc = 0; for (int e = 0; e < 32; ++e) { sh[e] = acc; acc += (cnt[e] + 255) >> 8; } sh[32] = acc; }
    __syncthreads();
}
__device__ __forceinline__ void epi_moe1(const GemmDesc& g, LAS unsigned char* lds, const f32x4 (&acc)[2][2][4][2], const Unit& u, int wr, int wc, int fr, int fq) {
    { bf16_t* HB = g.O1;
        const LAS int* tabt = (const LAS int*)(lds + LDS_TABT) + u.slot * 256;
#pragma unroll
        for (int ai = 0; ai < 2; ++ai)
#pragma unroll
            for (int m = 0; m < 4; ++m) {
                const int rl = ai * HALF + wr * 64 + m * 16 + fr;
                if (tabt[rl] >= 0) {
                    const float rs = ((const LAS float*)(lds + LDS_TABG))[u.slot * 256 + rl] * (g.f8 ? 1.0f / F8_WSCALE : 1.0f);
                    const f32x4 g0 = acc[ai][0][m][0] * rs, g1 = acc[ai][0][m][1] * rs, u0 = acc[ai][1][m][0] * rs, u1 = acc[ai][1][m][1] * rs;
                    if (g.f8) {
                        u32x2 w8; w8.x = pk4_fp8(g0[0] * sigmoidf_(g0[0]) * u0[0] * F8_HSCALE, g0[1] * sigmoidf_(g0[1]) * u0[1] * F8_HSCALE, g0[2] * sigmoidf_(g0[2]) * u0[2] * F8_HSCALE, g0[3] * sigmoidf_(g0[3]) * u0[3] * F8_HSCALE);
                        w8.y = pk4_fp8(g1[0] * sigmoidf_(g1[0]) * u1[0] * F8_HSCALE, g1[1] * sigmoidf_(g1[1]) * u1[1] * F8_HSCALE, g1[2] * sigmoidf_(g1[2]) * u1[2] * F8_HSCALE, g1[3] * sigmoidf_(g1[3]) * u1[3] * F8_HSCALE);
                        *(u32x2*)((unsigned char*)HB + ((size_t)u.pm * 256 + rl) * DEXP + u.pn * 128 + wc * 32 + 8 * fq) = w8;
                    } else {
                    u32x4 w; w.x = cvt_pk_bf16(g0[0] * sigmoidf_(g0[0]) * u0[0], g0[1] * sigmoidf_(g0[1]) * u0[1]); w.y = cvt_pk_bf16(g0[2] * sigmoidf_(g0[2]) * u0[2], g0[3] * sigmoidf_(g0[3]) * u0[3]);
                    w.z = cvt_pk_bf16(g1[0] * sigmoidf_(g1[0]) * u1[0], g1[1] * sigmoidf_(g1[1]) * u1[1]); w.w = cvt_pk_bf16(g1[2] * sigmoidf_(g1[2]) * u1[2], g1[3] * sigmoidf_(g1[3]) * u1[3]);
                    *(u32x4*)(HB + ((size_t)u.pm * 256 + rl) * DEXP + u.pn * 128 + wc * 32 + 8 * fq) = w;
                    }
                }
                asm volatile("" ::: "memory");
            }
    }
}
__device__ __forceinline__ bool moe_roles(GemmDesc& g) {
    const int rounds = (g.nwg + GRID - 1) / GRID, per = rounds ? (g.nwg + rounds - 1) / rounds : GRID, ngw = ((per + 7) / 8) * 8 < GRID ? ((per + 7) / 8) * 8 : GRID;
    const int bid = opaque_bid(), rnk = bid >> 3;
    g.stride = ngw; g.vb = rnk * 8 + (bid & 7);
    if (rnk * 8 >= ngw) { g.nwg = 0; return true; }
    return false;
}
__device__ __forceinline__ bool phase_moe1(CArgs& a, int layer, LAS unsigned char* lds, GemmDesc& g) {
    LAS int* sh = (LAS int*)(lds + LDS_SH);
    const int* cnt = (const int*)(a.ws + WS_CTL) + CW_CNT + layer * 32;
    moe_scan(cnt, sh);
    g.kind = EPI_MOE1; g.K = D; g.perm = 1; g.gather = 1; g.moe = 1; g.npn = 4; g.nwg = sh[32] * 4; g.nM = 0; g.nN = 4;
    g.A = (const char*)(a.ws + WS_H); g.Bt = (const char*)(a.ws + WS_W1) + (size_t)layer * 32 * 1024 * 1024 * 2; g.wstride = (size_t)1024 * 1024 * 2;
    g.tstepA = 0; g.tstepB = (size_t)256 * 1024 * 2; g.cnt = cnt; g.LTOK = (const int*)(a.ws + WS_LTOK); g.LGATE = (const float*)(a.ws + WS_LRS); g.O1 = (bf16_t*)(a.ws + WS_HB);
    if (layer == F8_LAYER) { g.f8 = 1; g.K = D / 2; g.A = (const char*)(a.ws + WS_Z); g.arow = D; g.wstride = (size_t)1024 * 1024; g.tstepB = (size_t)256 * 1024; }
    return moe_roles(g);
}
__device__ __forceinline__ void epi_moe2(const GemmDesc& g, LAS unsigned char* lds, const f32x4 (&acc)[2][2][4][2], const Unit& u, int wr, int wc, int fr, int fq) {
    { bf16_t* YB = g.O1;
        const LAS int* tabt = (const LAS int*)(lds + LDS_TABT) + u.slot * 256; const LAS float* tabg = (const LAS float*)(lds + LDS_TABG) + u.slot * 256;
#pragma unroll
        for (int ai = 0; ai < 2; ++ai)
#pragma unroll
            for (int m = 0; m < 4; ++m) {
                const int rl = ai * HALF + wr * 64 + m * 16 + fr; const int rt = tabt[rl];
                if (rt >= 0) {
                    const float gs = tabg[rl] * (g.f8 ? 1.0f / (F8_WSCALE * F8_HSCALE) : 1.0f);
                    bf16_t* yp = YB + ((size_t)(rt & 0x3fffffff) * 2 + (rt >> 30)) * D + u.pn * BM + wc * 32 + 8 * fq;
#pragma unroll
                    for (int bj = 0; bj < 2; ++bj) { const f32x4 v0 = acc[ai][bj][m][0] * gs, v1 = acc[ai][bj][m][1] * gs;
                        u32x4 w; w.x = cvt_pk_bf16(v0[0], v0[1]); w.y = cvt_pk_bf16(v0[2], v0[3]); w.z = cvt_pk_bf16(v1[0], v1[1]); w.w = cvt_pk_bf16(v1[2], v1[3]);
                        *(u32x4*)(yp + bj * HALF) = w; }
                }
                asm volatile("" ::: "memory");
            }
    }
}
__device__ __forceinline__ bool phase_moe2(CArgs& a, int layer, LAS unsigned char* lds, GemmDesc& g) {
    LAS int* sh = (LAS int*)(lds + LDS_SH);
    const int* cnt = (const int*)(a.ws + WS_CTL) + CW_CNT + layer * 32;
    moe_scan(cnt, sh);
    g.kind = EPI_MOE2; g.K = DEXP; g.perm = 1; g.gather = 0; g.moe = 1; g.npn = 4; g.nwg = sh[32] * 4; g.nM = 0; g.nN = 4;
    g.A = (const char*)(a.ws + WS_HB); g.Bt = (const char*)(a.ws + WS_W2) + (size_t)layer * 32 * 1024 * 512 * 2; g.wstride = (size_t)1024 * 512 * 2;
    g.tstepA = (size_t)256 * DEXP * 2; g.tstepB = (size_t)256 * DEXP * 2; g.cnt = cnt; g.LTOK = (const int*)(a.ws + WS_LTOK); g.LGATE = (const float*)(a.ws + WS_LGATE); g.O1 = (bf16_t*)(a.ws + WS_YB);
    if (layer == F8_LAYER) { g.f8 = 1; g.K = DEXP / 2; g.wstride = (size_t)1024 * 512; g.tstepA = (size_t)256 * DEXP; g.tstepB = (size_t)256 * DEXP; }
    return moe_roles(g);
}
__device__ __forceinline__ void gemm_epilogue(const GemmDesc& g, LAS unsigned char* lds, const f32x4 (&acc)[2][2][4][2], const Unit& u, int wr, int wc, int fr, int fq) {
    asm volatile("" : "+v"(fr), "+v"(fq));
    switch (g.kind) {
        case EPI_GLU: epi_glu(g, acc, u, wr, wc, fr, fq); break;
        case EPI_OPROJ: epi_oproj(g, acc, u, wr, wc, fr, fq); break;
        case EPI_KVQ: epi_kvq(g, acc, u, wr, wc, fr, fq); break;
        case EPI_MOE1: epi_moe1(g, lds, acc, u, wr, wc, fr, fq); break;
        default: epi_moe2(g, lds, acc, u, wr, wc, fr, fq); break;
    }
}

constexpr int AT_NSLOT = 272, AT_VROW = 552, AT_KBYTES = AT_NSLOT * 128, AT_VBYTES = 64 * AT_VROW;
__device__ __forceinline__ void attn_tile(LAS unsigned char* Ks, LAS unsigned char* Vs, const bf16x8 qf0, const bf16x8 qf1, bf16_t* op, float sink, int nblk  , int kb0  , int srel  , int smin  , int lmeta  , int tc, int q4) {
    f32x4 s[10];
#pragma unroll
    for (int bi = 0; bi < 10; ++bi) {
        s[bi] = (f32x4){-1e30f, -1e30f, -1e30f, -1e30f};
        if (bi < nblk) {
            const int sl = (bi == 0 ? 0 : 16 + 16 * (kb0 + bi - 1)) + tc;
            const LAS unsigned char* kr = Ks + sl * 128;
            const bf16x8 kf0 = *(const LAS bf16x8*)(kr + ((q4 ^ (sl & 7)) << 4)), kf1 = *(const LAS bf16x8*)(kr + (((4 + q4) ^ (sl & 7)) << 4));
            f32x4 acc = {0.f, 0.f, 0.f, 0.f};
            acc = mfma16(kf0, qf0, acc); acc = mfma16(kf1, qf1, acc);
#pragma unroll
            for (int r = 0; r < 4; ++r) {
                const int kk = 16 * (kb0 + bi - 1) + 4 * q4 + r;
                const bool ok = bi == 0 ? (4 * q4 + r <= lmeta) : (kk >= smin && kk <= srel && kk >= srel - 127);
                s[bi][r] = ok ? acc[r] : -1e30f;
            }
        }
    }
    float m = sink;
#pragma unroll
    for (int bi = 0; bi < 10; ++bi) m = fmaxf(m, fmaxf(fmaxf(s[bi][0], s[bi][1]), fmaxf(s[bi][2], s[bi][3])));
    m = xor32_max(xor16_max(m));
    float den = 0.f;
    unsigned pk[10][2];
#pragma unroll
    for (int bi = 0; bi < 10; ++bi) {
        float p[4];
#pragma unroll
        for (int r = 0; r < 4; ++r) { p[r] = s[bi][r] > -1e29f ? fast_exp(s[bi][r] - m) : 0.f; den += p[r]; }
        pk[bi][0] = cvt_pk_bf16(p[0], p[1]); pk[bi][1] = cvt_pk_bf16(p[2], p[3]);
    }
    den = quad_sum(den);
    den += fast_exp(sink - m);
    const float inv = 1.0f / den;
    f32x4 o[4];
#pragma unroll
    for (int dt = 0; dt < 4; ++dt) o[dt] = (f32x4){0.f, 0.f, 0.f, 0.f};
#pragma unroll
    for (int pp = 0; pp < 5; ++pp) {
        if (2 * pp < nblk) {
            const int biA = 2 * pp, biB = 2 * pp + 1;
            const int slA = biA == 0 ? 0 : 16 + 16 * (kb0 + biA - 1), slB = biB < nblk ? 16 + 16 * (kb0 + biB - 1) : slA;
            u32x4 pw; pw.x = pk[biA][0]; pw.y = pk[biA][1]; pw.z = pk[biB][0]; pw.w = pk[biB][1];
            const bf16x8 pf = as_bf16x8(pw);
#pragma unroll
            for (int dt = 0; dt < 4; ++dt) {
                const LAS unsigned char* vr = Vs + (16 * dt + tc) * AT_VROW + 8 * q4;
                const u32x2 va = *(const LAS u32x2*)(vr + slA * 2), vb = *(const LAS u32x2*)(vr + slB * 2);
                u32x4 vw; vw.x = va.x; vw.y = va.y; vw.z = vb.x; vw.w = vb.y;
                o[dt] = mfma16(as_bf16x8(vw), pf, o[dt]);
            }
        }
    }
#pragma unroll
    for (int dt = 0; dt < 4; ++dt) { u32x2 w; w.x = cvt_pk_bf16(o[dt][0] * inv, o[dt][1] * inv); w.y = cvt_pk_bf16(o[dt][2] * inv, o[dt][3] * inv); *(u32x2*)(op + 16 * dt) = w; }
}
constexpr int AT_BUF = 70656;
struct AtUnit { int meta, kvh, b, s0; };
__device__ __forceinline__ AtUnit at_decode(int unit) { AtUnit u; u.meta = unit >= NB * 4 * 16; const int qt = u.meta ? 0 : (unit & 15); u.kvh = u.meta ? unit - NB * 4 * 16 : ((unit >> 4) & 3); u.b = u.meta ? 0 : (unit >> 6); u.s0 = qt * 128; return u; }
__device__ __forceinline__ void at_fill_load(const bf16_t* K, const bf16_t* VT, const AtUnit& u, int tid, u32x4 (&kr)[5], u32x4 (&vr)[5]) {
#pragma unroll
    for (int i = 0; i < 5; ++i) {
        const int idx = tid + i * NTHREADS;
        { const int sl = idx >> 3, c = idx & 7, sw = u.s0 - 128 + (sl - 16);
          u32x4 v = {0u, 0u, 0u, 0u};
          if (idx < AT_NSLOT * 8) { if (sl < 16) v = *(const u32x4*)(K + (size_t)(NREAL + sl) * 256 + u.kvh * 64 + c * 8); else if (!u.meta && sw >= 0) v = *(const u32x4*)(K + (size_t)(u.b * SEQ + sw) * 256 + u.kvh * 64 + c * 8); }
          kr[i] = v; }
        { const int d = idx / 34, ch = idx - d * 34, sw = u.s0 - 128 + 8 * (ch - 2);
          u32x4 v = {0u, 0u, 0u, 0u};
          if (idx < 64 * 34) { if (ch < 2) v = *(const u32x4*)(VT + VT_META + (size_t)(u.kvh * 64 + d) * 16 + ch * 8); else if (!u.meta && sw >= 0) v = *(const u32x4*)(VT + ((size_t)(u.b * 4 + u.kvh) * 64 + d) * SEQ + sw); }
          vr[i] = v; }
    }
}
__device__ __forceinline__ void at_fill_store(LAS unsigned char* Ks, LAS unsigned char* Vs, int tid, const u32x4 (&kr)[5], const u32x4 (&vr)[5]) {
#pragma unroll
    for (int i = 0; i < 5; ++i) {
        const int idx = tid + i * NTHREADS;
        if (idx < AT_NSLOT * 8) { const int sl = idx >> 3, c = idx & 7; *(LAS u32x4*)(Ks + sl * 128 + ((c ^ (sl & 7)) << 4)) = kr[i]; }
        if (idx < 64 * 34) { const int d = idx / 34, ch = idx - d * 34; *(LAS u32x2*)(Vs + d * AT_VROW + ch * 16) = (u32x2){vr[i].x, vr[i].y}; *(LAS u32x2*)(Vs + d * AT_VROW + ch * 16 + 8) = (u32x2){vr[i].z, vr[i].w}; }
    }
}
__device__ __forceinline__ void phase_attn(CArgs& a, int j, LAS unsigned char* lds) {
    const int tid = opaque_tid(), lane = tid & 63, wid = tid >> 6, tc = lane & 15, q4 = lane >> 4;
    const bf16_t* Q = (const bf16_t*)(a.ws + WS_Q); const bf16_t* K = (const bf16_t*)(a.ws + WS_K); const bf16_t* VT = (const bf16_t*)(a.ws + WS_VT);
    bf16_t* O = (bf16_t*)(a.ws + WS_Z);
    constexpr int NU = NB * 4 * 16 + 4;
    int unit = opaque_bid(), cur = 0;
    if (unit >= NU) return;
    u32x4 kr[5], vr[5];
    { const AtUnit u0 = at_decode(unit); at_fill_load(K, VT, u0, tid, kr, vr); at_fill_store(lds, lds + AT_KBYTES, tid, kr, vr); }
    __syncthreads();
#pragma unroll 1
    for (;;) {
        const AtUnit u = at_decode(unit);
        const int nextu = unit + GRID; const bool more = nextu < NU;
        LAS unsigned char* Ks = lds + cur * AT_BUF; LAS unsigned char* Vs = Ks + AT_KBYTES;
        const int g = wid & 3, hq = u.kvh * 4 + g, jt0 = wid >> 2;
        const float sink = a.in[19][j * 16 + hq];
        if (more) { const AtUnit un = at_decode(nextu); at_fill_load(K, VT, un, tid, kr, vr); }
        if (u.meta) {
            if (wid < 4) { const size_t row = (size_t)(NREAL + tc); const bf16_t* qp = Q + row * D + hq * 64 + 8 * q4;
                attn_tile(Ks, Vs, as_bf16x8(*(const u32x4*)qp), as_bf16x8(*(const u32x4*)(qp + 32)), O + row * D + hq * 64 + 4 * q4, sink, 1, 0, 0, 0, tc, tc, q4); }
        } else {
            const bf16_t* qbase = Q + ((size_t)(u.b * SEQ + u.s0 + tc)) * D + hq * 64 + 8 * q4;
            u32x4 qn0 = *(const u32x4*)(qbase + (size_t)(16 * jt0) * D), qn1 = *(const u32x4*)(qbase + (size_t)(16 * jt0) * D + 32);
#pragma unroll 1
            for (int t = 0; t < 4; ++t) {
                const int jt = jt0 + 2 * t; const size_t row = (size_t)(u.b * SEQ + u.s0 + 16 * jt + tc);
                const bf16x8 q0 = as_bf16x8(qn0), q1 = as_bf16x8(qn1);
                if (t < 3) { qn0 = *(const u32x4*)(qbase + (size_t)(16 * (jt + 2)) * D); qn1 = *(const u32x4*)(qbase + (size_t)(16 * (jt + 2)) * D + 32); }
                attn_tile(Ks, Vs, q0, q1, O + row * D + hq * 64 + 4 * q4, sink, 10, jt, 128 + 16 * jt + tc, 128 - u.s0, 64, tc, q4);
            }
        }
        if (!more) break;
        at_fill_store(lds + (cur ^ 1) * AT_BUF, lds + (cur ^ 1) * AT_BUF + AT_KBYTES, tid, kr, vr);
        __syncthreads();
        cur ^= 1; unit = nextu;
    }
}

__device__ __forceinline__ void phase_route(CArgs& a, int layer, bool dry, LAS unsigned char* lds) {
    LAS unsigned char* Wf = lds; LAS float* LG = (LAS float*)(lds + 98304); LAS int* hist = (LAS int*)(lds + 98304 + 24576); LAS int* hbase = hist + 32;
    const int tid = opaque_tid(), lane = tid & 63, wid = tid >> 6, tc = lane & 15, q4 = lane >> 4;
    for (int idx = tid; idx < 3 * 32 * 64; idx += NTHREADS) *(LAS u32x4*)(Wf + (size_t)idx * 16) = *(const u32x4*)(a.ws + WS_RW + (size_t)layer * 98304 + (size_t)idx * 16);
    if (tid < 32) hist[tid] = 0;
    __syncthreads();
    const bf16_t* H = (const bf16_t*)(a.ws + WS_H); float* LRS = (float*)(a.ws + (dry ? WS_DUMLG : WS_LRS));
    int* cnt = (int*)(a.ws + WS_CTL) + (dry ? CW_DUMCNT : CW_CNT) + layer * 32; int* LTOK = (int*)(a.ws + (dry ? WS_DUMLT : WS_LTOK)); float* LGATE = (float*)(a.ws + (dry ? WS_DUMLG : WS_LGATE));
    const int tile = wid * GRID + opaque_bid();
    const bool active = tile < RT / 16;
    int e1, e2, r1, r2; float g1, g2, rstd_keep;
    asm volatile("" : "=v"(e1), "=v"(e2), "=v"(r1), "=v"(r2), "=v"(g1), "=v"(g2), "=v"(rstd_keep));
    if (active) {
        const int row = tile * 16 + tc;
        float ss = 0.f;
        f32x4 acc[3];
#pragma unroll
        for (int rt = 0; rt < 3; ++rt) acc[rt] = (f32x4){0.f, 0.f, 0.f, 0.f};
        const bf16_t* hp = H + (size_t)row * D + 8 * q4;
#pragma unroll 1
        for (int kb = 0; kb < 4; ++kb) {
            u32x4 hv[8];
#pragma unroll
            for (int k8 = 0; k8 < 8; ++k8) hv[k8] = *(const u32x4*)(hp + 32 * (kb * 8 + k8));
#pragma unroll
            for (int k8 = 0; k8 < 8; ++k8) {
                const int ks = kb * 8 + k8; const bf16x8 xf = as_bf16x8(hv[k8]);
                { const u32x4 hw = hv[k8]; const float e0 = bf16_lo(hw.x), e1 = bf16_hi(hw.x), e2 = bf16_lo(hw.y), e3 = bf16_hi(hw.y), e4 = bf16_lo(hw.z), e5 = bf16_hi(hw.z), e6 = bf16_lo(hw.w), e7 = bf16_hi(hw.w);
                  ss += (e0 * e0 + e1 * e1) + (e2 * e2 + e3 * e3) + (e4 * e4 + e5 * e5) + (e6 * e6 + e7 * e7);
                  if (layer == F8_LAYER) { u32x2 w8; w8.x = pk4_fp8(e0, e1, e2, e3); w8.y = pk4_fp8(e4, e5, e6, e7); *(u32x2*)(a.ws + WS_Z + (size_t)row * D + 32 * ks + 8 * q4) = w8; } }
#pragma unroll
                for (int rt = 0; rt < 3; ++rt) acc[rt] = mfma16(*(LAS bf16x8*)(Wf + ((size_t)(rt * 32 + ks) * 64 + lane) * 16), xf, acc[rt]);
            }
        }
        ss = quad_sum(ss);
        const float rstd = 1.0f / sqrtf(ss * (1.0f / D) + RMS_EPS); rstd_keep = rstd;
        LAS float* lg = LG + wid * 16 * 48;
#pragma unroll
        for (int rt = 0; rt < 3; ++rt)
#pragma unroll
            for (int r = 0; r < 4; ++r) lg[tc * 48 + 16 * rt + 4 * q4 + r] = acc[rt][r] * rstd;
        asm volatile("s_waitcnt lgkmcnt(0)" ::: "memory");
        if (lane < 16) {
            const LAS float* mylg = lg + lane * 48;
            float gl[4]; int gi = 0; float gm;
#pragma unroll
            for (int i = 0; i < 4; ++i) gl[i] = mylg[i] + a.in[23][layer * NGRP + i];
            gm = gl[0];
#pragma unroll
            for (int i = 1; i < 4; ++i) if (gl[i] > gm) { gm = gl[i]; gi = i; }
            float gz = 0.f;
#pragma unroll
            for (int i = 0; i < 4; ++i) gz += expf(gl[i] - gm);
            const float pg = 1.0f / gz;
            float el[8];
#pragma unroll
            for (int i = 0; i < 8; ++i) el[i] = mylg[4 + gi * 8 + i] + a.in[25][layer * NEXP + gi * 8 + i];
            int i1 = 0; float m1 = el[0];
#pragma unroll
            for (int i = 1; i < 8; ++i) if (el[i] > m1) { m1 = el[i]; i1 = i; }
            int i2 = -1; float m2 = -3.0e38f;
#pragma unroll
            for (int i = 0; i < 8; ++i) if (i != i1 && el[i] > m2) { m2 = el[i]; i2 = i; }
            float one = 1.0f; asm volatile("" : "+v"(one));
            const float x2 = expf(m2 - m1), q1 = one / (one + x2);
            g1 = pg * q1; g2 = pg * x2 * q1; e1 = gi * 8 + i1; e2 = gi * 8 + i2;
            r1 = __hip_atomic_fetch_add(&hist[e1], 1, __ATOMIC_RELAXED, __HIP_MEMORY_SCOPE_WORKGROUP); r2 = __hip_atomic_fetch_add(&hist[e2], 1, __ATOMIC_RELAXED, __HIP_MEMORY_SCOPE_WORKGROUP);
        }
    }
    __syncthreads();
    if (tid < 32) hbase[tid] = hist[tid] ? atomicAdd(&cnt[tid], hist[tid]) : 0;
    __syncthreads();
    if (active && lane < 16) {
        const int row = tile * 16 + lane;
        const int s1 = hbase[e1] + r1, s2 = hbase[e2] + r2;
        LTOK[(size_t)e1 * RT + s1] = row; LGATE[(size_t)e1 * RT + s1] = g1; LRS[(size_t)e1 * RT + s1] = rstd_keep;
        LTOK[(size_t)e2 * RT + s2] = row | (1 << 30); LGATE[(size_t)e2 * RT + s2] = g2; LRS[(size_t)e2 * RT + s2] = rstd_keep;
    }
}

__device__ __forceinline__ void comb_load(const bf16_t* H, const bf16_t* YB, int row, int lane, u32x4 (&w)[2][3]) {
    const bf16_t* hp = H + (size_t)row * D; const bf16_t* y0 = YB + (size_t)row * 2 * D;
#pragma unroll
    for (int j = 0; j < 2; ++j) { const int c = 8 * lane + 512 * j; w[j][0] = *(const u32x4*)(hp + c); w[j][1] = *(const u32x4*)(y0 + c); w[j][2] = *(const u32x4*)(y0 + D + c); }
}
__device__ __forceinline__ void comb_finish(CArgs& a, int layer, bool dry, int row, int lane, const u32x4 (&w)[2][3]) {
    float v[2][8]; float ssq = 0.f;
#pragma unroll
    for (int j = 0; j < 2; ++j) {
        const u32x4 hw = w[j][0], p0 = w[j][1], p1 = w[j][2];
        v[j][0] = bf16_lo(hw.x) + bf16_lo(p0.x) + bf16_lo(p1.x); v[j][1] = bf16_hi(hw.x) + bf16_hi(p0.x) + bf16_hi(p1.x);
        v[j][2] = bf16_lo(hw.y) + bf16_lo(p0.y) + bf16_lo(p1.y); v[j][3] = bf16_hi(hw.y) + bf16_hi(p0.y) + bf16_hi(p1.y);
        v[j][4] = bf16_lo(hw.z) + bf16_lo(p0.z) + bf16_lo(p1.z); v[j][5] = bf16_hi(hw.z) + bf16_hi(p0.z) + bf16_hi(p1.z);
        v[j][6] = bf16_lo(hw.w) + bf16_lo(p0.w) + bf16_lo(p1.w); v[j][7] = bf16_hi(hw.w) + bf16_hi(p0.w) + bf16_hi(p1.w);
#pragma unroll
        for (int e = 0; e < 8; ++e) ssq += v[j][e] * v[j][e];
    }
    ssq = wave_sum(ssq);
    const float rstd = 1.0f / sqrtf(ssq * (1.0f / D) + RMS_EPS);
    if (layer < 3) {
        bf16_t* ho = (bf16_t*)(a.ws + (dry ? WS_DUMH : WS_H)) + (size_t)row * D;
#pragma unroll
        for (int j = 0; j < 2; ++j) {
            const int c = 8 * lane + 512 * j;
            u32x4 o; o.x = cvt_pk_bf16(v[j][0], v[j][1]); o.y = cvt_pk_bf16(v[j][2], v[j][3]); o.z = cvt_pk_bf16(v[j][4], v[j][5]); o.w = cvt_pk_bf16(v[j][6], v[j][7]);
            *(u32x4*)(ho + c) = o;
        }
        if (lane == 0) ((float*)(a.ws + (dry ? WS_DUMSSQ : WS_RSTD)))[row] = rstd;
    } else if (row < NREAL) {
        float* op = a.out + (size_t)row * D;
#pragma unroll
        for (int j = 0; j < 2; ++j) { const int c = 8 * lane + 512 * j; const f32x4 g0 = *(const f32x4*)(a.in[5] + c), g1 = *(const f32x4*)(a.in[5] + c + 4);
            f32x4 o0, o1; o0[0] = v[j][0] * rstd * g0[0]; o0[1] = v[j][1] * rstd * g0[1]; o0[2] = v[j][2] * rstd * g0[2]; o0[3] = v[j][3] * rstd * g0[3];
            o1[0] = v[j][4] * rstd * g1[0]; o1[1] = v[j][5] * rstd * g1[1]; o1[2] = v[j][6] * rstd * g1[2]; o1[3] = v[j][7] * rstd * g1[3];
            *(f32x4*)(op + c) = o0; *(f32x4*)(op + c + 4) = o1; }
    }
}
__device__ __forceinline__ void phase_combine(CArgs& a, int layer, bool dry) {
    const int lane = opaque_tid() & 63, gw = opaque_bid() * 8 + (opaque_tid() >> 6);
    const bf16_t* H = (const bf16_t*)(a.ws + WS_H); const bf16_t* YB = (const bf16_t*)(a.ws + WS_YB);
    for (int row = gw; row < RT; row += GRID * 16) {
        const int row1 = row + GRID * 8; const bool two = row1 < RT;
        u32x4 wa[2][3], wb[2][3];
        comb_load(H, YB, row, lane, wa);
        if (two) comb_load(H, YB, row1, lane, wb);
        comb_finish(a, layer, dry, row, lane, wa);
        if (two) comb_finish(a, layer, dry, row1, lane, wb);
    }
}

enum { PH_PREP = 0, PH_S5, PH_GLU, PH_ROUTE, PH_G1, PH_G2, PH_COMB, PH_KVQ, PH_ATT, PH_OPROJ, PH_QG };
constexpr int NPH = 27;
__constant__ int c_prog[NPH][2] = {
    {PH_PREP, 0},
    {PH_S5, 0}, {PH_GLU, 0}, {PH_ROUTE, 0}, {PH_G1, 0}, {PH_G2, 0}, {PH_COMB, 0},
    {PH_S5, 1}, {PH_GLU, 1}, {PH_ROUTE, 1}, {PH_G1, 1}, {PH_G2, 1}, {PH_COMB, 1},
    {PH_KVQ, 2}, {PH_ATT, 2}, {PH_OPROJ, 2}, {PH_ROUTE, 2}, {PH_G1, 2}, {PH_G2, 2}, {PH_COMB, 2},
    {PH_QG, 3}, {PH_ATT, 3}, {PH_OPROJ, 3}, {PH_ROUTE, 3}, {PH_G1, 3}, {PH_G2, 3}, {PH_COMB, 3},
};

__global__ void __launch_bounds__(NTHREADS) yoco_fwd(Args a) {
    extern __shared__ __attribute__((aligned(16))) unsigned char smem_raw[];
    LAS unsigned char* lds = (LAS unsigned char*)smem_raw;
    volatile LAS unsigned* const st = (volatile LAS unsigned*)(lds + LDS_BYTES - 64);
    if (threadIdx.x < 16) st[threadIdx.x] = 0u;
    __syncthreads();
    if (a.ph_hi - a.ph_lo > 1) xcd_barrier_post((unsigned*)(a.ws + WS_CTL) + CW_BAR);
    CArgs* const kp = (CArgs*)__builtin_amdgcn_kernarg_segment_ptr();
#if defined(PROBE_TMASK)
    unsigned long long t_acc = 0ull;
#endif
    for (int ph = a.ph_lo; ph < a.ph_hi; ++ph) {
        const int type = c_prog[ph][0], layer = c_prog[ph][1];
#if defined(PROBE_TMASK)
        const unsigned long long t_ph0 = __builtin_amdgcn_s_memrealtime();
#endif
        const int reps = type == a.rep_type ? a.rep_n : 0;
        for (int r = 0; r <= reps; ++r) {
            const bool dry = r > 0;
            CArgs* lp = kp; asm volatile("" : "+s"(lp));
            CArgs& la = *lp;
            GemmDesc g; g.f8 = 0; g.arow = D * 2; bool is_gemm = true; int conv_budget = 0, conv_limit = 0;
            BgConv bg{lp, st};
            switch (type) {
                case PH_GLU: phase_glu(la, layer, dry, lds, g); break;
                case PH_G1: if (phase_moe1(la, layer, lds, g)) { conv_budget = 18; conv_limit = (layer + 2) * 32 * NWT_E; } break;
                case PH_G2: if (phase_moe2(la, layer, lds, g)) { conv_budget = 12; conv_limit = (layer + 3) * 32 * NWT_E; } break;
                case PH_KVQ: case PH_QG: phase_kvq_q(la, type == PH_QG ? 1 : 0, lds, g); break;
                case PH_OPROJ: phase_oproj(la, layer - 2, dry, lds, g); break;
                default: is_gemm = false; break;
            }
            g.skip_epi = 0;
#if defined(PROBE_SKIPEPI)
            if (dry) g.skip_epi = 1;
#endif
            if (is_gemm) { if (g.f8) gemm_run<true>(lds, g); else gemm_run<false>(lds, g); if (conv_budget) bg.run_until(conv_limit < NWT_MOE ? conv_limit : NWT_MOE, conv_budget); }
            else switch (type) {
                case PH_PREP: phase_prep(la, lds); break;
                case PH_S5: phase_s5(la, layer, lds); break;
                case PH_ROUTE: phase_route(la, layer, dry, lds); break;
                case PH_COMB: phase_combine(la, layer, dry); break;
                default: phase_attn(la, layer - 2, lds); break;
            }
            if (type == PH_ROUTE && !dry) { bg.run_until((layer + 1) * 32 * NWT_E, 1 << 20); bg.drain_others((layer + 1) * 32 * NWT_E); }
            if (r < reps || ph + 1 < a.ph_hi) { if (a.ph_hi - a.ph_lo > 1) xcd_barrier((unsigned*)(la.ws + WS_CTL) + CW_BAR, st, bg); }
        }
#if defined(PROBE_TMASK)
        if ((PROBE_TMASK >> type) & 1) t_acc += __builtin_amdgcn_s_memrealtime() - t_ph0;
#endif
        if (a.rep_type == 100 && ph + 1 < a.ph_hi) for (int r = 0; r < a.rep_n; ++r) { BgConv bg{kp, st}; xcd_barrier((unsigned*)(a.ws + WS_CTL) + CW_BAR, st, bg); }
    }
#if defined(PROBE_TMASK)
    if (blockIdx.x == 0) { const unsigned long long t0 = __builtin_amdgcn_s_memrealtime(); while (__builtin_amdgcn_s_memrealtime() - t0 < 8ull * t_acc) __builtin_amdgcn_s_sleep(32); }
#endif
}

extern "C" void kernel_launch(void* const* d_in, const int* in_sizes, int n_in, void* d_out, int out_size, void* d_ws, size_t ws_size, hipStream_t stream) {
    static int ready = 0;
    if (ready == 0) {
        if (n_in != 29 || ws_size < WS_END) { fprintf(stderr, "kernel_launch: expected 29 inputs and >= %zu bytes of workspace (got %d, %zu)\n", (size_t)WS_END, n_in, ws_size); ready = -1; return; }
        if (hipFuncSetAttribute((const void*)yoco_fwd, hipFuncAttributeMaxDynamicSharedMemorySize, LDS_BYTES) != hipSuccess) { fprintf(stderr, "kernel_launch: hipFuncSetAttribute failed\n"); ready = -1; return; }
        ready = 1;
    }
    if (ready < 0) return;
    (void)hipMemsetAsync((char*)d_ws + WS_CTL, 0, CTL_BYTES, stream);
    Args a{};
    for (int i = 0; i < 29; ++i) a.in[i] = (const float*)d_in[i];
    a.out = (float*)d_out; a.ws = (unsigned char*)d_ws;
#if defined(PROBE_TYPE)
    a.rep_type = PROBE_TYPE; a.rep_n = PROBE_N;
#else
    a.rep_type = -1; a.rep_n = 0;
#endif
#if MK_N_LAUNCHES == 1
    a.ph_lo = 0; a.ph_hi = NPH;
    hipLaunchKernelGGL(yoco_fwd, dim3(GRID), dim3(NTHREADS), LDS_BYTES, stream, a);
#else
    for (int ph = 0; ph < NPH; ++ph) { a.ph_lo = ph; a.ph_hi = ph + 1; hipLaunchKernelGGL(yoco_fwd, dim3(GRID), dim3(NTHREADS), LDS_BYTES, stream, a); }
#endif
}
```

```cpp
#include <hip/hip_runtime.h>
#include <cstdio>
#include <cstdint>

#ifndef MK_N_LAUNCHES
#define MK_N_LAUNCHES 1
#endif

#define LAS __attribute__((address_space(3)))
typedef unsigned short bf16_t;
typedef short bf16x8 __attribute__((ext_vector_type(8)));
typedef float f32x4 __attribute__((ext_vector_type(4)));
typedef float f32x2 __attribute__((ext_vector_type(2)));
typedef unsigned u32x4 __attribute__((ext_vector_type(4)));
typedef unsigned u32x2 __attribute__((ext_vector_type(2)));

constexpr int D = 1024, NB = 8, SEQ = 2048, NMETA = 16, LT = SEQ + NMETA  ;
constexpr int NREAL = NB * SEQ  , RT = NREAL + NMETA  , RPAD = 16640;
constexpr int NEXP = 32, DEXP = 512, NGRP = 4, EPG = 8;
constexpr int NTHREADS = 512, GRID = 256;
constexpr int LDS_BYTES = 155648;
constexpr float RMS_EPS = 1e-6f;
__device__ __forceinline__ int row_of(int b, int pos) { return pos < NMETA ? NREAL + pos : b * SEQ + (pos - NMETA); }

constexpr size_t al256(size_t x) { return (x + 255) & ~(size_t)255; }
constexpr size_t WS_CTL = 0;
constexpr size_t CTL_BYTES = 32768;
constexpr int CW_BAR = 0;
constexpr int CW_CNT = 4096;
constexpr int CW_DUMCNT = 4096 + 256;
constexpr int CW_BGC = 6144;
constexpr size_t WS_H = WS_CTL + CTL_BYTES;
constexpr size_t WS_RSTD = WS_H + al256((size_t)RPAD * D * 2);
constexpr size_t WS_LRS = WS_RSTD + al256((size_t)RPAD * 4);
constexpr size_t WS_U = WS_LRS + al256((size_t)NEXP * RT * 4);
constexpr size_t WS_Z = WS_U + 256;
constexpr size_t WS_XN = WS_Z + al256((size_t)RPAD * D * 2);
constexpr size_t WS_Q = WS_XN + 256;
constexpr size_t WS_K = WS_Q + al256((size_t)RPAD * D * 2);
constexpr size_t WS_VT = WS_K + al256((size_t)RPAD * 256 * 2);
constexpr size_t VT_META = (size_t)NB * 256 * SEQ;
constexpr size_t WS_LTOK = WS_VT + al256((size_t)RPAD * 256 * 2);
constexpr size_t WS_LGATE = WS_LTOK + al256((size_t)NEXP * RT * 4);
constexpr int HB_ROWS = 2 * RT + NEXP * 256;
constexpr size_t WS_HB = WS_LGATE + al256((size_t)NEXP * RT * 4);
constexpr size_t WS_YB = WS_HB + al256((size_t)HB_ROWS * DEXP * 2);
constexpr size_t TBL_K = 0, TBL_M = 16 * 1024, TBL_N = TBL_M + 64 * 1024, TBL_A16 = TBL_N + 64 * 1024, TBL_STRIDE = TBL_A16 + 512;
constexpr size_t WS_TBL = WS_YB + al256((size_t)RT * 2 * D * 2);
constexpr size_t WS_WGLU = WS_TBL + al256((size_t)2 * 64 * TBL_STRIDE);
constexpr size_t WS_WKVQ = WS_WGLU + (size_t)2 * 2048 * 1024 * 2;
constexpr size_t WS_WQ1 = WS_WKVQ + (size_t)1536 * 1024 * 2;
constexpr size_t WS_WO = WS_WQ1 + (size_t)1024 * 1024 * 2;
constexpr size_t WS_W1 = WS_WO + (size_t)2 * 1024 * 1024 * 2;
constexpr size_t WS_W2 = WS_W1 + (size_t)4 * 32 * 1024 * 1024 * 2;
constexpr size_t WS_RW = WS_W2 + (size_t)4 * 32 * 1024 * 512 * 2;
constexpr size_t WS_DUMH = WS_RW + (size_t)4 * 98304;
constexpr size_t WS_DUMSSQ = WS_DUMH + al256((size_t)RT * D * 4);
constexpr size_t WS_DUMLT = WS_DUMSSQ + al256((size_t)RT * 32 * 4);
constexpr size_t WS_DUMLG = WS_DUMLT + al256((size_t)NEXP * RT * 4);
#if defined(PROBE_TYPE)
constexpr size_t WS_END = WS_DUMLG + al256((size_t)NEXP * RT * 4);
#else
constexpr size_t WS_END = WS_DUMH;
#endif

struct Args {
    const float* in[29];
    float* out;
    unsigned char* ws;
    int ph_lo, ph_hi;
    int rep_type, rep_n;
};
typedef const __attribute__((address_space(4))) Args CArgs;

__device__ __forceinline__ unsigned cvt_pk_bf16(float lo, float hi) { unsigned r; asm volatile("v_cvt_pk_bf16_f32 %0, %1, %2" : "=v"(r) : "v"(lo), "v"(hi)); return r; }
__device__ __forceinline__ float bf16_lo(unsigned w) { return __uint_as_float(w << 16); }
__device__ __forceinline__ float bf16_hi(unsigned w) { return __uint_as_float(w & 0xffff0000u); }
__device__ __forceinline__ float fast_rcp(float x) { return __builtin_amdgcn_rcpf(x); }
__device__ __forceinline__ float fast_exp(float x) { return __builtin_amdgcn_exp2f(x * 1.4426950408889634f); }
__device__ __forceinline__ float sigmoidf_(float x) { return fast_rcp(1.0f + fast_exp(-x)); }
__device__ __forceinline__ float gelu_tanh(float x) { const float v = 0.7978845608028654f * (x + 0.044715f * x * x * x); return x * sigmoidf_(2.0f * v); }
__device__ __forceinline__ bf16x8 as_bf16x8(u32x4 v) { return __builtin_bit_cast(bf16x8, v); }
__device__ __forceinline__ f32x4 mfma16(bf16x8 a, bf16x8 b, f32x4 c) { return __builtin_amdgcn_mfma_f32_16x16x32_bf16(a, b, c, 0, 0, 0); }
constexpr int F8_LAYER = 2;
constexpr float F8_WSCALE = 64.f, F8_HSCALE = 8.f;
typedef int i32x8 __attribute__((ext_vector_type(8)));
typedef int i32x4 __attribute__((ext_vector_type(4)));
__device__ __forceinline__ unsigned pk4_fp8(float a, float b, float c, float d) {
    int w = 0;
    w = __builtin_amdgcn_cvt_pk_fp8_f32(__builtin_amdgcn_fmed3f(a, -448.f, 448.f), __builtin_amdgcn_fmed3f(b, -448.f, 448.f), w, false);
    w = __builtin_amdgcn_cvt_pk_fp8_f32(__builtin_amdgcn_fmed3f(c, -448.f, 448.f), __builtin_amdgcn_fmed3f(d, -448.f, 448.f), w, true);
    return (unsigned)w;
}
__device__ __forceinline__ f32x4 mfma8(bf16x8 a0, bf16x8 a1, bf16x8 b0, bf16x8 b1, f32x4 c) {
    const i32x8 a = __builtin_shufflevector(__builtin_bit_cast(i32x4, a0), __builtin_bit_cast(i32x4, a1), 0, 1, 2, 3, 4, 5, 6, 7);
    const i32x8 b = __builtin_shufflevector(__builtin_bit_cast(i32x4, b0), __builtin_bit_cast(i32x4, b1), 0, 1, 2, 3, 4, 5, 6, 7);
    return __builtin_amdgcn_mfma_scale_f32_16x16x128_f8f6f4(a, b, c, 0, 0, 0, 0, 0, 0);
}
__device__ __forceinline__ float xor32_sum(float v) { auto r = __builtin_amdgcn_permlane32_swap(__float_as_uint(v), __float_as_uint(v), false, false); return __uint_as_float(r[0]) + __uint_as_float(r[1]); }
__device__ __forceinline__ float xor16_sum(float v) { auto r = __builtin_amdgcn_permlane16_swap(__float_as_uint(v), __float_as_uint(v), false, false); return __uint_as_float(r[0]) + __uint_as_float(r[1]); }
__device__ __forceinline__ float xor32_max(float v) { auto r = __builtin_amdgcn_permlane32_swap(__float_as_uint(v), __float_as_uint(v), false, false); return fmaxf(__uint_as_float(r[0]), __uint_as_float(r[1])); }
__device__ __forceinline__ float xor16_max(float v) { auto r = __builtin_amdgcn_permlane16_swap(__float_as_uint(v), __float_as_uint(v), false, false); return fmaxf(__uint_as_float(r[0]), __uint_as_float(r[1])); }
__device__ __forceinline__ float quad_sum(float v) { return xor32_sum(xor16_sum(v)); }
template <int X> __device__ __forceinline__ float swz_xor(float v) { return __uint_as_float((unsigned)__builtin_amdgcn_ds_swizzle((int)__float_as_uint(v), (X << 10) | 0x1f)); }
__device__ __forceinline__ float wave_sum(float v) {
    v += swz_xor<1>(v); v += swz_xor<2>(v); v += swz_xor<4>(v); v += swz_xor<8>(v);
    return quad_sum(v);
}
__device__ __forceinline__ int opaque_bid() { int b = blockIdx.x; asm volatile("" : "+s"(b)); return b; }
__device__ __forceinline__ int opaque_tid() { int t = threadIdx.x; asm volatile("" : "+v"(t)); return t; }

#define XB_TMO      128
#define XB_XCNT(j)  (256  + 64 * (j))
#define XB_XSUB(j)  (1280 + 64 * (j))
#define XB_XGEN(j)  (2304 + 64 * (j))
#define XB_TOP      3328
#define XB_TOPGEN   3392
#define XCD_BAR_WORDS 3456
#define XB_SPIN_CAP (1u << 22)
__device__ __forceinline__ unsigned xb_ld(unsigned* p)              { return __hip_atomic_load(p, __ATOMIC_RELAXED, __HIP_MEMORY_SCOPE_AGENT); }
__device__ __forceinline__ unsigned xb_add(unsigned* p, unsigned v) { return __hip_atomic_fetch_add(p, v, __ATOMIC_RELAXED, __HIP_MEMORY_SCOPE_AGENT); }
__device__ __forceinline__ unsigned xb_xcc_id() { return (unsigned)__builtin_amdgcn_s_getreg((3 << 11) | 20) & 0xFu; }
#define XB_SPIN(cond, bar) do { unsigned _sp = 0; while (cond) { __builtin_amdgcn_s_sleep(1); \
    if ((++_sp & 255u) == 0u) { if (xb_ld(&(bar)[XB_TMO])) break; if (_sp > XB_SPIN_CAP) { atomicAdd(&(bar)[XB_TMO], 1u); break; } } } } while (0)
__device__ __forceinline__ void xcd_barrier_post(unsigned* bar) { if (threadIdx.x == 0) (void)xb_add(&bar[XB_XCNT(xb_xcc_id())], 1u); }
__device__ __forceinline__ void xcd_barrier_complete(unsigned* bar, unsigned x, unsigned& nloc, unsigned& nx) {
    const unsigned G = gridDim.x;
    unsigned sum, cnt, mine, sp = 0u;
    for (;;) {
        sum = 0u; cnt = 0u; mine = 0u;
#pragma unroll
        for (unsigned j = 0; j < 16; ++j) { const unsigned c = xb_ld(&bar[XB_XCNT(j)]); sum += c; cnt += (c > 0u) ? 1u : 0u; mine = (j == x) ? c : mine; }
        if (sum == G) break;
        __builtin_amdgcn_s_sleep(1);
        if ((++sp & 255u) == 0u) { if (xb_ld(&bar[XB_TMO])) break; if (sp > XB_SPIN_CAP) { atomicAdd(&bar[XB_TMO], 1u); break; } }
    }
    nloc = mine > 0u ? mine : 1u; nx = cnt > 0u ? cnt : 1u;
}
template <class BG>
__device__ __forceinline__ void xcd_barrier(unsigned* bar_, volatile LAS unsigned* st, BG& bg) {
    asm volatile("s_waitcnt vmcnt(0)" ::: "memory");
    __syncthreads();
    const unsigned flag0 = st[2];
    if (threadIdx.x >= 64) {
        while (st[2] == flag0) bg.step();
        bg.park();
    } else if (threadIdx.x == 0) {
        unsigned* bar = bar_; asm volatile("" : "+v"(bar));
        const unsigned bx = xb_xcc_id();
        __builtin_amdgcn_s_waitcnt(0);
        unsigned nloc = st[0], nx = st[1];
        if (nloc == 0u) { xcd_barrier_complete(bar, bx, nloc, nx); st[0] = nloc; st[1] = nx; }
        const unsigned old = xb_add(&bar[XB_XSUB(bx)], 1u);
        const unsigned gen = old / nloc;
        if (old + 1u == (gen + 1u) * nloc) {
            __builtin_amdgcn_fence(__ATOMIC_RELEASE, "agent");
            asm volatile("s_waitcnt vmcnt(0)" ::: "memory");
            const unsigned og = xb_add(&bar[XB_TOP], 1u);
            const unsigned tg = og / nx;
            if (og + 1u == (tg + 1u) * nx) xb_add(&bar[XB_TOPGEN], 1u);
            else XB_SPIN(xb_ld(&bar[XB_TOPGEN]) == tg, bar);
            __builtin_amdgcn_fence(__ATOMIC_ACQUIRE, "agent");
            xb_add(&bar[XB_XGEN(bx)], 1u);
            asm volatile("s_waitcnt vmcnt(0)" ::: "memory");
        } else {
            XB_SPIN(xb_ld(&bar[XB_XGEN(bx)]) == gen, bar);
            __builtin_amdgcn_fence(__ATOMIC_ACQUIRE, "agent");
            asm volatile("s_waitcnt vmcnt(0)" ::: "memory");
        }
        st[2] = flag0 + 1u;
    }
    __syncthreads();
}
constexpr int BM = 256, BK = 64, HALF = 128, HTB = HALF * BK * 2, STAGE_BYTES = 8 * HTB, NXCD = 8, WGM = 8;
constexpr int LDS_TABO = STAGE_BYTES;
constexpr int LDS_TABT = LDS_TABO + 3072;
constexpr int LDS_TABG = LDS_TABT + 3072;
constexpr int LDS_SH = LDS_TABG + 3072;
__host__ __device__ __forceinline__ int lds_byte(int r, int c) { const int st = (r >> 4) * 2 + (c >> 5), rr = r & 15, cc = c & 31, ob = rr * 64 + cc * 2; return st * 1024 + (ob ^ (((ob >> 9) & 1) << 5)); }
__host__ __device__ __forceinline__ void stage_rc(int b, int& R, int& C) { const int st = b / 1024, sb = b % 1024, swz = sb ^ (((sb >> 9) & 1) << 5); R = (st >> 1) * 16 + swz / 64; C = (st & 1) * 32 + (swz % 64) / 2; }
__host__ __device__ __forceinline__ int perm32(int rho) { const int n = rho >> 4, i = rho & 15; return 8 * (i >> 2) + 4 * n + (i & 3); }
struct Unit { int pm, pn, e, slot; };
__device__ __forceinline__ int xcd_chunk(int wgid, int nwg) { const int q = nwg / NXCD, r = nwg % NXCD, xcd = wgid % NXCD, off = wgid / NXCD; return (xcd < r ? xcd * (q + 1) : r * (q + 1) + (xcd - r) * q) + off; }

enum { EPI_GLU = 0, EPI_OPROJ, EPI_KVQ, EPI_MOE1, EPI_MOE2 };
struct GemmDesc {
    int kind, K, perm, gather, moe, skip_epi, stride, vb;
    int f8, arow;
    int nM, nN, nwg, npn; const char* A; const char* Bt; size_t tstepA, tstepB, wstride; const int* cnt; const int* LTOK; const float* LGATE;
    const float* res32; const bf16_t* res16; bf16_t* Hout; const float* bias; const float* bias2; const float* rstd; bf16_t* O1; bf16_t* O2; bf16_t* O3; int jq, cbase;
};
__device__ __forceinline__ bool order_next(const GemmDesc& g, LAS unsigned char* lds, int i, Unit& u) {
    const int L = i * g.stride + g.vb; if (L >= g.nwg) return false;
    const int wgid = xcd_chunk(L, g.nwg);
    if (g.moe) {
        const LAS int* sh = (const LAS int*)(lds + LDS_SH);
        int e = 0;
        for (int q = 1; q < 32; ++q) if (wgid >= g.npn * sh[q]) e = q;
        const int nmt = sh[e + 1] - sh[e], local = wgid - g.npn * sh[e];
        u.pn = local / nmt; u.pm = sh[e] + (local - u.pn * nmt); u.e = e; u.slot = i % 3;
    } else {
        const int nig = WGM * g.nN, gid = wgid / nig, fm = gid * WGM, gsz = (g.nM - fm) < WGM ? (g.nM - fm) : WGM;
        u.pm = fm + ((wgid % nig) % gsz); u.pn = (wgid % nig) / gsz; u.e = 0; u.slot = 0;
    }
    return true;
}
__device__ __forceinline__ const char* order_a(const GemmDesc& g, const Unit& u) { return g.gather ? g.A : g.A + (size_t)u.pm * g.tstepA; }
__device__ __forceinline__ const char* order_b(const GemmDesc& g, const Unit& u) { return g.Bt + (size_t)u.e * g.wstride + (size_t)u.pn * g.tstepB; }
__device__ __forceinline__ void order_fill(const GemmDesc& g, LAS unsigned char* lds, const Unit& u) {
    const int t = opaque_tid();
    if (t < 256) {
        const LAS int* sh = (const LAS int*)(lds + LDS_SH);
        const int ne = g.cnt[u.e], idx = (u.pm - sh[u.e]) * 256 + t, ci = idx < ne ? idx : ne - 1;
        const int v = g.LTOK[(size_t)u.e * RT + ci];
        ((LAS unsigned*)(lds + LDS_TABO))[u.slot * 256 + t] = (unsigned)(v & 0x3fffffff) * (unsigned)g.arow;
        ((LAS int*)(lds + LDS_TABT))[u.slot * 256 + t] = idx < ne ? v : -1;
        ((LAS float*)(lds + LDS_TABG))[u.slot * 256 + t] = g.LGATE[(size_t)u.e * RT + ci];
    }
}
__device__ __forceinline__ void gemm_epilogue(const GemmDesc& g, LAS unsigned char* lds, const f32x4 (&acc)[2][2][4][2], const Unit& u, int wr, int wc, int fr, int fq);

template <bool F8>
__device__ __forceinline__ void gemm_run(LAS unsigned char* lds, const GemmDesc& g) {
    const int tid = opaque_tid(), wid = __builtin_amdgcn_readfirstlane(tid >> 6), lane = tid & 63, wr = wid >> 2, wc = wid & 3, fr = lane & 15, fq = lane >> 4;
    const int K = g.K, nt = K / BK;
    unsigned voffB[2], go[2][2];
    const size_t kstep = (size_t)(BK * 2);
    const size_t hstep = (size_t)HALF * K * 2;
#pragma unroll
    for (int i = 0; i < 2; ++i) { int R, C; stage_rc(tid * 16 + i * 8192, R, C); const int Rb = g.perm ? ((R & ~31) + perm32(R & 31)) : R;
        voffB[i] = (unsigned)(Rb * K + C) * 2u; go[0][i] = (unsigned)(R * K + C) * 2u; go[1][i] = go[0][i] + (unsigned)hstep; }
    const unsigned ldsw = (unsigned)wid * 1024u;
    const int aoff = lds_byte(wr * 64 + fr, fq * 8), boff = lds_byte(wc * 32 + fr, fq * 8);
#define PG8_SA(b, h) (((b) * 2 + (h)) * HTB)
#define PG8_SB(b, h) ((4 + (b) * 2 + (h)) * HTB)
#define PG8_GLDS(src, dstoff) __builtin_amdgcn_global_load_lds((const unsigned*)(src), (LAS unsigned*)(lds + (dstoff)), 16, 0, 0)
#define PG8_STAGE_B(bufoff, gbase) do { _Pragma("unroll") for (int _i = 0; _i < 2; ++_i) PG8_GLDS((const char*)(gbase) + voffB[_i], (bufoff) + ldsw + _i * 8192); } while (0)
#define PG8_GO_LOAD(tsel) do { if (g.gather) { _Pragma("unroll") for (int _i = 0; _i < 2; ++_i) { int _R, _C; stage_rc(tid * 16 + _i * 8192, _R, _C); _Pragma("unroll") for (int _h = 0; _h < 2; ++_h) \
            go[_h][_i] = *(const LAS unsigned*)(lds + LDS_TABO + (tsel) * 1024 + _h * 512 + _R * 4) + (unsigned)(_C * 2); } } } while (0)
#define PG8_STAGE_A(bufoff, gbase, kt, h) do { _Pragma("unroll") for (int _i = 0; _i < 2; ++_i) PG8_GLDS((const char*)(gbase) + (size_t)(kt) * kstep + go[h][_i], (bufoff) + ldsw + _i * 8192); } while (0)
#define PG8_STAGE_AN(bufoff, gbase, tsel, kt, h) do { if (last && g.gather) { _Pragma("unroll") for (int _i = 0; _i < 2; ++_i) { int _R, _C; stage_rc(tid * 16 + _i * 8192, _R, _C); \
            const unsigned _o = *(const LAS unsigned*)(lds + LDS_TABO + (tsel) * 1024 + (h) * 512 + _R * 4) + (unsigned)(_C * 2); PG8_GLDS((const char*)(gbase) + (size_t)(kt) * kstep + _o, (bufoff) + ldsw + _i * 8192); } \
        } else PG8_STAGE_A(bufoff, gbase, kt, h); } while (0)
#define PG8_LDA(dst, b, h) do { _Pragma("unroll") for (int m = 0; m < 4; ++m) _Pragma("unroll") for (int k = 0; k < 2; ++k) dst[m][k] = *(const LAS bf16x8*)(lds + PG8_SA(b, h) + aoff + m * 2048 + k * 1024); } while (0)
#define PG8_LDB(dst, b, h) do { _Pragma("unroll") for (int n = 0; n < 2; ++n) _Pragma("unroll") for (int k = 0; k < 2; ++k) dst[n][k] = *(const LAS bf16x8*)(lds + PG8_SB(b, h) + boff + n * 2048 + k * 1024); } while (0)
#define PG8_MMA(ai, bj, At, Bt) do { __builtin_amdgcn_s_setprio(1); if constexpr (F8) { _Pragma("unroll") for (int m = 0; m < 4; ++m) _Pragma("unroll") for (int n = 0; n < 2; ++n) \
        acc[ai][bj][m][n] = mfma8(Bt[n][0], Bt[n][1], At[m][0], At[m][1], acc[ai][bj][m][n]); } else { _Pragma("unroll") for (int m = 0; m < 4; ++m) _Pragma("unroll") for (int n = 0; n < 2; ++n) _Pragma("unroll") for (int k = 0; k < 2; ++k) \
        acc[ai][bj][m][n] = __builtin_amdgcn_mfma_f32_16x16x32_bf16(Bt[n][k], At[m][k], acc[ai][bj][m][n], 0, 0, 0); } __builtin_amdgcn_s_setprio(0); } while (0)
#define PG8_WAIT_V(n) asm volatile("s_waitcnt vmcnt(" #n ")" ::: "memory")
#define PG8_WAIT_L(n) asm volatile("s_waitcnt lgkmcnt(" #n ")" ::: "memory")
#define PG8_BAR __builtin_amdgcn_s_barrier()
#define PG8_SCHED __builtin_amdgcn_sched_barrier(0)
    Unit cur, nxt; int ui = 0;
    if (!order_next(g, lds, 0, cur)) return;
    f32x4 acc[2][2][4][2];
#pragma unroll
    for (int a = 0; a < 2; ++a)
#pragma unroll
        for (int b = 0; b < 2; ++b)
#pragma unroll
            for (int m = 0; m < 4; ++m)
#pragma unroll
                for (int n = 0; n < 2; ++n) acc[a][b][m][n] = (f32x4){0.f, 0.f, 0.f, 0.f};
    bf16x8 At[4][2], B0[2][2], B1[2][2];
    if (g.moe) { order_fill(g, lds, cur); __syncthreads(); PG8_GO_LOAD(cur.slot); }
    const char* cA = order_a(g, cur); const char* cB = order_b(g, cur); int cT = cur.slot;
    PG8_STAGE_B(PG8_SB(0, 0), cB); PG8_STAGE_B(PG8_SB(0, 1), cB + hstep); PG8_STAGE_A(PG8_SA(0, 0), cA, 0, 0); PG8_STAGE_A(PG8_SA(0, 1), cA, 0, 1);
    if (wr == 1) PG8_BAR;
    PG8_WAIT_V(2); PG8_BAR;
    PG8_STAGE_B(PG8_SB(1, 0), cB + kstep); PG8_STAGE_A(PG8_SA(1, 0), cA, 1, 0); PG8_STAGE_B(PG8_SB(1, 1), cB + hstep + kstep);
    PG8_WAIT_V(6); PG8_BAR;
    for (;;) {
        const bool has_next = order_next(g, lds, ui + 1, nxt);
        if (g.moe && has_next) order_fill(g, lds, nxt);
        const char* nA = has_next ? order_a(g, nxt) : cA; const char* nB = has_next ? order_b(g, nxt) : cB; const int nT = has_next ? nxt.slot : cT;
        for (int t = 0; t < nt; t += 2) {
            const bool last = (t == nt - 2);
            const char* a2b = last ? nA : cA; const int a2k = last ? 0 : t + 2, a3k = a2k + 1;
            const char* b2 = last ? nB : cB + (size_t)(t + 2) * kstep; const char* b3 = b2 + kstep;
            PG8_LDB(B0, 0, 0); PG8_LDB(B1, 0, 1); PG8_SCHED; PG8_LDA(At, 0, 0); PG8_STAGE_A(PG8_SA(1, 1), cA, t + 1, 1);
            PG8_WAIT_V(8); PG8_WAIT_L(0); PG8_BAR; PG8_MMA(0, 0, At, B0); PG8_MMA(0, 1, At, B1); PG8_BAR; PG8_SCHED;
            PG8_LDA(At, 0, 1); PG8_STAGE_B(PG8_SB(0, 0), b2); PG8_STAGE_B(PG8_SB(0, 1), b2 + hstep); PG8_STAGE_AN(PG8_SA(0, 0), a2b, nT, a2k, 0);
            PG8_WAIT_V(8); PG8_WAIT_L(0); PG8_BAR; PG8_MMA(1, 0, At, B0); PG8_MMA(1, 1, At, B1); PG8_BAR; PG8_SCHED;
            PG8_LDB(B0, 1, 0); PG8_LDB(B1, 1, 1); PG8_SCHED; PG8_LDA(At, 1, 0); PG8_STAGE_AN(PG8_SA(0, 1), a2b, nT, a2k, 1);
            PG8_WAIT_V(8); PG8_WAIT_L(0); PG8_BAR; PG8_MMA(0, 0, At, B0); PG8_MMA(0, 1, At, B1); PG8_BAR; PG8_SCHED;
            PG8_LDA(At, 1, 1); PG8_STAGE_B(PG8_SB(1, 0), b3); PG8_STAGE_B(PG8_SB(1, 1), b3 + hstep); PG8_STAGE_AN(PG8_SA(1, 0), a2b, nT, a3k, 0);
            PG8_WAIT_V(8); PG8_WAIT_L(0); PG8_BAR; PG8_MMA(1, 0, At, B0); PG8_MMA(1, 1, At, B1); PG8_BAR; PG8_SCHED;
        }
        if (wr == 0) PG8_BAR;
        if (!g.skip_epi) gemm_epilogue(g, lds, acc, cur, wr, wc, fr, fq);
        if (!has_next) break;
#pragma unroll
        for (int a = 0; a < 2; ++a)
#pragma unroll
            for (int b = 0; b < 2; ++b)
#pragma unroll
                for (int m = 0; m < 4; ++m)
#pragma unroll
                    for (int n = 0; n < 2; ++n) acc[a][b][m][n] = (f32x4){0.f, 0.f, 0.f, 0.f};
        cur = nxt; cA = nA; cB = nB; cT = nT; ++ui;
        PG8_GO_LOAD(cT);
        if (wr == 1) PG8_BAR;
    }
    PG8_WAIT_V(0);
    PG8_BAR;
#undef PG8_SA
#undef PG8_SB
#undef PG8_GLDS
#undef PG8_STAGE_A
#undef PG8_STAGE_AN
#undef PG8_GO_LOAD
#undef PG8_STAGE_B
#undef PG8_LDA
#undef PG8_LDB
#undef PG8_MMA
#undef PG8_WAIT_V
#undef PG8_WAIT_L
#undef PG8_BAR
#undef PG8_SCHED
}
__device__ __forceinline__ f32x4 meta_dot(const bf16_t* Am, const bf16_t* Brow0, int K, int fr, int fq) {
    f32x4 acc = {0.f, 0.f, 0.f, 0.f};
    const bf16_t* ap = Am + (size_t)fr * K + 8 * fq; const bf16_t* bp = Brow0 + (size_t)fr * K + 8 * fq;
#pragma unroll 4
    for (int ks = 0; ks < K / 32; ++ks) acc = mfma16(as_bf16x8(*(const u32x4*)(bp + 32 * ks)), as_bf16x8(*(const u32x4*)(ap + 32 * ks)), acc);
    return acc;
}

struct ConvDesc { const float* src; const float* gain; bf16_t* dst; int ld, K, mode, kblk, nblk; };
constexpr int NWT_E = 768;
constexpr int NWT_MOE = 4 * 32 * NWT_E, NWT_DENSE = 2 * 1024 + 256 + 2 * 512 + 2 * 512;
__device__ __forceinline__ ConvDesc conv_decode(CArgs& a, int ti) {
    ConvDesc d;
    if (ti < NWT_MOE) {
        const int le = ti / NWT_E, r = ti % NWT_E, which = r >> 8, tt = r & 255, layer = le >> 5;
        if (which < 2) { d.src = a.in[26 + which] + (size_t)le * D * DEXP; d.ld = DEXP; d.K = D; d.gain = a.in[3] + (size_t)layer * D; d.dst = (bf16_t*)(a.ws + WS_W1) + (size_t)le * 1024 * 1024; d.mode = 1 + which; d.nblk = tt & 15; d.kblk = tt >> 4; }
        else { d.src = a.in[28] + (size_t)le * DEXP * D; d.ld = D; d.K = DEXP; d.gain = nullptr; d.dst = (bf16_t*)(a.ws + WS_W2) + (size_t)le * 1024 * 512; d.mode = 0; d.nblk = tt & 31; d.kblk = tt >> 5; }
    } else {
        int r = ti - NWT_MOE;
        if (r < 2048) { const int layer = r >> 10, tt = r & 1023, nb = tt & 63, half = nb >> 5;
            d.src = a.in[14] + (size_t)layer * D * 2 * D + half * D; d.ld = 2 * D; d.K = D; d.gain = nullptr; d.dst = (bf16_t*)(a.ws + WS_WGLU) + (size_t)layer * 2048 * 1024; d.mode = 1 + half; d.nblk = nb & 31; d.kblk = tt >> 6; }
        else if ((r -= 2048) < 256) { d.src = a.in[15]; d.ld = 512; d.K = D; d.gain = a.in[4]; d.dst = (bf16_t*)(a.ws + WS_WKVQ); d.mode = 0; d.nblk = r & 15; d.kblk = r >> 4; }
        else if ((r -= 256) < 1024) { const int j = r >> 9, tt = r & 511;
            d.src = a.in[17] + (size_t)j * D * D; d.ld = D; d.K = D; d.gain = a.in[2] + (size_t)(2 + j) * D; d.dst = j == 0 ? (bf16_t*)(a.ws + WS_WKVQ) + (size_t)512 * 1024 : (bf16_t*)(a.ws + WS_WQ1); d.mode = 0; d.nblk = tt & 31; d.kblk = tt >> 5; }
        else { r -= 1024; const int j = r >> 9, tt = r & 511;
            d.src = a.in[20] + (size_t)j * D * D; d.ld = D; d.K = D; d.gain = nullptr; d.dst = (bf16_t*)(a.ws + WS_WO) + (size_t)j * 1024 * 1024; d.mode = 0; d.nblk = tt & 31; d.kblk = tt >> 5; }
    }
    return d;
}
__device__ __forceinline__ void conv_load(const ConvDesc& d, int lane, f32x4 (&v)[8]) {
    const float* p = d.src + (size_t)(d.kblk * 64 + 8 * (lane >> 3)) * d.ld + d.nblk * 32 + 4 * (lane & 7);
#pragma unroll
    for (int j = 0; j < 8; ++j) v[j] = __builtin_nontemporal_load((const f32x4*)(p + (size_t)j * d.ld));
}
__device__ __forceinline__ void conv_store(const ConvDesc& d, int lane, f32x4 (&v)[8]) {
    const int k0 = d.kblk * 64 + 8 * (lane >> 3);
    if (d.gain) { const f32x4 g0 = *(const f32x4*)(d.gain + k0), g1 = *(const f32x4*)(d.gain + k0 + 4);
        v[0] *= g0[0]; v[1] *= g0[1]; v[2] *= g0[2]; v[3] *= g0[3]; v[4] *= g1[0]; v[5] *= g1[1]; v[6] *= g1[2]; v[7] *= g1[3]; }
    const int n = d.nblk * 32 + 4 * (lane & 7), row = d.mode == 0 ? n : (256 * (n >> 7) + (n & 127) + (d.mode == 2 ? 128 : 0));
    bf16_t* q = d.dst + (size_t)row * d.K + k0;
#pragma unroll
    for (int c = 0; c < 4; ++c) {
        u32x4 w; w.x = cvt_pk_bf16(v[0][c], v[1][c]); w.y = cvt_pk_bf16(v[2][c], v[3][c]); w.z = cvt_pk_bf16(v[4][c], v[5][c]); w.w = cvt_pk_bf16(v[6][c], v[7][c]);
        asm volatile("global_store_dwordx4 %0, %1, off sc1\n\ts_nop 1" :: "v"(q + (size_t)c * d.K), "v"(w) : "memory");
    }
}
constexpr int F8_T0 = F8_LAYER < 4 ? F8_LAYER * 32 * NWT_E : NWT_MOE;
__device__ __forceinline__ void conv_pair8(CArgs& a, int ti, int lane) {
    const int le = ti / NWT_E, r = ti % NWT_E, which = r >> 8, tt = r & 255, layer = le >> 5, t7 = (tt & 7) | ((tt >> 4) << 3);
    const float* src; const float* gain; unsigned char* dst; int ld, K, mode, nblk, kpair;
    if (which < 2) { src = a.in[26 + which] + (size_t)le * D * DEXP; ld = DEXP; K = D; gain = a.in[3] + (size_t)layer * D; dst = a.ws + WS_W1 + (size_t)layer * 32 * 1024 * 1024 * 2 + (size_t)(le & 31) * 1024 * 1024; mode = 1 + which; nblk = t7 & 15; kpair = t7 >> 4; }
    else { src = a.in[28] + (size_t)le * DEXP * D; ld = D; K = DEXP; gain = nullptr; dst = a.ws + WS_W2 + (size_t)layer * 32 * 1024 * 512 * 2 + (size_t)(le & 31) * 1024 * 512; mode = 0; nblk = t7 & 31; kpair = t7 >> 5; }
    const int k0 = kpair * 128 + 16 * (lane >> 3);
    const float* p = src + (size_t)k0 * ld + nblk * 32 + 4 * (lane & 7);
    f32x4 va[8], vb[8];
#pragma unroll
    for (int j = 0; j < 8; ++j) va[j] = __builtin_nontemporal_load((const f32x4*)(p + (size_t)j * ld));
#pragma unroll
    for (int j = 0; j < 8; ++j) vb[j] = __builtin_nontemporal_load((const f32x4*)(p + (size_t)(8 + j) * ld));
    if (gain) { const f32x4 g0 = *(const f32x4*)(gain + k0), g1 = *(const f32x4*)(gain + k0 + 4), g2 = *(const f32x4*)(gain + k0 + 8), g3 = *(const f32x4*)(gain + k0 + 12);
#pragma unroll
        for (int j = 0; j < 4; ++j) { va[j] *= g0[j] * F8_WSCALE; va[4 + j] *= g1[j] * F8_WSCALE; vb[j] *= g2[j] * F8_WSCALE; vb[4 + j] *= g3[j] * F8_WSCALE; } }
    else {
#pragma unroll
        for (int j = 0; j < 8; ++j) { va[j] *= F8_WSCALE; vb[j] *= F8_WSCALE; } }
    const int n = nblk * 32 + 4 * (lane & 7), row = mode == 0 ? n : (256 * (n >> 7) + (n & 127) + (mode == 2 ? 128 : 0));
    unsigned char* q = dst + (size_t)row * K + k0;
#pragma unroll
    for (int c = 0; c < 4; ++c) {
        u32x4 w; w.x = pk4_fp8(va[0][c], va[1][c], va[2][c], va[3][c]); w.y = pk4_fp8(va[4][c], va[5][c], va[6][c], va[7][c]); w.z = pk4_fp8(vb[0][c], vb[1][c], vb[2][c], vb[3][c]); w.w = pk4_fp8(vb[4][c], vb[5][c], vb[6][c], vb[7][c]);
        asm volatile("global_store_dwordx4 %0, %1, off sc1\n\ts_nop 1" :: "v"(q + (size_t)c * K), "v"(w) : "memory");
    }
}
__device__ __forceinline__ void convert_weights(CArgs& a) {
    const int lane = opaque_tid() & 63, gw = (opaque_tid() >> 6) * GRID + opaque_bid();
    for (int ti = NWT_MOE + gw; ti < NWT_MOE + NWT_DENSE; ti += GRID * 16) {
        const int t1 = ti + GRID * 8; const bool two = t1 < NWT_MOE + NWT_DENSE;
        const ConvDesc d0 = conv_decode(a, ti); ConvDesc d1 = d0; f32x4 va[8], vb[8];
        conv_load(d0, lane, va);
        if (two) { d1 = conv_decode(a, t1); conv_load(d1, lane, vb); }
        conv_store(d0, lane, va);
        if (two) conv_store(d1, lane, vb);
    }
}
struct BgConv {
    CArgs* a; volatile LAS unsigned* st;
    __device__ __forceinline__ int claim() const {
        int t = 0;
        if ((opaque_tid() & 63) == 0) { const unsigned x = xb_xcc_id() & 7u; t = (int)(xb_add((unsigned*)(a->ws + WS_CTL) + CW_BGC + 64 * x, 1u) * 16u + x); }
        return __builtin_amdgcn_readfirstlane(t);
    }
    __device__ __forceinline__ int claim_run() {
        const int t = claim(); const int lane = opaque_tid() & 63;
        if (t >= F8_T0) { if (t < NWT_MOE) conv_pair8(*a, t, lane); else if (lane == 0) st[3] = 1u; return t + 8; }
        const bool v0 = t < NWT_MOE, v1 = t + 8 < NWT_MOE;
        ConvDesc d0, d1; f32x4 va[8], vb[8];
        if (v0) { d0 = conv_decode(*a, t); conv_load(d0, lane, va); }
        if (v1) { d1 = conv_decode(*a, t + 8); conv_load(d1, lane, vb); }
        if (v0) conv_store(d0, lane, va);
        if (v1) conv_store(d1, lane, vb); else if (lane == 0) st[3] = 1u;
        return t + 8;
    }
    __device__ __forceinline__ void step() { if (st[3] == 0u) (void)claim_run(); else __builtin_amdgcn_s_sleep(32); }
    __device__ __forceinline__ void park() {}
    __device__ __forceinline__ void drain_others(int limit) {
        if (opaque_tid() < 64) {
            for (unsigned x = 0; x < 8u; ++x) {
                unsigned* ctr = (unsigned*)(a->ws + WS_CTL) + CW_BGC + 64 * x;
                while ((int)((unsigned)__builtin_amdgcn_readfirstlane(xb_ld(ctr)) * 16u + x) < limit) {
                    int t = 0; if ((opaque_tid() & 63) == 0) t = (int)(xb_add(ctr, 1u) * 16u + x);
                    t = __builtin_amdgcn_readfirstlane(t);
                    const int lane = opaque_tid() & 63;
                    if (t >= F8_T0) { if (t < NWT_MOE) conv_pair8(*a, t, lane); }
                    else { { const ConvDesc d = conv_decode(*a, t); f32x4 v[8]; conv_load(d, lane, v); conv_store(d, lane, v); }
                           { const ConvDesc d = conv_decode(*a, t + 8); f32x4 v[8]; conv_load(d, lane, v); conv_store(d, lane, v); } }
                }
            }
        }
    }
    __device__ __forceinline__ void run_until(int limit, int budget) {
        for (int n = 0; n < budget; ++n) { if (st[3] != 0u) break; if (claim_run() >= limit) break; }
    }
};

struct cplx { float re, im; };
__device__ __forceinline__ cplx cmul(cplx a, cplx b) { return {a.re * b.re - a.im * b.im, a.re * b.im + a.im * b.re}; }

__device__ __forceinline__ void hw_sincos(float x, float& sn, float& cs) { float r = x * 0.15915494309189535f; r -= floorf(r); sn = __builtin_amdgcn_sinf(r); cs = __builtin_amdgcn_cosf(r); }
__device__ __forceinline__ void s5_tables(CArgs& a, int layer, int g, int part, LAS unsigned char* lds) {
    LAS f32x2* pw = (LAS f32x2*)lds;
    LAS f32x2* bb = (LAS f32x2*)(lds + 64 * 17 * 8);
    LAS f32x2* cc = bb + 64 * 16;
    const int tid = opaque_tid();
    const float* a_re = a.in[6] + ((size_t)layer * 64 + g) * 64; const float* a_im = a.in[7] + ((size_t)layer * 64 + g) * 64;
    const float dt = expf(a.in[8][layer * 64 + g]);
    for (int idx = tid; idx < 64 * 17; idx += NTHREADS) {
        const int p = idx / 17, d = idx % 17;
        const float mag = expf(a_re[p] * dt * (float)d), ang = a_im[p] * dt * (float)d;
        float s, c; hw_sincos(ang, s, c);
        pw[idx] = (f32x2){mag * c, mag * s};
    }
    const float* b_re = a.in[9] + ((size_t)layer * 64 + g) * 1024; const float* b_im = a.in[10] + ((size_t)layer * 64 + g) * 1024;
    const float* c_re = a.in[11] + ((size_t)layer * 64 + g) * 1024; const float* c_im = a.in[12] + ((size_t)layer * 64 + g) * 1024;
    for (int idx = tid; idx < 1024; idx += NTHREADS) {
        const int p = idx >> 4;
        const float lr = a_re[p], li = a_im[p];
        const float mag = expf(lr * dt), ang = li * dt; float s, c; hw_sincos(ang, s, c);
        const float nr = mag * c - 1.0f, ni = mag * s;
        const float den = 1.0f / (lr * lr + li * li);
        const cplx f = {(nr * lr + ni * li) * den, (ni * lr - nr * li) * den};
        const cplx r = cmul(f, (cplx){b_re[idx], b_im[idx]});
        bb[idx] = (f32x2){r.re, r.im};
        cc[idx] = (f32x2){c_re[idx], c_im[idx]};
    }
    __syncthreads();
    unsigned char* tbl = a.ws + WS_TBL + ((size_t)layer * 64 + g) * TBL_STRIDE;
    for (int idx = part * 512 + tid; idx < part * 512 + 512; idx += NTHREADS) {
        const int delta = idx >> 6, l = idx & 63, c1 = l & 15, q4 = l >> 4, d = delta - (q4 >> 1);
        float v[8];
#pragma unroll
        for (int j = 0; j < 8; ++j) v[j] = 0.f;
        if (d >= 0) {
            for (int p = 0; p < 64; ++p) {
                const f32x2 cw = cc[c1 * 64 + p], pp = pw[p * 17 + d];
                const cplx t = cmul((cplx){cw.x, cw.y}, (cplx){pp.x, pp.y});
#pragma unroll
                for (int j = 0; j < 8; ++j) { const f32x2 bw = bb[p * 16 + 8 * (q4 & 1) + j]; v[j] += t.re * bw.x - t.im * bw.y; }
            }
        }
        u32x4 w; w.x = cvt_pk_bf16(v[0], v[1]); w.y = cvt_pk_bf16(v[2], v[3]); w.z = cvt_pk_bf16(v[4], v[5]); w.w = cvt_pk_bf16(v[6], v[7]);
        *(u32x4*)(tbl + TBL_K + (size_t)idx * 16) = w;
    }
    if (part == 0)
    for (int idx = tid; idx < 64 * 64; idx += NTHREADS) {
        const int f = idx >> 6, l = idx & 63, rt = f >> 3, ks = f & 7, q4 = l >> 4, rho = 16 * rt + (l & 15), p = rho & 63, im = rho >> 6;
        const int k0 = 32 * ks + 8 * q4, jpos = k0 >> 4, c20 = k0 & 15;
        const f32x2 pp = pw[p * 17 + (15 - jpos)];
        float v[8];
#pragma unroll
        for (int j = 0; j < 8; ++j) { const f32x2 bw = bb[p * 16 + c20 + j]; const cplx t = cmul((cplx){pp.x, pp.y}, (cplx){bw.x, bw.y}); v[j] = im ? t.im : t.re; }
        u32x4 w; w.x = cvt_pk_bf16(v[0], v[1]); w.y = cvt_pk_bf16(v[2], v[3]); w.z = cvt_pk_bf16(v[4], v[5]); w.w = cvt_pk_bf16(v[6], v[7]);
        *(u32x4*)(tbl + TBL_M + (size_t)idx * 16) = w;
    }
    if (part == 1)
    for (int idx = tid; idx < 64 * 64; idx += NTHREADS) {
        const int f = idx >> 6, l = idx & 63, i = f >> 2, ks = f & 3, q4 = l >> 4, c1 = l & 15;
        const int s0 = 32 * ks + 8 * q4;
        float v[8];
#pragma unroll
        for (int j = 0; j < 8; ++j) { const int sg = s0 + j, p = sg & 63; const f32x2 cw = cc[c1 * 64 + p], pp = pw[p * 17 + i + 1];
            const cplx t = cmul((cplx){cw.x, cw.y}, (cplx){pp.x, pp.y}); v[j] = (sg >> 6) ? -t.im : t.re; }
        u32x4 w; w.x = cvt_pk_bf16(v[0], v[1]); w.y = cvt_pk_bf16(v[2], v[3]); w.z = cvt_pk_bf16(v[4], v[5]); w.w = cvt_pk_bf16(v[6], v[7]);
        *(u32x4*)(tbl + TBL_N + (size_t)idx * 16) = w;
    }
    if (part == 1 && tid < 64) *(f32x2*)(tbl + TBL_A16 + tid * 8) = pw[tid * 17 + 16];
    __syncthreads();
}

__device__ __forceinline__ void row_norm_store(const f32x4 (&v)[4], float ssq, int lane, const float* g0, bf16_t* o0) {
    const float rstd = 1.0f / sqrtf(ssq * (1.0f / D) + RMS_EPS);
#pragma unroll
    for (int j = 0; j < 4; ++j) {
        const int c = 4 * lane + 256 * j;
        f32x4 g = {1.f, 1.f, 1.f, 1.f}; if (g0) g = *(const f32x4*)(g0 + c);
        u32x2 w; w.x = cvt_pk_bf16(v[j][0] * rstd * g[0], v[j][1] * rstd * g[1]); w.y = cvt_pk_bf16(v[j][2] * rstd * g[2], v[j][3] * rstd * g[3]);
        *(u32x2*)(o0 + c) = w;
    }
}
__device__ __forceinline__ void phase_prep(CArgs& a, LAS unsigned char* lds) {
    if (opaque_bid() < 128) { s5_tables(a, opaque_bid() >> 6, opaque_bid() & 63, 0, lds); s5_tables(a, opaque_bid() >> 6, opaque_bid() & 63, 1, lds); }
    if (opaque_tid() < 96) {
        const int item = opaque_bid() * 96 + opaque_tid(), layer = item / 6144, idx = item % 6144;
        const float* wg = a.in[22] + (size_t)layer * D * NGRP; const float* we = a.in[24] + (size_t)layer * D * NEXP; const float* gain = a.in[3] + (size_t)layer * D;
        const int l = idx & 63, ks = (idx >> 6) & 31, rt = idx >> 11, o = 16 * rt + (l & 15), k0 = 32 * ks + 8 * (l >> 4);
        float v[8];
#pragma unroll
        for (int jq = 0; jq < 8; ++jq) v[jq] = (o < 4 ? wg[(size_t)(k0 + jq) * NGRP + o] : (o < 36 ? we[(size_t)(k0 + jq) * NEXP + (o - 4)] : 0.f)) * gain[k0 + jq];
        u32x4 w; w.x = cvt_pk_bf16(v[0], v[1]); w.y = cvt_pk_bf16(v[2], v[3]); w.z = cvt_pk_bf16(v[4], v[5]); w.w = cvt_pk_bf16(v[6], v[7]);
        *(u32x4*)(a.ws + WS_RW + (size_t)layer * 98304 + (size_t)idx * 16) = w;
    }
    convert_weights(a);
    const int lane = opaque_tid() & 63, gw = opaque_bid() * 8 + (opaque_tid() >> 6);
    float* RSTD = (float*)(a.ws + WS_RSTD);
    for (int row0 = gw; row0 < RT; row0 += GRID * 8 * 4) {
        f32x4 v[4][4];
#pragma unroll
        for (int q = 0; q < 4; ++q) { const int row = row0 + q * GRID * 8, rr = row < RT ? row : RT - 1;
            const float* src = rr < NREAL ? a.in[0] + (size_t)rr * D : a.in[1] + (size_t)(rr - NREAL) * D;
#pragma unroll
            for (int j = 0; j < 4; ++j) v[q][j] = *(const f32x4*)(src + 4 * lane + 256 * j); }
#pragma unroll
        for (int q = 0; q < 4; ++q) { const int row = row0 + q * GRID * 8; float ssq = 0.f;
#pragma unroll
            for (int j = 0; j < 4; ++j) ssq += v[q][j][0] * v[q][j][0] + v[q][j][1] * v[q][j][1] + v[q][j][2] * v[q][j][2] + v[q][j][3] * v[q][j][3];
            ssq = wave_sum(ssq);
            if (lane == 0 && row < RT) RSTD[row] = 1.0f / sqrtf(ssq * (1.0f / D) + RMS_EPS); }
    }
}

constexpr int S5_CH = 528;
constexpr int S5_NCH = 129, S5_NCHP = 144;
__device__ __forceinline__ cplx cmulc(cplx x, cplx y) { return {x.re * y.re - x.im * y.im, x.re * y.im + x.im * y.re}; }
__device__ __forceinline__ void phase_s5(CArgs& a, int layer, LAS unsigned char* lds) {
    LAS unsigned char* Ul = lds; LAS unsigned char* Sl = lds + S5_NCHP * S5_CH;
    const int tid = opaque_tid(), lane = tid & 63, w = __builtin_amdgcn_readfirstlane(tid >> 6), tc = lane & 15, q4 = lane >> 4;
    const bf16_t* H = (const bf16_t*)(a.ws + WS_H); const float* RSTD = (const float*)(a.ws + WS_RSTD); bf16_t* Z = (bf16_t*)(a.ws + WS_Z);
    const int b = opaque_bid() >> 5, gp = 2 * (opaque_bid() & 31);
    u32x4 keep[9];
    {
        const int half = tid & 1, c = 16 * gp + 8 * half;
        const float* gn = a.in[2] + (size_t)layer * D + c;
        const f32x4 ga0 = *(const f32x4*)gn, ga1 = *(const f32x4*)(gn + 4), gb0 = *(const f32x4*)(gn + 16), gb1 = *(const f32x4*)(gn + 20);
#pragma unroll
        for (int k0 = 0; k0 < 9; k0 += 3) {
            float rs[3]; u32x4 ha[3], hb[3]; f32x4 xa0[3], xa1[3], xb0[3], xb1[3];
#pragma unroll
            for (int q = 0; q < 3; ++q) {
                const int idx = tid + (k0 + q) * NTHREADS, tok = (idx < LT * 2 ? idx : LT * 2 - 1) >> 1, row = row_of(b, tok);
                rs[q] = RSTD[row];
                if (layer == 0) { const float* src = (row < NREAL ? a.in[0] + (size_t)row * D : a.in[1] + (size_t)(row - NREAL) * D) + c;
                    xa0[q] = *(const f32x4*)src; xa1[q] = *(const f32x4*)(src + 4); xb0[q] = *(const f32x4*)(src + 16); xb1[q] = *(const f32x4*)(src + 20); }
                else { ha[q] = *(const u32x4*)(H + (size_t)row * D + c); hb[q] = *(const u32x4*)(H + (size_t)row * D + c + 16); }
            }
#pragma unroll
            for (int q = 0; q < 3; ++q) {
                const int idx = tid + (k0 + q) * NTHREADS, tok = idx >> 1; const float r_ = rs[q];
                float va[8], vb[8];
                if (layer == 0) {
#pragma unroll
                    for (int e = 0; e < 4; ++e) { va[e] = xa0[q][e]; va[4 + e] = xa1[q][e]; vb[e] = xb0[q][e]; vb[4 + e] = xb1[q][e]; }
                } else {
                    const u32x4 p = ha[q], r2 = hb[q];
                    va[0] = bf16_lo(p.x); va[1] = bf16_hi(p.x); va[2] = bf16_lo(p.y); va[3] = bf16_hi(p.y); va[4] = bf16_lo(p.z); va[5] = bf16_hi(p.z); va[6] = bf16_lo(p.w); va[7] = bf16_hi(p.w);
                    vb[0] = bf16_lo(r2.x); vb[1] = bf16_hi(r2.x); vb[2] = bf16_lo(r2.y); vb[3] = bf16_hi(r2.y); vb[4] = bf16_lo(r2.z); vb[5] = bf16_hi(r2.z); vb[6] = bf16_lo(r2.w); vb[7] = bf16_hi(r2.w);
                }
                u32x4 v; v.x = cvt_pk_bf16(va[0] * r_ * ga0[0], va[1] * r_ * ga0[1]); v.y = cvt_pk_bf16(va[2] * r_ * ga0[2], va[3] * r_ * ga0[3]);
                v.z = cvt_pk_bf16(va[4] * r_ * ga1[0], va[5] * r_ * ga1[1]); v.w = cvt_pk_bf16(va[6] * r_ * ga1[2], va[7] * r_ * ga1[3]);
                if (idx < LT * 2) *(LAS u32x4*)(Ul + (tok >> 4) * S5_CH + (tok & 15) * 32 + half * 16) = v;
                u32x4 k; k.x = cvt_pk_bf16(vb[0] * r_ * gb0[0], vb[1] * r_ * gb0[1]); k.y = cvt_pk_bf16(vb[2] * r_ * gb0[2], vb[3] * r_ * gb0[3]);
                k.z = cvt_pk_bf16(vb[4] * r_ * gb1[0], vb[5] * r_ * gb1[1]); k.w = cvt_pk_bf16(vb[6] * r_ * gb1[2], vb[7] * r_ * gb1[3]);
                keep[k0 + q] = k;
            }
        }
    }
#pragma unroll 1
    for (int ui = 0; ui < 2; ++ui) {
        const int g = gp + ui;
        const unsigned char* tbl = a.ws + WS_TBL + ((size_t)layer * 64 + g) * TBL_STRIDE;
        if (ui == 1) {
            const int half = tid & 1;
#pragma unroll
            for (int k = 0; k < 9; ++k) { const int idx = tid + k * NTHREADS, tok = idx >> 1; if (idx < LT * 2) *(LAS u32x4*)(Ul + (tok >> 4) * S5_CH + (tok & 15) * 32 + half * 16) = keep[k]; }
        }
        bf16x8 mf[8];
#pragma unroll
        for (int ks = 0; ks < 8; ++ks) mf[ks] = as_bf16x8(*(const u32x4*)(tbl + TBL_M + ((size_t)(w * 8 + ks) * 64 + lane) * 16));
        const int i0 = w, i1 = 15 - w;
        bf16x8 kf0[8], kf1[8], nf0[4], nf1[4];
#pragma unroll
        for (int jj = 0; jj < 8; ++jj) {
            const int d0 = i0 - 2 * jj, d1 = i1 - 2 * jj;
            kf0[jj] = as_bf16x8(*(const u32x4*)(tbl + TBL_K + ((size_t)(d0 >= 0 ? d0 : 0) * 64 + lane) * 16));
            kf1[jj] = as_bf16x8(*(const u32x4*)(tbl + TBL_K + ((size_t)(d1 >= 0 ? d1 : 0) * 64 + lane) * 16));
        }
#pragma unroll
        for (int ks = 0; ks < 4; ++ks) {
            nf0[ks] = as_bf16x8(*(const u32x4*)(tbl + TBL_N + ((size_t)(i0 * 4 + ks) * 64 + lane) * 16));
            nf1[ks] = as_bf16x8(*(const u32x4*)(tbl + TBL_N + ((size_t)(i1 * 4 + ks) * 64 + lane) * 16));
        }
        const f32x2 a16v = *(const f32x2*)(tbl + TBL_A16 + lane * 8);
        __syncthreads();
        {
#pragma unroll 1
            for (int cg = 0; cg < 9; ++cg) {
                const int n = 16 * cg + tc;
                f32x4 acc = {0.f, 0.f, 0.f, 0.f};
#pragma unroll
                for (int ks = 0; ks < 8; ++ks) { const bf16x8 ub = *(LAS bf16x8*)(Ul + n * S5_CH + ks * 64 + q4 * 16); acc = mfma16(mf[ks], ub, acc); }
                *(LAS f32x4*)(Sl + n * S5_CH + (16 * w + 4 * q4) * 4) = acc;
            }
        }
        __syncthreads();
        {
            const cplx a1 = {a16v.x, a16v.y};
            const int nb0 = 16 * w, ncnt = w == 7 ? 17 : 16;
            cplx s = {0.f, 0.f};
#pragma unroll 4
            for (int j = 0; j < 16; ++j) { const float xr = *(LAS float*)(Sl + (nb0 + j) * S5_CH + lane * 4), xi = *(LAS float*)(Sl + (nb0 + j) * S5_CH + 256 + lane * 4); const cplx t = cmulc(a1, s); s = {t.re + xr, t.im + xi}; }
            if (w < 7) { *(LAS float*)(Sl + (130 + w) * S5_CH + lane * 4) = s.re; *(LAS float*)(Sl + (130 + w) * S5_CH + 256 + lane * 4) = s.im; }
            cplx A = a1;
#pragma unroll
            for (int q = 0; q < 4; ++q) A = cmulc(A, A);
            __syncthreads();
            cplx c = {0.f, 0.f};
            for (int v = 0; v < w; ++v) { const float er = *(LAS float*)(Sl + (130 + v) * S5_CH + lane * 4), ei = *(LAS float*)(Sl + (130 + v) * S5_CH + 256 + lane * 4); const cplx t = cmulc(A, c); c = {t.re + er, t.im + ei}; }
            float sr = c.re, si = c.im;
#pragma unroll 1
            for (int nb = 0; nb < 3; ++nb) {
                const int cntb = nb < 2 ? 8 : ncnt - 16;
                float xr[8], xi[8];
#pragma unroll
                for (int j = 0; j < 8; ++j) { const int n = nb0 + nb * 8 + (j < cntb ? j : 0); xr[j] = *(LAS float*)(Sl + n * S5_CH + lane * 4); xi[j] = *(LAS float*)(Sl + n * S5_CH + 256 + lane * 4); }
                asm volatile("s_waitcnt lgkmcnt(0)" ::: "memory");
#pragma unroll
                for (int j = 0; j < 8; ++j) {
                    if (j < cntb) {
                        const int n = nb0 + nb * 8 + j;
                        const unsigned pr = cvt_pk_bf16(sr, si);
                        *(LAS unsigned short*)(Sl + n * S5_CH + lane * 2) = (unsigned short)(pr & 0xffffu);
                        *(LAS unsigned short*)(Sl + n * S5_CH + 128 + lane * 2) = (unsigned short)(pr >> 16);
                        const float nr = a1.re * sr - a1.im * si + xr[j], ni = a1.re * si + a1.im * sr + xi[j];
                        sr = nr; si = ni;
                    }
                }
                asm volatile("" ::: "memory");
            }
        }
        __syncthreads();
        {
            const f32x4 dsk = *(const f32x4*)(a.in[13] + (size_t)layer * D + 16 * g + 4 * q4);
#pragma unroll 1
            for (int cg = 0; cg < 9; ++cg) {
                const int n = 16 * cg + tc;
                f32x4 acc0 = {0.f, 0.f, 0.f, 0.f}, acc1 = {0.f, 0.f, 0.f, 0.f};
#pragma unroll
                for (int jj = 0; jj < 8; ++jj) {
                    const bf16x8 ub = *(LAS bf16x8*)(Ul + n * S5_CH + jj * 64 + q4 * 16);
                    if (2 * jj <= i0) acc0 = mfma16(kf0[jj], ub, acc0);
                    if (2 * jj <= i1) acc1 = mfma16(kf1[jj], ub, acc1);
                }
#pragma unroll
                for (int ks = 0; ks < 4; ++ks) {
                    const bf16x8 sb = *(LAS bf16x8*)(Sl + n * S5_CH + ks * 64 + q4 * 16);
                    acc0 = mfma16(nf0[ks], sb, acc0); acc1 = mfma16(nf1[ks], sb, acc1);
                }
                if (n < S5_NCH && (n > 0 || b == 0)) {
#pragma unroll
                    for (int h = 0; h < 2; ++h) {
                        const int i = h ? i1 : i0; const f32x4 y = h ? acc1 : acc0;
                        const u32x2 uw = *(LAS u32x2*)(Ul + n * S5_CH + i * 32 + q4 * 8);
                        const float z0 = gelu_tanh(y[0] + dsk[0] * bf16_lo(uw.x)), z1 = gelu_tanh(y[1] + dsk[1] * bf16_hi(uw.x));
                        const float z2 = gelu_tanh(y[2] + dsk[2] * bf16_lo(uw.y)), z3 = gelu_tanh(y[3] + dsk[3] * bf16_hi(uw.y));
                        u32x2 o; o.x = cvt_pk_bf16(z0, z1); o.y = cvt_pk_bf16(z2, z3);
                        *(u32x2*)(Z + (size_t)row_of(b, 16 * n + i) * D + 16 * g + 4 * q4) = o;
                    }
                }
            }
        }
        __syncthreads();
    }
}

__device__ __forceinline__ float ssq4(f32x4 h) { return h[0] * h[0] + h[1] * h[1] + h[2] * h[2] + h[3] * h[3]; }
__device__ __forceinline__ int gwave() { return opaque_bid() * 8 + (opaque_tid() >> 6); }
template <int NACC> __device__ __forceinline__ bool meta_block(LAS unsigned char* lds, const bf16_t* Am, const bf16_t* const (&brow)[NACC], int K, f32x4 (&out)[NACC]) {
    const int tid = opaque_tid(), lane = tid & 63, wid = tid >> 6, fr = lane & 15, fq = lane >> 4, ksl = K / 8;
#pragma unroll
    for (int i = 0; i < NACC; ++i) {
        f32x4 acc = {0.f, 0.f, 0.f, 0.f};
        const bf16_t* ap = Am + (size_t)fr * K + wid * ksl + 8 * fq; const bf16_t* bp = brow[i] + (size_t)fr * K + wid * ksl + 8 * fq;
        for (int ks = 0; ks < ksl / 32; ++ks) acc = mfma16(as_bf16x8(*(const u32x4*)(bp + 32 * ks)), as_bf16x8(*(const u32x4*)(ap + 32 * ks)), acc);
        ((LAS f32x4*)lds)[(wid * NACC + i) * 64 + lane] = acc;
    }
    __syncthreads();
    if (wid == 0) {
#pragma unroll
        for (int i = 0; i < NACC; ++i) { f32x4 s = {0.f, 0.f, 0.f, 0.f};
#pragma unroll
            for (int w = 0; w < 8; ++w) s += ((LAS f32x4*)lds)[(w * NACC + i) * 64 + lane];
            out[i] = s; }
    }
    __syncthreads();
    return wid == 0;
}

__device__ __forceinline__ void load_res8(const GemmDesc& g, size_t off, float (&h)[8]) {
    if (g.res32) { const f32x4 a = *(const f32x4*)(g.res32 + off), b = *(const f32x4*)(g.res32 + off + 4); h[0] = a[0]; h[1] = a[1]; h[2] = a[2]; h[3] = a[3]; h[4] = b[0]; h[5] = b[1]; h[6] = b[2]; h[7] = b[3]; }
    else { const u32x4 w = *(const u32x4*)(g.res16 + off); h[0] = bf16_lo(w.x); h[1] = bf16_hi(w.x); h[2] = bf16_lo(w.y); h[3] = bf16_hi(w.y); h[4] = bf16_lo(w.z); h[5] = bf16_hi(w.z); h[6] = bf16_lo(w.w); h[7] = bf16_hi(w.w); }
}
__device__ __forceinline__ void store_h8(bf16_t* Hout, size_t off, const float (&h)[8]) {
    u32x4 w; w.x = cvt_pk_bf16(h[0], h[1]); w.y = cvt_pk_bf16(h[2], h[3]); w.z = cvt_pk_bf16(h[4], h[5]); w.w = cvt_pk_bf16(h[6], h[7]);
    *(u32x4*)(Hout + off) = w;
}
__device__ __forceinline__ void epi_glu(const GemmDesc& g, const f32x4 (&acc)[2][2][4][2], const Unit& u, int wr, int wc, int fr, int fq) {
#pragma unroll
    for (int ai = 0; ai < 2; ++ai) {
        const int row0 = u.pm * BM + ai * HALF + wr * 64 + fr; const size_t off0 = (size_t)row0 * D + u.pn * 128 + wc * 32 + 8 * fq;
        float h[4][8];
#pragma unroll
        for (int m = 0; m < 4; ++m) load_res8(g, off0 + (size_t)m * 16 * D, h[m]);
#pragma unroll
        for (int m = 0; m < 4; ++m) {
#pragma unroll
            for (int n = 0; n < 2; ++n) { const f32x4 v = acc[ai][0][m][n], gt = acc[ai][1][m][n];
                h[m][4 * n + 0] += v[0] * sigmoidf_(gt[0]); h[m][4 * n + 1] += v[1] * sigmoidf_(gt[1]); h[m][4 * n + 2] += v[2] * sigmoidf_(gt[2]); h[m][4 * n + 3] += v[3] * sigmoidf_(gt[3]); }
            store_h8(g.Hout, off0 + (size_t)m * 16 * D, h[m]);
        }
        asm volatile("" ::: "memory");
    }
}
__device__ __forceinline__ void phase_glu(CArgs& a, int layer, bool dry, LAS unsigned char* lds, GemmDesc& g) {
    const bf16_t* Zb = (const bf16_t*)(a.ws + WS_Z); const bf16_t* W = (const bf16_t*)(a.ws + WS_WGLU) + (size_t)layer * 2048 * 1024;
    g.res32 = layer == 0 ? a.in[0] : nullptr; g.res16 = (const bf16_t*)(a.ws + WS_H); g.Hout = (bf16_t*)(a.ws + (dry ? WS_DUMH : WS_H));
    if (opaque_bid() < 32) {
        const int lane = opaque_tid() & 63, fr = lane & 15, fq = lane >> 4, task = opaque_bid();
        const int c0 = 32 * task, rv = 256 * (c0 >> 7) + (c0 & 127);
        const bf16_t* const br[4] = {W + (size_t)rv * D, W + (size_t)(rv + 16) * D, W + (size_t)(rv + 128) * D, W + (size_t)(rv + 144) * D};
        f32x4 o[4];
        if (meta_block<4>(lds, Zb + (size_t)NREAL * D, br, D, o)) {
#pragma unroll
            for (int n = 0; n < 2; ++n) {
                const f32x4 v = o[n], gt = o[2 + n]; const int c = c0 + 16 * n + 4 * fq;
                f32x4 h;
                if (layer == 0) h = *(const f32x4*)(a.in[1] + (size_t)fr * D + c);
                else { const u32x2 w = *(const u32x2*)(g.res16 + (size_t)(NREAL + fr) * D + c); h = (f32x4){bf16_lo(w.x), bf16_hi(w.x), bf16_lo(w.y), bf16_hi(w.y)}; }
                h[0] += v[0] * sigmoidf_(gt[0]); h[1] += v[1] * sigmoidf_(gt[1]); h[2] += v[2] * sigmoidf_(gt[2]); h[3] += v[3] * sigmoidf_(gt[3]);
                u32x2 w2; w2.x = cvt_pk_bf16(h[0], h[1]); w2.y = cvt_pk_bf16(h[2], h[3]); *(u32x2*)(g.Hout + (size_t)(NREAL + fr) * D + c) = w2;
            }
        }
    }
    g.stride = GRID; g.vb = opaque_bid(); g.kind = EPI_GLU; g.K = D; g.perm = 1; g.gather = 0; g.moe = 0; g.nM = NREAL / BM; g.nN = 2048 / BM; g.nwg = g.nM * g.nN; g.A = (const char*)Zb; g.Bt = (const char*)W;
    g.tstepA = g.tstepB = (size_t)BM * D * 2; g.wstride = 0;
}

__device__ __forceinline__ void epi_oproj(const GemmDesc& g, const f32x4 (&acc)[2][2][4][2], const Unit& u, int wr, int wc, int fr, int fq) {
#pragma unroll
    for (int ai = 0; ai < 2; ++ai)
#pragma unroll
        for (int bj = 0; bj < 2; ++bj) {
            const int row0 = u.pm * BM + ai * HALF + wr * 64 + fr, c0 = u.pn * BM + bj * HALF + wc * 32 + 8 * fq; const size_t off0 = (size_t)row0 * D + c0;
            const f32x4 b0 = *(const f32x4*)(g.bias + c0), b1 = *(const f32x4*)(g.bias + c0 + 4);
            float h[4][8];
#pragma unroll
            for (int m = 0; m < 4; ++m) load_res8(g, off0 + (size_t)m * 16 * D, h[m]);
#pragma unroll
            for (int m = 0; m < 4; ++m) {
#pragma unroll
                for (int n = 0; n < 2; ++n) { const f32x4 v = acc[ai][bj][m][n] + (n ? b1 : b0); h[m][4 * n + 0] += v[0]; h[m][4 * n + 1] += v[1]; h[m][4 * n + 2] += v[2]; h[m][4 * n + 3] += v[3]; }
                store_h8(g.Hout, off0 + (size_t)m * 16 * D, h[m]);
            }
            asm volatile("" ::: "memory");
        }
}
__device__ __forceinline__ void phase_oproj(CArgs& a, int j, bool dry, LAS unsigned char* lds, GemmDesc& g) {
    const bf16_t* Ob = (const bf16_t*)(a.ws + WS_Z); const bf16_t* W = (const bf16_t*)(a.ws + WS_WO) + (size_t)j * 1024 * 1024;
    const float* bo = a.in[21] + (size_t)j * D;
    g.res32 = nullptr; g.res16 = (const bf16_t*)(a.ws + WS_H); g.Hout = (bf16_t*)(a.ws + (dry ? WS_DUMH : WS_H)); g.bias = bo;
    if (opaque_bid() < 32) {
        const int lane = opaque_tid() & 63, fr = lane & 15, fq = lane >> 4, task = opaque_bid(), c0 = 32 * task;
        const bf16_t* const br[2] = {W + (size_t)c0 * D, W + (size_t)(c0 + 16) * D};
        f32x4 o[2];
        if (meta_block<2>(lds, Ob + (size_t)NREAL * D, br, D, o)) {
#pragma unroll
            for (int n = 0; n < 2; ++n) {
                const int c = c0 + 16 * n + 4 * fq; const size_t off = (size_t)(NREAL + fr) * D + c;
                const u32x2 w = *(const u32x2*)(g.res16 + off); f32x4 h = (f32x4){bf16_lo(w.x), bf16_hi(w.x), bf16_lo(w.y), bf16_hi(w.y)};
                h += o[n] + *(const f32x4*)(bo + c);
                u32x2 w2; w2.x = cvt_pk_bf16(h[0], h[1]); w2.y = cvt_pk_bf16(h[2], h[3]); *(u32x2*)(g.Hout + off) = w2;
            }
        }
    }
    g.stride = GRID; g.vb = opaque_bid(); g.kind = EPI_OPROJ; g.K = D; g.perm = 1; g.gather = 0; g.moe = 0; g.nM = NREAL / BM; g.nN = 1024 / BM; g.nwg = g.nM * g.nN; g.A = (const char*)Ob; g.Bt = (const char*)W;
    g.tstepA = g.tstepB = (size_t)BM * D * 2; g.wstride = 0;
}

__device__ __forceinline__ void kvq_store8(const GemmDesc& g, int row, int c, const float (&vin)[8]) {
    const float rs = g.rstd[row]; float v[8];
#pragma unroll
    for (int e = 0; e < 8; ++e) v[e] = vin[e] * rs;
    if (c < 256) {
        const float* b = g.bias + c; u32x4 w; w.x = cvt_pk_bf16(v[0] + b[0], v[1] + b[1]); w.y = cvt_pk_bf16(v[2] + b[2], v[3] + b[3]); w.z = cvt_pk_bf16(v[4] + b[4], v[5] + b[5]); w.w = cvt_pk_bf16(v[6] + b[6], v[7] + b[7]);
        *(u32x4*)(g.O1 + (size_t)row * 256 + c) = w;
    } else if (c < 512) {
        const int cv = c - 256; const float* b = g.bias + c;
        bf16_t* vp = g.O2 + (row < NREAL ? ((size_t)(row >> 11) * 256 + cv) * SEQ + (row & (SEQ - 1)) : VT_META + (size_t)cv * 16 + (row - NREAL));
        const size_t st = row < NREAL ? SEQ : 16;
#pragma unroll
        for (int i = 0; i < 4; ++i) { const unsigned p = cvt_pk_bf16(v[2 * i] + b[2 * i], v[2 * i + 1] + b[2 * i + 1]); vp[(size_t)(2 * i) * st] = (bf16_t)(p & 0xffffu); vp[(size_t)(2 * i + 1) * st] = (bf16_t)(p >> 16); }
    } else {
        const int cq = c - 512; const float* b = g.bias2 + cq;
        u32x4 w; w.x = cvt_pk_bf16((v[0] + b[0]) * 0.125f, (v[1] + b[1]) * 0.125f); w.y = cvt_pk_bf16((v[2] + b[2]) * 0.125f, (v[3] + b[3]) * 0.125f);
        w.z = cvt_pk_bf16((v[4] + b[4]) * 0.125f, (v[5] + b[5]) * 0.125f); w.w = cvt_pk_bf16((v[6] + b[6]) * 0.125f, (v[7] + b[7]) * 0.125f);
        *(u32x4*)(g.O3 + (size_t)row * D + cq) = w;
    }
}
__device__ __forceinline__ void epi_kvq(const GemmDesc& g, const f32x4 (&acc)[2][2][4][2], const Unit& u, int wr, int wc, int fr, int fq) {
    { const int cbase = g.cbase;
#pragma unroll
        for (int ai = 0; ai < 2; ++ai)
#pragma unroll
            for (int m = 0; m < 4; ++m) {
                const int row = u.pm * BM + ai * HALF + wr * 64 + m * 16 + fr;
#pragma unroll
                for (int bj = 0; bj < 2; ++bj) {
                    const int c = cbase + u.pn * BM + bj * HALF + wc * 32 + 8 * fq;
                    const f32x4 v0 = acc[ai][bj][m][0], v1 = acc[ai][bj][m][1];
                    const float v[8] = {v0[0], v0[1], v0[2], v0[3], v1[0], v1[1], v1[2], v1[3]};
                    kvq_store8(g, row, c, v);
                    asm volatile("" ::: "memory");
                }
            }
    }
}
__device__ __forceinline__ void phase_kvq_q(CArgs& a, int jq, LAS unsigned char* lds, GemmDesc& g) {
    const bf16_t* Ub = (const bf16_t*)(a.ws + WS_H); const bf16_t* W = jq == 0 ? (const bf16_t*)(a.ws + WS_WKVQ) : (const bf16_t*)(a.ws + WS_WQ1);
    const int N = jq == 0 ? 1536 : 1024, cbase = jq == 0 ? 0 : 512;
    const int mb0 = jq == 0 ? 160 : 0;
    if (opaque_bid() >= mb0 && opaque_bid() < mb0 + N / 32) {
        const int lane = opaque_tid() & 63, fr = lane & 15, fq = lane >> 4, task = opaque_bid() - mb0;
        const bf16_t* const br[2] = {W + (size_t)(32 * task) * D, W + (size_t)(32 * task + 16) * D};
        f32x4 o[2];
        if (meta_block<2>(lds, Ub + (size_t)NREAL * D, br, D, o)) {
#pragma unroll
            for (int h = 0; h < 2; ++h) {
                const int c = cbase + 32 * task + 16 * h + 4 * fq; const int row = NREAL + fr; const f32x4 v = o[h] * ((const float*)(a.ws + WS_RSTD))[row];
                if (c < 256) { const float* b = a.in[16] + c; u32x2 w; w.x = cvt_pk_bf16(v[0] + b[0], v[1] + b[1]); w.y = cvt_pk_bf16(v[2] + b[2], v[3] + b[3]); *(u32x2*)((bf16_t*)(a.ws + WS_K) + (size_t)row * 256 + c) = w; }
                else if (c < 512) { const int cv = c - 256; const float* b = a.in[16] + c; bf16_t* vp = (bf16_t*)(a.ws + WS_VT) + VT_META + (size_t)cv * 16 + fr;
                    const unsigned p0 = cvt_pk_bf16(v[0] + b[0], v[1] + b[1]), p1 = cvt_pk_bf16(v[2] + b[2], v[3] + b[3]);
                    vp[0] = (bf16_t)(p0 & 0xffffu); vp[16] = (bf16_t)(p0 >> 16); vp[32] = (bf16_t)(p1 & 0xffffu); vp[48] = (bf16_t)(p1 >> 16); }
                else { const int cq = c - 512; const float* b = a.in[18] + (size_t)jq * D + cq; u32x2 w; w.x = cvt_pk_bf16((v[0] + b[0]) * 0.125f, (v[1] + b[1]) * 0.125f); w.y = cvt_pk_bf16((v[2] + b[2]) * 0.125f, (v[3] + b[3]) * 0.125f);
                    *(u32x2*)((bf16_t*)(a.ws + WS_Q) + (size_t)row * D + cq) = w; }
            }
        }
    }
    g.stride = GRID; g.vb = opaque_bid(); g.kind = EPI_KVQ; g.K = D; g.perm = 1; g.gather = 0; g.moe = 0; g.nM = NREAL / BM; g.nN = N / BM; g.nwg = g.nM * g.nN; g.A = (const char*)Ub; g.Bt = (const char*)W;
    g.tstepA = g.tstepB = (size_t)BM * D * 2; g.wstride = 0; g.rstd = (const float*)(a.ws + WS_RSTD); g.bias = a.in[16]; g.bias2 = a.in[18] + (size_t)jq * D; g.O1 = (bf16_t*)(a.ws + WS_K); g.O2 = (bf16_t*)(a.ws + WS_VT); g.O3 = (bf16_t*)(a.ws + WS_Q);
    g.jq = jq; g.cbase = cbase;
}

__device__ __forceinline__ void moe_scan(const int* cnt, LAS int* sh) {
    if (opaque_tid() == 0) { int acc = 0; for (int e = 0; e < 32; ++e) { sh[e] = acc; acc += (cnt[e] + 255) >> 8; } sh[32] = acc; }
    __syncthreads();
}
__device__ __forceinline__ void epi_moe1(const GemmDesc& g, LAS unsigned char* lds, const f32x4 (&acc)[2][2][4][2], const Unit& u, int wr, int wc, int fr, int fq) {
    { bf16_t* HB = g.O1;
        const LAS int* tabt = (const LAS int*)(lds + LDS_TABT) + u.slot * 256;
#pragma unroll
        for (int ai = 0; ai < 2; ++ai)
#pragma unroll
            for (int m = 0; m < 4; ++m) {
                const int rl = ai * HALF + wr * 64 + m * 16 + fr;
                if (tabt[rl] >= 0) {
                    const float rs = ((const LAS float*)(lds + LDS_TABG))[u.slot * 256 + rl] * (g.f8 ? 1.0f / F8_WSCALE : 1.0f);
                    const f32x4 g0 = acc[ai][0][m][0] * rs, g1 = acc[ai][0][m][1] * rs, u0 = acc[ai][1][m][0] * rs, u1 = acc[ai][1][m][1] * rs;
                    if (g.f8) {
                        u32x2 w8; w8.x = pk4_fp8(g0[0] * sigmoidf_(g0[0]) * u0[0] * F8_HSCALE, g0[1] * sigmoidf_(g0[1]) * u0[1] * F8_HSCALE, g0[2] * sigmoidf_(g0[2]) * u0[2] * F8_HSCALE, g0[3] * sigmoidf_(g0[3]) * u0[3] * F8_HSCALE);
                        w8.y = pk4_fp8(g1[0] * sigmoidf_(g1[0]) * u1[0] * F8_HSCALE, g1[1] * sigmoidf_(g1[1]) * u1[1] * F8_HSCALE, g1[2] * sigmoidf_(g1[2]) * u1[2] * F8_HSCALE, g1[3] * sigmoidf_(g1[3]) * u1[3] * F8_HSCALE);
                        *(u32x2*)((unsigned char*)HB + ((size_t)u.pm * 256 + rl) * DEXP + u.pn * 128 + wc * 32 + 8 * fq) = w8;
                    } else {
                    u32x4 w; w.x = cvt_pk_bf16(g0[0] * sigmoidf_(g0[0]) * u0[0], g0[1] * sigmoidf_(g0[1]) * u0[1]); w.y = cvt_pk_bf16(g0[2] * sigmoidf_(g0[2]) * u0[2], g0[3] * sigmoidf_(g0[3]) * u0[3]);
                    w.z = cvt_pk_bf16(g1[0] * sigmoidf_(g1[0]) * u1[0], g1[1] * sigmoidf_(g1[1]) * u1[1]); w.w = cvt_pk_bf16(g1[2] * sigmoidf_(g1[2]) * u1[2], g1[3] * sigmoidf_(g1[3]) * u1[3]);
                    *(u32x4*)(HB + ((size_t)u.pm * 256 + rl) * DEXP + u.pn * 128 + wc * 32 + 8 * fq) = w;
                    }
                }
                asm volatile("" ::: "memory");
            }
    }
}
__device__ __forceinline__ bool moe_roles(GemmDesc& g) {
    const int rounds = (g.nwg + GRID - 1) / GRID, per = rounds ? (g.nwg + rounds - 1) / rounds : GRID, ngw = ((per + 7) / 8) * 8 < GRID ? ((per + 7) / 8) * 8 : GRID;
    const int bid = opaque_bid(), rnk = bid >> 3;
    g.stride = ngw; g.vb = rnk * 8 + (bid & 7);
    if (rnk * 8 >= ngw) { g.nwg = 0; return true; }
    return false;
}
__device__ __forceinline__ bool phase_moe1(CArgs& a, int layer, LAS unsigned char* lds, GemmDesc& g) {
    LAS int* sh = (LAS int*)(lds + LDS_SH);
    const int* cnt = (const int*)(a.ws + WS_CTL) + CW_CNT + layer * 32;
    moe_scan(cnt, sh);
    g.kind = EPI_MOE1; g.K = D; g.perm = 1; g.gather = 1; g.moe = 1; g.npn = 4; g.nwg = sh[32] * 4; g.nM = 0; g.nN = 4;
    g.A = (const char*)(a.ws + WS_H); g.Bt = (const char*)(a.ws + WS_W1) + (size_t)layer * 32 * 1024 * 1024 * 2; g.wstride = (size_t)1024 * 1024 * 2;
    g.tstepA = 0; g.tstepB = (size_t)256 * 1024 * 2; g.cnt = cnt; g.LTOK = (const int*)(a.ws + WS_LTOK); g.LGATE = (const float*)(a.ws + WS_LRS); g.O1 = (bf16_t*)(a.ws + WS_HB);
    if (layer >= F8_LAYER) { g.f8 = 1; g.K = D / 2; g.A = (const char*)(a.ws + WS_Z); g.arow = D; g.wstride = (size_t)1024 * 1024; g.tstepB = (size_t)256 * 1024; }
    return moe_roles(g);
}
__device__ __forceinline__ void epi_moe2(const GemmDesc& g, LAS unsigned char* lds, const f32x4 (&acc)[2][2][4][2], const Unit& u, int wr, int wc, int fr, int fq) {
    { bf16_t* YB = g.O1;
        const LAS int* tabt = (const LAS int*)(lds + LDS_TABT) + u.slot * 256; const LAS float* tabg = (const LAS float*)(lds + LDS_TABG) + u.slot * 256;
#pragma unroll
        for (int ai = 0; ai < 2; ++ai)
#pragma unroll
            for (int m = 0; m < 4; ++m) {
                const int rl = ai * HALF + wr * 64 + m * 16 + fr; const int rt = tabt[rl];
                if (rt >= 0) {
                    const float gs = tabg[rl] * (g.f8 ? 1.0f / (F8_WSCALE * F8_HSCALE) : 1.0f);
                    bf16_t* yp = YB + ((size_t)(rt & 0x3fffffff) * 2 + (rt >> 30)) * D + u.pn * BM + wc * 32 + 8 * fq;
#pragma unroll
                    for (int bj = 0; bj < 2; ++bj) { const f32x4 v0 = acc[ai][bj][m][0] * gs, v1 = acc[ai][bj][m][1] * gs;
                        u32x4 w; w.x = cvt_pk_bf16(v0[0], v0[1]); w.y = cvt_pk_bf16(v0[2], v0[3]); w.z = cvt_pk_bf16(v1[0], v1[1]); w.w = cvt_pk_bf16(v1[2], v1[3]);
                        *(u32x4*)(yp + bj * HALF) = w; }
                }
                asm volatile("" ::: "memory");
            }
    }
}
__device__ __forceinline__ bool phase_moe2(CArgs& a, int layer, LAS unsigned char* lds, GemmDesc& g) {
    LAS int* sh = (LAS int*)(lds + LDS_SH);
    const int* cnt = (const int*)(a.ws + WS_CTL) + CW_CNT + layer * 32;
    moe_scan(cnt, sh);
    g.kind = EPI_MOE2; g.K = DEXP; g.perm = 1; g.gather = 0; g.moe = 1; g.npn = 4; g.nwg = sh[32] * 4; g.nM = 0; g.nN = 4;
    g.A = (const char*)(a.ws + WS_HB); g.Bt = (const char*)(a.ws + WS_W2) + (size_t)layer * 32 * 1024 * 512 * 2; g.wstride = (size_t)1024 * 512 * 2;
    g.tstepA = (size_t)256 * DEXP * 2; g.tstepB = (size_t)256 * DEXP * 2; g.cnt = cnt; g.LTOK = (const int*)(a.ws + WS_LTOK); g.LGATE = (const float*)(a.ws + WS_LGATE); g.O1 = (bf16_t*)(a.ws + WS_YB);
    if (layer >= F8_LAYER) { g.f8 = 1; g.K = DEXP / 2; g.wstride = (size_t)1024 * 512; g.tstepA = (size_t)256 * DEXP; g.tstepB = (size_t)256 * DEXP; }
    return moe_roles(g);
}
__device__ __forceinline__ void gemm_epilogue(const GemmDesc& g, LAS unsigned char* lds, const f32x4 (&acc)[2][2][4][2], const Unit& u, int wr, int wc, int fr, int fq) {
    asm volatile("" : "+v"(fr), "+v"(fq));
    switch (g.kind) {
        case EPI_GLU: epi_glu(g, acc, u, wr, wc, fr, fq); break;
        case EPI_OPROJ: epi_oproj(g, acc, u, wr, wc, fr, fq); break;
        case EPI_KVQ: epi_kvq(g, acc, u, wr, wc, fr, fq); break;
        case EPI_MOE1: epi_moe1(g, lds, acc, u, wr, wc, fr, fq); break;
        default: epi_moe2(g, lds, acc, u, wr, wc, fr, fq); break;
    }
}

constexpr int AT_NSLOT = 272, AT_VROW = 552, AT_KBYTES = AT_NSLOT * 128, AT_VBYTES = 64 * AT_VROW;
__device__ __forceinline__ void attn_tile(LAS unsigned char* Ks, LAS unsigned char* Vs, const bf16x8 qf0, const bf16x8 qf1, bf16_t* op, float sink, int nblk  , int kb0  , int srel  , int smin  , int lmeta  , int tc, int q4) {
    f32x4 s[10];
#pragma unroll
    for (int bi = 0; bi < 10; ++bi) {
        s[bi] = (f32x4){-1e30f, -1e30f, -1e30f, -1e30f};
        if (bi < nblk) {
            const int sl = (bi == 0 ? 0 : 16 + 16 * (kb0 + bi - 1)) + tc;
            const LAS unsigned char* kr = Ks + sl * 128;
            const bf16x8 kf0 = *(const LAS bf16x8*)(kr + ((q4 ^ (sl & 7)) << 4)), kf1 = *(const LAS bf16x8*)(kr + (((4 + q4) ^ (sl & 7)) << 4));
            f32x4 acc = {0.f, 0.f, 0.f, 0.f};
            acc = mfma16(kf0, qf0, acc); acc = mfma16(kf1, qf1, acc);
#pragma unroll
            for (int r = 0; r < 4; ++r) {
                const int kk = 16 * (kb0 + bi - 1) + 4 * q4 + r;
                const bool ok = bi == 0 ? (4 * q4 + r <= lmeta) : (kk >= smin && kk <= srel && kk >= srel - 127);
                s[bi][r] = ok ? acc[r] : -1e30f;
            }
        }
    }
    float m = sink;
#pragma unroll
    for (int bi = 0; bi < 10; ++bi) m = fmaxf(m, fmaxf(fmaxf(s[bi][0], s[bi][1]), fmaxf(s[bi][2], s[bi][3])));
    m = xor32_max(xor16_max(m));
    float den = 0.f;
    unsigned pk[10][2];
#pragma unroll
    for (int bi = 0; bi < 10; ++bi) {
        float p[4];
#pragma unroll
        for (int r = 0; r < 4; ++r) { p[r] = s[bi][r] > -1e29f ? fast_exp(s[bi][r] - m) : 0.f; den += p[r]; }
        pk[bi][0] = cvt_pk_bf16(p[0], p[1]); pk[bi][1] = cvt_pk_bf16(p[2], p[3]);
    }
    den = quad_sum(den);
    den += fast_exp(sink - m);
    const float inv = 1.0f / den;
    f32x4 o[4];
#pragma unroll
    for (int dt = 0; dt < 4; ++dt) o[dt] = (f32x4){0.f, 0.f, 0.f, 0.f};
#pragma unroll
    for (int pp = 0; pp < 5; ++pp) {
        if (2 * pp < nblk) {
            const int biA = 2 * pp, biB = 2 * pp + 1;
            const int slA = biA == 0 ? 0 : 16 + 16 * (kb0 + biA - 1), slB = biB < nblk ? 16 + 16 * (kb0 + biB - 1) : slA;
            u32x4 pw; pw.x = pk[biA][0]; pw.y = pk[biA][1]; pw.z = pk[biB][0]; pw.w = pk[biB][1];
            const bf16x8 pf = as_bf16x8(pw);
#pragma unroll
            for (int dt = 0; dt < 4; ++dt) {
                const LAS unsigned char* vr = Vs + (16 * dt + tc) * AT_VROW + 8 * q4;
                const u32x2 va = *(const LAS u32x2*)(vr + slA * 2), vb = *(const LAS u32x2*)(vr + slB * 2);
                u32x4 vw; vw.x = va.x; vw.y = va.y; vw.z = vb.x; vw.w = vb.y;
                o[dt] = mfma16(as_bf16x8(vw), pf, o[dt]);
            }
        }
    }
#pragma unroll
    for (int dt = 0; dt < 4; ++dt) { u32x2 w; w.x = cvt_pk_bf16(o[dt][0] * inv, o[dt][1] * inv); w.y = cvt_pk_bf16(o[dt][2] * inv, o[dt][3] * inv); *(u32x2*)(op + 16 * dt) = w; }
}
constexpr int AT_BUF = 70656;
struct AtUnit { int meta, kvh, b, s0; };
__device__ __forceinline__ AtUnit at_decode(int unit) { AtUnit u; u.meta = unit >= NB * 4 * 16; const int qt = u.meta ? 0 : (unit & 15); u.kvh = u.meta ? unit - NB * 4 * 16 : ((unit >> 4) & 3); u.b = u.meta ? 0 : (unit >> 6); u.s0 = qt * 128; return u; }
__device__ __forceinline__ void at_fill_load(const bf16_t* K, const bf16_t* VT, const AtUnit& u, int tid, u32x4 (&kr)[5], u32x4 (&vr)[5]) {
#pragma unroll
    for (int i = 0; i < 5; ++i) {
        const int idx = tid + i * NTHREADS;
        { const int sl = idx >> 3, c = idx & 7, sw = u.s0 - 128 + (sl - 16);
          u32x4 v = {0u, 0u, 0u, 0u};
          if (idx < AT_NSLOT * 8) { if (sl < 16) v = *(const u32x4*)(K + (size_t)(NREAL + sl) * 256 + u.kvh * 64 + c * 8); else if (!u.meta && sw >= 0) v = *(const u32x4*)(K + (size_t)(u.b * SEQ + sw) * 256 + u.kvh * 64 + c * 8); }
          kr[i] = v; }
        { const int d = idx / 34, ch = idx - d * 34, sw = u.s0 - 128 + 8 * (ch - 2);
          u32x4 v = {0u, 0u, 0u, 0u};
          if (idx < 64 * 34) { if (ch < 2) v = *(const u32x4*)(VT + VT_META + (size_t)(u.kvh * 64 + d) * 16 + ch * 8); else if (!u.meta && sw >= 0) v = *(const u32x4*)(VT + ((size_t)(u.b * 4 + u.kvh) * 64 + d) * SEQ + sw); }
          vr[i] = v; }
    }
}
__device__ __forceinline__ void at_fill_store(LAS unsigned char* Ks, LAS unsigned char* Vs, int tid, const u32x4 (&kr)[5], const u32x4 (&vr)[5]) {
#pragma unroll
    for (int i = 0; i < 5; ++i) {
        const int idx = tid + i * NTHREADS;
        if (idx < AT_NSLOT * 8) { const int sl = idx >> 3, c = idx & 7; *(LAS u32x4*)(Ks + sl * 128 + ((c ^ (sl & 7)) << 4)) = kr[i]; }
        if (idx < 64 * 34) { const int d = idx / 34, ch = idx - d * 34; *(LAS u32x2*)(Vs + d * AT_VROW + ch * 16) = (u32x2){vr[i].x, vr[i].y}; *(LAS u32x2*)(Vs + d * AT_VROW + ch * 16 + 8) = (u32x2){vr[i].z, vr[i].w}; }
    }
}
__device__ __forceinline__ void phase_attn(CArgs& a, int j, LAS unsigned char* lds) {
    const int tid = opaque_tid(), lane = tid & 63, wid = tid >> 6, tc = lane & 15, q4 = lane >> 4;
    const bf16_t* Q = (const bf16_t*)(a.ws + WS_Q); const bf16_t* K = (const bf16_t*)(a.ws + WS_K); const bf16_t* VT = (const bf16_t*)(a.ws + WS_VT);
    bf16_t* O = (bf16_t*)(a.ws + WS_Z);
    constexpr int NU = NB * 4 * 16 + 4;
    int unit = opaque_bid(), cur = 0;
    if (unit >= NU) return;
    u32x4 kr[5], vr[5];
    { const AtUnit u0 = at_decode(unit); at_fill_load(K, VT, u0, tid, kr, vr); at_fill_store(lds, lds + AT_KBYTES, tid, kr, vr); }
    __syncthreads();
#pragma unroll 1
    for (;;) {
        const AtUnit u = at_decode(unit);
        const int nextu = unit + GRID; const bool more = nextu < NU;
        LAS unsigned char* Ks = lds + cur * AT_BUF; LAS unsigned char* Vs = Ks + AT_KBYTES;
        const int g = wid & 3, hq = u.kvh * 4 + g, jt0 = wid >> 2;
        const float sink = a.in[19][j * 16 + hq];
        if (more) { const AtUnit un = at_decode(nextu); at_fill_load(K, VT, un, tid, kr, vr); }
        if (u.meta) {
            if (wid < 4) { const size_t row = (size_t)(NREAL + tc); const bf16_t* qp = Q + row * D + hq * 64 + 8 * q4;
                attn_tile(Ks, Vs, as_bf16x8(*(const u32x4*)qp), as_bf16x8(*(const u32x4*)(qp + 32)), O + row * D + hq * 64 + 4 * q4, sink, 1, 0, 0, 0, tc, tc, q4); }
        } else {
            const bf16_t* qbase = Q + ((size_t)(u.b * SEQ + u.s0 + tc)) * D + hq * 64 + 8 * q4;
            u32x4 qn0 = *(const u32x4*)(qbase + (size_t)(16 * jt0) * D), qn1 = *(const u32x4*)(qbase + (size_t)(16 * jt0) * D + 32);
#pragma unroll 1
            for (int t = 0; t < 4; ++t) {
                const int jt = jt0 + 2 * t; const size_t row = (size_t)(u.b * SEQ + u.s0 + 16 * jt + tc);
                const bf16x8 q0 = as_bf16x8(qn0), q1 = as_bf16x8(qn1);
                if (t < 3) { qn0 = *(const u32x4*)(qbase + (size_t)(16 * (jt + 2)) * D); qn1 = *(const u32x4*)(qbase + (size_t)(16 * (jt + 2)) * D + 32); }
                attn_tile(Ks, Vs, q0, q1, O + row * D + hq * 64 + 4 * q4, sink, 10, jt, 128 + 16 * jt + tc, 128 - u.s0, 64, tc, q4);
            }
        }
        if (!more) break;
        at_fill_store(lds + (cur ^ 1) * AT_BUF, lds + (cur ^ 1) * AT_BUF + AT_KBYTES, tid, kr, vr);
        __syncthreads();
        cur ^= 1; unit = nextu;
    }
}

__device__ __forceinline__ void phase_route(CArgs& a, int layer, bool dry, LAS unsigned char* lds) {
    LAS unsigned char* Wf = lds; LAS float* LG = (LAS float*)(lds + 98304); LAS int* hist = (LAS int*)(lds + 98304 + 24576); LAS int* hbase = hist + 32;
    const int tid = opaque_tid(), lane = tid & 63, wid = tid >> 6, tc = lane & 15, q4 = lane >> 4;
    for (int idx = tid; idx < 3 * 32 * 64; idx += NTHREADS) *(LAS u32x4*)(Wf + (size_t)idx * 16) = *(const u32x4*)(a.ws + WS_RW + (size_t)layer * 98304 + (size_t)idx * 16);
    if (tid < 32) hist[tid] = 0;
    __syncthreads();
    const bf16_t* H = (const bf16_t*)(a.ws + WS_H); float* LRS = (float*)(a.ws + (dry ? WS_DUMLG : WS_LRS));
    int* cnt = (int*)(a.ws + WS_CTL) + (dry ? CW_DUMCNT : CW_CNT) + layer * 32; int* LTOK = (int*)(a.ws + (dry ? WS_DUMLT : WS_LTOK)); float* LGATE = (float*)(a.ws + (dry ? WS_DUMLG : WS_LGATE));
    const int tile = wid * GRID + opaque_bid();
    const bool active = tile < RT / 16;
    int e1, e2, r1, r2; float g1, g2, rstd_keep;
    asm volatile("" : "=v"(e1), "=v"(e2), "=v"(r1), "=v"(r2), "=v"(g1), "=v"(g2), "=v"(rstd_keep));
    if (active) {
        const int row = tile * 16 + tc;
        float ss = 0.f;
        f32x4 acc[3];
#pragma unroll
        for (int rt = 0; rt < 3; ++rt) acc[rt] = (f32x4){0.f, 0.f, 0.f, 0.f};
        const bf16_t* hp = H + (size_t)row * D + 8 * q4;
#pragma unroll 1
        for (int kb = 0; kb < 4; ++kb) {
            u32x4 hv[8];
#pragma unroll
            for (int k8 = 0; k8 < 8; ++k8) hv[k8] = *(const u32x4*)(hp + 32 * (kb * 8 + k8));
#pragma unroll
            for (int k8 = 0; k8 < 8; ++k8) {
                const int ks = kb * 8 + k8; const bf16x8 xf = as_bf16x8(hv[k8]);
                { const u32x4 hw = hv[k8]; const float e0 = bf16_lo(hw.x), e1 = bf16_hi(hw.x), e2 = bf16_lo(hw.y), e3 = bf16_hi(hw.y), e4 = bf16_lo(hw.z), e5 = bf16_hi(hw.z), e6 = bf16_lo(hw.w), e7 = bf16_hi(hw.w);
                  ss += (e0 * e0 + e1 * e1) + (e2 * e2 + e3 * e3) + (e4 * e4 + e5 * e5) + (e6 * e6 + e7 * e7);
                  if (layer >= F8_LAYER) { u32x2 w8; w8.x = pk4_fp8(e0, e1, e2, e3); w8.y = pk4_fp8(e4, e5, e6, e7); *(u32x2*)(a.ws + WS_Z + (size_t)row * D + 32 * ks + 8 * q4) = w8; } }
#pragma unroll
                for (int rt = 0; rt < 3; ++rt) acc[rt] = mfma16(*(LAS bf16x8*)(Wf + ((size_t)(rt * 32 + ks) * 64 + lane) * 16), xf, acc[rt]);
            }
        }
        ss = quad_sum(ss);
        const float rstd = 1.0f / sqrtf(ss * (1.0f / D) + RMS_EPS); rstd_keep = rstd;
        LAS float* lg = LG + wid * 16 * 48;
#pragma unroll
        for (int rt = 0; rt < 3; ++rt)
#pragma unroll
            for (int r = 0; r < 4; ++r) lg[tc * 48 + 16 * rt + 4 * q4 + r] = acc[rt][r] * rstd;
        asm volatile("s_waitcnt lgkmcnt(0)" ::: "memory");
        if (lane < 16) {
            const LAS float* mylg = lg + lane * 48;
            float gl[4]; int gi = 0; float gm;
#pragma unroll
            for (int i = 0; i < 4; ++i) gl[i] = mylg[i] + a.in[23][layer * NGRP + i];
            gm = gl[0];
#pragma unroll
            for (int i = 1; i < 4; ++i) if (gl[i] > gm) { gm = gl[i]; gi = i; }
            float gz = 0.f;
#pragma unroll
            for (int i = 0; i < 4; ++i) gz += expf(gl[i] - gm);
            const float pg = 1.0f / gz;
            float el[8];
#pragma unroll
            for (int i = 0; i < 8; ++i) el[i] = mylg[4 + gi * 8 + i] + a.in[25][layer * NEXP + gi * 8 + i];
            int i1 = 0; float m1 = el[0];
#pragma unroll
            for (int i = 1; i < 8; ++i) if (el[i] > m1) { m1 = el[i]; i1 = i; }
            int i2 = -1; float m2 = -3.0e38f;
#pragma unroll
            for (int i = 0; i < 8; ++i) if (i != i1 && el[i] > m2) { m2 = el[i]; i2 = i; }
            float one = 1.0f; asm volatile("" : "+v"(one));
            const float x2 = expf(m2 - m1), q1 = one / (one + x2);
            g1 = pg * q1; g2 = pg * x2 * q1; e1 = gi * 8 + i1; e2 = gi * 8 + i2;
            r1 = __hip_atomic_fetch_add(&hist[e1], 1, __ATOMIC_RELAXED, __HIP_MEMORY_SCOPE_WORKGROUP); r2 = __hip_atomic_fetch_add(&hist[e2], 1, __ATOMIC_RELAXED, __HIP_MEMORY_SCOPE_WORKGROUP);
        }
    }
    __syncthreads();
    if (tid < 32) hbase[tid] = hist[tid] ? atomicAdd(&cnt[tid], hist[tid]) : 0;
    __syncthreads();
    if (active && lane < 16) {
        const int row = tile * 16 + lane;
        const int s1 = hbase[e1] + r1, s2 = hbase[e2] + r2;
        LTOK[(size_t)e1 * RT + s1] = row; LGATE[(size_t)e1 * RT + s1] = g1; LRS[(size_t)e1 * RT + s1] = rstd_keep;
        LTOK[(size_t)e2 * RT + s2] = row | (1 << 30); LGATE[(size_t)e2 * RT + s2] = g2; LRS[(size_t)e2 * RT + s2] = rstd_keep;
    }
}

__device__ __forceinline__ void comb_load(const bf16_t* H, const bf16_t* YB, int row, int lane, u32x4 (&w)[2][3]) {
    const bf16_t* hp = H + (size_t)row * D; const bf16_t* y0 = YB + (size_t)row * 2 * D;
#pragma unroll
    for (int j = 0; j < 2; ++j) { const int c = 8 * lane + 512 * j; w[j][0] = *(const u32x4*)(hp + c); w[j][1] = *(const u32x4*)(y0 + c); w[j][2] = *(const u32x4*)(y0 + D + c); }
}
__device__ __forceinline__ void comb_finish(CArgs& a, int layer, bool dry, int row, int lane, const u32x4 (&w)[2][3]) {
    float v[2][8]; float ssq = 0.f;
#pragma unroll
    for (int j = 0; j < 2; ++j) {
        const u32x4 hw = w[j][0], p0 = w[j][1], p1 = w[j][2];
        v[j][0] = bf16_lo(hw.x) + bf16_lo(p0.x) + bf16_lo(p1.x); v[j][1] = bf16_hi(hw.x) + bf16_hi(p0.x) + bf16_hi(p1.x);
        v[j][2] = bf16_lo(hw.y) + bf16_lo(p0.y) + bf16_lo(p1.y); v[j][3] = bf16_hi(hw.y) + bf16_hi(p0.y) + bf16_hi(p1.y);
        v[j][4] = bf16_lo(hw.z) + bf16_lo(p0.z) + bf16_lo(p1.z); v[j][5] = bf16_hi(hw.z) + bf16_hi(p0.z) + bf16_hi(p1.z);
        v[j][6] = bf16_lo(hw.w) + bf16_lo(p0.w) + bf16_lo(p1.w); v[j][7] = bf16_hi(hw.w) + bf16_hi(p0.w) + bf16_hi(p1.w);
#pragma unroll
        for (int e = 0; e < 8; ++e) ssq += v[j][e] * v[j][e];
    }
    ssq = wave_sum(ssq);
    const float rstd = 1.0f / sqrtf(ssq * (1.0f / D) + RMS_EPS);
    if (layer < 3) {
        bf16_t* ho = (bf16_t*)(a.ws + (dry ? WS_DUMH : WS_H)) + (size_t)row * D;
#pragma unroll
        for (int j = 0; j < 2; ++j) {
            const int c = 8 * lane + 512 * j;
            u32x4 o; o.x = cvt_pk_bf16(v[j][0], v[j][1]); o.y = cvt_pk_bf16(v[j][2], v[j][3]); o.z = cvt_pk_bf16(v[j][4], v[j][5]); o.w = cvt_pk_bf16(v[j][6], v[j][7]);
            *(u32x4*)(ho + c) = o;
        }
        if (lane == 0) ((float*)(a.ws + (dry ? WS_DUMSSQ : WS_RSTD)))[row] = rstd;
    } else if (row < NREAL) {
        float* op = a.out + (size_t)row * D;
#pragma unroll
        for (int j = 0; j < 2; ++j) { const int c = 8 * lane + 512 * j; const f32x4 g0 = *(const f32x4*)(a.in[5] + c), g1 = *(const f32x4*)(a.in[5] + c + 4);
            f32x4 o0, o1; o0[0] = v[j][0] * rstd * g0[0]; o0[1] = v[j][1] * rstd * g0[1]; o0[2] = v[j][2] * rstd * g0[2]; o0[3] = v[j][3] * rstd * g0[3];
            o1[0] = v[j][4] * rstd * g1[0]; o1[1] = v[j][5] * rstd * g1[1]; o1[2] = v[j][6] * rstd * g1[2]; o1[3] = v[j][7] * rstd * g1[3];
            *(f32x4*)(op + c) = o0; *(f32x4*)(op + c + 4) = o1; }
    }
}
__device__ __forceinline__ void phase_combine(CArgs& a, int layer, bool dry) {
    const int lane = opaque_tid() & 63, gw = opaque_bid() * 8 + (opaque_tid() >> 6);
    const bf16_t* H = (const bf16_t*)(a.ws + WS_H); const bf16_t* YB = (const bf16_t*)(a.ws + WS_YB);
    for (int row = gw; row < RT; row += GRID * 16) {
        const int row1 = row + GRID * 8; const bool two = row1 < RT;
        u32x4 wa[2][3], wb[2][3];
        comb_load(H, YB, row, lane, wa);
        if (two) comb_load(H, YB, row1, lane, wb);
        comb_finish(a, layer, dry, row, lane, wa);
        if (two) comb_finish(a, layer, dry, row1, lane, wb);
    }
}

enum { PH_PREP = 0, PH_S5, PH_GLU, PH_ROUTE, PH_G1, PH_G2, PH_COMB, PH_KVQ, PH_ATT, PH_OPROJ, PH_QG };
constexpr int NPH = 27;
__constant__ int c_prog[NPH][2] = {
    {PH_PREP, 0},
    {PH_S5, 0}, {PH_GLU, 0}, {PH_ROUTE, 0}, {PH_G1, 0}, {PH_G2, 0}, {PH_COMB, 0},
    {PH_S5, 1}, {PH_GLU, 1}, {PH_ROUTE, 1}, {PH_G1, 1}, {PH_G2, 1}, {PH_COMB, 1},
    {PH_KVQ, 2}, {PH_ATT, 2}, {PH_OPROJ, 2}, {PH_ROUTE, 2}, {PH_G1, 2}, {PH_G2, 2}, {PH_COMB, 2},
    {PH_QG, 3}, {PH_ATT, 3}, {PH_OPROJ, 3}, {PH_ROUTE, 3}, {PH_G1, 3}, {PH_G2, 3}, {PH_COMB, 3},
};

__global__ void __launch_bounds__(NTHREADS) yoco_fwd(Args a) {
    extern __shared__ __attribute__((aligned(16))) unsigned char smem_raw[];
    LAS unsigned char* lds = (LAS unsigned char*)smem_raw;
    volatile LAS unsigned* const st = (volatile LAS unsigned*)(lds + LDS_BYTES - 64);
    if (threadIdx.x < 16) st[threadIdx.x] = 0u;
    __syncthreads();
    if (a.ph_hi - a.ph_lo > 1) xcd_barrier_post((unsigned*)(a.ws + WS_CTL) + CW_BAR);
    CArgs* const kp = (CArgs*)__builtin_amdgcn_kernarg_segment_ptr();
#if defined(PROBE_TMASK)
    unsigned long long t_acc = 0ull;
#endif
    for (int ph = a.ph_lo; ph < a.ph_hi; ++ph) {
        const int type = c_prog[ph][0], layer = c_prog[ph][1];
#if defined(PROBE_TMASK)
        const unsigned long long t_ph0 = __builtin_amdgcn_s_memrealtime();
#endif
        const int reps = type == a.rep_type ? a.rep_n : 0;
        for (int r = 0; r <= reps; ++r) {
            const bool dry = r > 0;
            CArgs* lp = kp; asm volatile("" : "+s"(lp));
            CArgs& la = *lp;
            GemmDesc g; g.f8 = 0; g.arow = D * 2; bool is_gemm = true; int conv_budget = 0, conv_limit = 0;
            BgConv bg{lp, st};
            switch (type) {
                case PH_GLU: phase_glu(la, layer, dry, lds, g); break;
                case PH_G1: if (phase_moe1(la, layer, lds, g)) { conv_budget = 18; conv_limit = (layer + 2) * 32 * NWT_E; } break;
                case PH_G2: if (phase_moe2(la, layer, lds, g)) { conv_budget = 12; conv_limit = (layer + 3) * 32 * NWT_E; } break;
                case PH_KVQ: case PH_QG: phase_kvq_q(la, type == PH_QG ? 1 : 0, lds, g); break;
                case PH_OPROJ: phase_oproj(la, layer - 2, dry, lds, g); break;
                default: is_gemm = false; break;
            }
            g.skip_epi = 0;
#if defined(PROBE_SKIPEPI)
            if (dry) g.skip_epi = 1;
#endif
            if (is_gemm) { if (g.f8) gemm_run<true>(lds, g); else gemm_run<false>(lds, g); if (conv_budget) bg.run_until(conv_limit < NWT_MOE ? conv_limit : NWT_MOE, conv_budget); }
            else switch (type) {
                case PH_PREP: phase_prep(la, lds); break;
                case PH_S5: phase_s5(la, layer, lds); break;
                case PH_ROUTE: phase_route(la, layer, dry, lds); break;
                case PH_COMB: phase_combine(la, layer, dry); break;
                default: phase_attn(la, layer - 2, lds); break;
            }
            if (type == PH_ROUTE && !dry) { bg.run_until((layer + 1) * 32 * NWT_E, 1 << 20); bg.drain_others((layer + 1) * 32 * NWT_E); }
            if (r < reps || ph + 1 < a.ph_hi) { if (a.ph_hi - a.ph_lo > 1) xcd_barrier((unsigned*)(la.ws + WS_CTL) + CW_BAR, st, bg); }
        }
#if defined(PROBE_TMASK)
        if ((PROBE_TMASK >> type) & 1) t_acc += __builtin_amdgcn_s_memrealtime() - t_ph0;
#endif
        if (a.rep_type == 100 && ph + 1 < a.ph_hi) for (int r = 0; r < a.rep_n; ++r) { BgConv bg{kp, st}; xcd_barrier((unsigned*)(a.ws + WS_CTL) + CW_BAR, st, bg); }
    }
#if defined(PROBE_TMASK)
    if (blockIdx.x == 0) { const unsigned long long t0 = __builtin_amdgcn_s_memrealtime(); while (__builtin_amdgcn_s_memrealtime() - t0 < 8ull * t_acc) __builtin_amdgcn_s_sleep(32); }
#endif
}

extern "C" void kernel_launch(void* const* d_in, const int* in_sizes, int n_in, void* d_out, int out_size, void* d_ws, size_t ws_size, hipStream_t stream) {
    static int ready = 0;
    if (ready == 0) {
        if (n_in != 29 || ws_size < WS_END) { fprintf(stderr, "kernel_launch: expected 29 inputs and >= %zu bytes of workspace (got %d, %zu)\n", (size_t)WS_END, n_in, ws_size); ready = -1; return; }
        if (hipFuncSetAttribute((const void*)yoco_fwd, hipFuncAttributeMaxDynamicSharedMemorySize, LDS_BYTES) != hipSuccess) { fprintf(stderr, "kernel_launch: hipFuncSetAttribute failed\n"); ready = -1; return; }
        ready = 1;
    }
    if (ready < 0) return;
    (void)hipMemsetAsync((char*)d_ws + WS_CTL, 0, CTL_BYTES, stream);
    Args a{};
    for (int i = 0; i < 29; ++i) a.in[i] = (const float*)d_in[i];
    a.out = (float*)d_out; a.ws = (unsigned char*)d_ws;
#if defined(PROBE_TYPE)
    a.rep_type = PROBE_TYPE; a.rep_n = PROBE_N;
#else
    a.rep_type = -1; a.rep_n = 0;
#endif
#if MK_N_LAUNCHES == 1
    a.ph_lo = 0; a.ph_hi = NPH;
    hipLaunchKernelGGL(yoco_fwd, dim3(GRID), dim3(NTHREADS), LDS_BYTES, stream, a);
#else
    for (int ph = 0; ph < NPH; ++ph) { a.ph_lo = ph; a.ph_hi = ph + 1; hipLaunchKernelGGL(yoco_fwd, dim3(GRID), dim3(NTHREADS), LDS_BYTES, stream, a); }
#endif
}
```

```cpp
#include <hip/hip_runtime.h>
#include <cstdio>
#include <cstdint>

#ifndef MK_N_LAUNCHES
#define MK_N_LAUNCHES 1
#endif

#define LAS __attribute__((address_space(3)))
typedef unsigned short bf16_t;
typedef short bf16x8 __attribute__((ext_vector_type(8)));
typedef float f32x4 __attribute__((ext_vector_type(4)));
typedef float f32x2 __attribute__((ext_vector_type(2)));
typedef unsigned u32x4 __attribute__((ext_vector_type(4)));
typedef unsigned u32x2 __attribute__((ext_vector_type(2)));

constexpr int D = 1024, NB = 8, SEQ = 2048, NMETA = 16, LT = SEQ + NMETA  ;
constexpr int NREAL = NB * SEQ  , RT = NREAL + NMETA  , RPAD = 16640;
constexpr int NEXP = 32, DEXP = 512, NGRP = 4, EPG = 8;
constexpr int NTHREADS = 512, GRID = 256;
constexpr int LDS_BYTES = 155648;
constexpr float RMS_EPS = 1e-6f;
__device__ __forceinline__ int row_of(int b, int pos) { return pos < NMETA ? NREAL + pos : b * SEQ + (pos - NMETA); }

constexpr size_t al256(size_t x) { return (x + 255) & ~(size_t)255; }
constexpr size_t WS_CTL = 0;
constexpr size_t CTL_BYTES = 32768;
constexpr int CW_BAR = 0;
constexpr int CW_CNT = 4096;
constexpr int CW_DUMCNT = 4096 + 256;
constexpr int CW_BGC = 6144;
constexpr size_t WS_H = WS_CTL + CTL_BYTES;
constexpr size_t WS_RSTD = WS_H + al256((size_t)RPAD * D * 2);
constexpr size_t WS_LRS = WS_RSTD + al256((size_t)RPAD * 4);
constexpr size_t WS_U = WS_LRS + al256((size_t)NEXP * RT * 4);
constexpr size_t WS_Z = WS_U + 256;
constexpr size_t WS_XN = WS_Z + al256((size_t)RPAD * D * 2);
constexpr size_t WS_Q = WS_XN + 256;
constexpr size_t WS_K = WS_Q + al256((size_t)RPAD * D * 2);
constexpr size_t WS_VT = WS_K + al256((size_t)RPAD * 256 * 2);
constexpr size_t VT_META = (size_t)NB * 256 * SEQ;
constexpr size_t WS_LTOK = WS_VT + al256((size_t)RPAD * 256 * 2);
constexpr size_t WS_LGATE = WS_LTOK + al256((size_t)NEXP * RT * 4);
constexpr int HB_ROWS = 2 * RT + NEXP * 256;
constexpr size_t WS_HB = WS_LGATE + al256((size_t)NEXP * RT * 4);
constexpr size_t WS_YB = WS_HB + al256((size_t)HB_ROWS * DEXP * 2);
constexpr size_t TBL_K = 0, TBL_M = 16 * 1024, TBL_N = TBL_M + 64 * 1024, TBL_A16 = TBL_N + 64 * 1024, TBL_STRIDE = TBL_A16 + 512;
constexpr size_t WS_TBL = WS_YB + al256((size_t)RT * 2 * D * 2);
constexpr size_t WS_WGLU = WS_TBL + al256((size_t)2 * 64 * TBL_STRIDE);
constexpr size_t WS_WKVQ = WS_WGLU + (size_t)2 * 2048 * 1024 * 2;
constexpr size_t WS_WQ1 = WS_WKVQ + (size_t)1536 * 1024 * 2;
constexpr size_t WS_WO = WS_WQ1 + (size_t)1024 * 1024 * 2;
constexpr size_t WS_W1 = WS_WO + (size_t)2 * 1024 * 1024 * 2;
constexpr size_t WS_W2 = WS_W1 + (size_t)4 * 32 * 1024 * 1024 * 2;
constexpr size_t WS_RW = WS_W2 + (size_t)4 * 32 * 1024 * 512 * 2;
constexpr size_t WS_DUMH = WS_RW + (size_t)4 * 98304;
constexpr size_t WS_DUMSSQ = WS_DUMH + al256((size_t)RT * D * 4);
constexpr size_t WS_DUMLT = WS_DUMSSQ + al256((size_t)RT * 32 * 4);
constexpr size_t WS_DUMLG = WS_DUMLT + al256((size_t)NEXP * RT * 4);
#if defined(PROBE_TYPE)
constexpr size_t WS_END = WS_DUMLG + al256((size_t)NEXP * RT * 4);
#else
constexpr size_t WS_END = WS_DUMH;
#endif

struct Args {
    const float* in[29];
    float* out;
    unsigned char* ws;
    int ph_lo, ph_hi;
    int rep_type, rep_n;
};
typedef const __attribute__((address_space(4))) Args CArgs;

__device__ __forceinline__ unsigned cvt_pk_bf16(float lo, float hi) { unsigned r; asm volatile("v_cvt_pk_bf16_f32 %0, %1, %2" : "=v"(r) : "v"(lo), "v"(hi)); return r; }
__device__ __forceinline__ float bf16_lo(unsigned w) { return __uint_as_float(w << 16); }
__device__ __forceinline__ float bf16_hi(unsigned w) { return __uint_as_float(w & 0xffff0000u); }
__device__ __forceinline__ float fast_rcp(float x) { return __builtin_amdgcn_rcpf(x); }
__device__ __forceinline__ float fast_exp(float x) { return __builtin_amdgcn_exp2f(x * 1.4426950408889634f); }
__device__ __forceinline__ float sigmoidf_(float x) { return fast_rcp(1.0f + fast_exp(-x)); }
__device__ __forceinline__ float gelu_tanh(float x) { const float v = 0.7978845608028654f * (x + 0.044715f * x * x * x); return x * sigmoidf_(2.0f * v); }
__device__ __forceinline__ bf16x8 as_bf16x8(u32x4 v) { return __builtin_bit_cast(bf16x8, v); }
__device__ __forceinline__ f32x4 mfma16(bf16x8 a, bf16x8 b, f32x4 c) { return __builtin_amdgcn_mfma_f32_16x16x32_bf16(a, b, c, 0, 0, 0); }
constexpr int F8_LAYER = 1;
constexpr float F8_WSCALE = 64.f, F8_HSCALE = 8.f;
typedef int i32x8 __attribute__((ext_vector_type(8)));
typedef int i32x4 __attribute__((ext_vector_type(4)));
__device__ __forceinline__ unsigned pk4_fp8(float a, float b, float c, float d) {
    int w = 0;
    w = __builtin_amdgcn_cvt_pk_fp8_f32(__builtin_amdgcn_fmed3f(a, -448.f, 448.f), __builtin_amdgcn_fmed3f(b, -448.f, 448.f), w, false);
    w = __builtin_amdgcn_cvt_pk_fp8_f32(__builtin_amdgcn_fmed3f(c, -448.f, 448.f), __builtin_amdgcn_fmed3f(d, -448.f, 448.f), w, true);
    return (unsigned)w;
}
__device__ __forceinline__ f32x4 mfma8(bf16x8 a0, bf16x8 a1, bf16x8 b0, bf16x8 b1, f32x4 c) {
    const i32x8 a = __builtin_shufflevector(__builtin_bit_cast(i32x4, a0), __builtin_bit_cast(i32x4, a1), 0, 1, 2, 3, 4, 5, 6, 7);
    const i32x8 b = __builtin_shufflevector(__builtin_bit_cast(i32x4, b0), __builtin_bit_cast(i32x4, b1), 0, 1, 2, 3, 4, 5, 6, 7);
    return __builtin_amdgcn_mfma_scale_f32_16x16x128_f8f6f4(a, b, c, 0, 0, 0, 0, 0, 0);
}
__device__ __forceinline__ float xor32_sum(float v) { auto r = __builtin_amdgcn_permlane32_swap(__float_as_uint(v), __float_as_uint(v), false, false); return __uint_as_float(r[0]) + __uint_as_float(r[1]); }
__device__ __forceinline__ float xor16_sum(float v) { auto r = __builtin_amdgcn_permlane16_swap(__float_as_uint(v), __float_as_uint(v), false, false); return __uint_as_float(r[0]) + __uint_as_float(r[1]); }
__device__ __forceinline__ float xor32_max(float v) { auto r = __builtin_amdgcn_permlane32_swap(__float_as_uint(v), __float_as_uint(v), false, false); return fmaxf(__uint_as_float(r[0]), __uint_as_float(r[1])); }
__device__ __forceinline__ float xor16_max(float v) { auto r = __builtin_amdgcn_permlane16_swap(__float_as_uint(v), __float_as_uint(v), false, false); return fmaxf(__uint_as_float(r[0]), __uint_as_float(r[1])); }
__device__ __forceinline__ float quad_sum(float v) { return xor32_sum(xor16_sum(v)); }
template <int X> __device__ __forceinline__ float swz_xor(float v) { return __uint_as_float((unsigned)__builtin_amdgcn_ds_swizzle((int)__float_as_uint(v), (X << 10) | 0x1f)); }
__device__ __forceinline__ float wave_sum(float v) {
    v += swz_xor<1>(v); v += swz_xor<2>(v); v += swz_xor<4>(v); v += swz_xor<8>(v);
    return quad_sum(v);
}
__device__ __forceinline__ int opaque_bid() { int b = blockIdx.x; asm volatile("" : "+s"(b)); return b; }
__device__ __forceinline__ int opaque_tid() { int t = threadIdx.x; asm volatile("" : "+v"(t)); return t; }

#define XB_TMO      128
#define XB_XCNT(j)  (256  + 64 * (j))
#define XB_XSUB(j)  (1280 + 64 * (j))
#define XB_XGEN(j)  (2304 + 64 * (j))
#define XB_TOP      3328
#define XB_TOPGEN   3392
#define XCD_BAR_WORDS 3456
#define XB_SPIN_CAP (1u << 22)
__device__ __forceinline__ unsigned xb_ld(unsigned* p)              { return __hip_atomic_load(p, __ATOMIC_RELAXED, __HIP_MEMORY_SCOPE_AGENT); }
__device__ __forceinline__ unsigned xb_add(unsigned* p, unsigned v) { return __hip_atomic_fetch_add(p, v, __ATOMIC_RELAXED, __HIP_MEMORY_SCOPE_AGENT); }
__device__ __forceinline__ unsigned xb_xcc_id() { return (unsigned)__builtin_amdgcn_s_getreg((3 << 11) | 20) & 0xFu; }
#define XB_SPIN(cond, bar) do { unsigned _sp = 0; while (cond) { __builtin_amdgcn_s_sleep(1); \
    if ((++_sp & 255u) == 0u) { if (xb_ld(&(bar)[XB_TMO])) break; if (_sp > XB_SPIN_CAP) { atomicAdd(&(bar)[XB_TMO], 1u); break; } } } } while (0)
__device__ __forceinline__ void xcd_barrier_post(unsigned* bar) { if (threadIdx.x == 0) (void)xb_add(&bar[XB_XCNT(xb_xcc_id())], 1u); }
__device__ __forceinline__ void xcd_barrier_complete(unsigned* bar, unsigned x, unsigned& nloc, unsigned& nx) {
    const unsigned G = gridDim.x;
    unsigned sum, cnt, mine, sp = 0u;
    for (;;) {
        sum = 0u; cnt = 0u; mine = 0u;
#pragma unroll
        for (unsigned j = 0; j < 16; ++j) { const unsigned c = xb_ld(&bar[XB_XCNT(j)]); sum += c; cnt += (c > 0u) ? 1u : 0u; mine = (j == x) ? c : mine; }
        if (sum == G) break;
        __builtin_amdgcn_s_sleep(1);
        if ((++sp & 255u) == 0u) { if (xb_ld(&bar[XB_TMO])) break; if (sp > XB_SPIN_CAP) { atomicAdd(&bar[XB_TMO], 1u); break; } }
    }
    nloc = mine > 0u ? mine : 1u; nx = cnt > 0u ? cnt : 1u;
}
template <class BG>
__device__ __forceinline__ void xcd_barrier(unsigned* bar_, volatile LAS unsigned* st, BG& bg) {
    asm volatile("s_waitcnt vmcnt(0)" ::: "memory");
    __syncthreads();
    const unsigned flag0 = st[2];
    if (threadIdx.x >= 64) {
        while (st[2] == flag0) bg.step();
        bg.park();
    } else if (threadIdx.x == 0) {
        unsigned* bar = bar_; asm volatile("" : "+v"(bar));
        const unsigned bx = xb_xcc_id();
        __builtin_amdgcn_s_waitcnt(0);
        unsigned nloc = st[0], nx = st[1];
        if (nloc == 0u) { xcd_barrier_complete(bar, bx, nloc, nx); st[0] = nloc; st[1] = nx; }
        const unsigned old = xb_add(&bar[XB_XSUB(bx)], 1u);
        const unsigned gen = old / nloc;
        if (old + 1u == (gen + 1u) * nloc) {
            __builtin_amdgcn_fence(__ATOMIC_RELEASE, "agent");
            asm volatile("s_waitcnt vmcnt(0)" ::: "memory");
            const unsigned og = xb_add(&bar[XB_TOP], 1u);
            const unsigned tg = og / nx;
            if (og + 1u == (tg + 1u) * nx) xb_add(&bar[XB_TOPGEN], 1u);
            else XB_SPIN(xb_ld(&bar[XB_TOPGEN]) == tg, bar);
            __builtin_amdgcn_fence(__ATOMIC_ACQUIRE, "agent");
            xb_add(&bar[XB_XGEN(bx)], 1u);
            asm volatile("s_waitcnt vmcnt(0)" ::: "memory");
        } else {
            XB_SPIN(xb_ld(&bar[XB_XGEN(bx)]) == gen, bar);
            __builtin_amdgcn_fence(__ATOMIC_ACQUIRE, "agent");
            asm volatile("s_waitcnt vmcnt(0)" ::: "memory");
        }
        st[2] = flag0 + 1u;
    }
    __syncthreads();
}
constexpr int BM = 256, BK = 64, HALF = 128, HTB = HALF * BK * 2, STAGE_BYTES = 8 * HTB, NXCD = 8, WGM = 8;
constexpr int LDS_TABO = STAGE_BYTES;
constexpr int LDS_TABT = LDS_TABO + 3072;
constexpr int LDS_TABG = LDS_TABT + 3072;
constexpr int LDS_SH = LDS_TABG + 3072;
__host__ __device__ __forceinline__ int lds_byte(int r, int c) { const int st = (r >> 4) * 2 + (c >> 5), rr = r & 15, cc = c & 31, ob = rr * 64 + cc * 2; return st * 1024 + (ob ^ (((ob >> 9) & 1) << 5)); }
__host__ __device__ __forceinline__ void stage_rc(int b, int& R, int& C) { const int st = b / 1024, sb = b % 1024, swz = sb ^ (((sb >> 9) & 1) << 5); R = (st >> 1) * 16 + swz / 64; C = (st & 1) * 32 + (swz % 64) / 2; }
__host__ __device__ __forceinline__ int perm32(int rho) { const int n = rho >> 4, i = rho & 15; return 8 * (i >> 2) + 4 * n + (i & 3); }
struct Unit { int pm, pn, e, slot; };
__device__ __forceinline__ int xcd_chunk(int wgid, int nwg) { const int q = nwg / NXCD, r = nwg % NXCD, xcd = wgid % NXCD, off = wgid / NXCD; return (xcd < r ? xcd * (q + 1) : r * (q + 1) + (xcd - r) * q) + off; }

enum { EPI_GLU = 0, EPI_OPROJ, EPI_KVQ, EPI_MOE1, EPI_MOE2 };
struct GemmDesc {
    int kind, K, perm, gather, moe, skip_epi, stride, vb;
    int f8, arow;
    int nM, nN, nwg, npn; const char* A; const char* Bt; size_t tstepA, tstepB, wstride; const int* cnt; const int* LTOK; const float* LGATE;
    const float* res32; const bf16_t* res16; bf16_t* Hout; const float* bias; const float* bias2; const float* rstd; bf16_t* O1; bf16_t* O2; bf16_t* O3; int jq, cbase;
};
__device__ __forceinline__ bool order_next(const GemmDesc& g, LAS unsigned char* lds, int i, Unit& u) {
    const int L = i * g.stride + g.vb; if (L >= g.nwg) return false;
    const int wgid = xcd_chunk(L, g.nwg);
    if (g.moe) {
        const LAS int* sh = (const LAS int*)(lds + LDS_SH);
        int e = 0;
        for (int q = 1; q < 32; ++q) if (wgid >= g.npn * sh[q]) e = q;
        const int nmt = sh[e + 1] - sh[e], local = wgid - g.npn * sh[e];
        u.pn = local / nmt; u.pm = sh[e] + (local - u.pn * nmt); u.e = e; u.slot = i % 3;
    } else {
        const int nig = WGM * g.nN, gid = wgid / nig, fm = gid * WGM, gsz = (g.nM - fm) < WGM ? (g.nM - fm) : WGM;
        u.pm = fm + ((wgid % nig) % gsz); u.pn = (wgid % nig) / gsz; u.e = 0; u.slot = 0;
    }
    return true;
}
__device__ __forceinline__ const char* order_a(const GemmDesc& g, const Unit& u) { return g.gather ? g.A : g.A + (size_t)u.pm * g.tstepA; }
__device__ __forceinline__ const char* order_b(const GemmDesc& g, const Unit& u) { return g.Bt + (size_t)u.e * g.wstride + (size_t)u.pn * g.tstepB; }
__device__ __forceinline__ void order_fill(const GemmDesc& g, LAS unsigned char* lds, const Unit& u) {
    const int t = opaque_tid();
    if (t < 256) {
        const LAS int* sh = (const LAS int*)(lds + LDS_SH);
        const int ne = g.cnt[u.e], idx = (u.pm - sh[u.e]) * 256 + t, ci = idx < ne ? idx : ne - 1;
        const int v = g.LTOK[(size_t)u.e * RT + ci];
        ((LAS unsigned*)(lds + LDS_TABO))[u.slot * 256 + t] = (unsigned)(v & 0x3fffffff) * (unsigned)g.arow;
        ((LAS int*)(lds + LDS_TABT))[u.slot * 256 + t] = idx < ne ? v : -1;
        ((LAS float*)(lds + LDS_TABG))[u.slot * 256 + t] = g.LGATE[(size_t)u.e * RT + ci];
    }
}
__device__ __forceinline__ void gemm_epilogue(const GemmDesc& g, LAS unsigned char* lds, const f32x4 (&acc)[2][2][4][2], const Unit& u, int wr, int wc, int fr, int fq);

template <bool F8>
__device__ __forceinline__ void gemm_run(LAS unsigned char* lds, const GemmDesc& g) {
    const int tid = opaque_tid(), wid = __builtin_amdgcn_readfirstlane(tid >> 6), lane = tid & 63, wr = wid >> 2, wc = wid & 3, fr = lane & 15, fq = lane >> 4;
    const int K = g.K, nt = K / BK;
    unsigned voffB[2], go[2][2];
    const size_t kstep = (size_t)(BK * 2);
    const size_t hstep = (size_t)HALF * K * 2;
#pragma unroll
    for (int i = 0; i < 2; ++i) { int R, C; stage_rc(tid * 16 + i * 8192, R, C); const int Rb = g.perm ? ((R & ~31) + perm32(R & 31)) : R;
        voffB[i] = (unsigned)(Rb * K + C) * 2u; go[0][i] = (unsigned)(R * K + C) * 2u; go[1][i] = go[0][i] + (unsigned)hstep; }
    const unsigned ldsw = (unsigned)wid * 1024u;
    const int aoff = lds_byte(wr * 64 + fr, fq * 8), boff = lds_byte(wc * 32 + fr, fq * 8);
#define PG8_SA(b, h) (((b) * 2 + (h)) * HTB)
#define PG8_SB(b, h) ((4 + (b) * 2 + (h)) * HTB)
#define PG8_GLDS(src, dstoff) __builtin_amdgcn_global_load_lds((const unsigned*)(src), (LAS unsigned*)(lds + (dstoff)), 16, 0, 0)
#define PG8_STAGE_B(bufoff, gbase) do { _Pragma("unroll") for (int _i = 0; _i < 2; ++_i) PG8_GLDS((const char*)(gbase) + voffB[_i], (bufoff) + ldsw + _i * 8192); } while (0)
#define PG8_GO_LOAD(tsel) do { if (g.gather) { _Pragma("unroll") for (int _i = 0; _i < 2; ++_i) { int _R, _C; stage_rc(tid * 16 + _i * 8192, _R, _C); _Pragma("unroll") for (int _h = 0; _h < 2; ++_h) \
            go[_h][_i] = *(const LAS unsigned*)(lds + LDS_TABO + (tsel) * 1024 + _h * 512 + _R * 4) + (unsigned)(_C * 2); } } } while (0)
#define PG8_STAGE_A(bufoff, gbase, kt, h) do { _Pragma("unroll") for (int _i = 0; _i < 2; ++_i) PG8_GLDS((const char*)(gbase) + (size_t)(kt) * kstep + go[h][_i], (bufoff) + ldsw + _i * 8192); } while (0)
#define PG8_STAGE_AN(bufoff, gbase, tsel, kt, h) do { if (last && g.gather) { _Pragma("unroll") for (int _i = 0; _i < 2; ++_i) { int _R, _C; stage_rc(tid * 16 + _i * 8192, _R, _C); \
            const unsigned _o = *(const LAS unsigned*)(lds + LDS_TABO + (tsel) * 1024 + (h) * 512 + _R * 4) + (unsigned)(_C * 2); PG8_GLDS((const char*)(gbase) + (size_t)(kt) * kstep + _o, (bufoff) + ldsw + _i * 8192); } \
        } else PG8_STAGE_A(bufoff, gbase, kt, h); } while (0)
#define PG8_LDA(dst, b, h) do { _Pragma("unroll") for (int m = 0; m < 4; ++m) _Pragma("unroll") for (int k = 0; k < 2; ++k) dst[m][k] = *(const LAS bf16x8*)(lds + PG8_SA(b, h) + aoff + m * 2048 + k * 1024); } while (0)
#define PG8_LDB(dst, b, h) do { _Pragma("unroll") for (int n = 0; n < 2; ++n) _Pragma("unroll") for (int k = 0; k < 2; ++k) dst[n][k] = *(const LAS bf16x8*)(lds + PG8_SB(b, h) + boff + n * 2048 + k * 1024); } while (0)
#define PG8_MMA(ai, bj, At, Bt) do { __builtin_amdgcn_s_setprio(1); if constexpr (F8) { _Pragma("unroll") for (int m = 0; m < 4; ++m) _Pragma("unroll") for (int n = 0; n < 2; ++n) \
        acc[ai][bj][m][n] = mfma8(Bt[n][0], Bt[n][1], At[m][0], At[m][1], acc[ai][bj][m][n]); } else { _Pragma("unroll") for (int m = 0; m < 4; ++m) _Pragma("unroll") for (int n = 0; n < 2; ++n) _Pragma("unroll") for (int k = 0; k < 2; ++k) \
        acc[ai][bj][m][n] = __builtin_amdgcn_mfma_f32_16x16x32_bf16(Bt[n][k], At[m][k], acc[ai][bj][m][n], 0, 0, 0); } __builtin_amdgcn_s_setprio(0); } while (0)
#define PG8_WAIT_V(n) asm volatile("s_waitcnt vmcnt(" #n ")" ::: "memory")
#define PG8_WAIT_L(n) asm volatile("s_waitcnt lgkmcnt(" #n ")" ::: "memory")
#define PG8_BAR __builtin_amdgcn_s_barrier()
#define PG8_SCHED __builtin_amdgcn_sched_barrier(0)
    Unit cur, nxt; int ui = 0;
    if (!order_next(g, lds, 0, cur)) return;
    f32x4 acc[2][2][4][2];
#pragma unroll
    for (int a = 0; a < 2; ++a)
#pragma unroll
        for (int b = 0; b < 2; ++b)
#pragma unroll
            for (int m = 0; m < 4; ++m)
#pragma unroll
                for (int n = 0; n < 2; ++n) acc[a][b][m][n] = (f32x4){0.f, 0.f, 0.f, 0.f};
    bf16x8 At[4][2], B0[2][2], B1[2][2];
    if (g.moe) { order_fill(g, lds, cur); __syncthreads(); PG8_GO_LOAD(cur.slot); }
    const char* cA = order_a(g, cur); const char* cB = order_b(g, cur); int cT = cur.slot;
    PG8_STAGE_B(PG8_SB(0, 0), cB); PG8_STAGE_B(PG8_SB(0, 1), cB + hstep); PG8_STAGE_A(PG8_SA(0, 0), cA, 0, 0); PG8_STAGE_A(PG8_SA(0, 1), cA, 0, 1);
    if (wr == 1) PG8_BAR;
    PG8_WAIT_V(2); PG8_BAR;
    PG8_STAGE_B(PG8_SB(1, 0), cB + kstep); PG8_STAGE_A(PG8_SA(1, 0), cA, 1, 0); PG8_STAGE_B(PG8_SB(1, 1), cB + hstep + kstep);
    PG8_WAIT_V(6); PG8_BAR;
    for (;;) {
        const bool has_next = order_next(g, lds, ui + 1, nxt);
        if (g.moe && has_next) order_fill(g, lds, nxt);
        const char* nA = has_next ? order_a(g, nxt) : cA; const char* nB = has_next ? order_b(g, nxt) : cB; const int nT = has_next ? nxt.slot : cT;
        for (int t = 0; t < nt; t += 2) {
            const bool last = (t == nt - 2);
            const char* a2b = last ? nA : cA; const int a2k = last ? 0 : t + 2, a3k = a2k + 1;
            const char* b2 = last ? nB : cB + (size_t)(t + 2) * kstep; const char* b3 = b2 + kstep;
            PG8_LDB(B0, 0, 0); PG8_LDB(B1, 0, 1); PG8_SCHED; PG8_LDA(At, 0, 0); PG8_STAGE_A(PG8_SA(1, 1), cA, t + 1, 1);
            PG8_WAIT_V(8); PG8_WAIT_L(0); PG8_BAR; PG8_MMA(0, 0, At, B0); PG8_MMA(0, 1, At, B1); PG8_BAR; PG8_SCHED;
            PG8_LDA(At, 0, 1); PG8_STAGE_B(PG8_SB(0, 0), b2); PG8_STAGE_B(PG8_SB(0, 1), b2 + hstep); PG8_STAGE_AN(PG8_SA(0, 0), a2b, nT, a2k, 0);
            PG8_WAIT_V(8); PG8_WAIT_L(0); PG8_BAR; PG8_MMA(1, 0, At, B0); PG8_MMA(1, 1, At, B1); PG8_BAR; PG8_SCHED;
            PG8_LDB(B0, 1, 0); PG8_LDB(B1, 1, 1); PG8_SCHED; PG8_LDA(At, 1, 0); PG8_STAGE_AN(PG8_SA(0, 1), a2b, nT, a2k, 1);
            PG8_WAIT_V(8); PG8_WAIT_L(0); PG8_BAR; PG8_MMA(0, 0, At, B0); PG8_MMA(0, 1, At, B1); PG8_BAR; PG8_SCHED;
            PG8_LDA(At, 1, 1); PG8_STAGE_B(PG8_SB(1, 0), b3); PG8_STAGE_B(PG8_SB(1, 1), b3 + hstep); PG8_STAGE_AN(PG8_SA(1, 0), a2b, nT, a3k, 0);
            PG8_WAIT_V(8); PG8_WAIT_L(0); PG8_BAR; PG8_MMA(1, 0, At, B0); PG8_MMA(1, 1, At, B1); PG8_BAR; PG8_SCHED;
        }
        if (wr == 0) PG8_BAR;
        if (!g.skip_epi) gemm_epilogue(g, lds, acc, cur, wr, wc, fr, fq);
        if (!has_next) break;
#pragma unroll
        for (int a = 0; a < 2; ++a)
#pragma unroll
            for (int b = 0; b < 2; ++b)
#pragma unroll
                for (int m = 0; m < 4; ++m)
#pragma unroll
                    for (int n = 0; n < 2; ++n) acc[a][b][m][n] = (f32x4){0.f, 0.f, 0.f, 0.f};
        cur = nxt; cA = nA; cB = nB; cT = nT; ++ui;
        PG8_GO_LOAD(cT);
        if (wr == 1) PG8_BAR;
    }
    PG8_WAIT_V(0);
    PG8_BAR;
#undef PG8_SA
#undef PG8_SB
#undef PG8_GLDS
#undef PG8_STAGE_A
#undef PG8_STAGE_AN
#undef PG8_GO_LOAD
#undef PG8_STAGE_B
#undef PG8_LDA
#undef PG8_LDB
#undef PG8_MMA
#undef PG8_WAIT_V
#undef PG8_WAIT_L
#undef PG8_BAR
#undef PG8_SCHED
}
__device__ __forceinline__ f32x4 meta_dot(const bf16_t* Am, const bf16_t* Brow0, int K, int fr, int fq) {
    f32x4 acc = {0.f, 0.f, 0.f, 0.f};
    const bf16_t* ap = Am + (size_t)fr * K + 8 * fq; const bf16_t* bp = Brow0 + (size_t)fr * K + 8 * fq;
#pragma unroll 4
    for (int ks = 0; ks < K / 32; ++ks) acc = mfma16(as_bf16x8(*(const u32x4*)(bp + 32 * ks)), as_bf16x8(*(const u32x4*)(ap + 32 * ks)), acc);
    return acc;
}

struct ConvDesc { const float* src; const float* gain; bf16_t* dst; int ld, K, mode, kblk, nblk; };
constexpr int NWT_E = 768;
constexpr int NWT_MOE = 4 * 32 * NWT_E, NWT_DENSE = 2 * 1024 + 256 + 2 * 512 + 2 * 512;
__device__ __forceinline__ ConvDesc conv_decode(CArgs& a, int ti) {
    ConvDesc d;
    if (ti < NWT_MOE) {
        const int le = ti / NWT_E, r = ti % NWT_E, which = r >> 8, tt = r & 255, layer = le >> 5;
        if (which < 2) { d.src = a.in[26 + which] + (size_t)le * D * DEXP; d.ld = DEXP; d.K = D; d.gain = a.in[3] + (size_t)layer * D; d.dst = (bf16_t*)(a.ws + WS_W1) + (size_t)le * 1024 * 1024; d.mode = 1 + which; d.nblk = tt & 15; d.kblk = tt >> 4; }
        else { d.src = a.in[28] + (size_t)le * DEXP * D; d.ld = D; d.K = DEXP; d.gain = nullptr; d.dst = (bf16_t*)(a.ws + WS_W2) + (size_t)le * 1024 * 512; d.mode = 0; d.nblk = tt & 31; d.kblk = tt >> 5; }
    } else {
        int r = ti - NWT_MOE;
        if (r < 2048) { const int layer = r >> 10, tt = r & 1023, nb = tt & 63, half = nb >> 5;
            d.src = a.in[14] + (size_t)layer * D * 2 * D + half * D; d.ld = 2 * D; d.K = D; d.gain = nullptr; d.dst = (bf16_t*)(a.ws + WS_WGLU) + (size_t)layer * 2048 * 1024; d.mode = 1 + half; d.nblk = nb & 31; d.kblk = tt >> 6; }
        else if ((r -= 2048) < 256) { d.src = a.in[15]; d.ld = 512; d.K = D; d.gain = a.in[4]; d.dst = (bf16_t*)(a.ws + WS_WKVQ); d.mode = 0; d.nblk = r & 15; d.kblk = r >> 4; }
        else if ((r -= 256) < 1024) { const int j = r >> 9, tt = r & 511;
            d.src = a.in[17] + (size_t)j * D * D; d.ld = D; d.K = D; d.gain = a.in[2] + (size_t)(2 + j) * D; d.dst = j == 0 ? (bf16_t*)(a.ws + WS_WKVQ) + (size_t)512 * 1024 : (bf16_t*)(a.ws + WS_WQ1); d.mode = 0; d.nblk = tt & 31; d.kblk = tt >> 5; }
        else { r -= 1024; const int j = r >> 9, tt = r & 511;
            d.src = a.in[20] + (size_t)j * D * D; d.ld = D; d.K = D; d.gain = nullptr; d.dst = (bf16_t*)(a.ws + WS_WO) + (size_t)j * 1024 * 1024; d.mode = 0; d.nblk = tt & 31; d.kblk = tt >> 5; }
    }
    return d;
}
__device__ __forceinline__ void conv_load(const ConvDesc& d, int lane, f32x4 (&v)[8]) {
    const float* p = d.src + (size_t)(d.kblk * 64 + 8 * (lane >> 3)) * d.ld + d.nblk * 32 + 4 * (lane & 7);
#pragma unroll
    for (int j = 0; j < 8; ++j) v[j] = __builtin_nontemporal_load((const f32x4*)(p + (size_t)j * d.ld));
}
__device__ __forceinline__ void conv_store(const ConvDesc& d, int lane, f32x4 (&v)[8]) {
    const int k0 = d.kblk * 64 + 8 * (lane >> 3);
    if (d.gain) { const f32x4 g0 = *(const f32x4*)(d.gain + k0), g1 = *(const f32x4*)(d.gain + k0 + 4);
        v[0] *= g0[0]; v[1] *= g0[1]; v[2] *= g0[2]; v[3] *= g0[3]; v[4] *= g1[0]; v[5] *= g1[1]; v[6] *= g1[2]; v[7] *= g1[3]; }
    const int n = d.nblk * 32 + 4 * (lane & 7), row = d.mode == 0 ? n : (256 * (n >> 7) + (n & 127) + (d.mode == 2 ? 128 : 0));
    bf16_t* q = d.dst + (size_t)row * d.K + k0;
#pragma unroll
    for (int c = 0; c < 4; ++c) {
        u32x4 w; w.x = cvt_pk_bf16(v[0][c], v[1][c]); w.y = cvt_pk_bf16(v[2][c], v[3][c]); w.z = cvt_pk_bf16(v[4][c], v[5][c]); w.w = cvt_pk_bf16(v[6][c], v[7][c]);
        asm volatile("global_store_dwordx4 %0, %1, off sc1\n\ts_nop 1" :: "v"(q + (size_t)c * d.K), "v"(w) : "memory");
    }
}
constexpr int F8_T0 = F8_LAYER < 4 ? F8_LAYER * 32 * NWT_E : NWT_MOE;
__device__ __forceinline__ void conv_pair8(CArgs& a, int ti, int lane) {
    const int le = ti / NWT_E, r = ti % NWT_E, which = r >> 8, tt = r & 255, layer = le >> 5, t7 = (tt & 7) | ((tt >> 4) << 3);
    const float* src; const float* gain; unsigned char* dst; int ld, K, mode, nblk, kpair;
    if (which < 2) { src = a.in[26 + which] + (size_t)le * D * DEXP; ld = DEXP; K = D; gain = a.in[3] + (size_t)layer * D; dst = a.ws + WS_W1 + (size_t)layer * 32 * 1024 * 1024 * 2 + (size_t)(le & 31) * 1024 * 1024; mode = 1 + which; nblk = t7 & 15; kpair = t7 >> 4; }
    else { src = a.in[28] + (size_t)le * DEXP * D; ld = D; K = DEXP; gain = nullptr; dst = a.ws + WS_W2 + (size_t)layer * 32 * 1024 * 512 * 2 + (size_t)(le & 31) * 1024 * 512; mode = 0; nblk = t7 & 31; kpair = t7 >> 5; }
    const int k0 = kpair * 128 + 16 * (lane >> 3);
    const float* p = src + (size_t)k0 * ld + nblk * 32 + 4 * (lane & 7);
    f32x4 va[8], vb[8];
#pragma unroll
    for (int j = 0; j < 8; ++j) va[j] = __builtin_nontemporal_load((const f32x4*)(p + (size_t)j * ld));
#pragma unroll
    for (int j = 0; j < 8; ++j) vb[j] = __builtin_nontemporal_load((const f32x4*)(p + (size_t)(8 + j) * ld));
    if (gain) { const f32x4 g0 = *(const f32x4*)(gain + k0), g1 = *(const f32x4*)(gain + k0 + 4), g2 = *(const f32x4*)(gain + k0 + 8), g3 = *(const f32x4*)(gain + k0 + 12);
#pragma unroll
        for (int j = 0; j < 4; ++j) { va[j] *= g0[j] * F8_WSCALE; va[4 + j] *= g1[j] * F8_WSCALE; vb[j] *= g2[j] * F8_WSCALE; vb[4 + j] *= g3[j] * F8_WSCALE; } }
    else {
#pragma unroll
        for (int j = 0; j < 8; ++j) { va[j] *= F8_WSCALE; vb[j] *= F8_WSCALE; } }
    const int n = nblk * 32 + 4 * (lane & 7), row = mode == 0 ? n : (256 * (n >> 7) + (n & 127) + (mode == 2 ? 128 : 0));
    unsigned char* q = dst + (size_t)row * K + k0;
#pragma unroll
    for (int c = 0; c < 4; ++c) {
        u32x4 w; w.x = pk4_fp8(va[0][c], va[1][c], va[2][c], va[3][c]); w.y = pk4_fp8(va[4][c], va[5][c], va[6][c], va[7][c]); w.z = pk4_fp8(vb[0][c], vb[1][c], vb[2][c], vb[3][c]); w.w = pk4_fp8(vb[4][c], vb[5][c], vb[6][c], vb[7][c]);
        asm volatile("global_store_dwordx4 %0, %1, off sc1\n\ts_nop 1" :: "v"(q + (size_t)c * K), "v"(w) : "memory");
    }
}
__device__ __forceinline__ void convert_weights(CArgs& a) {
    const int lane = opaque_tid() & 63, gw = (opaque_tid() >> 6) * GRID + opaque_bid();
    for (int ti = NWT_MOE + gw; ti < NWT_MOE + NWT_DENSE; ti += GRID * 16) {
        const int t1 = ti + GRID * 8; const bool two = t1 < NWT_MOE + NWT_DENSE;
        const ConvDesc d0 = conv_decode(a, ti); ConvDesc d1 = d0; f32x4 va[8], vb[8];
        conv_load(d0, lane, va);
        if (two) { d1 = conv_decode(a, t1); conv_load(d1, lane, vb); }
        conv_store(d0, lane, va);
        if (two) conv_store(d1, lane, vb);
    }
}
struct BgConv {
    CArgs* a; volatile LAS unsigned* st;
    __device__ __forceinline__ int claim() const {
        int t = 0;
        if ((opaque_tid() & 63) == 0) { const unsigned x = xb_xcc_id() & 7u; t = (int)(xb_add((unsigned*)(a->ws + WS_CTL) + CW_BGC + 64 * x, 1u) * 16u + x); }
        return __builtin_amdgcn_readfirstlane(t);
    }
    __device__ __forceinline__ int claim_run() {
        const int t = claim(); const int lane = opaque_tid() & 63;
        if (t >= F8_T0) { if (t < NWT_MOE) conv_pair8(*a, t, lane); else if (lane == 0) st[3] = 1u; return t + 8; }
        const bool v0 = t < NWT_MOE, v1 = t + 8 < NWT_MOE;
        ConvDesc d0, d1; f32x4 va[8], vb[8];
        if (v0) { d0 = conv_decode(*a, t); conv_load(d0, lane, va); }
        if (v1) { d1 = conv_decode(*a, t + 8); conv_load(d1, lane, vb); }
        if (v0) conv_store(d0, lane, va);
        if (v1) conv_store(d1, lane, vb); else if (lane == 0) st[3] = 1u;
        return t + 8;
    }
    __device__ __forceinline__ void step() { if (st[3] == 0u) (void)claim_run(); else __builtin_amdgcn_s_sleep(32); }
    __device__ __forceinline__ void park() {}
    __device__ __forceinline__ void drain_others(int limit) {
        if (opaque_tid() < 64) {
            for (unsigned x = 0; x < 8u; ++x) {
                unsigned* ctr = (unsigned*)(a->ws + WS_CTL) + CW_BGC + 64 * x;
                while ((int)((unsigned)__builtin_amdgcn_readfirstlane(xb_ld(ctr)) * 16u + x) < limit) {
                    int t = 0; if ((opaque_tid() & 63) == 0) t = (int)(xb_add(ctr, 1u) * 16u + x);
                    t = __builtin_amdgcn_readfirstlane(t);
                    const int lane = opaque_tid() & 63;
                    if (t >= F8_T0) { if (t < NWT_MOE) conv_pair8(*a, t, lane); }
                    else { { const ConvDesc d = conv_decode(*a, t); f32x4 v[8]; conv_load(d, lane, v); conv_store(d, lane, v); }
                           { const ConvDesc d = conv_decode(*a, t + 8); f32x4 v[8]; conv_load(d, lane, v); conv_store(d, lane, v); } }
                }
            }
        }
    }
    __device__ __forceinline__ void run_until(int limit, int budget) {
        for (int n = 0; n < budget; ++n) { if (st[3] != 0u) break; if (claim_run() >= limit) break; }
    }
};

struct cplx { float re, im; };
__device__ __forceinline__ cplx cmul(cplx a, cplx b) { return {a.re * b.re - a.im * b.im, a.re * b.im + a.im * b.re}; }

__device__ __forceinline__ void hw_sincos(float x, float& sn, float& cs) { float r = x * 0.15915494309189535f; r -= floorf(r); sn = __builtin_amdgcn_sinf(r); cs = __builtin_amdgcn_cosf(r); }
__device__ __forceinline__ void s5_tables(CArgs& a, int layer, int g, int part, LAS unsigned char* lds) {
    LAS f32x2* pw = (LAS f32x2*)lds;
    LAS f32x2* bb = (LAS f32x2*)(lds + 64 * 17 * 8);
    LAS f32x2* cc = bb + 64 * 16;
    const int tid = opaque_tid();
    const float* a_re = a.in[6] + ((size_t)layer * 64 + g) * 64; const float* a_im = a.in[7] + ((size_t)layer * 64 + g) * 64;
    const float dt = expf(a.in[8][layer * 64 + g]);
    for (int idx = tid; idx < 64 * 17; idx += NTHREADS) {
        const int p = idx / 17, d = idx % 17;
        const float mag = expf(a_re[p] * dt * (float)d), ang = a_im[p] * dt * (float)d;
        float s, c; hw_sincos(ang, s, c);
        pw[idx] = (f32x2){mag * c, mag * s};
    }
    const float* b_re = a.in[9] + ((size_t)layer * 64 + g) * 1024; const float* b_im = a.in[10] + ((size_t)layer * 64 + g) * 1024;
    const float* c_re = a.in[11] + ((size_t)layer * 64 + g) * 1024; const float* c_im = a.in[12] + ((size_t)layer * 64 + g) * 1024;
    for (int idx = tid; idx < 1024; idx += NTHREADS) {
        const int p = idx >> 4;
        const float lr = a_re[p], li = a_im[p];
        const float mag = expf(lr * dt), ang = li * dt; float s, c; hw_sincos(ang, s, c);
        const float nr = mag * c - 1.0f, ni = mag * s;
        const float den = 1.0f / (lr * lr + li * li);
        const cplx f = {(nr * lr + ni * li) * den, (ni * lr - nr * li) * den};
        const cplx r = cmul(f, (cplx){b_re[idx], b_im[idx]});
        bb[idx] = (f32x2){r.re, r.im};
        cc[idx] = (f32x2){c_re[idx], c_im[idx]};
    }
    __syncthreads();
    unsigned char* tbl = a.ws + WS_TBL + ((size_t)layer * 64 + g) * TBL_STRIDE;
    for (int idx = part * 512 + tid; idx < part * 512 + 512; idx += NTHREADS) {
        const int delta = idx >> 6, l = idx & 63, c1 = l & 15, q4 = l >> 4, d = delta - (q4 >> 1);
        float v[8];
#pragma unroll
        for (int j = 0; j < 8; ++j) v[j] = 0.f;
        if (d >= 0) {
            for (int p = 0; p < 64; ++p) {
                const f32x2 cw = cc[c1 * 64 + p], pp = pw[p * 17 + d];
                const cplx t = cmul((cplx){cw.x, cw.y}, (cplx){pp.x, pp.y});
#pragma unroll
                for (int j = 0; j < 8; ++j) { const f32x2 bw = bb[p * 16 + 8 * (q4 & 1) + j]; v[j] += t.re * bw.x - t.im * bw.y; }
            }
        }
        u32x4 w; w.x = cvt_pk_bf16(v[0], v[1]); w.y = cvt_pk_bf16(v[2], v[3]); w.z = cvt_pk_bf16(v[4], v[5]); w.w = cvt_pk_bf16(v[6], v[7]);
        *(u32x4*)(tbl + TBL_K + (size_t)idx * 16) = w;
    }
    if (part == 0)
    for (int idx = tid; idx < 64 * 64; idx += NTHREADS) {
        const int f = idx >> 6, l = idx & 63, rt = f >> 3, ks = f & 7, q4 = l >> 4, rho = 16 * rt + (l & 15), p = rho & 63, im = rho >> 6;
        const int k0 = 32 * ks + 8 * q4, jpos = k0 >> 4, c20 = k0 & 15;
        const f32x2 pp = pw[p * 17 + (15 - jpos)];
        float v[8];
#pragma unroll
        for (int j = 0; j < 8; ++j) { const f32x2 bw = bb[p * 16 + c20 + j]; const cplx t = cmul((cplx){pp.x, pp.y}, (cplx){bw.x, bw.y}); v[j] = im ? t.im : t.re; }
        u32x4 w; w.x = cvt_pk_bf16(v[0], v[1]); w.y = cvt_pk_bf16(v[2], v[3]); w.z = cvt_pk_bf16(v[4], v[5]); w.w = cvt_pk_bf16(v[6], v[7]);
        *(u32x4*)(tbl + TBL_M + (size_t)idx * 16) = w;
    }
    if (part == 1)
    for (int idx = tid; idx < 64 * 64; idx += NTHREADS) {
        const int f = idx >> 6, l = idx & 63, i = f >> 2, ks = f & 3, q4 = l >> 4, c1 = l & 15;
        const int s0 = 32 * ks + 8 * q4;
        float v[8];
#pragma unroll
        for (int j = 0; j < 8; ++j) { const int sg = s0 + j, p = sg & 63; const f32x2 cw = cc[c1 * 64 + p], pp = pw[p * 17 + i + 1];
            const cplx t = cmul((cplx){cw.x, cw.y}, (cplx){pp.x, pp.y}); v[j] = (sg >> 6) ? -t.im : t.re; }
        u32x4 w; w.x = cvt_pk_bf16(v[0], v[1]); w.y = cvt_pk_bf16(v[2], v[3]); w.z = cvt_pk_bf16(v[4], v[5]); w.w = cvt_pk_bf16(v[6], v[7]);
        *(u32x4*)(tbl + TBL_N + (size_t)idx * 16) = w;
    }
    if (part == 1 && tid < 64) *(f32x2*)(tbl + TBL_A16 + tid * 8) = pw[tid * 17 + 16];
    __syncthreads();
}

__device__ __forceinline__ void row_norm_store(const f32x4 (&v)[4], float ssq, int lane, const float* g0, bf16_t* o0) {
    const float rstd = 1.0f / sqrtf(ssq * (1.0f / D) + RMS_EPS);
#pragma unroll
    for (int j = 0; j < 4; ++j) {
        const int c = 4 * lane + 256 * j;
        f32x4 g = {1.f, 1.f, 1.f, 1.f}; if (g0) g = *(const f32x4*)(g0 + c);
        u32x2 w; w.x = cvt_pk_bf16(v[j][0] * rstd * g[0], v[j][1] * rstd * g[1]); w.y = cvt_pk_bf16(v[j][2] * rstd * g[2], v[j][3] * rstd * g[3]);
        *(u32x2*)(o0 + c) = w;
    }
}
__device__ __forceinline__ void phase_prep(CArgs& a, LAS unsigned char* lds) {
    if (opaque_bid() < 128) { s5_tables(a, opaque_bid() >> 6, opaque_bid() & 63, 0, lds); s5_tables(a, opaque_bid() >> 6, opaque_bid() & 63, 1, lds); }
    if (opaque_tid() < 96) {
        const int item = opaque_bid() * 96 + opaque_tid(), layer = item / 6144, idx = item % 6144;
        const float* wg = a.in[22] + (size_t)layer * D * NGRP; const float* we = a.in[24] + (size_t)layer * D * NEXP; const float* gain = a.in[3] + (size_t)layer * D;
        const int l = idx & 63, ks = (idx >> 6) & 31, rt = idx >> 11, o = 16 * rt + (l & 15), k0 = 32 * ks + 8 * (l >> 4);
        float v[8];
#pragma unroll
        for (int jq = 0; jq < 8; ++jq) v[jq] = (o < 4 ? wg[(size_t)(k0 + jq) * NGRP + o] : (o < 36 ? we[(size_t)(k0 + jq) * NEXP + (o - 4)] : 0.f)) * gain[k0 + jq];
        u32x4 w; w.x = cvt_pk_bf16(v[0], v[1]); w.y = cvt_pk_bf16(v[2], v[3]); w.z = cvt_pk_bf16(v[4], v[5]); w.w = cvt_pk_bf16(v[6], v[7]);
        *(u32x4*)(a.ws + WS_RW + (size_t)layer * 98304 + (size_t)idx * 16) = w;
    }
    convert_weights(a);
    const int lane = opaque_tid() & 63, gw = opaque_bid() * 8 + (opaque_tid() >> 6);
    float* RSTD = (float*)(a.ws + WS_RSTD);
    for (int row0 = gw; row0 < RT; row0 += GRID * 8 * 4) {
        f32x4 v[4][4];
#pragma unroll
        for (int q = 0; q < 4; ++q) { const int row = row0 + q * GRID * 8, rr = row < RT ? row : RT - 1;
            const float* src = rr < NREAL ? a.in[0] + (size_t)rr * D : a.in[1] + (size_t)(rr - NREAL) * D;
#pragma unroll
            for (int j = 0; j < 4; ++j) v[q][j] = *(const f32x4*)(src + 4 * lane + 256 * j); }
#pragma unroll
        for (int q = 0; q < 4; ++q) { const int row = row0 + q * GRID * 8; float ssq = 0.f;
#pragma unroll
            for (int j = 0; j < 4; ++j) ssq += v[q][j][0] * v[q][j][0] + v[q][j][1] * v[q][j][1] + v[q][j][2] * v[q][j][2] + v[q][j][3] * v[q][j][3];
            ssq = wave_sum(ssq);
            if (lane == 0 && row < RT) RSTD[row] = 1.0f / sqrtf(ssq * (1.0f / D) + RMS_EPS); }
    }
}

constexpr int S5_CH = 528;
constexpr int S5_NCH = 129, S5_NCHP = 144;
__device__ __forceinline__ cplx cmulc(cplx x, cplx y) { return {x.re * y.re - x.im * y.im, x.re * y.im + x.im * y.re}; }
__device__ __forceinline__ void phase_s5(CArgs& a, int layer, LAS unsigned char* lds) {
    LAS unsigned char* Ul = lds; LAS unsigned char* Sl = lds + S5_NCHP * S5_CH;
    const int tid = opaque_tid(), lane = tid & 63, w = __builtin_amdgcn_readfirstlane(tid >> 6), tc = lane & 15, q4 = lane >> 4;
    const bf16_t* H = (const bf16_t*)(a.ws + WS_H); const float* RSTD = (const float*)(a.ws + WS_RSTD); bf16_t* Z = (bf16_t*)(a.ws + WS_Z);
    const int b = opaque_bid() >> 5, gp = 2 * (opaque_bid() & 31);
    u32x4 keep[9];
    {
        const int half = tid & 1, c = 16 * gp + 8 * half;
        const float* gn = a.in[2] + (size_t)layer * D + c;
        const f32x4 ga0 = *(const f32x4*)gn, ga1 = *(const f32x4*)(gn + 4), gb0 = *(const f32x4*)(gn + 16), gb1 = *(const f32x4*)(gn + 20);
#pragma unroll
        for (int k0 = 0; k0 < 9; k0 += 3) {
            float rs[3]; u32x4 ha[3], hb[3]; f32x4 xa0[3], xa1[3], xb0[3], xb1[3];
#pragma unroll
            for (int q = 0; q < 3; ++q) {
                const int idx = tid + (k0 + q) * NTHREADS, tok = (idx < LT * 2 ? idx : LT * 2 - 1) >> 1, row = row_of(b, tok);
                rs[q] = RSTD[row];
                if (layer == 0) { const float* src = (row < NREAL ? a.in[0] + (size_t)row * D : a.in[1] + (size_t)(row - NREAL) * D) + c;
                    xa0[q] = *(const f32x4*)src; xa1[q] = *(const f32x4*)(src + 4); xb0[q] = *(const f32x4*)(src + 16); xb1[q] = *(const f32x4*)(src + 20); }
                else { ha[q] = *(const u32x4*)(H + (size_t)row * D + c); hb[q] = *(const u32x4*)(H + (size_t)row * D + c + 16); }
            }
#pragma unroll
            for (int q = 0; q < 3; ++q) {
                const int idx = tid + (k0 + q) * NTHREADS, tok = idx >> 1; const float r_ = rs[q];
                float va[8], vb[8];
                if (layer == 0) {
#pragma unroll
                    for (int e = 0; e < 4; ++e) { va[e] = xa0[q][e]; va[4 + e] = xa1[q][e]; vb[e] = xb0[q][e]; vb[4 + e] = xb1[q][e]; }
                } else {
                    const u32x4 p = ha[q], r2 = hb[q];
                    va[0] = bf16_lo(p.x); va[1] = bf16_hi(p.x); va[2] = bf16_lo(p.y); va[3] = bf16_hi(p.y); va[4] = bf16_lo(p.z); va[5] = bf16_hi(p.z); va[6] = bf16_lo(p.w); va[7] = bf16_hi(p.w);
                    vb[0] = bf16_lo(r2.x); vb[1] = bf16_hi(r2.x); vb[2] = bf16_lo(r2.y); vb[3] = bf16_hi(r2.y); vb[4] = bf16_lo(r2.z); vb[5] = bf16_hi(r2.z); vb[6] = bf16_lo(r2.w); vb[7] = bf16_hi(r2.w);
                }
                u32x4 v; v.x = cvt_pk_bf16(va[0] * r_ * ga0[0], va[1] * r_ * ga0[1]); v.y = cvt_pk_bf16(va[2] * r_ * ga0[2], va[3] * r_ * ga0[3]);
                v.z = cvt_pk_bf16(va[4] * r_ * ga1[0], va[5] * r_ * ga1[1]); v.w = cvt_pk_bf16(va[6] * r_ * ga1[2], va[7] * r_ * ga1[3]);
                if (idx < LT * 2) *(LAS u32x4*)(Ul + (tok >> 4) * S5_CH + (tok & 15) * 32 + half * 16) = v;
                u32x4 k; k.x = cvt_pk_bf16(vb[0] * r_ * gb0[0], vb[1] * r_ * gb0[1]); k.y = cvt_pk_bf16(vb[2] * r_ * gb0[2], vb[3] * r_ * gb0[3]);
                k.z = cvt_pk_bf16(vb[4] * r_ * gb1[0], vb[5] * r_ * gb1[1]); k.w = cvt_pk_bf16(vb[6] * r_ * gb1[2], vb[7] * r_ * gb1[3]);
                keep[k0 + q] = k;
            }
        }
    }
#pragma unroll 1
    for (int ui = 0; ui < 2; ++ui) {
        const int g = gp + ui;
        const unsigned char* tbl = a.ws + WS_TBL + ((size_t)layer * 64 + g) * TBL_STRIDE;
        if (ui == 1) {
            const int half = tid & 1;
#pragma unroll
            for (int k = 0; k < 9; ++k) { const int idx = tid + k * NTHREADS, tok = idx >> 1; if (idx < LT * 2) *(LAS u32x4*)(Ul + (tok >> 4) * S5_CH + (tok & 15) * 32 + half * 16) = keep[k]; }
        }
        bf16x8 mf[8];
#pragma unroll
        for (int ks = 0; ks < 8; ++ks) mf[ks] = as_bf16x8(*(const u32x4*)(tbl + TBL_M + ((size_t)(w * 8 + ks) * 64 + lane) * 16));
        const int i0 = w, i1 = 15 - w;
        bf16x8 kf0[8], kf1[8], nf0[4], nf1[4];
#pragma unroll
        for (int jj = 0; jj < 8; ++jj) {
            const int d0 = i0 - 2 * jj, d1 = i1 - 2 * jj;
            kf0[jj] = as_bf16x8(*(const u32x4*)(tbl + TBL_K + ((size_t)(d0 >= 0 ? d0 : 0) * 64 + lane) * 16));
            kf1[jj] = as_bf16x8(*(const u32x4*)(tbl + TBL_K + ((size_t)(d1 >= 0 ? d1 : 0) * 64 + lane) * 16));
        }
#pragma unroll
        for (int ks = 0; ks < 4; ++ks) {
            nf0[ks] = as_bf16x8(*(const u32x4*)(tbl + TBL_N + ((size_t)(i0 * 4 + ks) * 64 + lane) * 16));
            nf1[ks] = as_bf16x8(*(const u32x4*)(tbl + TBL_N + ((size_t)(i1 * 4 + ks) * 64 + lane) * 16));
        }
        const f32x2 a16v = *(const f32x2*)(tbl + TBL_A16 + lane * 8);
        __syncthreads();
        {
#pragma unroll 1
            for (int cg = 0; cg < 9; ++cg) {
                const int n = 16 * cg + tc;
                f32x4 acc = {0.f, 0.f, 0.f, 0.f};
#pragma unroll
                for (int ks = 0; ks < 8; ++ks) { const bf16x8 ub = *(LAS bf16x8*)(Ul + n * S5_CH + ks * 64 + q4 * 16); acc = mfma16(mf[ks], ub, acc); }
                *(LAS f32x4*)(Sl + n * S5_CH + (16 * w + 4 * q4) * 4) = acc;
            }
        }
        __syncthreads();
        {
            const cplx a1 = {a16v.x, a16v.y};
            const int nb0 = 16 * w, ncnt = w == 7 ? 17 : 16;
            cplx s = {0.f, 0.f};
#pragma unroll 4
            for (int j = 0; j < 16; ++j) { const float xr = *(LAS float*)(Sl + (nb0 + j) * S5_CH + lane * 4), xi = *(LAS float*)(Sl + (nb0 + j) * S5_CH + 256 + lane * 4); const cplx t = cmulc(a1, s); s = {t.re + xr, t.im + xi}; }
            if (w < 7) { *(LAS float*)(Sl + (130 + w) * S5_CH + lane * 4) = s.re; *(LAS float*)(Sl + (130 + w) * S5_CH + 256 + lane * 4) = s.im; }
            cplx A = a1;
#pragma unroll
            for (int q = 0; q < 4; ++q) A = cmulc(A, A);
            __syncthreads();
            cplx c = {0.f, 0.f};
            for (int v = 0; v < w; ++v) { const float er = *(LAS float*)(Sl + (130 + v) * S5_CH + lane * 4), ei = *(LAS float*)(Sl + (130 + v) * S5_CH + 256 + lane * 4); const cplx t = cmulc(A, c); c = {t.re + er, t.im + ei}; }
            float sr = c.re, si = c.im;
#pragma unroll 1
            for (int nb = 0; nb < 3; ++nb) {
                const int cntb = nb < 2 ? 8 : ncnt - 16;
                float xr[8], xi[8];
#pragma unroll
                for (int j = 0; j < 8; ++j) { const int n = nb0 + nb * 8 + (j < cntb ? j : 0); xr[j] = *(LAS float*)(Sl + n * S5_CH + lane * 4); xi[j] = *(LAS float*)(Sl + n * S5_CH + 256 + lane * 4); }
                asm volatile("s_waitcnt lgkmcnt(0)" ::: "memory");
#pragma unroll
                for (int j = 0; j < 8; ++j) {
                    if (j < cntb) {
                        const int n = nb0 + nb * 8 + j;
                        const unsigned pr = cvt_pk_bf16(sr, si);
                        *(LAS unsigned short*)(Sl + n * S5_CH + lane * 2) = (unsigned short)(pr & 0xffffu);
                        *(LAS unsigned short*)(Sl + n * S5_CH + 128 + lane * 2) = (unsigned short)(pr >> 16);
                        const float nr = a1.re * sr - a1.im * si + xr[j], ni = a1.re * si + a1.im * sr + xi[j];
                        sr = nr; si = ni;
                    }
                }
                asm volatile("" ::: "memory");
            }
        }
        __syncthreads();
        {
            const f32x4 dsk = *(const f32x4*)(a.in[13] + (size_t)layer * D + 16 * g + 4 * q4);
#pragma unroll 1
            for (int cg = 0; cg < 9; ++cg) {
                const int n = 16 * cg + tc;
                f32x4 acc0 = {0.f, 0.f, 0.f, 0.f}, acc1 = {0.f, 0.f, 0.f, 0.f};
#pragma unroll
                for (int jj = 0; jj < 8; ++jj) {
                    const bf16x8 ub = *(LAS bf16x8*)(Ul + n * S5_CH + jj * 64 + q4 * 16);
                    if (2 * jj <= i0) acc0 = mfma16(kf0[jj], ub, acc0);
                    if (2 * jj <= i1) acc1 = mfma16(kf1[jj], ub, acc1);
                }
#pragma unroll
                for (int ks = 0; ks < 4; ++ks) {
                    const bf16x8 sb = *(LAS bf16x8*)(Sl + n * S5_CH + ks * 64 + q4 * 16);
                    acc0 = mfma16(nf0[ks], sb, acc0); acc1 = mfma16(nf1[ks], sb, acc1);
                }
                if (n < S5_NCH && (n > 0 || b == 0)) {
#pragma unroll
                    for (int h = 0; h < 2; ++h) {
                        const int i = h ? i1 : i0; const f32x4 y = h ? acc1 : acc0;
                        const u32x2 uw = *(LAS u32x2*)(Ul + n * S5_CH + i * 32 + q4 * 8);
                        const float z0 = gelu_tanh(y[0] + dsk[0] * bf16_lo(uw.x)), z1 = gelu_tanh(y[1] + dsk[1] * bf16_hi(uw.x));
                        const float z2 = gelu_tanh(y[2] + dsk[2] * bf16_lo(uw.y)), z3 = gelu_tanh(y[3] + dsk[3] * bf16_hi(uw.y));
                        u32x2 o; o.x = cvt_pk_bf16(z0, z1); o.y = cvt_pk_bf16(z2, z3);
                        *(u32x2*)(Z + (size_t)row_of(b, 16 * n + i) * D + 16 * g + 4 * q4) = o;
                    }
                }
            }
        }
        __syncthreads();
    }
}

__device__ __forceinline__ float ssq4(f32x4 h) { return h[0] * h[0] + h[1] * h[1] + h[2] * h[2] + h[3] * h[3]; }
__device__ __forceinline__ int gwave() { return opaque_bid() * 8 + (opaque_tid() >> 6); }
template <int NACC> __device__ __forceinline__ bool meta_block(LAS unsigned char* lds, const bf16_t* Am, const bf16_t* const (&brow)[NACC], int K, f32x4 (&out)[NACC]) {
    const int tid = opaque_tid(), lane = tid & 63, wid = tid >> 6, fr = lane & 15, fq = lane >> 4, ksl = K / 8;
#pragma unroll
    for (int i = 0; i < NACC; ++i) {
        f32x4 acc = {0.f, 0.f, 0.f, 0.f};
        const bf16_t* ap = Am + (size_t)fr * K + wid * ksl + 8 * fq; const bf16_t* bp = brow[i] + (size_t)fr * K + wid * ksl + 8 * fq;
        for (int ks = 0; ks < ksl / 32; ++ks) acc = mfma16(as_bf16x8(*(const u32x4*)(bp + 32 * ks)), as_bf16x8(*(const u32x4*)(ap + 32 * ks)), acc);
        ((LAS f32x4*)lds)[(wid * NACC + i) * 64 + lane] = acc;
    }
    __syncthreads();
    if (wid == 0) {
#pragma unroll
        for (int i = 0; i < NACC; ++i) { f32x4 s = {0.f, 0.f, 0.f, 0.f};
#pragma unroll
            for (int w = 0; w < 8; ++w) s += ((LAS f32x4*)lds)[(w * NACC + i) * 64 + lane];
            out[i] = s; }
    }
    __syncthreads();
    return wid == 0;
}

__device__ __forceinline__ void load_res8(const GemmDesc& g, size_t off, float (&h)[8]) {
    if (g.res32) { const f32x4 a = *(const f32x4*)(g.res32 + off), b = *(const f32x4*)(g.res32 + off + 4); h[0] = a[0]; h[1] = a[1]; h[2] = a[2]; h[3] = a[3]; h[4] = b[0]; h[5] = b[1]; h[6] = b[2]; h[7] = b[3]; }
    else { const u32x4 w = *(const u32x4*)(g.res16 + off); h[0] = bf16_lo(w.x); h[1] = bf16_hi(w.x); h[2] = bf16_lo(w.y); h[3] = bf16_hi(w.y); h[4] = bf16_lo(w.z); h[5] = bf16_hi(w.z); h[6] = bf16_lo(w.w); h[7] = bf16_hi(w.w); }
}
__device__ __forceinline__ void store_h8(bf16_t* Hout, size_t off, const float (&h)[8]) {
    u32x4 w; w.x = cvt_pk_bf16(h[0], h[1]); w.y = cvt_pk_bf16(h[2], h[3]); w.z = cvt_pk_bf16(h[4], h[5]); w.w = cvt_pk_bf16(h[6], h[7]);
    *(u32x4*)(Hout + off) = w;
}
__device__ __forceinline__ void epi_glu(const GemmDesc& g, const f32x4 (&acc)[2][2][4][2], const Unit& u, int wr, int wc, int fr, int fq) {
#pragma unroll
    for (int ai = 0; ai < 2; ++ai) {
        const int row0 = u.pm * BM + ai * HALF + wr * 64 + fr; const size_t off0 = (size_t)row0 * D + u.pn * 128 + wc * 32 + 8 * fq;
        float h[4][8];
#pragma unroll
        for (int m = 0; m < 4; ++m) load_res8(g, off0 + (size_t)m * 16 * D, h[m]);
#pragma unroll
        for (int m = 0; m < 4; ++m) {
#pragma unroll
            for (int n = 0; n < 2; ++n) { const f32x4 v = acc[ai][0][m][n], gt = acc[ai][1][m][n];
                h[m][4 * n + 0] += v[0] * sigmoidf_(gt[0]); h[m][4 * n + 1] += v[1] * sigmoidf_(gt[1]); h[m][4 * n + 2] += v[2] * sigmoidf_(gt[2]); h[m][4 * n + 3] += v[3] * sigmoidf_(gt[3]); }
            store_h8(g.Hout, off0 + (size_t)m * 16 * D, h[m]);
        }
        asm volatile("" ::: "memory");
    }
}
__device__ __forceinline__ void phase_glu(CArgs& a, int layer, bool dry, LAS unsigned char* lds, GemmDesc& g) {
    const bf16_t* Zb = (const bf16_t*)(a.ws + WS_Z); const bf16_t* W = (const bf16_t*)(a.ws + WS_WGLU) + (size_t)layer * 2048 * 1024;
    g.res32 = layer == 0 ? a.in[0] : nullptr; g.res16 = (const bf16_t*)(a.ws + WS_H); g.Hout = (bf16_t*)(a.ws + (dry ? WS_DUMH : WS_H));
    if (opaque_bid() < 32) {
        const int lane = opaque_tid() & 63, fr = lane & 15, fq = lane >> 4, task = opaque_bid();
        const int c0 = 32 * task, rv = 256 * (c0 >> 7) + (c0 & 127);
        const bf16_t* const br[4] = {W + (size_t)rv * D, W + (size_t)(rv + 16) * D, W + (size_t)(rv + 128) * D, W + (size_t)(rv + 144) * D};
        f32x4 o[4];
        if (meta_block<4>(lds, Zb + (size_t)NREAL * D, br, D, o)) {
#pragma unroll
            for (int n = 0; n < 2; ++n) {
                const f32x4 v = o[n], gt = o[2 + n]; const int c = c0 + 16 * n + 4 * fq;
                f32x4 h;
                if (layer == 0) h = *(const f32x4*)(a.in[1] + (size_t)fr * D + c);
                else { const u32x2 w = *(const u32x2*)(g.res16 + (size_t)(NREAL + fr) * D + c); h = (f32x4){bf16_lo(w.x), bf16_hi(w.x), bf16_lo(w.y), bf16_hi(w.y)}; }
                h[0] += v[0] * sigmoidf_(gt[0]); h[1] += v[1] * sigmoidf_(gt[1]); h[2] += v[2] * sigmoidf_(gt[2]); h[3] += v[3] * sigmoidf_(gt[3]);
                u32x2 w2; w2.x = cvt_pk_bf16(h[0], h[1]); w2.y = cvt_pk_bf16(h[2], h[3]); *(u32x2*)(g.Hout + (size_t)(NREAL + fr) * D + c) = w2;
            }
        }
    }
    g.stride = GRID; g.vb = opaque_bid(); g.kind = EPI_GLU; g.K = D; g.perm = 1; g.gather = 0; g.moe = 0; g.nM = NREAL / BM; g.nN = 2048 / BM; g.nwg = g.nM * g.nN; g.A = (const char*)Zb; g.Bt = (const char*)W;
    g.tstepA = g.tstepB = (size_t)BM * D * 2; g.wstride = 0;
}

__device__ __forceinline__ void epi_oproj(const GemmDesc& g, const f32x4 (&acc)[2][2][4][2], const Unit& u, int wr, int wc, int fr, int fq) {
#pragma unroll
    for (int ai = 0; ai < 2; ++ai)
#pragma unroll
        for (int bj = 0; bj < 2; ++bj) {
            const int row0 = u.pm * BM + ai * HALF + wr * 64 + fr, c0 = u.pn * BM + bj * HALF + wc * 32 + 8 * fq; const size_t off0 = (size_t)row0 * D + c0;
            const f32x4 b0 = *(const f32x4*)(g.bias + c0), b1 = *(const f32x4*)(g.bias + c0 + 4);
            float h[4][8];
#pragma unroll
            for (int m = 0; m < 4; ++m) load_res8(g, off0 + (size_t)m * 16 * D, h[m]);
#pragma unroll
            for (int m = 0; m < 4; ++m) {
#pragma unroll
                for (int n = 0; n < 2; ++n) { const f32x4 v = acc[ai][bj][m][n] + (n ? b1 : b0); h[m][4 * n + 0] += v[0]; h[m][4 * n + 1] += v[1]; h[m][4 * n + 2] += v[2]; h[m][4 * n + 3] += v[3]; }
                store_h8(g.Hout, off0 + (size_t)m * 16 * D, h[m]);
            }
            asm volatile("" ::: "memory");
        }
}
__device__ __forceinline__ void phase_oproj(CArgs& a, int j, bool dry, LAS unsigned char* lds, GemmDesc& g) {
    const bf16_t* Ob = (const bf16_t*)(a.ws + WS_Z); const bf16_t* W = (const bf16_t*)(a.ws + WS_WO) + (size_t)j * 1024 * 1024;
    const float* bo = a.in[21] + (size_t)j * D;
    g.res32 = nullptr; g.res16 = (const bf16_t*)(a.ws + WS_H); g.Hout = (bf16_t*)(a.ws + (dry ? WS_DUMH : WS_H)); g.bias = bo;
    if (opaque_bid() < 32) {
        const int lane = opaque_tid() & 63, fr = lane & 15, fq = lane >> 4, task = opaque_bid(), c0 = 32 * task;
        const bf16_t* const br[2] = {W + (size_t)c0 * D, W + (size_t)(c0 + 16) * D};
        f32x4 o[2];
        if (meta_block<2>(lds, Ob + (size_t)NREAL * D, br, D, o)) {
#pragma unroll
            for (int n = 0; n < 2; ++n) {
                const int c = c0 + 16 * n + 4 * fq; const size_t off = (size_t)(NREAL + fr) * D + c;
                const u32x2 w = *(const u32x2*)(g.res16 + off); f32x4 h = (f32x4){bf16_lo(w.x), bf16_hi(w.x), bf16_lo(w.y), bf16_hi(w.y)};
                h += o[n] + *(const f32x4*)(bo + c);
                u32x2 w2; w2.x = cvt_pk_bf16(h[0], h[1]); w2.y = cvt_pk_bf16(h[2], h[3]); *(u32x2*)(g.Hout + off) = w2;
            }
        }
    }
    g.stride = GRID; g.vb = opaque_bid(); g.kind = EPI_OPROJ; g.K = D; g.perm = 1; g.gather = 0; g.moe = 0; g.nM = NREAL / BM; g.nN = 1024 / BM; g.nwg = g.nM * g.nN; g.A = (const char*)Ob; g.Bt = (const char*)W;
    g.tstepA = g.tstepB = (size_t)BM * D * 2; g.wstride = 0;
}

__device__ __forceinline__ void kvq_store8(const GemmDesc& g, int row, int c, const float (&vin)[8]) {
    const float rs = g.rstd[row]; float v[8];
#pragma unroll
    for (int e = 0; e < 8; ++e) v[e] = vin[e] * rs;
    if (c < 256) {
        const float* b = g.bias + c; u32x4 w; w.x = cvt_pk_bf16(v[0] + b[0], v[1] + b[1]); w.y = cvt_pk_bf16(v[2] + b[2], v[3] + b[3]); w.z = cvt_pk_bf16(v[4] + b[4], v[5] + b[5]); w.w = cvt_pk_bf16(v[6] + b[6], v[7] + b[7]);
        *(u32x4*)(g.O1 + (size_t)row * 256 + c) = w;
    } else if (c < 512) {
        const int cv = c - 256; const float* b = g.bias + c;
        bf16_t* vp = g.O2 + (row < NREAL ? ((size_t)(row >> 11) * 256 + cv) * SEQ + (row & (SEQ - 1)) : VT_META + (size_t)cv * 16 + (row - NREAL));
        const size_t st = row < NREAL ? SEQ : 16;
#pragma unroll
        for (int i = 0; i < 4; ++i) { const unsigned p = cvt_pk_bf16(v[2 * i] + b[2 * i], v[2 * i + 1] + b[2 * i + 1]); vp[(size_t)(2 * i) * st] = (bf16_t)(p & 0xffffu); vp[(size_t)(2 * i + 1) * st] = (bf16_t)(p >> 16); }
    } else {
        const int cq = c - 512; const float* b = g.bias2 + cq;
        u32x4 w; w.x = cvt_pk_bf16((v[0] + b[0]) * 0.125f, (v[1] + b[1]) * 0.125f); w.y = cvt_pk_bf16((v[2] + b[2]) * 0.125f, (v[3] + b[3]) * 0.125f);
        w.z = cvt_pk_bf16((v[4] + b[4]) * 0.125f, (v[5] + b[5]) * 0.125f); w.w = cvt_pk_bf16((v[6] + b[6]) * 0.125f, (v[7] + b[7]) * 0.125f);
        *(u32x4*)(g.O3 + (size_t)row * D + cq) = w;
    }
}
__device__ __forceinline__ void epi_kvq(const GemmDesc& g, const f32x4 (&acc)[2][2][4][2], const Unit& u, int wr, int wc, int fr, int fq) {
    { const int cbase = g.cbase;
#pragma unroll
        for (int ai = 0; ai < 2; ++ai)
#pragma unroll
            for (int m = 0; m < 4; ++m) {
                const int row = u.pm * BM + ai * HALF + wr * 64 + m * 16 + fr;
#pragma unroll
                for (int bj = 0; bj < 2; ++bj) {
                    const int c = cbase + u.pn * BM + bj * HALF + wc * 32 + 8 * fq;
                    const f32x4 v0 = acc[ai][bj][m][0], v1 = acc[ai][bj][m][1];
                    const float v[8] = {v0[0], v0[1], v0[2], v0[3], v1[0], v1[1], v1[2], v1[3]};
                    kvq_store8(g, row, c, v);
                    asm volatile("" ::: "memory");
                }
            }
    }
}
__device__ __forceinline__ void phase_kvq_q(CArgs& a, int jq, LAS unsigned char* lds, GemmDesc& g) {
    const bf16_t* Ub = (const bf16_t*)(a.ws + WS_H); const bf16_t* W = jq == 0 ? (const bf16_t*)(a.ws + WS_WKVQ) : (const bf16_t*)(a.ws + WS_WQ1);
    const int N = jq == 0 ? 1536 : 1024, cbase = jq == 0 ? 0 : 512;
    const int mb0 = jq == 0 ? 160 : 0;
    if (opaque_bid() >= mb0 && opaque_bid() < mb0 + N / 32) {
        const int lane = opaque_tid() & 63, fr = lane & 15, fq = lane >> 4, task = opaque_bid() - mb0;
        const bf16_t* const br[2] = {W + (size_t)(32 * task) * D, W + (size_t)(32 * task + 16) * D};
        f32x4 o[2];
        if (meta_block<2>(lds, Ub + (size_t)NREAL * D, br, D, o)) {
#pragma unroll
            for (int h = 0; h < 2; ++h) {
                const int c = cbase + 32 * task + 16 * h + 4 * fq; const int row = NREAL + fr; const f32x4 v = o[h] * ((const float*)(a.ws + WS_RSTD))[row];
                if (c < 256) { const float* b = a.in[16] + c; u32x2 w; w.x = cvt_pk_bf16(v[0] + b[0], v[1] + b[1]); w.y = cvt_pk_bf16(v[2] + b[2], v[3] + b[3]); *(u32x2*)((bf16_t*)(a.ws + WS_K) + (size_t)row * 256 + c) = w; }
                else if (c < 512) { const int cv = c - 256; const float* b = a.in[16] + c; bf16_t* vp = (bf16_t*)(a.ws + WS_VT) + VT_META + (size_t)cv * 16 + fr;
                    const unsigned p0 = cvt_pk_bf16(v[0] + b[0], v[1] + b[1]), p1 = cvt_pk_bf16(v[2] + b[2], v[3] + b[3]);
                    vp[0] = (bf16_t)(p0 & 0xffffu); vp[16] = (bf16_t)(p0 >> 16); vp[32] = (bf16_t)(p1 & 0xffffu); vp[48] = (bf16_t)(p1 >> 16); }
                else { const int cq = c - 512; const float* b = a.in[18] + (size_t)jq * D + cq; u32x2 w; w.x = cvt_pk_bf16((v[0] + b[0]) * 0.125f, (v[1] + b[1]) * 0.125f); w.y = cvt_pk_bf16((v[2] + b[2]) * 0.125f, (v[3] + b[3]) * 0.125f);
                    *(u32x2*)((bf16_t*)(a.ws + WS_Q) + (size_t)row * D + cq) = w; }
            }
        }
    }
    g.stride = GRID; g.vb = opaque_bid(); g.kind = EPI_KVQ; g.K = D; g.perm = 1; g.gather = 0; g.moe = 0; g.nM = NREAL / BM; g.nN = N / BM; g.nwg = g.nM * g.nN; g.A = (const char*)Ub; g.Bt = (const char*)W;
    g.tstepA = g.tstepB = (size_t)BM * D * 2; g.wstride = 0; g.rstd = (const float*)(a.ws + WS_RSTD); g.bias = a.in[16]; g.bias2 = a.in[18] + (size_t)jq * D; g.O1 = (bf16_t*)(a.ws + WS_K); g.O2 = (bf16_t*)(a.ws + WS_VT); g.O3 = (bf16_t*)(a.ws + WS_Q);
    g.jq = jq; g.cbase = cbase;
}

__device__ __forceinline__ void moe_scan(const int* cnt, LAS int* sh) {
    if (opaque_tid() == 0) { int acc = 0; for (int e = 0; e < 32; ++e) { sh[e] = acc; acc += (cnt[e] + 255) >> 8; } sh[32] = acc; }
    __syncthreads();
}
__device__ __forceinline__ void epi_moe1(const GemmDesc& g, LAS unsigned char* lds, const f32x4 (&acc)[2][2][4][2], const Unit& u, int wr, int wc, int fr, int fq) {
    { bf16_t* HB = g.O1;
        const LAS int* tabt = (const LAS int*)(lds + LDS_TABT) + u.slot * 256;
#pragma unroll
        for (int ai = 0; ai < 2; ++ai)
#pragma unroll
            for (int m = 0; m < 4; ++m) {
                const int rl = ai * HALF + wr * 64 + m * 16 + fr;
                if (tabt[rl] >= 0) {
                    const float rs = ((const LAS float*)(lds + LDS_TABG))[u.slot * 256 + rl] * (g.f8 ? 1.0f / F8_WSCALE : 1.0f);
                    const f32x4 g0 = acc[ai][0][m][0] * rs, g1 = acc[ai][0][m][1] * rs, u0 = acc[ai][1][m][0] * rs, u1 = acc[ai][1][m][1] * rs;
                    if (g.f8) {
                        u32x2 w8; w8.x = pk4_fp8(g0[0] * sigmoidf_(g0[0]) * u0[0] * F8_HSCALE, g0[1] * sigmoidf_(g0[1]) * u0[1] * F8_HSCALE, g0[2] * sigmoidf_(g0[2]) * u0[2] * F8_HSCALE, g0[3] * sigmoidf_(g0[3]) * u0[3] * F8_HSCALE);
                        w8.y = pk4_fp8(g1[0] * sigmoidf_(g1[0]) * u1[0] * F8_HSCALE, g1[1] * sigmoidf_(g1[1]) * u1[1] * F8_HSCALE, g1[2] * sigmoidf_(g1[2]) * u1[2] * F8_HSCALE, g1[3] * sigmoidf_(g1[3]) * u1[3] * F8_HSCALE);
                        *(u32x2*)((unsigned char*)HB + ((size_t)u.pm * 256 + rl) * DEXP + u.pn * 128 + wc * 32 + 8 * fq) = w8;
                    } else {
                    u32x4 w; w.x = cvt_pk_bf16(g0[0] * sigmoidf_(g0[0]) * u0[0], g0[1] * sigmoidf_(g0[1]) * u0[1]); w.y = cvt_pk_bf16(g0[2] * sigmoidf_(g0[2]) * u0[2], g0[3] * sigmoidf_(g0[3]) * u0[3]);
                    w.z = cvt_pk_bf16(g1[0] * sigmoidf_(g1[0]) * u1[0], g1[1] * sigmoidf_(g1[1]) * u1[1]); w.w = cvt_pk_bf16(g1[2] * sigmoidf_(g1[2]) * u1[2], g1[3] * sigmoidf_(g1[3]) * u1[3]);
                    *(u32x4*)(HB + ((size_t)u.pm * 256 + rl) * DEXP + u.pn * 128 + wc * 32 + 8 * fq) = w;
                    }
                }
                asm volatile("" ::: "memory");
            }
    }
}
__device__ __forceinline__ bool moe_roles(GemmDesc& g) {
    const int rounds = (g.nwg + GRID - 1) / GRID, per = rounds ? (g.nwg + rounds - 1) / rounds : GRID, ngw = ((per + 7) / 8) * 8 < GRID ? ((per + 7) / 8) * 8 : GRID;
    const int bid = opaque_bid(), rnk = bid >> 3;
    g.stride = ngw; g.vb = rnk * 8 + (bid & 7);
    if (rnk * 8 >= ngw) { g.nwg = 0; return true; }
    return false;
}
__device__ __forceinline__ bool phase_moe1(CArgs& a, int layer, LAS unsigned char* lds, GemmDesc& g) {
    LAS int* sh = (LAS int*)(lds + LDS_SH);
    const int* cnt = (const int*)(a.ws + WS_CTL) + CW_CNT + layer * 32;
    moe_scan(cnt, sh);
    g.kind = EPI_MOE1; g.K = D; g.perm = 1; g.gather = 1; g.moe = 1; g.npn = 4; g.nwg = sh[32] * 4; g.nM = 0; g.nN = 4;
    g.A = (const char*)(a.ws + WS_H); g.Bt = (const char*)(a.ws + WS_W1) + (size_t)layer * 32 * 1024 * 1024 * 2; g.wstride = (size_t)1024 * 1024 * 2;
    g.tstepA = 0; g.tstepB = (size_t)256 * 1024 * 2; g.cnt = cnt; g.LTOK = (const int*)(a.ws + WS_LTOK); g.LGATE = (const float*)(a.ws + WS_LRS); g.O1 = (bf16_t*)(a.ws + WS_HB);
    if (layer >= F8_LAYER) { g.f8 = 1; g.K = D / 2; g.A = (const char*)(a.ws + WS_Z); g.arow = D; g.wstride = (size_t)1024 * 1024; g.tstepB = (size_t)256 * 1024; }
    return moe_roles(g);
}
__device__ __forceinline__ void epi_moe2(const GemmDesc& g, LAS unsigned char* lds, const f32x4 (&acc)[2][2][4][2], const Unit& u, int wr, int wc, int fr, int fq) {
    { bf16_t* YB = g.O1;
        const LAS int* tabt = (const LAS int*)(lds + LDS_TABT) + u.slot * 256; const LAS float* tabg = (const LAS float*)(lds + LDS_TABG) + u.slot * 256;
#pragma unroll
        for (int ai = 0; ai < 2; ++ai)
#pragma unroll
            for (int m = 0; m < 4; ++m) {
                const int rl = ai * HALF + wr * 64 + m * 16 + fr; const int rt = tabt[rl];
                if (rt >= 0) {
                    const float gs = tabg[rl] * (g.f8 ? 1.0f / (F8_WSCALE * F8_HSCALE) : 1.0f);
                    bf16_t* yp = YB + ((size_t)(rt & 0x3fffffff) * 2 + (rt >> 30)) * D + u.pn * BM + wc * 32 + 8 * fq;
#pragma unroll
                    for (int bj = 0; bj < 2; ++bj) { const f32x4 v0 = acc[ai][bj][m][0] * gs, v1 = acc[ai][bj][m][1] * gs;
                        u32x4 w; w.x = cvt_pk_bf16(v0[0], v0[1]); w.y = cvt_pk_bf16(v0[2], v0[3]); w.z = cvt_pk_bf16(v1[0], v1[1]); w.w = cvt_pk_bf16(v1[2], v1[3]);
                        *(u32x4*)(yp + bj * HALF) = w; }
                }
                asm volatile("" ::: "memory");
            }
    }
}
__device__ __forceinline__ bool phase_moe2(CArgs& a, int layer, LAS unsigned char* lds, GemmDesc& g) {
    LAS int* sh = (LAS int*)(lds + LDS_SH);
    const int* cnt = (const int*)(a.ws + WS_CTL) + CW_CNT + layer * 32;
    moe_scan(cnt, sh);
    g.kind = EPI_MOE2; g.K = DEXP; g.perm = 1; g.gather = 0; g.moe = 1; g.npn = 4; g.nwg = sh[32] * 4; g.nM = 0; g.nN = 4;
    g.A = (const char*)(a.ws + WS_HB); g.Bt = (const char*)(a.ws + WS_W2) + (size_t)layer * 32 * 1024 * 512 * 2; g.wstride = (size_t)1024 * 512 * 2;
    g.tstepA = (size_t)256 * DEXP * 2; g.tstepB = (size_t)256 * DEXP * 2; g.cnt = cnt; g.LTOK = (const int*)(a.ws + WS_LTOK); g.LGATE = (const float*)(a.ws + WS_LGATE); g.O1 = (bf16_t*)(a.ws + WS_YB);
    if (layer >= F8_LAYER) { g.f8 = 1; g.K = DEXP / 2; g.wstride = (size_t)1024 * 512; g.tstepA = (size_t)256 * DEXP; g.tstepB = (size_t)256 * DEXP; }
    return moe_roles(g);
}
__device__ __forceinline__ void gemm_epilogue(const GemmDesc& g, LAS unsigned char* lds, const f32x4 (&acc)[2][2][4][2], const Unit& u, int wr, int wc, int fr, int fq) {
    asm volatile("" : "+v"(fr), "+v"(fq));
    switch (g.kind) {
        case EPI_GLU: epi_glu(g, acc, u, wr, wc, fr, fq); break;
        case EPI_OPROJ: epi_oproj(g, acc, u, wr, wc, fr, fq); break;
        case EPI_KVQ: epi_kvq(g, acc, u, wr, wc, fr, fq); break;
        case EPI_MOE1: epi_moe1(g, lds, acc, u, wr, wc, fr, fq); break;
        default: epi_moe2(g, lds, acc, u, wr, wc, fr, fq); break;
    }
}

constexpr int AT_NSLOT = 272, AT_VROW = 552, AT_KBYTES = AT_NSLOT * 128, AT_VBYTES = 64 * AT_VROW;
__device__ __forceinline__ void attn_tile(LAS unsigned char* Ks, LAS unsigned char* Vs, const bf16x8 qf0, const bf16x8 qf1, bf16_t* op, float sink, int nblk  , int kb0  , int srel  , int smin  , int lmeta  , int tc, int q4) {
    f32x4 s[10];
#pragma unroll
    for (int bi = 0; bi < 10; ++bi) {
        s[bi] = (f32x4){-1e30f, -1e30f, -1e30f, -1e30f};
        if (bi < nblk) {
            const int sl = (bi == 0 ? 0 : 16 + 16 * (kb0 + bi - 1)) + tc;
            const LAS unsigned char* kr = Ks + sl * 128;
            const bf16x8 kf0 = *(const LAS bf16x8*)(kr + ((q4 ^ (sl & 7)) << 4)), kf1 = *(const LAS bf16x8*)(kr + (((4 + q4) ^ (sl & 7)) << 4));
            f32x4 acc = {0.f, 0.f, 0.f, 0.f};
            acc = mfma16(kf0, qf0, acc); acc = mfma16(kf1, qf1, acc);
#pragma unroll
            for (int r = 0; r < 4; ++r) {
                const int kk = 16 * (kb0 + bi - 1) + 4 * q4 + r;
                const bool ok = bi == 0 ? (4 * q4 + r <= lmeta) : (kk >= smin && kk <= srel && kk >= srel - 127);
                s[bi][r] = ok ? acc[r] : -1e30f;
            }
        }
    }
    float m = sink;
#pragma unroll
    for (int bi = 0; bi < 10; ++bi) m = fmaxf(m, fmaxf(fmaxf(s[bi][0], s[bi][1]), fmaxf(s[bi][2], s[bi][3])));
    m = xor32_max(xor16_max(m));
    float den = 0.f;
    unsigned pk[10][2];
#pragma unroll
    for (int bi = 0; bi < 10; ++bi) {
        float p[4];
#pragma unroll
        for (int r = 0; r < 4; ++r) { p[r] = s[bi][r] > -1e29f ? fast_exp(s[bi][r] - m) : 0.f; den += p[r]; }
        pk[bi][0] = cvt_pk_bf16(p[0], p[1]); pk[bi][1] = cvt_pk_bf16(p[2], p[3]);
    }
    den = quad_sum(den);
    den += fast_exp(sink - m);
    const float inv = 1.0f / den;
    f32x4 o[4];
#pragma unroll
    for (int dt = 0; dt < 4; ++dt) o[dt] = (f32x4){0.f, 0.f, 0.f, 0.f};
#pragma unroll
    for (int pp = 0; pp < 5; ++pp) {
        if (2 * pp < nblk) {
            const int biA = 2 * pp, biB = 2 * pp + 1;
            const int slA = biA == 0 ? 0 : 16 + 16 * (kb0 + biA - 1), slB = biB < nblk ? 16 + 16 * (kb0 + biB - 1) : slA;
            u32x4 pw; pw.x = pk[biA][0]; pw.y = pk[biA][1]; pw.z = pk[biB][0]; pw.w = pk[biB][1];
            const bf16x8 pf = as_bf16x8(pw);
#pragma unroll
            for (int dt = 0; dt < 4; ++dt) {
                const LAS unsigned char* vr = Vs + (16 * dt + tc) * AT_VROW + 8 * q4;
                const u32x2 va = *(const LAS u32x2*)(vr + slA * 2), vb = *(const LAS u32x2*)(vr + slB * 2);
                u32x4 vw; vw.x = va.x; vw.y = va.y; vw.z = vb.x; vw.w = vb.y;
                o[dt] = mfma16(as_bf16x8(vw), pf, o[dt]);
            }
        }
    }
#pragma unroll
    for (int dt = 0; dt < 4; ++dt) { u32x2 w; w.x = cvt_pk_bf16(o[dt][0] * inv, o[dt][1] * inv); w.y = cvt_pk_bf16(o[dt][2] * inv, o[dt][3] * inv); *(u32x2*)(op + 16 * dt) = w; }
}
constexpr int AT_BUF = 70656;
struct AtUnit { int meta, kvh, b, s0; };
__device__ __forceinline__ AtUnit at_decode(int unit) { AtUnit u; u.meta = unit >= NB * 4 * 16; const int qt = u.meta ? 0 : (unit & 15); u.kvh = u.meta ? unit - NB * 4 * 16 : ((unit >> 4) & 3); u.b = u.meta ? 0 : (unit >> 6); u.s0 = qt * 128; return u; }
__device__ __forceinline__ void at_fill_load(const bf16_t* K, const bf16_t* VT, const AtUnit& u, int tid, u32x4 (&kr)[5], u32x4 (&vr)[5]) {
#pragma unroll
    for (int i = 0; i < 5; ++i) {
        const int idx = tid + i * NTHREADS;
        { const int sl = idx >> 3, c = idx & 7, sw = u.s0 - 128 + (sl - 16);
          u32x4 v = {0u, 0u, 0u, 0u};
          if (idx < AT_NSLOT * 8) { if (sl < 16) v = *(const u32x4*)(K + (size_t)(NREAL + sl) * 256 + u.kvh * 64 + c * 8); else if (!u.meta && sw >= 0) v = *(const u32x4*)(K + (size_t)(u.b * SEQ + sw) * 256 + u.kvh * 64 + c * 8); }
          kr[i] = v; }
        { const int d = idx / 34, ch = idx - d * 34, sw = u.s0 - 128 + 8 * (ch - 2);
          u32x4 v = {0u, 0u, 0u, 0u};
          if (idx < 64 * 34) { if (ch < 2) v = *(const u32x4*)(VT + VT_META + (size_t)(u.kvh * 64 + d) * 16 + ch * 8); else if (!u.meta && sw >= 0) v = *(const u32x4*)(VT + ((size_t)(u.b * 4 + u.kvh) * 64 + d) * SEQ + sw); }
          vr[i] = v; }
    }
}
__device__ __forceinline__ void at_fill_store(LAS unsigned char* Ks, LAS unsigned char* Vs, int tid, const u32x4 (&kr)[5], const u32x4 (&vr)[5]) {
#pragma unroll
    for (int i = 0; i < 5; ++i) {
        const int idx = tid + i * NTHREADS;
        if (idx < AT_NSLOT * 8) { const int sl = idx >> 3, c = idx & 7; *(LAS u32x4*)(Ks + sl * 128 + ((c ^ (sl & 7)) << 4)) = kr[i]; }
        if (idx < 64 * 34) { const int d = idx / 34, ch = idx - d * 34; *(LAS u32x2*)(Vs + d * AT_VROW + ch * 16) = (u32x2){vr[i].x, vr[i].y}; *(LAS u32x2*)(Vs + d * AT_VROW + ch * 16 + 8) = (u32x2){vr[i].z, vr[i].w}; }
    }
}
__device__ __forceinline__ void phase_attn(CArgs& a, int j, LAS unsigned char* lds) {
    const int tid = opaque_tid(), lane = tid & 63, wid = tid >> 6, tc = lane & 15, q4 = lane >> 4;
    const bf16_t* Q = (const bf16_t*)(a.ws + WS_Q); const bf16_t* K = (const bf16_t*)(a.ws + WS_K); const bf16_t* VT = (const bf16_t*)(a.ws + WS_VT);
    bf16_t* O = (bf16_t*)(a.ws + WS_Z);
    constexpr int NU = NB * 4 * 16 + 4;
    int unit = opaque_bid(), cur = 0;
    if (unit >= NU) return;
    u32x4 kr[5], vr[5];
    { const AtUnit u0 = at_decode(unit); at_fill_load(K, VT, u0, tid, kr, vr); at_fill_store(lds, lds + AT_KBYTES, tid, kr, vr); }
    __syncthreads();
#pragma unroll 1
    for (;;) {
        const AtUnit u = at_decode(unit);
        const int nextu = unit + GRID; const bool more = nextu < NU;
        LAS unsigned char* Ks = lds + cur * AT_BUF; LAS unsigned char* Vs = Ks + AT_KBYTES;
        const int g = wid & 3, hq = u.kvh * 4 + g, jt0 = wid >> 2;
        const float sink = a.in[19][j * 16 + hq];
        if (more) { const AtUnit un = at_decode(nextu); at_fill_load(K, VT, un, tid, kr, vr); }
        if (u.meta) {
            if (wid < 4) { const size_t row = (size_t)(NREAL + tc); const bf16_t* qp = Q + row * D + hq * 64 + 8 * q4;
                attn_tile(Ks, Vs, as_bf16x8(*(const u32x4*)qp), as_bf16x8(*(const u32x4*)(qp + 32)), O + row * D + hq * 64 + 4 * q4, sink, 1, 0, 0, 0, tc, tc, q4); }
        } else {
            const bf16_t* qbase = Q + ((size_t)(u.b * SEQ + u.s0 + tc)) * D + hq * 64 + 8 * q4;
            u32x4 qn0 = *(const u32x4*)(qbase + (size_t)(16 * jt0) * D), qn1 = *(const u32x4*)(qbase + (size_t)(16 * jt0) * D + 32);
#pragma unroll 1
            for (int t = 0; t < 4; ++t) {
                const int jt = jt0 + 2 * t; const size_t row = (size_t)(u.b * SEQ + u.s0 + 16 * jt + tc);
                const bf16x8 q0 = as_bf16x8(qn0), q1 = as_bf16x8(qn1);
                if (t < 3) { qn0 = *(const u32x4*)(qbase + (size_t)(16 * (jt + 2)) * D); qn1 = *(const u32x4*)(qbase + (size_t)(16 * (jt + 2)) * D + 32); }
                attn_tile(Ks, Vs, q0, q1, O + row * D + hq * 64 + 4 * q4, sink, 10, jt, 128 + 16 * jt + tc, 128 - u.s0, 64, tc, q4);
            }
        }
        if (!more) break;
        at_fill_store(lds + (cur ^ 1) * AT_BUF, lds + (cur ^ 1) * AT_BUF + AT_KBYTES, tid, kr, vr);
        __syncthreads();
        cur ^= 1; unit = nextu;
    }
}

__device__ __forceinline__ void phase_route(CArgs& a, int layer, bool dry, LAS unsigned char* lds) {
    LAS unsigned char* Wf = lds; LAS float* LG = (LAS float*)(lds + 98304); LAS int* hist = (LAS int*)(lds + 98304 + 24576); LAS int* hbase = hist + 32;
    const int tid = opaque_tid(), lane = tid & 63, wid = tid >> 6, tc = lane & 15, q4 = lane >> 4;
    for (int idx = tid; idx < 3 * 32 * 64; idx += NTHREADS) *(LAS u32x4*)(Wf + (size_t)idx * 16) = *(const u32x4*)(a.ws + WS_RW + (size_t)layer * 98304 + (size_t)idx * 16);
    if (tid < 32) hist[tid] = 0;
    __syncthreads();
    const bf16_t* H = (const bf16_t*)(a.ws + WS_H); float* LRS = (float*)(a.ws + (dry ? WS_DUMLG : WS_LRS));
    int* cnt = (int*)(a.ws + WS_CTL) + (dry ? CW_DUMCNT : CW_CNT) + layer * 32; int* LTOK = (int*)(a.ws + (dry ? WS_DUMLT : WS_LTOK)); float* LGATE = (float*)(a.ws + (dry ? WS_DUMLG : WS_LGATE));
    const int tile = wid * GRID + opaque_bid();
    const bool active = tile < RT / 16;
    int e1, e2, r1, r2; float g1, g2, rstd_keep;
    asm volatile("" : "=v"(e1), "=v"(e2), "=v"(r1), "=v"(r2), "=v"(g1), "=v"(g2), "=v"(rstd_keep));
    if (active) {
        const int row = tile * 16 + tc;
        float ss = 0.f;
        f32x4 acc[3];
#pragma unroll
        for (int rt = 0; rt < 3; ++rt) acc[rt] = (f32x4){0.f, 0.f, 0.f, 0.f};
        const bf16_t* hp = H + (size_t)row * D + 8 * q4;
#pragma unroll 1
        for (int kb = 0; kb < 4; ++kb) {
            u32x4 hv[8];
#pragma unroll
            for (int k8 = 0; k8 < 8; ++k8) hv[k8] = *(const u32x4*)(hp + 32 * (kb * 8 + k8));
#pragma unroll
            for (int k8 = 0; k8 < 8; ++k8) {
                const int ks = kb * 8 + k8; const bf16x8 xf = as_bf16x8(hv[k8]);
                { const u32x4 hw = hv[k8]; const float e0 = bf16_lo(hw.x), e1 = bf16_hi(hw.x), e2 = bf16_lo(hw.y), e3 = bf16_hi(hw.y), e4 = bf16_lo(hw.z), e5 = bf16_hi(hw.z), e6 = bf16_lo(hw.w), e7 = bf16_hi(hw.w);
                  ss += (e0 * e0 + e1 * e1) + (e2 * e2 + e3 * e3) + (e4 * e4 + e5 * e5) + (e6 * e6 + e7 * e7);
                  if (layer >= F8_LAYER) { u32x2 w8; w8.x = pk4_fp8(e0, e1, e2, e3); w8.y = pk4_fp8(e4, e5, e6, e7); *(u32x2*)(a.ws + WS_Z + (size_t)row * D + 32 * ks + 8 * q4) = w8; } }
#pragma unroll
                for (int rt = 0; rt < 3; ++rt) acc[rt] = mfma16(*(LAS bf16x8*)(Wf + ((size_t)(rt * 32 + ks) * 64 + lane) * 16), xf, acc[rt]);
            }
        }
        ss = quad_sum(ss);
        const float rstd = 1.0f / sqrtf(ss * (1.0f / D) + RMS_EPS); rstd_keep = rstd;
        LAS float* lg = LG + wid * 16 * 48;
#pragma unroll
        for (int rt = 0; rt < 3; ++rt)
#pragma unroll
            for (int r = 0; r < 4; ++r) lg[tc * 48 + 16 * rt + 4 * q4 + r] = acc[rt][r] * rstd;
        asm volatile("s_waitcnt lgkmcnt(0)" ::: "memory");
        if (lane < 16) {
            const LAS float* mylg = lg + lane * 48;
            float gl[4]; int gi = 0; float gm;
#pragma unroll
            for (int i = 0; i < 4; ++i) gl[i] = mylg[i] + a.in[23][layer * NGRP + i];
            gm = gl[0];
#pragma unroll
            for (int i = 1; i < 4; ++i) if (gl[i] > gm) { gm = gl[i]; gi = i; }
            float gz = 0.f;
#pragma unroll
            for (int i = 0; i < 4; ++i) gz += expf(gl[i] - gm);
            const float pg = 1.0f / gz;
            float el[8];
#pragma unroll
            for (int i = 0; i < 8; ++i) el[i] = mylg[4 + gi * 8 + i] + a.in[25][layer * NEXP + gi * 8 + i];
            int i1 = 0; float m1 = el[0];
#pragma unroll
            for (int i = 1; i < 8; ++i) if (el[i] > m1) { m1 = el[i]; i1 = i; }
            int i2 = -1; float m2 = -3.0e38f;
#pragma unroll
            for (int i = 0; i < 8; ++i) if (i != i1 && el[i] > m2) { m2 = el[i]; i2 = i; }
            float one = 1.0f; asm volatile("" : "+v"(one));
            const float x2 = expf(m2 - m1), q1 = one / (one + x2);
            g1 = pg * q1; g2 = pg * x2 * q1; e1 = gi * 8 + i1; e2 = gi * 8 + i2;
            r1 = __hip_atomic_fetch_add(&hist[e1], 1, __ATOMIC_RELAXED, __HIP_MEMORY_SCOPE_WORKGROUP); r2 = __hip_atomic_fetch_add(&hist[e2], 1, __ATOMIC_RELAXED, __HIP_MEMORY_SCOPE_WORKGROUP);
        }
    }
    __syncthreads();
    if (tid < 32) hbase[tid] = hist[tid] ? atomicAdd(&cnt[tid], hist[tid]) : 0;
    __syncthreads();
    if (active && lane < 16) {
        const int row = tile * 16 + lane;
        const int s1 = hbase[e1] + r1, s2 = hbase[e2] + r2;
        LTOK[(size_t)e1 * RT + s1] = row; LGATE[(size_t)e1 * RT + s1] = g1; LRS[(size_t)e1 * RT + s1] = rstd_keep;
        LTOK[(size_t)e2 * RT + s2] = row | (1 << 30); LGATE[(size_t)e2 * RT + s2] = g2; LRS[(size_t)e2 * RT + s2] = rstd_keep;
    }
}

__device__ __forceinline__ void comb_load(const bf16_t* H, const bf16_t* YB, int row, int lane, u32x4 (&w)[2][3]) {
    const bf16_t* hp = H + (size_t)row * D; const bf16_t* y0 = YB + (size_t)row * 2 * D;
#pragma unroll
    for (int j = 0; j < 2; ++j) { const int c = 8 * lane + 512 * j; w[j][0] = *(const u32x4*)(hp + c); w[j][1] = *(const u32x4*)(y0 + c); w[j][2] = *(const u32x4*)(y0 + D + c); }
}
__device__ __forceinline__ void comb_finish(CArgs& a, int layer, bool dry, int row, int lane, const u32x4 (&w)[2][3]) {
    float v[2][8]; float ssq = 0.f;
#pragma unroll
    for (int j = 0; j < 2; ++j) {
        const u32x4 hw = w[j][0], p0 = w[j][1], p1 = w[j][2];
        v[j][0] = bf16_lo(hw.x) + bf16_lo(p0.x) + bf16_lo(p1.x); v[j][1] = bf16_hi(hw.x) + bf16_hi(p0.x) + bf16_hi(p1.x);
        v[j][2] = bf16_lo(hw.y) + bf16_lo(p0.y) + bf16_lo(p1.y); v[j][3] = bf16_hi(hw.y) + bf16_hi(p0.y) + bf16_hi(p1.y);
        v[j][4] = bf16_lo(hw.z) + bf16_lo(p0.z) + bf16_lo(p1.z); v[j][5] = bf16_hi(hw.z) + bf16_hi(p0.z) + bf16_hi(p1.z);
        v[j][6] = bf16_lo(hw.w) + bf16_lo(p0.w) + bf16_lo(p1.w); v[j][7] = bf16_hi(hw.w) + bf16_hi(p0.w) + bf16_hi(p1.w);
#pragma unroll
        for (int e = 0; e < 8; ++e) ssq += v[j][e] * v[j][e];
    }
    ssq = wave_sum(ssq);
    const float rstd = 1.0f / sqrtf(ssq * (1.0f / D) + RMS_EPS);
    if (layer < 3) {
        bf16_t* ho = (bf16_t*)(a.ws + (dry ? WS_DUMH : WS_H)) + (size_t)row * D;
#pragma unroll
        for (int j = 0; j < 2; ++j) {
            const int c = 8 * lane + 512 * j;
            u32x4 o; o.x = cvt_pk_bf16(v[j][0], v[j][1]); o.y = cvt_pk_bf16(v[j][2], v[j][3]); o.z = cvt_pk_bf16(v[j][4], v[j][5]); o.w = cvt_pk_bf16(v[j][6], v[j][7]);
            *(u32x4*)(ho + c) = o;
        }
        if (lane == 0) ((float*)(a.ws + (dry ? WS_DUMSSQ : WS_RSTD)))[row] = rstd;
    } else if (row < NREAL) {
        float* op = a.out + (size_t)row * D;
#pragma unroll
        for (int j = 0; j < 2; ++j) { const int c = 8 * lane + 512 * j; const f32x4 g0 = *(const f32x4*)(a.in[5] + c), g1 = *(const f32x4*)(a.in[5] + c + 4);
            f32x4 o0, o1; o0[0] = v[j][0] * rstd * g0[0]; o0[1] = v[j][1] * rstd * g0[1]; o0[2] = v[j][2] * rstd * g0[2]; o0[3] = v[j][3] * rstd * g0[3];
            o1[0] = v[j][4] * rstd * g1[0]; o1[1] = v[j][5] * rstd * g1[1]; o1[2] = v[j][6] * rstd * g1[2]; o1[3] = v[j][7] * rstd * g1[3];
            *(f32x4*)(op + c) = o0; *(f32x4*)(op + c + 4) = o1; }
    }
}
__device__ __forceinline__ void phase_combine(CArgs& a, int layer, bool dry) {
    const int lane = opaque_tid() & 63, gw = opaque_bid() * 8 + (opaque_tid() >> 6);
    const bf16_t* H = (const bf16_t*)(a.ws + WS_H); const bf16_t* YB = (const bf16_t*)(a.ws + WS_YB);
    for (int row = gw; row < RT; row += GRID * 16) {
        const int row1 = row + GRID * 8; const bool two = row1 < RT;
        u32x4 wa[2][3], wb[2][3];
        comb_load(H, YB, row, lane, wa);
        if (two) comb_load(H, YB, row1, lane, wb);
        comb_finish(a, layer, dry, row, lane, wa);
        if (two) comb_finish(a, layer, dry, row1, lane, wb);
    }
}

enum { PH_PREP = 0, PH_S5, PH_GLU, PH_ROUTE, PH_G1, PH_G2, PH_COMB, PH_KVQ, PH_ATT, PH_OPROJ, PH_QG };
constexpr int NPH = 27;
__constant__ int c_prog[NPH][2] = {
    {PH_PREP, 0},
    {PH_S5, 0}, {PH_GLU, 0}, {PH_ROUTE, 0}, {PH_G1, 0}, {PH_G2, 0}, {PH_COMB, 0},
    {PH_S5, 1}, {PH_GLU, 1}, {PH_ROUTE, 1}, {PH_G1, 1}, {PH_G2, 1}, {PH_COMB, 1},
    {PH_KVQ, 2}, {PH_ATT, 2}, {PH_OPROJ, 2}, {PH_ROUTE, 2}, {PH_G1, 2}, {PH_G2, 2}, {PH_COMB, 2},
    {PH_QG, 3}, {PH_ATT, 3}, {PH_OPROJ, 3}, {PH_ROUTE, 3}, {PH_G1, 3}, {PH_G2, 3}, {PH_COMB, 3},
};

__global__ void __launch_bounds__(NTHREADS) yoco_fwd(Args a) {
    extern __shared__ __attribute__((aligned(16))) unsigned char smem_raw[];
    LAS unsigned char* lds = (LAS unsigned char*)smem_raw;
    volatile LAS unsigned* const st = (volatile LAS unsigned*)(lds + LDS_BYTES - 64);
    if (threadIdx.x < 16) st[threadIdx.x] = 0u;
    __syncthreads();
    if (a.ph_hi - a.ph_lo > 1) xcd_barrier_post((unsigned*)(a.ws + WS_CTL) + CW_BAR);
    CArgs* const kp = (CArgs*)__builtin_amdgcn_kernarg_segment_ptr();
#if defined(PROBE_TMASK)
    unsigned long long t_acc = 0ull;
#endif
    for (int ph = a.ph_lo; ph < a.ph_hi; ++ph) {
        const int type = c_prog[ph][0], layer = c_prog[ph][1];
#if defined(PROBE_TMASK)
        const unsigned long long t_ph0 = __builtin_amdgcn_s_memrealtime();
#endif
        const int reps = type == a.rep_type ? a.rep_n : 0;
        for (int r = 0; r <= reps; ++r) {
            const bool dry = r > 0;
            CArgs* lp = kp; asm volatile("" : "+s"(lp));
            CArgs& la = *lp;
            GemmDesc g; g.f8 = 0; g.arow = D * 2; bool is_gemm = true; int conv_budget = 0, conv_limit = 0;
            BgConv bg{lp, st};
            switch (type) {
                case PH_GLU: phase_glu(la, layer, dry, lds, g); break;
                case PH_G1: if (phase_moe1(la, layer, lds, g)) { conv_budget = 18; conv_limit = (layer + 2) * 32 * NWT_E; } break;
                case PH_G2: if (phase_moe2(la, layer, lds, g)) { conv_budget = 12; conv_limit = (layer + 3) * 32 * NWT_E; } break;
                case PH_KVQ: case PH_QG: phase_kvq_q(la, type == PH_QG ? 1 : 0, lds, g); break;
                case PH_OPROJ: phase_oproj(la, layer - 2, dry, lds, g); break;
                default: is_gemm = false; break;
            }
            g.skip_epi = 0;
#if defined(PROBE_SKIPEPI)
            if (dry) g.skip_epi = 1;
#endif
            if (is_gemm) { if (g.f8) gemm_run<true>(lds, g); else gemm_run<false>(lds, g); if (conv_budget) bg.run_until(conv_limit < NWT_MOE ? conv_limit : NWT_MOE, conv_budget); }
            else switch (type) {
                case PH_PREP: phase_prep(la, lds); break;
                case PH_S5: phase_s5(la, layer, lds); break;
                case PH_ROUTE: phase_route(la, layer, dry, lds); break;
                case PH_COMB: phase_combine(la, layer, dry); break;
                default: phase_attn(la, layer - 2, lds); break;
            }
            if (type == PH_ROUTE && !dry) { bg.run_until((layer + 1) * 32 * NWT_E, 1 << 20); bg.drain_others((layer + 1) * 32 * NWT_E); }
            if (r < reps || ph + 1 < a.ph_hi) { if (a.ph_hi - a.ph_lo > 1) xcd_barrier((unsigned*)(la.ws + WS_CTL) + CW_BAR, st, bg); }
        }
#if defined(PROBE_TMASK)
        if ((PROBE_TMASK >> type) & 1) t_acc += __builtin_amdgcn_s_memrealtime() - t_ph0;
#endif
        if (a.rep_type == 100 && ph + 1 < a.ph_hi) for (int r = 0; r < a.rep_n; ++r) { BgConv bg{kp, st}; xcd_barrier((unsigned*)(a.ws + WS_CTL) + CW_BAR, st, bg); }
    }
#if defined(PROBE_TMASK)
    if (blockIdx.x == 0) { const unsigned long long t0 = __builtin_amdgcn_s_memrealtime(); while (__builtin_amdgcn_s_memrealtime() - t0 < 8ull * t_acc) __builtin_amdgcn_s_sleep(32); }
#endif
}

extern "C" void kernel_launch(void* const* d_in, const int* in_sizes, int n_in, void* d_out, int out_size, void* d_ws, size_t ws_size, hipStream_t stream) {
    static int ready = 0;
    if (ready == 0) {
        if (n_in != 29 || ws_size < WS_END) { fprintf(stderr, "kernel_launch: expected 29 inputs and >= %zu bytes of workspace (got %d, %zu)\n", (size_t)WS_END, n_in, ws_size); ready = -1; return; }
        if (hipFuncSetAttribute((const void*)yoco_fwd, hipFuncAttributeMaxDynamicSharedMemorySize, LDS_BYTES) != hipSuccess) { fprintf(stderr, "kernel_launch: hipFuncSetAttribute failed\n"); ready = -1; return; }
        ready = 1;
    }
    if (ready < 0) return;
    (void)hipMemsetAsync((char*)d_ws + WS_CTL, 0, CTL_BYTES, stream);
    Args a{};
    for (int i = 0; i < 29; ++i) a.in[i] = (const float*)d_in[i];
    a.out = (float*)d_out; a.ws = (unsigned char*)d_ws;
#if defined(PROBE_TYPE)
    a.rep_type = PROBE_TYPE; a.rep_n = PROBE_N;
#else
    a.rep_type = -1; a.rep_n = 0;
#endif
#if MK_N_LAUNCHES == 1
    a.ph_lo = 0; a.ph_hi = NPH;
    hipLaunchKernelGGL(yoco_fwd, dim3(GRID), dim3(NTHREADS), LDS_BYTES, stream, a);
#else
    for (int ph = 0; ph < NPH; ++ph) { a.ph_lo = ph; a.ph_hi = ph + 1; hipLaunchKernelGGL(yoco_fwd, dim3(GRID), dim3(NTHREADS), LDS_BYTES, stream, a); }
#endif
}
```
